# Optimizing an MI355X kernel written in HIP

```python
import jax, jax.numpy as jnp
from jax import lax
import numpy as np

D_MODEL = 1024
BATCH = 16
SEQ = 2048
DEPTH = 2

MLA_HEADS = 6
MLA_NOPE = 64
MLA_ROPE = 32
MLA_V = 64
MLA_Q_RANK = 256
MLA_KV_RANK = 128
ATTN_Q_BLOCK = 128
RET_HEADS = 5
RET_DK = 64
RET_DV = 64
RET_CHUNK = 128
MOBA_HEADS = 5
MOBA_DH = 64
MOBA_BLOCK = 256
MOBA_TOPK = 3
MOBA_Q_CHUNK = 64
ROPE_THETA = 10000.0
LN_EPS = 1e-5
RMS_EPS = 1e-6
D_FF = 2816
N_EXPERTS = 8
TOP_K = 2
D_FF_EXPERT = 3584
DN_ALPHA = (2 * DEPTH) ** 0.25
DN_BETA = (8 * DEPTH) ** -0.25

W_MLA_OUT = MLA_HEADS * MLA_V
W_RET_OUT = RET_HEADS * RET_DV
W_MOBA_OUT = MOBA_HEADS * MOBA_DH
MIX_WIDTH = W_MLA_OUT + W_RET_OUT + W_MOBA_OUT
IN_SIZES = (MLA_Q_RANK, MLA_KV_RANK, MLA_ROPE,
            RET_HEADS * RET_DK, RET_HEADS * RET_DK, RET_HEADS * RET_DV, RET_HEADS * RET_DV,
            MOBA_HEADS * MOBA_DH, MOBA_HEADS * MOBA_DH, MOBA_HEADS * MOBA_DH)
D_IN = sum(IN_SIZES)
N_DENSE = (DEPTH + 1) // 2
N_MOE = DEPTH // 2

kernel_name = "hymba_mla_retnet_moba_deepnorm_moe"


def layer_norm(x, g, b):
    xf = x.astype(jnp.float32)
    mu = jnp.mean(xf, -1, keepdims=True)
    var = jnp.mean(jnp.square(xf - mu), -1, keepdims=True)
    return ((xf - mu) * lax.rsqrt(var + LN_EPS) * g.astype(jnp.float32) + b.astype(jnp.float32)).astype(x.dtype)


def rms_norm(x, g):
    xf = x.astype(jnp.float32)
    y = xf * lax.rsqrt(jnp.mean(jnp.square(xf), -1, keepdims=True) + RMS_EPS)
    return (y * g.astype(jnp.float32)).astype(x.dtype)


def rope_tables(n_pos, dim):
    pos = jnp.arange(n_pos, dtype=jnp.float32)
    inv = ROPE_THETA ** (-jnp.arange(0, dim, 2, dtype=jnp.float32) / dim)
    ang = pos[:, None] * inv[None, :]
    return jnp.cos(ang), jnp.sin(ang)


def apply_rope(x, cos, sin):
    shp = (1, cos.shape[0]) + (1,) * (x.ndim - 3) + (cos.shape[1],)
    c = cos.reshape(shp).astype(x.dtype)
    s = sin.reshape(shp).astype(x.dtype)
    x1, x2 = jnp.split(x, 2, axis=-1)
    return jnp.concatenate([x1 * c - x2 * s, x1 * s + x2 * c], axis=-1)


def mla_attention(c_q, c_kv, k_rope, q_norm_g, kv_norm_g, w_uq, w_ukv, cos, sin):
    B, S, _ = c_q.shape
    H, QB = MLA_HEADS, ATTN_Q_BLOCK
    q = (rms_norm(c_q, q_norm_g) @ w_uq).reshape(B, S, H, MLA_NOPE + MLA_ROPE)
    q_nope = q[..., :MLA_NOPE]
    q_pe = apply_rope(q[..., MLA_NOPE:], cos, sin)
    kv = (rms_norm(c_kv, kv_norm_g) @ w_ukv).reshape(B, S, H, MLA_NOPE + MLA_V)
    k_nope, v = kv[..., :MLA_NOPE], kv[..., MLA_NOPE:]
    k_pe = apply_rope(k_rope, cos, sin)
    scale = (MLA_NOPE + MLA_ROPE) ** -0.5
    nq = S // QB
    qn_blocks = q_nope.reshape(B, nq, QB, H, MLA_NOPE).transpose(1, 0, 2, 3, 4)
    qp_blocks = q_pe.reshape(B, nq, QB, H, MLA_ROPE).transpose(1, 0, 2, 3, 4)
    k_pos = jnp.arange(S)

    def block(args):
        qn, qp, start = args
        s = (jnp.einsum('bqhd,bkhd->bhqk', qn, k_nope)
             + jnp.einsum('bqhd,bkd->bhqk', qp, k_pe)).astype(jnp.float32) * scale
        q_pos = start + jnp.arange(QB)
        s = jnp.where(k_pos[None, :] <= q_pos[:, None], s, -jnp.inf)
        p = jax.nn.softmax(s, axis=-1).astype(v.dtype)
        return jnp.einsum('bhqk,bkhd->bqhd', p, v)

    o = lax.map(block, (qn_blocks, qp_blocks, jnp.arange(nq) * QB))
    return o.transpose(1, 0, 2, 3, 4).reshape(B, S, W_MLA_OUT)


def retention(q, k, v, g, cos, sin):
    B, S, _ = q.shape
    H, C = RET_HEADS, RET_CHUNK
    nc = S // C
    f32 = jnp.float32
    q = apply_rope(q.reshape(B, S, H, RET_DK), cos, sin)
    k = apply_rope(k.reshape(B, S, H, RET_DK), cos, sin) * (RET_DK ** -0.5)
    v = v.reshape(B, S, H, RET_DV)
    log_gamma = jnp.log(1.0 - 2.0 ** (-5.0 - jnp.arange(H, dtype=f32)))
    qc = q.reshape(B, nc, C, H, RET_DK)
    kc = k.reshape(B, nc, C, H, RET_DK)
    vc = v.reshape(B, nc, C, H, RET_DV)
    idx = jnp.arange(C, dtype=f32)
    diff = idx[:, None] - idx[None, :]
    decay_in = jnp.where(diff >= 0, jnp.exp(log_gamma[:, None, None] * jnp.maximum(diff, 0.0)), 0.0)
    intra = jnp.einsum('bnihd,bnjhd->bnhij', qc, kc).astype(f32) * decay_in
    o_intra = jnp.einsum('bnhij,bnjhe->bnihe', intra.astype(v.dtype), vc).astype(f32)
    k_decay = jnp.exp(log_gamma[:, None] * (C - 1.0 - idx))
    kv = jnp.einsum('bnjhd,hj,bnjhe->nbhde', kc.astype(f32), k_decay, vc.astype(f32))
    chunk_decay = jnp.exp(log_gamma * C)[None, :, None, None]

    def step(R, kv_n):
        return R * chunk_decay + kv_n, R

    _, R_prev = lax.scan(step, jnp.zeros((B, H, RET_DK, RET_DV), f32), kv)
    q_decay = jnp.exp(log_gamma[:, None] * (idx + 1.0))
    o_cross = jnp.einsum('bnihd,nbhde,hi->bnihe', qc.astype(f32), R_prev, q_decay)
    o = (o_intra + o_cross).reshape(B, S, H, RET_DV)
    mu = jnp.mean(o, -1, keepdims=True)
    var = jnp.mean(jnp.square(o - mu), -1, keepdims=True)
    o = ((o - mu) * lax.rsqrt(var + RMS_EPS)).reshape(B, S, W_RET_OUT)
    return (jax.nn.silu(g.astype(f32)) * o).astype(q.dtype)


def moba_attention(q, k, v):
    B, S, _ = q.shape
    H, dh, BLK, QC = MOBA_HEADS, MOBA_DH, MOBA_BLOCK, MOBA_Q_CHUNK
    f32 = jnp.float32
    nb = -(-S // BLK)
    Sp = nb * BLK
    pad = Sp - S

    def heads(t):
        t = jnp.pad(t.reshape(B, S, H, dh), ((0, 0), (0, pad), (0, 0), (0, 0)))
        return t.transpose(0, 2, 1, 3)

    q, k, v = heads(q), heads(k), heads(v)
    k_blk = k.reshape(B, H, nb, BLK, dh)
    v_blk = v.reshape(B, H, nb, BLK, dh)
    k_mean = jnp.mean(k_blk.astype(f32), axis=3)
    slopes = 2.0 ** (-8.0 * (jnp.arange(H, dtype=f32) + 1.0) / H)
    n_sel = min(MOBA_TOPK, nb - 1)
    scale = dh ** -0.5
    nqc = Sp // QC
    q_chunks = q.reshape(B, H, nqc, QC, dh).transpose(2, 0, 1, 3, 4)
    bi = jnp.arange(B)[:, None, None, None]
    hi = jnp.arange(H)[None, :, None, None]
    blk_off = jnp.arange(BLK)

    def chunk(args):
        qc, start = args
        blk = start // BLK
        q_pos = start + jnp.arange(QC)
        k_own = lax.dynamic_index_in_dim(k_blk, blk, axis=2, keepdims=False)
        v_own = lax.dynamic_index_in_dim(v_blk, blk, axis=2, keepdims=False)
        own_pos = blk * BLK + blk_off
        s_own = (jnp.einsum('bhqd,bhkd->bhqk', qc, k_own).astype(f32) * scale
                 - slopes[:, None, None] * (q_pos[:, None] - own_pos[None, :]).astype(f32))
        s_own = jnp.where(own_pos[None, :] <= q_pos[:, None], s_own, -jnp.inf)
        if n_sel == 0:
            p = jax.nn.softmax(s_own, axis=-1).astype(v.dtype)
            return jnp.einsum('bhqk,bhkd->bhqd', p, v_own)
        gate = jnp.einsum('bhqd,bhnd->bhqn', qc.astype(f32), k_mean)
        gate = jnp.where(jnp.arange(nb) < blk, gate, -jnp.inf)
        _, sel = lax.top_k(gate, n_sel)
        k_sel = k_blk[bi, hi, sel]
        v_sel = v_blk[bi, hi, sel]
        sel_pos = sel[..., None] * BLK + blk_off
        s_sel = (jnp.einsum('bhqd,bhqnkd->bhqnk', qc, k_sel).astype(f32) * scale
                 - slopes[:, None, None, None] * (q_pos[:, None, None] - sel_pos).astype(f32))
        slot_ok = jnp.arange(n_sel) < blk
        s_sel = jnp.where(slot_ok[:, None], s_sel, -jnp.inf)
        s_all = jnp.concatenate([s_sel.reshape(B, H, QC, n_sel * BLK), s_own], axis=-1)
        p = jax.nn.softmax(s_all, axis=-1).astype(v.dtype)
        p_sel = p[..., :n_sel * BLK].reshape(B, H, QC, n_sel, BLK)
        return (jnp.einsum('bhqnk,bhqnkd->bhqd', p_sel, v_sel)
                + jnp.einsum('bhqk,bhkd->bhqd', p[..., n_sel * BLK:], v_own))

    o = lax.map(chunk, (q_chunks, jnp.arange(nqc) * QC))
    o = o.transpose(1, 0, 3, 2, 4).reshape(B, Sp, W_MOBA_OUT)
    return o[:, :S]


def hybrid_mixer(x, w_in, q_norm_g, kv_norm_g, w_uq, w_ukv, beta_mla, beta_moba, w_o,
                 cos_a, sin_a, cos_b, sin_b):
    h = x @ w_in
    splits = [int(s) for s in np.cumsum(IN_SIZES)[:-1]]
    c_q, c_kv, k_rope, rq, rk, rv, rg, mq, mk, mv = jnp.split(h, splits, axis=-1)
    o_a = rms_norm(mla_attention(c_q, c_kv, k_rope, q_norm_g, kv_norm_g, w_uq, w_ukv, cos_a, sin_a), beta_mla)
    o_b = retention(rq, rk, rv, rg, cos_b, sin_b)
    o_c = rms_norm(moba_attention(mq, mk, mv), beta_moba)
    return jnp.concatenate([o_a, o_b, o_c], axis=-1) @ w_o


def swiglu(x, w_gate, w_up, w_down):
    return (jax.nn.silu(x @ w_gate) * (x @ w_up)) @ w_down


def moe_swiglu(x, w_router, w_gate, w_up, w_down):
    B, S, D = x.shape
    xt = x.reshape(B * S, D)
    logits = (xt @ w_router).astype(jnp.float32)
    top_v, top_i = lax.top_k(logits, TOP_K)
    top_w = jax.nn.softmax(top_v, axis=-1)
    gates = jnp.sum(jax.nn.one_hot(top_i, N_EXPERTS, dtype=jnp.float32) * top_w[..., None], axis=1)
    y = jnp.zeros((B * S, D), jnp.float32)
    for e in range(N_EXPERTS):
        y = y + gates[:, e:e + 1] * swiglu(xt, w_gate[e], w_up[e], w_down[e]).astype(jnp.float32)
    return y.astype(x.dtype).reshape(B, S, D)


def setup_inputs(seed: int = 0) -> dict:
    key = jax.random.key(seed)
    ks = jax.random.split(key, 24)
    f32 = jnp.float32
    nrm = lambda k, shp, s: jax.random.normal(k, shp, f32) * s
    x = jax.random.normal(ks[0], (BATCH, SEQ, D_MODEL), f32)
    col_scale = jnp.concatenate([
        jnp.full((s,), DN_BETA if i in (5, 9) else 1.0, f32) for i, s in enumerate(IN_SIZES)])
    w_in = nrm(ks[1], (DEPTH, D_MODEL, D_IN), D_MODEL ** -0.5) * col_scale
    ukv_scale = jnp.tile(jnp.concatenate([jnp.ones((MLA_NOPE,), f32), jnp.full((MLA_V,), DN_BETA, f32)]), MLA_HEADS)
    return {
        "x": x,
        "ln_emb_g": 1.0 + nrm(ks[2], (D_MODEL,), 0.02),
        "ln_emb_b": nrm(ks[3], (D_MODEL,), 0.02),
        "w_in": w_in,
        "q_norm_g": 1.0 + nrm(ks[4], (DEPTH, MLA_Q_RANK), 0.02),
        "kv_norm_g": 1.0 + nrm(ks[5], (DEPTH, MLA_KV_RANK), 0.02),
        "w_uq": nrm(ks[6], (DEPTH, MLA_Q_RANK, MLA_HEADS * (MLA_NOPE + MLA_ROPE)), MLA_Q_RANK ** -0.5),
        "w_ukv": nrm(ks[7], (DEPTH, MLA_KV_RANK, MLA_HEADS * (MLA_NOPE + MLA_V)), MLA_KV_RANK ** -0.5) * ukv_scale,
        "beta_mla": 1.0 + nrm(ks[8], (DEPTH, W_MLA_OUT), 0.02),
        "beta_moba": 1.0 + nrm(ks[9], (DEPTH, W_MOBA_OUT), 0.02),
        "w_o": nrm(ks[10], (DEPTH, MIX_WIDTH, D_MODEL), MIX_WIDTH ** -0.5 * DN_BETA),
        "ln1_g": 1.0 + nrm(ks[11], (DEPTH, D_MODEL), 0.02),
        "ln1_b": nrm(ks[12], (DEPTH, D_MODEL), 0.02),
        "ffn_w_gate": nrm(ks[13], (N_DENSE, D_MODEL, D_FF), D_MODEL ** -0.5 * DN_BETA),
        "ffn_w_up": nrm(ks[14], (N_DENSE, D_MODEL, D_FF), D_MODEL ** -0.5 * DN_BETA),
        "ffn_w_down": nrm(ks[15], (N_DENSE, D_FF, D_MODEL), D_FF ** -0.5 * DN_BETA),
        "router": nrm(ks[16], (N_MOE, D_MODEL, N_EXPERTS), D_MODEL ** -0.5),
        "exp_w_gate": nrm(ks[17], (N_MOE, N_EXPERTS, D_MODEL, D_FF_EXPERT), D_MODEL ** -0.5 * DN_BETA),
        "exp_w_up": nrm(ks[18], (N_MOE, N_EXPERTS, D_MODEL, D_FF_EXPERT), D_MODEL ** -0.5 * DN_BETA),
        "exp_w_down": nrm(ks[19], (N_MOE, N_EXPERTS, D_FF_EXPERT, D_MODEL), D_FF_EXPERT ** -0.5 * DN_BETA),
        "ln2_g": 1.0 + nrm(ks[20], (DEPTH, D_MODEL), 0.02),
        "ln2_b": nrm(ks[21], (DEPTH, D_MODEL), 0.02),
    }


def reference(x, ln_emb_g, ln_emb_b, w_in, q_norm_g, kv_norm_g, w_uq, w_ukv, beta_mla, beta_moba,
              w_o, ln1_g, ln1_b, ffn_w_gate, ffn_w_up, ffn_w_down, router, exp_w_gate, exp_w_up,
              exp_w_down, ln2_g, ln2_b):
    S = x.shape[1]
    cos_a, sin_a = rope_tables(S, MLA_ROPE)
    cos_b, sin_b = rope_tables(S, RET_DK)
    x = layer_norm(x, ln_emb_g, ln_emb_b)
    for l in range(DEPTH):
        mix = hybrid_mixer(x, w_in[l], q_norm_g[l], kv_norm_g[l], w_uq[l], w_ukv[l],
                           beta_mla[l], beta_moba[l], w_o[l], cos_a, sin_a, cos_b, sin_b)
        x = layer_norm(DN_ALPHA * x + mix, ln1_g[l], ln1_b[l])
        if l % 2 == 0:
            j = l // 2
            f = swiglu(x, ffn_w_gate[j], ffn_w_up[j], ffn_w_down[j])
        else:
            j = l // 2
            f = moe_swiglu(x, router[j], exp_w_gate[j], exp_w_up[j], exp_w_down[j])
        x = layer_norm(DN_ALPHA * x + f, ln2_g[l], ln2_b[l])
    return x
```

```cpp
#include <hip/hip_runtime.h>
#include <cstdio>
#include <cstdint>
#include <cmath>

#ifndef MK_ONE_LAUNCH
#define MK_ONE_LAUNCH 0
#endif

#define LAS __attribute__((address_space(3)))
#define GAS __attribute__((address_space(1)))
typedef _Float16 f16;
typedef _Float16 f16x2 __attribute__((ext_vector_type(2)));
typedef _Float16 f16x4 __attribute__((ext_vector_type(4)));
typedef _Float16 f16x8 __attribute__((ext_vector_type(8)));
typedef float f32x2 __attribute__((ext_vector_type(2)));
typedef float f32x4 __attribute__((ext_vector_type(4)));
typedef unsigned u32x2 __attribute__((ext_vector_type(2)));
typedef unsigned u32x4 __attribute__((ext_vector_type(4)));
typedef GAS unsigned gu32;

constexpr int BATCH = 16, SEQ = 2048, T = BATCH * SEQ, D = 1024;
constexpr int HW = 2816;
constexpr int HC_CQ = 0, HC_CKV = 256, HC_KR = 384, HC_RQ = 416, HC_RK = 736, HC_RV = 1056, HC_RG = 1376, HC_MQ = 1696, HC_MK = 2016, HC_MV = 2336, HC_END = 2656;
constexpr int QW = 768, KVW = 768;
constexpr int OC_RET = 384, OC_MOBA = 704;
constexpr int FF = 2816, FE = 3584, NE = 8;
constexpr float LN_EPS = 1e-5f, RMS_EPS = 1e-6f;
constexpr float DN_ALPHA = 1.41421356237f;
constexpr float LOG2E = 1.4426950408889634f;
constexpr int MOE_CHUNK = 64, MOE_NCHUNK = 5, MOE_MAXP = 264;

constexpr size_t MiB = 1u << 20;
constexpr size_t WS_CTL = 0, CTL_ZERO_BYTES = 256 * 1024;
constexpr size_t WS_ROPE = 256 * 1024;
constexpr size_t WS_SSQ_Q = 1 * MiB;
constexpr size_t WS_SSQ_KV = WS_SSQ_Q + (size_t)T * 16;
constexpr size_t WS_SSQ_O = 2 * MiB;
constexpr size_t WS_KMEAN = 4 * MiB;
constexpr size_t WS_TOPI = WS_KMEAN + 256 * 1024;
constexpr size_t WS_TOPW = WS_TOPI + (size_t)T * 8;
constexpr size_t WS_CNT = WS_TOPW + (size_t)T * 8;
constexpr size_t WS_ROWTOK = WS_CNT + 8192;
constexpr size_t WS_ROWW = WS_ROWTOK + (size_t)MOE_MAXP * 256 * 4;
constexpr size_t WS_PANE = WS_ROWW + (size_t)MOE_MAXP * 256 * 4;
constexpr size_t WS_WIN = 6 * MiB;
constexpr size_t WS_WUQ = 17 * MiB;
constexpr size_t WS_WUKV = 18 * MiB;
constexpr size_t WS_WO = 19 * MiB;
constexpr size_t WS_WGU = 23 * MiB;
constexpr size_t WS_WDN = 34 * MiB;
constexpr size_t WS_EGU = 40 * MiB;
constexpr size_t WS_EDN = 152 * MiB;
constexpr size_t WS_XB = 208 * MiB;
constexpr size_t WS_H = 272 * MiB;
constexpr size_t WS_O = 448 * MiB;
constexpr size_t WS_END = 512 * MiB;
static_assert(WS_PANE + (MOE_MAXP + 8) * 4 <= WS_WIN, "ws map");

constexpr int CW_TMO = 0, CW_BAR = 1024;

constexpr int RING_BYTES = 131072;
constexpr int MISC_OFF = RING_BYTES;
constexpr int LDS_BYTES = 147456;

__device__ __forceinline__ unsigned pk_f16(float lo, float hi) { f16x2 v = {(f16)lo, (f16)hi}; return __builtin_bit_cast(unsigned, v); }
template <int X> __device__ __forceinline__ float swz_xor(float v) { return __int_as_float(__builtin_amdgcn_ds_swizzle(__float_as_int(v), (X << 10) | 0x1f)); }
__device__ __forceinline__ float wave_sum(float v) {
    v += swz_xor<1>(v); v += swz_xor<2>(v); v += swz_xor<4>(v); v += swz_xor<8>(v); v += swz_xor<16>(v);
    const auto rr = __builtin_amdgcn_permlane32_swap(__float_as_uint(v), __float_as_uint(v), false, false);
    return __uint_as_float(rr[0]) + __uint_as_float(rr[1]);
}
__device__ __forceinline__ float silu_f(float x) { return x * __builtin_amdgcn_rcpf(1.f + __expf(-x)); }

#define XB_TMO      128
#define XB_XCNT(j)  (256  + 64 * (j))
#define XB_XSUB(j)  (1280 + 64 * (j))
#define XB_XGEN(j)  (2304 + 64 * (j))
#define XB_TOP      3328
#define XB_TOPGEN   3392
#define XCD_BAR_WORDS 3456
#define XB_SPIN_CAP (1u << 18)
__device__ __forceinline__ unsigned xb_ld(unsigned* p)              { return __hip_atomic_load(p, __ATOMIC_RELAXED, __HIP_MEMORY_SCOPE_AGENT); }
__device__ __forceinline__ unsigned xb_add(unsigned* p, unsigned v) { return __hip_atomic_fetch_add(p, v, __ATOMIC_RELAXED, __HIP_MEMORY_SCOPE_AGENT); }
__device__ __forceinline__ unsigned xb_xcc_id() { return (unsigned)__builtin_amdgcn_s_getreg((3 << 11) | 20) & 0xFu; }
#define XB_SPIN(cond, bar) do { unsigned _sp = 0; while (cond) { __builtin_amdgcn_s_sleep(1); \
    if ((++_sp & 255u) == 0u) { if (xb_ld(&(bar)[XB_TMO])) break; if (_sp > XB_SPIN_CAP) { atomicAdd(&(bar)[XB_TMO], 1u); break; } } } } while (0)
struct XcdBarrier { unsigned* bar; unsigned x; volatile LAS unsigned* st; };
__device__ __forceinline__ XcdBarrier xcd_barrier_post(unsigned* bar, volatile LAS unsigned* st) {
    XcdBarrier b; b.bar = bar; b.x = xb_xcc_id(); b.st = st;
    if (threadIdx.x == 0) (void)xb_add(&bar[XB_XCNT(b.x)], 1u);
    return b;
}
__device__ __forceinline__ void xcd_barrier_complete(unsigned* bar, unsigned x, unsigned& nloc, unsigned& nx) {
    const unsigned G = gridDim.x * gridDim.y * gridDim.z;
    unsigned sum, cnt, mine, sp = 0u;
    for (;;) {
        sum = 0u; cnt = 0u; mine = 0u;
#pragma unroll
        for (unsigned j = 0; j < 16; ++j) { const unsigned c = xb_ld(&bar[XB_XCNT(j)]); sum += c; cnt += (c > 0u) ? 1u : 0u; mine = (j == x) ? c : mine; }
        if (sum == G) break;
        __builtin_amdgcn_s_sleep(1);
        if ((++sp & 255u) == 0u) { if (xb_ld(&bar[XB_TMO])) break; if (sp > XB_SPIN_CAP) { atomicAdd(&bar[XB_TMO], 1u); break; } }
    }
    nloc = mine > 0u ? mine : 1u; nx = cnt > 0u ? cnt : 1u;
}
__device__ __forceinline__ void xcd_barrier(const XcdBarrier& b) {
    asm volatile("s_waitcnt vmcnt(0)" ::: "memory");
    __syncthreads();
    if (threadIdx.x == 0) {
        unsigned* bar = b.bar;
        __builtin_amdgcn_s_waitcnt(0);
        unsigned nloc = b.st[0], nx = b.st[1];
        if (nloc == 0u) { xcd_barrier_complete(bar, b.x, nloc, nx); b.st[0] = nloc; b.st[1] = nx; }
        const unsigned old = xb_add(&bar[XB_XSUB(b.x)], 1u);
        const unsigned gen = old / nloc;
        if (old + 1u == (gen + 1u) * nloc) {
            __builtin_amdgcn_fence(__ATOMIC_RELEASE, "agent");
            asm volatile("s_waitcnt vmcnt(0)" ::: "memory");
            const unsigned og = xb_add(&bar[XB_TOP], 1u);
            const unsigned tg = og / nx;
            if (og + 1u == (tg + 1u) * nx) xb_add(&bar[XB_TOPGEN], 1u);
            else XB_SPIN(xb_ld(&bar[XB_TOPGEN]) == tg, bar);
            __builtin_amdgcn_fence(__ATOMIC_ACQUIRE, "agent");
            xb_add(&bar[XB_XGEN(b.x)], 1u);
            asm volatile("s_waitcnt vmcnt(0)" ::: "memory");
        } else {
            XB_SPIN(xb_ld(&bar[XB_XGEN(b.x)]) == gen, bar);
            __builtin_amdgcn_fence(__ATOMIC_ACQUIRE, "agent");
            asm volatile("s_waitcnt vmcnt(0)" ::: "memory");
        }
    }
    __syncthreads();
}

namespace pg8 {
constexpr int BM = 256, BK = 64, HALF = 128, HTB = HALF * BK * 2, STAGE_BYTES = 8 * HTB, NXCD = 8, WGM = 8;
__host__ __device__ __forceinline__ int lds_byte(int r, int c) { const int st = (r >> 4) * 2 + (c >> 5), rr = r & 15, cc = c & 31, ob = rr * 64 + cc * 2; return st * 1024 + (ob ^ (((ob >> 9) & 1) << 5)); }
__host__ __device__ __forceinline__ void stage_rc(int b, int& R, int& C) { const int st = b / 1024, sb = b % 1024, swz = sb ^ (((sb >> 9) & 1) << 5); R = (st >> 1) * 16 + swz / 64; C = (st & 1) * 32 + (swz % 64) / 2; }
__host__ __device__ __forceinline__ int perm32(int rho) { const int n = rho >> 4, i = rho & 15; return 8 * (i >> 2) + 4 * n + (i & 3); }

struct Unit { int pm, pn; };
struct Gemm { const f16* A; int lda; const f16* Bt; int ldb; int K; };

struct StaticOrder {
    static constexpr bool GATHER = false;
    int nM, nN, nwg, G, c, pm0;
    __device__ void init(int nM_, int nN_, int G_, int c_, int pm0_ = 0) { nM = nM_; nN = nN_; nwg = nM * nN; G = G_; c = c_; pm0 = pm0_; }
    __device__ bool next(int i, Unit& u) const {
        const long L = (long)i * G + c; if (L >= nwg) return false;
        int wgid = (int)L; { const int q = nwg / NXCD, r = nwg % NXCD, xcd = wgid % NXCD, off = wgid / NXCD; wgid = (xcd < r ? xcd * (q + 1) : r * (q + 1) + (xcd - r) * q) + off; }
        const int nig = WGM * nN, gid = wgid / nig, fm = gid * WGM, gsz = (nM - fm) < WGM ? (nM - fm) : WGM;
        u.pm = pm0 + fm + ((wgid % nig) % gsz); u.pn = (wgid % nig) / gsz; return true;
    }
    __device__ __forceinline__ int a_row(const Unit& u, int r) const { return u.pm * BM + r; }
    __device__ __forceinline__ size_t b_base(const Unit&) const { return 0; }
};
struct MoeGather {
    static constexpr bool GATHER = true;
    StaticOrder so; const int* rowtok; const int* pane; size_t estride;
    __device__ bool next(int i, Unit& u) const { return so.next(i, u); }
    __device__ __forceinline__ int a_row(const Unit& u, int r) const { const int t = rowtok[u.pm * BM + r]; return t < 0 ? 0 : (t >> 1); }
    __device__ __forceinline__ size_t b_base(const Unit& u) const { return (size_t)pane[u.pm] * estride; }
};
struct MoeDense {
    static constexpr bool GATHER = false;
    StaticOrder so; const int* pane; size_t estride; int arow0;
    __device__ bool next(int i, Unit& u) const { return so.next(i, u); }
    __device__ __forceinline__ int a_row(const Unit& u, int r) const { return (u.pm - arow0) * BM + r; }
    __device__ __forceinline__ size_t b_base(const Unit& u) const { return (size_t)pane[u.pm] * estride; }
};

struct EpiF16 {
    static constexpr bool PERM = true;
    f16* O; int ldc;
    __device__ __forceinline__ void operator()(const f32x4 (&acc)[2][2][4][2], const Unit& u, int wr, int wc, int fr, int fq) const {
        const int row0 = u.pm * BM + wr * 64 + fr, col0 = u.pn * BM + wc * 32 + 8 * fq;
#pragma unroll
        for (int ai = 0; ai < 2; ++ai)
#pragma unroll
            for (int m = 0; m < 4; ++m) { f16* rowp = O + (size_t)(row0 + ai * HALF + m * 16) * ldc + col0;
#pragma unroll
                for (int bj = 0; bj < 2; ++bj) { const f32x4 v0 = acc[ai][bj][m][0], v1 = acc[ai][bj][m][1];
                    u32x4 w; w.x = pk_f16(v0[0], v0[1]); w.y = pk_f16(v0[2], v0[3]); w.z = pk_f16(v1[0], v1[1]); w.w = pk_f16(v1[2], v1[3]);
                    *(u32x4*)(rowp + bj * HALF) = w; } }
    }
};
struct EpiResF32 {
    static constexpr bool PERM = false;
    const f16* X; float* Y; int ldc; float alpha;
    __device__ __forceinline__ void operator()(const f32x4 (&acc)[2][2][4][2], const Unit& u, int wr, int wc, int fr, int fq) const {
        const int row0 = u.pm * BM + wr * 64 + fr, col0 = u.pn * BM + wc * 32 + 4 * fq;
#pragma unroll
        for (int ai = 0; ai < 2; ++ai)
#pragma unroll
            for (int m = 0; m < 4; ++m) { const size_t off = (size_t)(row0 + ai * HALF + m * 16) * ldc + col0;
#pragma unroll
                for (int bj = 0; bj < 2; ++bj)
#pragma unroll
                    for (int n = 0; n < 2; ++n) { const f16x4 xv = *(const f16x4*)(X + off + bj * HALF + n * 16); const f32x4 a = acc[ai][bj][m][n];
                        f32x4 o; o[0] = alpha * (float)xv[0] + a[0]; o[1] = alpha * (float)xv[1] + a[1]; o[2] = alpha * (float)xv[2] + a[2]; o[3] = alpha * (float)xv[3] + a[3];
                        *(f32x4*)(Y + off + bj * HALF + n * 16) = o; } }
    }
};
struct EpiSwiGLU {
    static constexpr bool PERM = true;
    f16* O; int ldc; int pm0;
    __device__ __forceinline__ void operator()(const f32x4 (&acc)[2][2][4][2], const Unit& u, int wr, int wc, int fr, int fq) const {
        const int row0 = (u.pm - pm0) * BM + wr * 64 + fr, col0 = u.pn * HALF + wc * 32 + 8 * fq;
#pragma unroll
        for (int ai = 0; ai < 2; ++ai)
#pragma unroll
            for (int m = 0; m < 4; ++m) { f16* rowp = O + (size_t)(row0 + ai * HALF + m * 16) * ldc + col0;
                float r[8];
#pragma unroll
                for (int n = 0; n < 2; ++n)
#pragma unroll
                    for (int e = 0; e < 4; ++e) r[n * 4 + e] = silu_f(acc[ai][0][m][n][e]) * acc[ai][1][m][n][e];
                u32x4 w; w.x = pk_f16(r[0], r[1]); w.y = pk_f16(r[2], r[3]); w.z = pk_f16(r[4], r[5]); w.w = pk_f16(r[6], r[7]);
                *(u32x4*)rowp = w; }
    }
};
struct EpiScatter {
    static constexpr bool PERM = true;
    f16* C0; size_t slot_stride; const int* rowtok; const float* roww;
    __device__ __forceinline__ void operator()(const f32x4 (&acc)[2][2][4][2], const Unit& u, int wr, int wc, int fr, int fq) const {
        const int row0 = u.pm * BM + wr * 64 + fr, col0 = u.pn * BM + wc * 32 + 8 * fq;
#pragma unroll
        for (int ai = 0; ai < 2; ++ai)
#pragma unroll
            for (int m = 0; m < 4; ++m) { const int prow = row0 + ai * HALF + m * 16; const int ts = rowtok[prow]; const float w = roww[prow];
                if (ts >= 0) { f16* rowp = C0 + (size_t)(ts & 1) * slot_stride + (size_t)(ts >> 1) * D + col0;
#pragma unroll
                    for (int bj = 0; bj < 2; ++bj) { const f32x4 v0 = acc[ai][bj][m][0] * w, v1 = acc[ai][bj][m][1] * w;
                        u32x4 o; o.x = pk_f16(v0[0], v0[1]); o.y = pk_f16(v0[2], v0[3]); o.z = pk_f16(v1[0], v1[1]); o.w = pk_f16(v1[2], v1[3]);
                        *(u32x4*)(rowp + bj * HALF) = o; } } }
    }
};

template <class Sched>
__device__ __forceinline__ void a_offsets(const Sched& S, const Unit& u, int lda, int tid, unsigned (&ao)[2][2]) {
#pragma unroll
    for (int h = 0; h < 2; ++h)
#pragma unroll
        for (int i = 0; i < 2; ++i) { int R, C; stage_rc(tid * 16 + i * 8192, R, C); ao[h][i] = ((unsigned)S.a_row(u, h * HALF + R) * (unsigned)lda + (unsigned)C) * 2u; }
}

template <class Epi, class Sched, bool ALIGN_EPI>
__device__ __forceinline__ void gemm_phase(LAS unsigned char* lds, const Gemm g, const Sched& S, const Epi& E) {
    constexpr bool GATHER = Sched::GATHER;
    int tid_ = threadIdx.x; asm volatile("" : "+v"(tid_));
    const int tid = tid_, wid = __builtin_amdgcn_readfirstlane(tid >> 6), lane = tid & 63, wr = wid >> 2, wc = wid & 3, fr = lane & 15, fq = lane >> 4;
    const int K = g.K, nt = K / BK;
    unsigned voffB[2], voffA[2];
#pragma unroll
    for (int i = 0; i < 2; ++i) { int R, C; stage_rc(tid * 16 + i * 8192, R, C); const int Rb = Epi::PERM ? ((R & ~31) + perm32(R & 31)) : R; voffB[i] = (unsigned)(Rb * g.ldb + C) * 2u; voffA[i] = (unsigned)(R * g.lda + C) * 2u; }
    const size_t kstep = (size_t)(BK * 2);
    const size_t hstepB = (size_t)HALF * g.ldb * 2, tstepB = 2 * hstepB;
    const size_t hstepA = (size_t)HALF * g.lda * 2;
    const unsigned ldsw = (unsigned)wid * 1024u;
    const int aoff = lds_byte(wr * 64 + fr, fq * 8), boff = lds_byte(wc * 32 + fr, fq * 8);
#define PG8_SA(b, h) (((b) * 2 + (h)) * HTB)
#define PG8_SB(b, h) ((4 + (b) * 2 + (h)) * HTB)
#define PG8_STAGEB(bufoff, gbase) do { _Pragma("unroll") for (int _i = 0; _i < 2; ++_i) \
        __builtin_amdgcn_global_load_lds((const unsigned*)((const char*)(gbase) + voffB[_i]), (LAS unsigned*)(lds + (bufoff) + ldsw + _i * 8192), 16, 0, 0); } while (0)
#define PG8_STAGEA(bufoff, ub, kb, h) do { _Pragma("unroll") for (int _i = 0; _i < 2; ++_i) \
        __builtin_amdgcn_global_load_lds((const unsigned*)((ub) + (kb) + (GATHER ? (size_t)0 : (size_t)(h) * hstepA) + (GATHER ? cao[h][_i] : voffA[_i])), (LAS unsigned*)(lds + (bufoff) + ldsw + _i * 8192), 16, 0, 0); } while (0)
#define PG8_LDA(dst, b, h) do { _Pragma("unroll") for (int m = 0; m < 4; ++m) _Pragma("unroll") for (int k = 0; k < 2; ++k) dst[m][k] = *(const LAS f16x8*)(lds + PG8_SA(b, h) + aoff + m * 2048 + k * 1024); } while (0)
#define PG8_LDB(dst, b, h) do { _Pragma("unroll") for (int n = 0; n < 2; ++n) _Pragma("unroll") for (int k = 0; k < 2; ++k) dst[n][k] = *(const LAS f16x8*)(lds + PG8_SB(b, h) + boff + n * 2048 + k * 1024); } while (0)
#define PG8_MMA(ai, bj, At, Bt) do { __builtin_amdgcn_s_setprio(1); _Pragma("unroll") for (int m = 0; m < 4; ++m) _Pragma("unroll") for (int n = 0; n < 2; ++n) _Pragma("unroll") for (int k = 0; k < 2; ++k) \
        acc[ai][bj][m][n] = __builtin_amdgcn_mfma_f32_16x16x32_f16(Bt[n][k], At[m][k], acc[ai][bj][m][n], 0, 0, 0); __builtin_amdgcn_s_setprio(0); } while (0)
#define PG8_WAIT_V(n) asm volatile("s_waitcnt vmcnt(" #n ")" ::: "memory")
#define PG8_WAIT_L(n) asm volatile("s_waitcnt lgkmcnt(" #n ")" ::: "memory")
#define PG8_BAR __builtin_amdgcn_s_barrier()
#define PG8_SCHED __builtin_amdgcn_sched_barrier(0)
    Unit cur, nxt; int ui = 0;
    if (!S.next(0, cur)) return;
    f32x4 acc[2][2][4][2];
#pragma unroll
    for (int a = 0; a < 2; ++a)
#pragma unroll
        for (int b = 0; b < 2; ++b)
#pragma unroll
            for (int m = 0; m < 4; ++m)
#pragma unroll
                for (int n = 0; n < 2; ++n) acc[a][b][m][n] = (f32x4){0.f, 0.f, 0.f, 0.f};
    f16x8 At[4][2], B0[2][2], B1[2][2];
    unsigned cao[2][2];
    if constexpr (GATHER) a_offsets(S, cur, g.lda, tid, cao);
    const char* cA = (const char*)g.A + (GATHER ? (size_t)0 : (size_t)S.a_row(cur, 0) * g.lda * 2);
    const char* cB = (const char*)g.Bt + S.b_base(cur) + (size_t)cur.pn * tstepB;
    PG8_STAGEB(PG8_SB(0, 0), cB); PG8_STAGEB(PG8_SB(0, 1), cB + hstepB); PG8_STAGEA(PG8_SA(0, 0), cA, 0, 0); PG8_STAGEA(PG8_SA(0, 1), cA, 0, 1);
    if (wr == 1) PG8_BAR;
    PG8_WAIT_V(2); PG8_BAR;
    PG8_STAGEB(PG8_SB(1, 0), cB + kstep); PG8_STAGEA(PG8_SA(1, 0), cA, kstep, 0); PG8_STAGEB(PG8_SB(1, 1), cB + hstepB + kstep);
    PG8_WAIT_V(6); PG8_BAR;
    for (;;) {
        const bool has_next = S.next(ui + 1, nxt);
        const char* nB = cB; const char* nA = cA;
        if (has_next) { nB = (const char*)g.Bt + S.b_base(nxt) + (size_t)nxt.pn * tstepB; nA = (const char*)g.A + (GATHER ? (size_t)0 : (size_t)S.a_row(nxt, 0) * g.lda * 2); }
        for (int t = 0; t < nt; t += 2) {
            const bool last = (t == nt - 2);
            const size_t ka1 = (size_t)(t + 1) * kstep;
            const size_t ka2 = last ? 0 : (size_t)(t + 2) * kstep, ka3 = ka2 + kstep;
            const char* a2 = last ? nA : cA;
            const char* b2 = last ? nB : cB + (size_t)(t + 2) * kstep; const char* b3 = b2 + kstep;
            PG8_LDB(B0, 0, 0); PG8_LDB(B1, 0, 1); PG8_SCHED; PG8_LDA(At, 0, 0); PG8_STAGEA(PG8_SA(1, 1), cA, ka1, 1);
            if constexpr (GATHER) { if (last && has_next) a_offsets(S, nxt, g.lda, tid, cao); }
            PG8_WAIT_V(8); PG8_WAIT_L(0); PG8_BAR; PG8_MMA(0, 0, At, B0); PG8_MMA(0, 1, At, B1); PG8_BAR; PG8_SCHED;
            PG8_LDA(At, 0, 1); PG8_STAGEB(PG8_SB(0, 0), b2); PG8_STAGEB(PG8_SB(0, 1), b2 + hstepB); PG8_STAGEA(PG8_SA(0, 0), a2, ka2, 0);
            PG8_WAIT_V(8); PG8_WAIT_L(0); PG8_BAR; PG8_MMA(1, 0, At, B0); PG8_MMA(1, 1, At, B1); PG8_BAR; PG8_SCHED;
            PG8_LDB(B0, 1, 0); PG8_LDB(B1, 1, 1); PG8_SCHED; PG8_LDA(At, 1, 0); PG8_STAGEA(PG8_SA(0, 1), a2, ka2, 1);
            PG8_WAIT_V(8); PG8_WAIT_L(0); PG8_BAR; PG8_MMA(0, 0, At, B0); PG8_MMA(0, 1, At, B1); PG8_BAR; PG8_SCHED;
            PG8_LDA(At, 1, 1); PG8_STAGEB(PG8_SB(1, 0), b3); PG8_STAGEB(PG8_SB(1, 1), b3 + hstepB); PG8_STAGEA(PG8_SA(1, 0), a2, ka3, 0);
            PG8_WAIT_V(8); PG8_WAIT_L(0); PG8_BAR; PG8_MMA(1, 0, At, B0); PG8_MMA(1, 1, At, B1); PG8_BAR; PG8_SCHED;
        }
        if constexpr (ALIGN_EPI) { if (wr == 0) PG8_BAR; }
        { int t2 = threadIdx.x; asm volatile("" : "+v"(t2)); const int l2 = t2 & 63; E(acc, cur, wr, wc, l2 & 15, l2 >> 4); }
        if (!has_next) break;
#pragma unroll
        for (int a = 0; a < 2; ++a)
#pragma unroll
            for (int b = 0; b < 2; ++b)
#pragma unroll
                for (int m = 0; m < 4; ++m)
#pragma unroll
                    for (int n = 0; n < 2; ++n) acc[a][b][m][n] = (f32x4){0.f, 0.f, 0.f, 0.f};
        cur = nxt; cB = nB; cA = nA; ++ui;
        if constexpr (ALIGN_EPI) { if (wr == 1) PG8_BAR; }
    }
    PG8_WAIT_V(0);
    if constexpr (!ALIGN_EPI) { if (wr == 0) PG8_BAR; }
    PG8_BAR;
#undef PG8_SA
#undef PG8_SB
#undef PG8_STAGEA
#undef PG8_STAGEB
#undef PG8_LDA
#undef PG8_LDB
#undef PG8_MMA
#undef PG8_WAIT_V
#undef PG8_WAIT_L
#undef PG8_BAR
#undef PG8_SCHED
}
}

struct Args {
    const float* x; const float* ln_emb_g; const float* ln_emb_b; const float* w_in; const float* q_norm_g; const float* kv_norm_g;
    const float* w_uq; const float* w_ukv; const float* beta_mla; const float* beta_moba; const float* w_o; const float* ln1_g; const float* ln1_b;
    const float* ffn_w_gate; const float* ffn_w_up; const float* ffn_w_down; const float* router; const float* exp_w_gate; const float* exp_w_up;
    const float* exp_w_down; const float* ln2_g; const float* ln2_b;
    float* out; unsigned char* ws; int ph_lo, ph_hi;
};
struct Frame {
    LAS unsigned char* lds; int tid, lane, wave, bid, G;
};

enum { CM_ID = 0, CM_WIN = 1, CM_UQ = 2, CM_UKV = 3, CM_GU = 4 };
__device__ __forceinline__ int colmap(int kind, int n, int aux) {
    switch (kind) {
    case CM_WIN: {
        if (n >= HC_END) return -1;
        if (n >= HC_RQ && n < HC_RV) { const int base = n < HC_RK ? HC_RQ : HC_RK, r = n - base, hh = r >> 6, p = r & 63; const int d = ((p >> 5) << 4) + (p & 15) + ((p & 16) ? 32 : 0); return base + hh * 64 + d; }
        return n; }
    case CM_UQ: {
        if (n < 384) return (n >> 6) * 96 + (n & 63);
        if (n < 576) { const int r = n - 384; return (r >> 5) * 96 + 64 + (r & 31); }
        return -1; }
    case CM_UKV: {
        if (n < 384) return (n >> 6) * 128 + (n & 63);
        { const int r = n - 384; return (r >> 6) * 128 + 64 + (r & 63); } }
    case CM_GU: {
        const int j = n >> 8, w = n & 255; return j * 128 + (w & 127) + ((w >> 7) ? aux : 0); }
    default: return n;
    }
}
__device__ __forceinline__ void transpose_item(const float* W0, const float* W1, int K, int N, f16* WT, int kind, const float* kscale, const float* kscale2, LAS float* scr, int item, int nblk, int lane) {
    const int kb = item / nblk, nb = item % nblk, k0 = 64 * kb, n0 = 32 * nb;
    const int nn = lane & 31; int sc = colmap(kind, n0 + nn, N); const float* W = W0;
    if (kind == CM_GU && sc >= N) { sc -= N; W = W1; }
#pragma unroll 8
    for (int i = 0; i < 32; ++i) { const int kk = 2 * i + (lane >> 5); float v = 0.f; if (sc >= 0) v = W[(size_t)(k0 + kk) * N + sc]; if (kscale2) { const int k = k0 + kk; v *= k < 384 ? kscale[k] : (k >= 704 ? kscale2[k - 704] : 1.0f); } else if (kscale) v *= kscale[k0 + kk]; scr[kk * 33 + nn] = v; }
    asm volatile("s_waitcnt lgkmcnt(0)" ::: "memory");
    const int c = lane & 7;
#pragma unroll
    for (int j = 0; j < 4; ++j) { const int n = (lane >> 3) + 8 * j; const LAS float* s = scr + (8 * c) * 33 + n;
        u32x4 o; o.x = pk_f16(s[0 * 33], s[1 * 33]); o.y = pk_f16(s[2 * 33], s[3 * 33]); o.z = pk_f16(s[4 * 33], s[5 * 33]); o.w = pk_f16(s[6 * 33], s[7 * 33]);
        *(u32x4*)(WT + (size_t)(n0 + n) * K + k0 + 8 * c) = o; }
    asm volatile("s_waitcnt lgkmcnt(0)" ::: "memory");
}

__device__ __forceinline__ void ln_stats(const f32x4 (&v)[4], float& mean, float& rstd) {
    float s = 0.f;
#pragma unroll
    for (int j = 0; j < 4; ++j) s += (v[j][0] + v[j][1]) + (v[j][2] + v[j][3]);
    mean = wave_sum(s) * (1.f / D); float s2 = 0.f;
#pragma unroll
    for (int j = 0; j < 4; ++j) { const f32x4 d = v[j] - mean; s2 += (d[0] * d[0] + d[1] * d[1]) + (d[2] * d[2] + d[3] * d[3]); }
    rstd = 1.0f / sqrtf(wave_sum(s2) * (1.f / D) + LN_EPS);
}

template <int DK>
__device__ __forceinline__ void stage_kv(LAS float* Ks, LAS float* Vs, const f16* kp, int kld, const f16* k2p, int k2ld, const f16* vp, int vld, size_t row0, int tid) {
    constexpr int KCH = DK / 8;
    for (int t = tid; t < 32 * KCH + 32 * 8; t += 512) {
        if (t < 32 * KCH) { const int key = t / KCH, ch = t % KCH; const f16* src = (ch < 8) ? kp + (row0 + key) * kld + ch * 8 : k2p + (row0 + key) * k2ld + (ch - 8) * 8;
            const f16x8 v = *(const f16x8*)src; LAS float* d = Ks + key * DK + ch * 8;
#pragma unroll
            for (int e = 0; e < 8; ++e) d[e] = (float)v[e]; }
        else { const int t2 = t - 32 * KCH, key = t2 >> 3, ch = t2 & 7; const f16x8 v = *(const f16x8*)(vp + (row0 + key) * vld + ch * 8); LAS float* d = Vs + key * 64 + ch * 8;
#pragma unroll
            for (int e = 0; e < 8; ++e) d[e] = (float)v[e]; }
    }
}

template <int MODE>
__device__ __forceinline__ void attn_softmax_simple(const Frame& F, const f16* qb, const f16* kvb, const f16* hb, const float* kmean, f16* ob, float* ssq_o) {
    constexpr int DK = MODE == 0 ? 96 : 64, NHD = MODE == 0 ? 6 : 5;
    LAS float* Ks = (LAS float*)F.lds; LAS float* Vs = Ks + 32 * DK; LAS float* KM = Vs + 32 * 64;
    const int tid = F.tid;
    for (int unit = F.bid; unit < BATCH * NHD * 4; unit += F.G) {
        const int qt = 3 - (unit % 4), hh = (unit / 4) % NHD, b = unit / (4 * NHD);
        const size_t brow = (size_t)b * SEQ; const int qpos = qt * 512 + tid; const size_t row = brow + qpos;
        float q[DK];
        if (MODE == 0) {
#pragma unroll
            for (int c = 0; c < 8; ++c) { const f16x8 v = *(const f16x8*)(qb + row * QW + hh * 64 + c * 8);
#pragma unroll
                for (int e = 0; e < 8; ++e) q[c * 8 + e] = (float)v[e]; }
#pragma unroll
            for (int c = 0; c < 4; ++c) { const f16x8 v = *(const f16x8*)(qb + row * QW + 384 + hh * 32 + c * 8);
#pragma unroll
                for (int e = 0; e < 8; ++e) q[64 + c * 8 + e] = (float)v[e]; }
        } else {
#pragma unroll
            for (int c = 0; c < 8; ++c) { const f16x8 v = *(const f16x8*)(hb + row * HW + HC_MQ + hh * 64 + c * 8);
#pragma unroll
                for (int e = 0; e < 8; ++e) q[c * 8 + e] = (float)v[e]; }
        }
        const int blk = qpos >> 8; unsigned sel = 0u; float slope2 = 0.f;
        if (MODE == 1) {
            __syncthreads();
            { const int n = tid >> 6, d = tid & 63; KM[n * 64 + d] = kmean[(size_t)(b * 8 + n) * 320 + hh * 64 + d]; }
            __syncthreads();
            float gt[8];
#pragma unroll
            for (int n = 0; n < 8; ++n) { float s = 0.f;
#pragma unroll
                for (int d = 0; d < 64; ++d) s += q[d] * KM[n * 64 + d];
                gt[n] = s; }
#pragma unroll
            for (int n = 0; n < 8; ++n) { int rank = 0;
#pragma unroll
                for (int m = 0; m < 8; ++m) if (m < blk && m != n) rank += (gt[m] > gt[n] || (gt[m] == gt[n] && m < n)) ? 1 : 0;
                if (n < blk && rank < 3) sel |= 1u << n; }
            slope2 = exp2f(-8.0f * (float)(hh + 1) / 5.0f) * LOG2E;
        }
        float o[64];
#pragma unroll
        for (int d = 0; d < 64; ++d) o[d] = 0.f;
        float mrun = -INFINITY, lrun = 0.f;
        const int nkeys = (qt + 1) * 512;
        for (int k0 = 0; k0 < nkeys; k0 += 32) {
            __syncthreads();
            if (MODE == 0) stage_kv<96>(Ks, Vs, kvb + hh * 64, KVW, hb + HC_KR, HW, kvb + 384 + hh * 64, KVW, brow + k0, tid);
            else stage_kv<64>(Ks, Vs, hb + HC_MK + hh * 64, HW, nullptr, 0, hb + HC_MV + hh * 64, HW, brow + k0, tid);
            __syncthreads();
            bool part;
            if (MODE == 0) part = k0 <= qpos;
            else { const int n = k0 >> 8; part = (n == blk) ? (k0 <= qpos) : (n < blk && ((sel >> n) & 1u)); }
            if (part) {
#pragma unroll 1
                for (int j = 0; j < 32; ++j) {
                    if (k0 + j > qpos) break;
                    const LAS float* Kj = Ks + j * DK; const LAS float* Vj = Vs + j * 64;
                    float a = 0.f;
#pragma unroll
                    for (int d = 0; d < DK; d += 4) { const f32x4 kv4 = *(const LAS f32x4*)(Kj + d); a += q[d] * kv4[0] + q[d + 1] * kv4[1] + q[d + 2] * kv4[2] + q[d + 3] * kv4[3]; }
                    if (MODE == 1) a -= slope2 * (float)(qpos - (k0 + j));
                    if (a > mrun) { const float alpha = exp2f(mrun - a); lrun *= alpha;
#pragma unroll
                        for (int d = 0; d < 64; ++d) o[d] *= alpha;
                        mrun = a; }
                    const float p = exp2f(a - mrun); lrun += p;
#pragma unroll
                    for (int d = 0; d < 64; d += 4) { const f32x4 v4 = *(const LAS f32x4*)(Vj + d); o[d] += p * v4[0]; o[d + 1] += p * v4[1]; o[d + 2] += p * v4[2]; o[d + 3] += p * v4[3]; }
                }
            }
        }
        const float inv = 1.0f / lrun; float ss = 0.f;
#pragma unroll
        for (int d = 0; d < 64; ++d) { o[d] *= inv; ss += o[d] * o[d]; }
        f16* op = ob + row * D + (MODE == 0 ? 0 : OC_MOBA) + hh * 64;
#pragma unroll
        for (int c = 0; c < 8; ++c) { u32x4 w; w.x = pk_f16(o[c * 8], o[c * 8 + 1]); w.y = pk_f16(o[c * 8 + 2], o[c * 8 + 3]); w.z = pk_f16(o[c * 8 + 4], o[c * 8 + 5]); w.w = pk_f16(o[c * 8 + 6], o[c * 8 + 7]); *(u32x4*)(op + c * 8) = w; }
        ssq_o[row * 16 + (MODE == 0 ? 0 : 6) + hh] = ss;
    }
}
__device__ __forceinline__ void attn_ret_simple(const Frame& F, const f16* hb, f16* ob) {
    LAS float* Ks = (LAS float*)F.lds; LAS float* Vs = Ks + 32 * 64;
    const int tid = F.tid;
    for (int unit = F.bid; unit < BATCH * 5 * 4; unit += F.G) {
        const int qt = 3 - (unit % 4), hh = (unit / 4) % 5, b = unit / 20;
        const size_t brow = (size_t)b * SEQ; const int qpos = qt * 512 + tid; const size_t row = brow + qpos;
        float q[64];
#pragma unroll
        for (int c = 0; c < 8; ++c) { const f16x8 v = *(const f16x8*)(hb + row * HW + HC_RQ + hh * 64 + c * 8);
#pragma unroll
            for (int e = 0; e < 8; ++e) q[c * 8 + e] = (float)v[e]; }
        const float lg2 = log2f(1.0f - exp2f(-5.0f - (float)hh));
        float o[64];
#pragma unroll
        for (int d = 0; d < 64; ++d) o[d] = 0.f;
        const int nkeys = (qt + 1) * 512;
        for (int k0 = 0; k0 < nkeys; k0 += 32) {
            __syncthreads();
            stage_kv<64>(Ks, Vs, hb + HC_RK + hh * 64, HW, nullptr, 0, hb + HC_RV + hh * 64, HW, brow + k0, tid);
            __syncthreads();
            if (k0 <= qpos) {
#pragma unroll 1
                for (int j = 0; j < 32; ++j) {
                    const int dl = qpos - (k0 + j); if (dl < 0) break;
                    const LAS float* Kj = Ks + j * 64; const LAS float* Vj = Vs + j * 64;
                    float a = 0.f;
#pragma unroll
                    for (int d = 0; d < 64; d += 4) { const f32x4 kv4 = *(const LAS f32x4*)(Kj + d); a += q[d] * kv4[0] + q[d + 1] * kv4[1] + q[d + 2] * kv4[2] + q[d + 3] * kv4[3]; }
                    const float p = a * exp2f(lg2 * (float)dl);
#pragma unroll
                    for (int d = 0; d < 64; d += 4) { const f32x4 v4 = *(const LAS f32x4*)(Vj + d); o[d] += p * v4[0]; o[d + 1] += p * v4[1]; o[d + 2] += p * v4[2]; o[d + 3] += p * v4[3]; }
                }
            }
        }
        float mu = 0.f;
#pragma unroll
        for (int d = 0; d < 64; ++d) mu += o[d];
        mu *= (1.f / 64.f); float var = 0.f;
#pragma unroll
        for (int d = 0; d < 64; ++d) { const float t = o[d] - mu; var += t * t; }
        const float rs = 1.0f / sqrtf(var * (1.f / 64.f) + RMS_EPS);
        f16* op = ob + row * D + OC_RET + hh * 64; const f16* gp = hb + row * HW + HC_RG + hh * 64;
#pragma unroll
        for (int c = 0; c < 8; ++c) { const f16x8 gv = *(const f16x8*)(gp + c * 8); float r[8];
#pragma unroll
            for (int e = 0; e < 8; ++e) r[e] = silu_f((float)gv[e]) * ((o[c * 8 + e] - mu) * rs);
            u32x4 w; w.x = pk_f16(r[0], r[1]); w.y = pk_f16(r[2], r[3]); w.z = pk_f16(r[4], r[5]); w.w = pk_f16(r[6], r[7]); *(u32x4*)(op + c * 8) = w; }
    }
}

constexpr int NWAVES = 8;
constexpr int PH_L0 = 1, PPL0 = 11, PH_L1 = PH_L0 + PPL0, PPL1 = 20, NPHASE = PH_L1 + PPL1;
typedef const __attribute__((address_space(4))) Args* KArgs;
__device__ __forceinline__ KArgs kargs() { KArgs p = (KArgs)__builtin_amdgcn_kernarg_segment_ptr(); asm volatile("" : "+s"(p)); return p; }
__device__ __forceinline__ Frame mkframe() {
    extern __shared__ __attribute__((aligned(16))) unsigned char lds_raw[];
    Frame F; F.lds = (LAS unsigned char*)lds_raw; int t = threadIdx.x; asm volatile("" : "+v"(t)); F.tid = t; F.lane = t & 63; F.wave = __builtin_amdgcn_readfirstlane(t >> 6); F.bid = blockIdx.x; F.G = gridDim.x; return F;
}
#define WSP(T_, off) ((T_*)(ws + (off)))

__device__ __forceinline__ void ph_prologue() {
    const Frame F = mkframe(); KArgs a = kargs(); unsigned char* ws = a->ws;
    const int gw = F.bid * NWAVES + F.wave, NGW = F.G * NWAVES;
    f16* Win = WSP(f16, WS_WIN); f16* Wuq = WSP(f16, WS_WUQ); f16* Wukv = WSP(f16, WS_WUKV); f16* Wo = WSP(f16, WS_WO); f16* Wgu = WSP(f16, WS_WGU); f16* Wdn = WSP(f16, WS_WDN);
    f16* Egu = WSP(f16, WS_EGU); f16* Edn = WSP(f16, WS_EDN); f16* xb = WSP(f16, WS_XB);
    float* cosA = WSP(float, WS_ROPE); float* sinA = cosA + SEQ * 16; float* cosB = sinA + SEQ * 16; float* sinB = cosB + SEQ * 32;
    LAS float* scr = (LAS float*)(F.lds + F.wave * 16384);
    constexpr int I_WIN = (D / 64) * (HW / 32), I_UQ = (256 / 64) * (768 / 32), I_UKV = (128 / 64) * (768 / 32), I_WO = (D / 64) * (D / 32);
    constexpr int I_GU = (D / 64) * (2 * FF / 32), I_DN = (FF / 64) * (D / 32), I_EGU = (D / 64) * (2 * FE / 32), I_EDN = (FE / 64) * (D / 32);
    constexpr int N_SMALL = 2 * (I_WIN + I_UQ + I_UKV + I_WO) + I_GU + I_DN, N_ALL = N_SMALL + NE * (I_EGU + I_EDN);
    for (int it = gw; it < N_ALL; it += NGW) {
        int r = it;
        if (r < 2 * I_WIN) { const int l = r / I_WIN; r %= I_WIN; transpose_item(a->w_in + (size_t)l * D * HC_END, nullptr, D, HC_END, Win + (size_t)l * HW * D, CM_WIN, nullptr, nullptr, scr, r, HW / 32, F.lane); continue; } r -= 2 * I_WIN;
        if (r < 2 * I_UQ) { const int l = r / I_UQ; r %= I_UQ; transpose_item(a->w_uq + (size_t)l * 256 * 576, nullptr, 256, 576, Wuq + (size_t)l * 768 * 256, CM_UQ, a->q_norm_g + l * 256, nullptr, scr, r, 768 / 32, F.lane); continue; } r -= 2 * I_UQ;
        if (r < 2 * I_UKV) { const int l = r / I_UKV; r %= I_UKV; transpose_item(a->w_ukv + (size_t)l * 128 * 768, nullptr, 128, 768, Wukv + (size_t)l * 768 * 128, CM_UKV, a->kv_norm_g + l * 128, nullptr, scr, r, 768 / 32, F.lane); continue; } r -= 2 * I_UKV;
        if (r < 2 * I_WO) { const int l = r / I_WO; r %= I_WO; transpose_item(a->w_o + (size_t)l * D * D, nullptr, D, D, Wo + (size_t)l * D * D, CM_ID, a->beta_mla + l * 384, a->beta_moba + l * 320, scr, r, D / 32, F.lane); continue; } r -= 2 * I_WO;
        if (r < I_GU) { transpose_item(a->ffn_w_gate, a->ffn_w_up, D, FF, Wgu, CM_GU, nullptr, nullptr, scr, r, 2 * FF / 32, F.lane); continue; } r -= I_GU;
        if (r < I_DN) { transpose_item(a->ffn_w_down, nullptr, FF, D, Wdn, CM_ID, nullptr, nullptr, scr, r, D / 32, F.lane); continue; } r -= I_DN;
        { const int e = r / (I_EGU + I_EDN); r %= (I_EGU + I_EDN);
          if (r < I_EGU) transpose_item(a->exp_w_gate + (size_t)e * D * FE, a->exp_w_up + (size_t)e * D * FE, D, FE, Egu + (size_t)e * 2 * FE * D, CM_GU, nullptr, nullptr, scr, r, 2 * FE / 32, F.lane);
          else transpose_item(a->exp_w_down + (size_t)e * FE * D, nullptr, FE, D, Edn + (size_t)e * D * FE, CM_ID, nullptr, nullptr, scr, r - I_EGU, D / 32, F.lane); }
    }
    for (int i = F.bid * 512 + F.tid; i < SEQ * 48; i += F.G * 512) {
        if (i < SEQ * 16) { const int pos = i >> 4, j = i & 15; const float inv = powf(10000.0f, -(float)(2 * j) / 32.0f); const float ang = (float)pos * inv; cosA[i] = cosf(ang); sinA[i] = sinf(ang); }
        else { const int k = i - SEQ * 16, pos = k >> 5, j = k & 31; const float inv = powf(10000.0f, -(float)(2 * j) / 64.0f); const float ang = (float)pos * inv; cosB[k] = cosf(ang); sinB[k] = sinf(ang); }
    }
    const float* xin = a->x; const float* gp = a->ln_emb_g; const float* bp = a->ln_emb_b;
    for (int m = gw; m < T; m += NGW) {
        const f32x4* xr = (const f32x4*)(xin + (size_t)m * D) + F.lane; f32x4 v[4];
#pragma unroll
        for (int j = 0; j < 4; ++j) v[j] = xr[64 * j];
        float mean, rstd; ln_stats(v, mean, rstd);
        u32x2* o8 = (u32x2*)(xb + (size_t)m * D) + F.lane;
#pragma unroll
        for (int j = 0; j < 4; ++j) { const f32x4 g = *((const f32x4*)gp + F.lane + 64 * j), bb = *((const f32x4*)bp + F.lane + 64 * j); const f32x4 y = (v[j] - mean) * rstd * g + bb;
            u32x2 w; w.x = pk_f16(y[0], y[1]); w.y = pk_f16(y[2], y[3]); o8[64 * j] = w; }
    }
}
__device__ __forceinline__ void ph_A(int l) {
    const Frame F = mkframe(); KArgs a = kargs(); unsigned char* ws = a->ws;
    pg8::Gemm g{WSP(f16, WS_XB), D, WSP(f16, WS_WIN) + (size_t)l * HW * D, D, D}; pg8::StaticOrder S; S.init(T / 256, HW / 256, F.G, F.bid);
    pg8::EpiF16 E{WSP(f16, WS_H), HW};
    pg8::gemm_phase<pg8::EpiF16, pg8::StaticOrder, true>(F.lds, g, S, E);
}
__device__ __forceinline__ void ph_A2() {
    const Frame F = mkframe(); KArgs a = kargs(); unsigned char* ws = a->ws;
    const int gw = F.bid * NWAVES + F.wave, NGW = F.G * NWAVES;
    f16* hbuf = WSP(f16, WS_H); float* ssq_q = WSP(float, WS_SSQ_Q); float* ssq_kv = WSP(float, WS_SSQ_KV); float* kmean = WSP(float, WS_KMEAN);
    const float* cosA = WSP(float, WS_ROPE); const float* sinA = cosA + SEQ * 16; const float* cosB = sinA + SEQ * 16; const float* sinB = cosB + SEQ * 32;
    for (int m = gw; m < T; m += NGW) {
        f16* hr = hbuf + (size_t)m * HW; const int pos = m & (SEQ - 1); const int lane = F.lane;
        { const f16x4 v = *(const f16x4*)(hr + HC_CQ + 4 * lane); float s = (float)v[0] * (float)v[0] + (float)v[1] * (float)v[1] + (float)v[2] * (float)v[2] + (float)v[3] * (float)v[3];
          s = wave_sum(s); if (lane < 4) ssq_q[(size_t)m * 4 + lane] = lane == 0 ? s : 0.f; }
        { const f16x2 v = *(const f16x2*)(hr + HC_CKV + 2 * lane); float s = (float)v[0] * (float)v[0] + (float)v[1] * (float)v[1];
          s = wave_sum(s); if (lane < 4) ssq_kv[(size_t)m * 4 + lane] = lane == 0 ? s : 0.f; }
        if (lane < 16) { const float c = cosA[pos * 16 + lane], s = sinA[pos * 16 + lane]; const float x1 = (float)hr[HC_KR + lane], x2 = (float)hr[HC_KR + 16 + lane];
            hr[HC_KR + lane] = (f16)(x1 * c - x2 * s); hr[HC_KR + 16 + lane] = (f16)(x1 * s + x2 * c); }
        if (lane < 32) { const float c = cosB[pos * 32 + lane], s = sinB[pos * 32 + lane]; const int p1 = ((lane >> 4) << 5) + (lane & 15);
#pragma unroll
            for (int hh = 0; hh < 5; ++hh) {
                { f16* p = hr + HC_RQ + hh * 64 + p1; const float x1 = (float)p[0], x2 = (float)p[16]; p[0] = (f16)(x1 * c - x2 * s); p[16] = (f16)(x1 * s + x2 * c); }
                { f16* p = hr + HC_RK + hh * 64 + p1; const float x1 = (float)p[0], x2 = (float)p[16]; p[0] = (f16)((x1 * c - x2 * s) * 0.125f); p[16] = (f16)((x1 * s + x2 * c) * 0.125f); } } }
#pragma unroll
        for (int j = 0; j < 5; ++j) { f16* p = hr + HC_MQ + lane + 64 * j; *p = (f16)((float)*p * (0.125f * LOG2E)); }
    }
    for (int i = F.bid * 512 + F.tid; i < 128 * 320; i += F.G * 512) { const int bk = i / 320, c = i % 320; const f16* p = hbuf + (size_t)bk * 256 * HW + HC_MK + c; float s = 0.f;
        for (int r = 0; r < 256; ++r) s += (float)p[(size_t)r * HW];
        kmean[i] = s * (1.f / 256.f); }
}
__device__ __forceinline__ void ph_B(int l) {
    { const Frame F = mkframe(); KArgs a = kargs(); unsigned char* ws = a->ws;
      pg8::Gemm g{WSP(f16, WS_H) + HC_CQ, HW, WSP(f16, WS_WUQ) + (size_t)l * 768 * 256, 256, 256}; pg8::StaticOrder S; S.init(T / 256, QW / 256, F.G, F.bid);
      pg8::EpiF16 E{(f16*)a->out, QW}; pg8::gemm_phase<pg8::EpiF16, pg8::StaticOrder, true>(F.lds, g, S, E); }
    { const Frame F = mkframe(); KArgs a = kargs(); unsigned char* ws = a->ws;
      pg8::Gemm g{WSP(f16, WS_H) + HC_CKV, HW, WSP(f16, WS_WUKV) + (size_t)l * 768 * 128, 128, 128}; pg8::StaticOrder S; S.init(T / 256, KVW / 256, F.G, F.bid);
      pg8::EpiF16 E{(f16*)((unsigned char*)a->out + 48 * MiB), KVW}; pg8::gemm_phase<pg8::EpiF16, pg8::StaticOrder, true>(F.lds, g, S, E); }
}
__device__ __forceinline__ void ph_B2() {
    const Frame F = mkframe(); KArgs a = kargs(); unsigned char* ws = a->ws;
    const int gw = F.bid * NWAVES + F.wave, NGW = F.G * NWAVES;
    const float* ssq_q = WSP(float, WS_SSQ_Q); const float* ssq_kv = WSP(float, WS_SSQ_KV); const float* cosA = WSP(float, WS_ROPE); const float* sinA = cosA + SEQ * 16;
    f16* qbuf = (f16*)a->out; f16* kvbuf = (f16*)((unsigned char*)a->out + 48 * MiB);
    for (int m = gw; m < T; m += NGW) {
        const int pos = m & (SEQ - 1), lane = F.lane;
        const float sq = (1.0f / sqrtf((ssq_q[(size_t)m * 4] + ssq_q[(size_t)m * 4 + 1] + ssq_q[(size_t)m * 4 + 2] + ssq_q[(size_t)m * 4 + 3]) * (1.f / 256.f) + RMS_EPS)) * (0.10206207261596575f * LOG2E);
        const float skv = 1.0f / sqrtf((ssq_kv[(size_t)m * 4] + ssq_kv[(size_t)m * 4 + 1] + ssq_kv[(size_t)m * 4 + 2] + ssq_kv[(size_t)m * 4 + 3]) * (1.f / 128.f) + RMS_EPS);
        f16* qr = qbuf + (size_t)m * QW; f16* kr = kvbuf + (size_t)m * KVW;
#pragma unroll
        for (int j = 0; j < 6; ++j) { f16* p = qr + lane + 64 * j; *p = (f16)((float)*p * sq); }
#pragma unroll
        for (int j = 0; j < 2; ++j) { const int pi = lane + 64 * j; if (pi < 96) { const int hh = pi >> 4, jj = pi & 15; const float c = cosA[pos * 16 + jj], s = sinA[pos * 16 + jj];
            f16* p = qr + 384 + hh * 32 + jj; const float x1 = (float)p[0] * sq, x2 = (float)p[16] * sq; p[0] = (f16)(x1 * c - x2 * s); p[16] = (f16)(x1 * s + x2 * c); } }
#pragma unroll
        for (int j = 0; j < 12; ++j) { f16* p = kr + lane + 64 * j; *p = (f16)((float)*p * skv); }
    }
}
__device__ __forceinline__ void ph_C() {
#ifndef SKIP_A0
    { const Frame F = mkframe(); KArgs a = kargs(); unsigned char* ws = a->ws;
      attn_softmax_simple<0>(F, (const f16*)a->out, (const f16*)((unsigned char*)a->out + 48 * MiB), WSP(f16, WS_H), WSP(float, WS_KMEAN), WSP(f16, WS_O), WSP(float, WS_SSQ_O)); }
#endif
#ifndef SKIP_A1
    { const Frame F = mkframe(); KArgs a = kargs(); unsigned char* ws = a->ws;
      attn_softmax_simple<1>(F, (const f16*)a->out, (const f16*)((unsigned char*)a->out + 48 * MiB), WSP(f16, WS_H), WSP(float, WS_KMEAN), WSP(f16, WS_O), WSP(float, WS_SSQ_O)); }
#endif
#ifndef SKIP_A2
    { const Frame F = mkframe(); KArgs a = kargs(); unsigned char* ws = a->ws;
      attn_ret_simple(F, WSP(f16, WS_H), WSP(f16, WS_O)); }
#endif
}
__device__ __forceinline__ void ph_C2() {
    const Frame F = mkframe(); KArgs a = kargs(); unsigned char* ws = a->ws;
    const int gw = F.bid * NWAVES + F.wave, NGW = F.G * NWAVES;
    const float* ssq_o = WSP(float, WS_SSQ_O); f16* obuf = WSP(f16, WS_O);
    for (int m = gw; m < T; m += NGW) {
        const int lane = F.lane; const float* sp = ssq_o + (size_t)m * 16;
        const float sa = 1.0f / sqrtf((sp[0] + sp[1] + sp[2] + sp[3] + sp[4] + sp[5]) * (1.f / 384.f) + RMS_EPS);
        const float sc = 1.0f / sqrtf((sp[6] + sp[7] + sp[8] + sp[9] + sp[10]) * (1.f / 320.f) + RMS_EPS);
        f16* orow = obuf + (size_t)m * D;
#pragma unroll
        for (int j = 0; j < 6; ++j) { f16* p = orow + lane + 64 * j; *p = (f16)((float)*p * sa); }
#pragma unroll
        for (int j = 0; j < 5; ++j) { f16* p = orow + OC_MOBA + lane + 64 * j; *p = (f16)((float)*p * sc); }
    }
}
__device__ __forceinline__ void ph_D(int l) {
    const Frame F = mkframe(); KArgs a = kargs(); unsigned char* ws = a->ws;
    pg8::Gemm g{WSP(f16, WS_O), D, WSP(f16, WS_WO) + (size_t)l * D * D, D, D}; pg8::StaticOrder S; S.init(T / 256, D / 256, F.G, F.bid);
    pg8::EpiResF32 E{WSP(f16, WS_XB), a->out, D, DN_ALPHA};
    pg8::gemm_phase<pg8::EpiResF32, pg8::StaticOrder, true>(F.lds, g, S, E);
}
__device__ __forceinline__ void ph_D2(int l) {
    const Frame F = mkframe(); KArgs a = kargs(); unsigned char* ws = a->ws;
    const float* ybuf = a->out; f16* xb = WSP(f16, WS_XB); int* topi = WSP(int, WS_TOPI); float* topw = WSP(float, WS_TOPW); int* cnt = WSP(int, WS_CNT);
    const float* gp = a->ln1_g + l * D; const float* bp = a->ln1_b + l * D; const float* router = a->router;
    LAS int* lcnt = (LAS int*)(F.lds);
    for (int vw = F.bid; vw < 256; vw += F.G) {
        if (l == 1) { __syncthreads(); if (F.tid < 8) lcnt[F.tid] = 0; __syncthreads(); }
        for (int rr = F.wave; rr < 128; rr += NWAVES) {
            const int m = vw * 128 + rr; const int lane = F.lane;
            const f32x4* yr = (const f32x4*)(ybuf + (size_t)m * D) + lane; f32x4 v[4];
#pragma unroll
            for (int j = 0; j < 4; ++j) v[j] = yr[64 * j];
            float mean, rstd; ln_stats(v, mean, rstd);
            u32x2* o8 = (u32x2*)(xb + (size_t)m * D) + lane;
#pragma unroll
            for (int j = 0; j < 4; ++j) { const f32x4 g = *((const f32x4*)gp + lane + 64 * j), bb = *((const f32x4*)bp + lane + 64 * j); v[j] = (v[j] - mean) * rstd * g + bb;
                u32x2 w; w.x = pk_f16(v[j][0], v[j][1]); w.y = pk_f16(v[j][2], v[j][3]); o8[64 * j] = w; }
            if (l == 1) {
                float lg[8];
#pragma unroll
                for (int e = 0; e < 8; ++e) lg[e] = 0.f;
#pragma unroll
                for (int j = 0; j < 4; ++j)
#pragma unroll
                    for (int e4 = 0; e4 < 4; ++e4) { const int c = 4 * lane + 256 * j + e4; const f32x4 r0 = *(const f32x4*)(router + (size_t)c * 8), r1 = *(const f32x4*)(router + (size_t)c * 8 + 4); const float xv = v[j][e4];
                        lg[0] += xv * r0[0]; lg[1] += xv * r0[1]; lg[2] += xv * r0[2]; lg[3] += xv * r0[3]; lg[4] += xv * r1[0]; lg[5] += xv * r1[1]; lg[6] += xv * r1[2]; lg[7] += xv * r1[3]; }
#pragma unroll
                for (int e = 0; e < 8; ++e) lg[e] = wave_sum(lg[e]);
                if (lane == 0) {
                    int i0 = 0; float v0 = lg[0];
#pragma unroll
                    for (int e = 1; e < 8; ++e) if (lg[e] > v0) { v0 = lg[e]; i0 = e; }
                    int i1 = -1; float v1 = -INFINITY;
#pragma unroll
                    for (int e = 0; e < 8; ++e) if (e != i0 && lg[e] > v1) { v1 = lg[e]; i1 = e; }
                    const float e1 = __expf(v1 - v0), w0 = 1.0f / (1.0f + e1), w1 = e1 * w0;
                    topi[(size_t)m * 2] = i0; topi[(size_t)m * 2 + 1] = i1; topw[(size_t)m * 2] = w0; topw[(size_t)m * 2 + 1] = w1;
                    __hip_atomic_fetch_add(&lcnt[i0], 1, __ATOMIC_RELAXED, __HIP_MEMORY_SCOPE_WORKGROUP); __hip_atomic_fetch_add(&lcnt[i1], 1, __ATOMIC_RELAXED, __HIP_MEMORY_SCOPE_WORKGROUP);
                }
            }
        }
        if (l == 1) { __syncthreads(); if (F.tid < 8) cnt[vw * 8 + F.tid] = lcnt[F.tid]; }
    }
}
__device__ __forceinline__ void ph_E() {
    const Frame F = mkframe(); KArgs a = kargs(); unsigned char* ws = a->ws;
    pg8::Gemm g{WSP(f16, WS_XB), D, WSP(f16, WS_WGU), D, D}; pg8::StaticOrder S; S.init(T / 256, 2 * FF / 256, F.G, F.bid);
    pg8::EpiSwiGLU E{WSP(f16, WS_H), FF, 0};
    pg8::gemm_phase<pg8::EpiSwiGLU, pg8::StaticOrder, true>(F.lds, g, S, E);
}
__device__ __forceinline__ void ph_F() {
    const Frame F = mkframe(); KArgs a = kargs(); unsigned char* ws = a->ws;
    pg8::Gemm g{WSP(f16, WS_H), FF, WSP(f16, WS_WDN), FF, FF}; pg8::StaticOrder S; S.init(T / 256, D / 256, F.G, F.bid);
    pg8::EpiResF32 E{WSP(f16, WS_XB), a->out, D, DN_ALPHA};
    pg8::gemm_phase<pg8::EpiResF32, pg8::StaticOrder, true>(F.lds, g, S, E);
}
__device__ __forceinline__ void ph_F2d() {
    const Frame F = mkframe(); KArgs a = kargs(); unsigned char* ws = a->ws;
    const int gw = F.bid * NWAVES + F.wave, NGW = F.G * NWAVES;
    const float* ybuf = a->out; f16* xb = WSP(f16, WS_XB); const float* gp = a->ln2_g; const float* bp = a->ln2_b;
    for (int m = gw; m < T; m += NGW) {
        const int lane = F.lane; const f32x4* yr = (const f32x4*)(ybuf + (size_t)m * D) + lane; f32x4 v[4];
#pragma unroll
        for (int j = 0; j < 4; ++j) v[j] = yr[64 * j];
        float mean, rstd; ln_stats(v, mean, rstd);
        u32x2* o8 = (u32x2*)(xb + (size_t)m * D) + lane;
#pragma unroll
        for (int j = 0; j < 4; ++j) { const f32x4 g = *((const f32x4*)gp + lane + 64 * j), bb = *((const f32x4*)bp + lane + 64 * j); const f32x4 y = (v[j] - mean) * rstd * g + bb;
            u32x2 w; w.x = pk_f16(y[0], y[1]); w.y = pk_f16(y[2], y[3]); o8[64 * j] = w; }
    }
}
__device__ __forceinline__ void ph_R3() {
    const Frame F = mkframe(); KArgs a = kargs(); unsigned char* ws = a->ws;
    const int* topi = WSP(int, WS_TOPI); const float* topw = WSP(float, WS_TOPW); const int* cnt = WSP(int, WS_CNT); int* rowtok = WSP(int, WS_ROWTOK); float* roww = WSP(float, WS_ROWW); int* pane = WSP(int, WS_PANE);
    LAS int* L = (LAS int*)F.lds;
    for (int vw = F.bid; vw < 256; vw += F.G) {
        __syncthreads();
        if (F.tid < 8) { const int e = F.tid; int tot = 0, mine = 0; for (int w = 0; w < 256; ++w) { const int c = cnt[w * 8 + e]; if (w < vw) mine += c; tot += c; } L[e] = tot; L[16 + e] = mine; }
        __syncthreads();
        if (F.tid == 0) { int b = 0; for (int e = 0; e < 8; ++e) { L[8 + e] = b; b += (L[e] + 255) & ~255; } L[24] = b; }
        __syncthreads();
        if (F.tid < 8) { const int e = F.tid; int p = L[8 + e] + L[16 + e];
            for (int t = 0; t < 128; ++t) { const int tok = vw * 128 + t;
#pragma unroll
                for (int s = 0; s < 2; ++s) if (topi[(size_t)tok * 2 + s] == e) { rowtok[p] = tok * 2 + s; roww[p] = topw[(size_t)tok * 2 + s]; ++p; } } }
        if (vw == 0) {
            for (int e = 0; e < 8; ++e) { const int s0 = L[8 + e] + L[e], s1 = L[8 + e] + ((L[e] + 255) & ~255);
                for (int p = s0 + F.tid; p < s1; p += 512) { rowtok[p] = -1; roww[p] = 0.f; }
                for (int p = (L[8 + e] >> 8) + F.tid; p < (s1 >> 8); p += 512) pane[p] = e; }
            if (F.tid == 0) pane[MOE_MAXP] = L[24] >> 8;
        }
    }
}
__device__ __forceinline__ void ph_M1(int c) {
    const Frame F = mkframe(); KArgs a = kargs(); unsigned char* ws = a->ws;
    const int* pane = WSP(int, WS_PANE);
    const int np = pane[MOE_MAXP]; int nm = np - c * MOE_CHUNK; nm = nm < 0 ? 0 : (nm > MOE_CHUNK ? MOE_CHUNK : nm);
    pg8::Gemm g{WSP(f16, WS_XB), D, WSP(f16, WS_EGU), D, D}; pg8::MoeGather S; S.so.init(nm, 2 * FE / 256, F.G, F.bid, c * MOE_CHUNK); S.rowtok = WSP(int, WS_ROWTOK); S.pane = pane; S.estride = (size_t)2 * FE * D * 2;
    pg8::EpiSwiGLU E{(f16*)a->out, FE, c * MOE_CHUNK};
    pg8::gemm_phase<pg8::EpiSwiGLU, pg8::MoeGather, true>(F.lds, g, S, E);
}
__device__ __forceinline__ void ph_M2(int c) {
    const Frame F = mkframe(); KArgs a = kargs(); unsigned char* ws = a->ws;
    const int* pane = WSP(int, WS_PANE);
    const int np = pane[MOE_MAXP]; int nm = np - c * MOE_CHUNK; nm = nm < 0 ? 0 : (nm > MOE_CHUNK ? MOE_CHUNK : nm);
    pg8::Gemm g{(const f16*)a->out, FE, WSP(f16, WS_EDN), FE, FE}; pg8::MoeDense S; S.so.init(nm, D / 256, F.G, F.bid, c * MOE_CHUNK); S.pane = pane; S.estride = (size_t)D * FE * 2; S.arow0 = c * MOE_CHUNK;
    pg8::EpiScatter E{WSP(f16, WS_H), (size_t)T * D, WSP(int, WS_ROWTOK), WSP(float, WS_ROWW)};
    pg8::gemm_phase<pg8::EpiScatter, pg8::MoeDense, true>(F.lds, g, S, E);
}
__device__ __forceinline__ void ph_F2m() {
    const Frame F = mkframe(); KArgs a = kargs(); unsigned char* ws = a->ws;
    const int gw = F.bid * NWAVES + F.wave, NGW = F.G * NWAVES;
    const f16* xb = WSP(f16, WS_XB); const f16* c0buf = WSP(f16, WS_H); const f16* c1buf = c0buf + (size_t)T * D; float* out = a->out; const float* gp = a->ln2_g + D; const float* bp = a->ln2_b + D;
    for (int m = gw; m < T; m += NGW) {
        const int lane = F.lane; f32x4 v[4];
        const f16x4* xr = (const f16x4*)(xb + (size_t)m * D) + lane; const f16x4* c0r = (const f16x4*)(c0buf + (size_t)m * D) + lane; const f16x4* c1r = (const f16x4*)(c1buf + (size_t)m * D) + lane;
#pragma unroll
        for (int j = 0; j < 4; ++j) { const f16x4 xv = xr[64 * j], p0 = c0r[64 * j], p1 = c1r[64 * j];
#pragma unroll
            for (int e = 0; e < 4; ++e) v[j][e] = DN_ALPHA * (float)xv[e] + ((float)p0[e] + (float)p1[e]); }
        float mean, rstd; ln_stats(v, mean, rstd);
        f32x4* orow = (f32x4*)(out + (size_t)m * D) + lane;
#pragma unroll
        for (int j = 0; j < 4; ++j) { const f32x4 g = *((const f32x4*)gp + lane + 64 * j), bb = *((const f32x4*)bp + lane + 64 * j); orow[64 * j] = (v[j] - mean) * rstd * g + bb; }
    }
}

#ifndef SITE_MASK
#define SITE_MASK 0xFFFFFFFFu
#endif
#define SITE(n) (((SITE_MASK) >> (n)) & 1u)
__global__ void __launch_bounds__(NWAVES * 64, 2) mega_fwd(Args args_unused) {
    extern __shared__ __attribute__((aligned(16))) unsigned char lds_raw[];
    volatile LAS unsigned* MISC = (volatile LAS unsigned*)((LAS unsigned char*)lds_raw + MISC_OFF);
    if (threadIdx.x < 64) MISC[threadIdx.x] = 0u;
    __syncthreads();
#if MK_ONE_LAUNCH
    XcdBarrier bar = xcd_barrier_post((unsigned*)(kargs()->ws + WS_CTL) + CW_BAR, MISC + 8);
#define GRID_BAR() xcd_barrier(bar)
#else
#define GRID_BAR() do {} while (0)
#endif
    const int lo = kargs()->ph_lo, hi = kargs()->ph_hi;
#define IN(k) (lo <= (k) && (k) < hi)
#define SEAM(k) do { if (IN(k) && IN((k) + 1)) GRID_BAR(); } while (0)
    if (SITE(0) && IN(0)) ph_prologue();
    SEAM(0);
    for (int l = 0; l < 2; ++l) {
        const int pb = l == 0 ? PH_L0 : PH_L1;
        if (SITE(1) && IN(pb + 0)) ph_A(l);
        SEAM(pb + 0);
        if (SITE(2) && IN(pb + 1)) ph_A2();
        SEAM(pb + 1);
        if (SITE(3) && IN(pb + 2)) ph_B(l);
        SEAM(pb + 2);
        if (SITE(4) && IN(pb + 3)) ph_B2();
        SEAM(pb + 3);
        if (SITE(5) && IN(pb + 4)) ph_C();
        SEAM(pb + 4);
        if (SITE(6) && IN(pb + 5)) ph_C2();
        SEAM(pb + 5);
        if (SITE(7) && IN(pb + 6)) ph_D(l);
        SEAM(pb + 6);
        if (SITE(8) && IN(pb + 7)) ph_D2(l);
        SEAM(pb + 7);
        if (l == 0) {
            if (SITE(9) && IN(pb + 8)) ph_E();
            SEAM(pb + 8);
            if (SITE(10) && IN(pb + 9)) ph_F();
            SEAM(pb + 9);
            if (SITE(11) && IN(pb + 10)) ph_F2d();
            SEAM(pb + 10);
        } else {
            if (SITE(12) && IN(pb + 8)) ph_R3();
            SEAM(pb + 8);
            for (int c = 0; c < MOE_NCHUNK; ++c) {
                if (SITE(13) && IN(pb + 9 + 2 * c)) ph_M1(c);
                SEAM(pb + 9 + 2 * c);
                if (SITE(14) && IN(pb + 10 + 2 * c)) ph_M2(c);
                SEAM(pb + 10 + 2 * c);
            }
            if (SITE(15) && IN(pb + 19)) ph_F2m();
        }
    }
#undef IN
#undef SEAM
}

extern "C" void kernel_launch(void* const* d_in, const int* in_sizes, int n_in, void* d_out, int out_size, void* d_ws, size_t ws_size, hipStream_t stream) {
    static int grid = 0;
    if (grid == 0) {
        if (n_in != 22 || in_sizes[0] != T * D || out_size != T * D || ws_size < WS_END) { fprintf(stderr, "kernel_launch: unexpected shapes / workspace (n_in %d, ws %zu)\n", n_in, ws_size); grid = -1; return; }
        int dev = 0, cus = 0;
        if (hipGetDevice(&dev) != hipSuccess || hipDeviceGetAttribute(&cus, hipDeviceAttributeMultiprocessorCount, dev) != hipSuccess) { grid = -1; return; }
        if (hipFuncSetAttribute((const void*)mega_fwd, hipFuncAttributeMaxDynamicSharedMemorySize, LDS_BYTES) != hipSuccess) { fprintf(stderr, "kernel_launch: hipFuncSetAttribute failed\n"); grid = -1; return; }
        int per_cu = 0;
        if (hipOccupancyMaxActiveBlocksPerMultiprocessor(&per_cu, (const void*)mega_fwd, NWAVES * 64, LDS_BYTES) != hipSuccess || per_cu < 1) { fprintf(stderr, "kernel_launch: occupancy query says %d\n", per_cu); }
        (void)hipGetLastError();
        grid = cus > 256 ? 256 : cus;
    }
    if (grid < 0) return;
    (void)hipMemsetAsync((char*)d_ws + WS_CTL, 0, CTL_ZERO_BYTES, stream);
    Args a{};
    a.x = (const float*)d_in[0]; a.ln_emb_g = (const float*)d_in[1]; a.ln_emb_b = (const float*)d_in[2]; a.w_in = (const float*)d_in[3]; a.q_norm_g = (const float*)d_in[4]; a.kv_norm_g = (const float*)d_in[5];
    a.w_uq = (const float*)d_in[6]; a.w_ukv = (const float*)d_in[7]; a.beta_mla = (const float*)d_in[8]; a.beta_moba = (const float*)d_in[9]; a.w_o = (const float*)d_in[10]; a.ln1_g = (const float*)d_in[11]; a.ln1_b = (const float*)d_in[12];
    a.ffn_w_gate = (const float*)d_in[13]; a.ffn_w_up = (const float*)d_in[14]; a.ffn_w_down = (const float*)d_in[15]; a.router = (const float*)d_in[16]; a.exp_w_gate = (const float*)d_in[17]; a.exp_w_up = (const float*)d_in[18];
    a.exp_w_down = (const float*)d_in[19]; a.ln2_g = (const float*)d_in[20]; a.ln2_b = (const float*)d_in[21];
    a.out = (float*)d_out; a.ws = (unsigned char*)d_ws;
#if MK_ONE_LAUNCH
    a.ph_lo = 0; a.ph_hi = NPHASE;
    hipLaunchKernelGGL(mega_fwd, dim3(grid), dim3(NWAVES * 64), LDS_BYTES, stream, a);
#else
    for (int p = 0; p < NPHASE; ++p) { a.ph_lo = p; a.ph_hi = p + 1; hipLaunchKernelGGL(mega_fwd, dim3(grid), dim3(NWAVES * 64), LDS_BYTES, stream, a); }
#endif
}
```

```cpp
#include <hip/hip_runtime.h>
#include <cstdio>
#include <cstdint>
#include <cmath>

#ifndef MK_ONE_LAUNCH
#define MK_ONE_LAUNCH 1
#endif

#define LAS __attribute__((address_space(3)))
#define GAS __attribute__((address_space(1)))
typedef _Float16 f16;
typedef _Float16 f16x2 __attribute__((ext_vector_type(2)));
typedef _Float16 f16x4 __attribute__((ext_vector_type(4)));
typedef _Float16 f16x8 __attribute__((ext_vector_type(8)));
typedef float f32x2 __attribute__((ext_vector_type(2)));
typedef float f32x4 __attribute__((ext_vector_type(4)));
typedef unsigned u32x2 __attribute__((ext_vector_type(2)));
typedef unsigned u32x4 __attribute__((ext_vector_type(4)));
typedef GAS unsigned gu32;

constexpr int BATCH = 16, SEQ = 2048, T = BATCH * SEQ, D = 1024;
constexpr int HW = 2816;
constexpr int HC_CQ = 0, HC_CKV = 256, HC_KR = 384, HC_RQ = 416, HC_RK = 736, HC_RV = 1056, HC_RG = 1376, HC_MQ = 1696, HC_MK = 2016, HC_MV = 2336, HC_END = 2656;
constexpr int QW = 768, KVW = 768;
constexpr int OC_RET = 384, OC_MOBA = 704;
constexpr int FF = 2816, FE = 3584, NE = 8;
constexpr float LN_EPS = 1e-5f, RMS_EPS = 1e-6f;
constexpr float DN_ALPHA = 1.41421356237f;
constexpr float LOG2E = 1.4426950408889634f;
constexpr int MOE_CHUNK = 64, MOE_NCHUNK = 5, MOE_MAXP = 264;

constexpr size_t MiB = 1u << 20;
constexpr size_t WS_CTL = 0, CTL_ZERO_BYTES = 256 * 1024;
constexpr size_t WS_ROPE = 256 * 1024;
constexpr size_t WS_SSQ_Q = 1 * MiB;
constexpr size_t WS_SSQ_KV = WS_SSQ_Q + (size_t)T * 16;
constexpr size_t WS_SSQ_O = 2 * MiB;
constexpr size_t WS_KMEAN = 4 * MiB;
constexpr size_t WS_TOPI = WS_KMEAN + 256 * 1024;
constexpr size_t WS_TOPW = WS_TOPI + (size_t)T * 8;
constexpr size_t WS_CNT = WS_TOPW + (size_t)T * 8;
constexpr size_t WS_ROWTOK = WS_CNT + 8192;
constexpr size_t WS_ROWW = WS_ROWTOK + (size_t)MOE_MAXP * 256 * 4;
constexpr size_t WS_PANE = WS_ROWW + (size_t)MOE_MAXP * 256 * 4;
constexpr size_t WS_WIN = 6 * MiB;
constexpr size_t WS_WUQ = 17 * MiB;
constexpr size_t WS_WUKV = 18 * MiB;
constexpr size_t WS_WO = 19 * MiB;
constexpr size_t WS_WGU = 23 * MiB;
constexpr size_t WS_WDN = 34 * MiB;
constexpr size_t WS_EGU = 40 * MiB;
constexpr size_t WS_EDN = 152 * MiB;
constexpr size_t WS_XB = 208 * MiB;
constexpr size_t WS_H = 272 * MiB;
constexpr size_t WS_O = 448 * MiB;
constexpr size_t WS_END = 512 * MiB;
static_assert(WS_PANE + (MOE_MAXP + 8) * 4 <= WS_WIN, "ws map");

constexpr int CW_TMO = 0, CW_BAR = 1024;

constexpr int RING_BYTES = 131072;
constexpr int MISC_OFF = RING_BYTES;
constexpr int LDS_BYTES = 147456;

__device__ __forceinline__ unsigned pk_f16(float lo, float hi) { f16x2 v = {(f16)lo, (f16)hi}; return __builtin_bit_cast(unsigned, v); }
template <int X> __device__ __forceinline__ float swz_xor(float v) { return __int_as_float(__builtin_amdgcn_ds_swizzle(__float_as_int(v), (X << 10) | 0x1f)); }
__device__ __forceinline__ float wave_sum(float v) {
    v += swz_xor<1>(v); v += swz_xor<2>(v); v += swz_xor<4>(v); v += swz_xor<8>(v); v += swz_xor<16>(v);
    const auto rr = __builtin_amdgcn_permlane32_swap(__float_as_uint(v), __float_as_uint(v), false, false);
    return __uint_as_float(rr[0]) + __uint_as_float(rr[1]);
}
__device__ __forceinline__ float silu_f(float x) { return x * __builtin_amdgcn_rcpf(1.f + __expf(-x)); }

#define XB_TMO      128
#define XB_XCNT(j)  (256  + 64 * (j))
#define XB_XSUB(j)  (1280 + 64 * (j))
#define XB_XGEN(j)  (2304 + 64 * (j))
#define XB_TOP      3328
#define XB_TOPGEN   3392
#define XCD_BAR_WORDS 3456
#define XB_SPIN_CAP (1u << 18)
__device__ __forceinline__ unsigned xb_ld(unsigned* p)              { return __hip_atomic_load(p, __ATOMIC_RELAXED, __HIP_MEMORY_SCOPE_AGENT); }
__device__ __forceinline__ unsigned xb_add(unsigned* p, unsigned v) { return __hip_atomic_fetch_add(p, v, __ATOMIC_RELAXED, __HIP_MEMORY_SCOPE_AGENT); }
__device__ __forceinline__ unsigned xb_xcc_id() { return (unsigned)__builtin_amdgcn_s_getreg((3 << 11) | 20) & 0xFu; }
#define XB_SPIN(cond, bar) do { unsigned _sp = 0; while (cond) { __builtin_amdgcn_s_sleep(1); \
    if ((++_sp & 255u) == 0u) { if (xb_ld(&(bar)[XB_TMO])) break; if (_sp > XB_SPIN_CAP) { atomicAdd(&(bar)[XB_TMO], 1u); break; } } } } while (0)
struct XcdBarrier { unsigned* bar; unsigned x; volatile LAS unsigned* st; };
__device__ __forceinline__ XcdBarrier xcd_barrier_post(unsigned* bar, volatile LAS unsigned* st) {
    XcdBarrier b; b.bar = bar; b.x = xb_xcc_id(); b.st = st;
    if (threadIdx.x == 0) (void)xb_add(&bar[XB_XCNT(b.x)], 1u);
    return b;
}
__device__ __forceinline__ void xcd_barrier_complete(unsigned* bar, unsigned x, unsigned& nloc, unsigned& nx) {
    const unsigned G = gridDim.x * gridDim.y * gridDim.z;
    unsigned sum, cnt, mine, sp = 0u;
    for (;;) {
        sum = 0u; cnt = 0u; mine = 0u;
#pragma unroll
        for (unsigned j = 0; j < 16; ++j) { const unsigned c = xb_ld(&bar[XB_XCNT(j)]); sum += c; cnt += (c > 0u) ? 1u : 0u; mine = (j == x) ? c : mine; }
        if (sum == G) break;
        __builtin_amdgcn_s_sleep(1);
        if ((++sp & 255u) == 0u) { if (xb_ld(&bar[XB_TMO])) break; if (sp > XB_SPIN_CAP) { atomicAdd(&bar[XB_TMO], 1u); break; } }
    }
    nloc = mine > 0u ? mine : 1u; nx = cnt > 0u ? cnt : 1u;
}
__device__ __forceinline__ void xcd_barrier(const XcdBarrier& b) {
    asm volatile("s_waitcnt vmcnt(0)" ::: "memory");
    __syncthreads();
    if (threadIdx.x == 0) {
        unsigned* bar = b.bar;
        __builtin_amdgcn_s_waitcnt(0);
        unsigned nloc = b.st[0], nx = b.st[1];
        if (nloc == 0u) { xcd_barrier_complete(bar, b.x, nloc, nx); b.st[0] = nloc; b.st[1] = nx; }
        const unsigned old = xb_add(&bar[XB_XSUB(b.x)], 1u);
        const unsigned gen = old / nloc;
        if (old + 1u == (gen + 1u) * nloc) {
            __builtin_amdgcn_fence(__ATOMIC_RELEASE, "agent");
            asm volatile("s_waitcnt vmcnt(0)" ::: "memory");
            const unsigned og = xb_add(&bar[XB_TOP], 1u);
            const unsigned tg = og / nx;
            if (og + 1u == (tg + 1u) * nx) xb_add(&bar[XB_TOPGEN], 1u);
            else XB_SPIN(xb_ld(&bar[XB_TOPGEN]) == tg, bar);
            __builtin_amdgcn_fence(__ATOMIC_ACQUIRE, "agent");
            xb_add(&bar[XB_XGEN(b.x)], 1u);
            asm volatile("s_waitcnt vmcnt(0)" ::: "memory");
        } else {
            XB_SPIN(xb_ld(&bar[XB_XGEN(b.x)]) == gen, bar);
            __builtin_amdgcn_fence(__ATOMIC_ACQUIRE, "agent");
            asm volatile("s_waitcnt vmcnt(0)" ::: "memory");
        }
    }
    __syncthreads();
}

namespace pg8 {
constexpr int BM = 256, BK = 64, HALF = 128, HTB = HALF * BK * 2, STAGE_BYTES = 8 * HTB, NXCD = 8, WGM = 8;
__host__ __device__ __forceinline__ int lds_byte(int r, int c) { const int st = (r >> 4) * 2 + (c >> 5), rr = r & 15, cc = c & 31, ob = rr * 64 + cc * 2; return st * 1024 + (ob ^ (((ob >> 9) & 1) << 5)); }
__host__ __device__ __forceinline__ void stage_rc(int b, int& R, int& C) { const int st = b / 1024, sb = b % 1024, swz = sb ^ (((sb >> 9) & 1) << 5); R = (st >> 1) * 16 + swz / 64; C = (st & 1) * 32 + (swz % 64) / 2; }
__host__ __device__ __forceinline__ int perm32(int rho) { const int n = rho >> 4, i = rho & 15; return 8 * (i >> 2) + 4 * n + (i & 3); }

struct Unit { int pm, pn; };
struct Gemm { const f16* A; int lda; const f16* Bt; int ldb; int K; };

struct StaticOrder {
    static constexpr bool GATHER = false;
    int nM, nN, nwg, G, c, pm0;
    __device__ void init(int nM_, int nN_, int G_, int c_, int pm0_ = 0) { nM = nM_; nN = nN_; nwg = nM * nN; G = G_; c = c_; pm0 = pm0_; }
    __device__ bool next(int i, Unit& u) const {
        const long L = (long)i * G + c; if (L >= nwg) return false;
        int wgid = (int)L; { const int q = nwg / NXCD, r = nwg % NXCD, xcd = wgid % NXCD, off = wgid / NXCD; wgid = (xcd < r ? xcd * (q + 1) : r * (q + 1) + (xcd - r) * q) + off; }
        const int nig = WGM * nN, gid = wgid / nig, fm = gid * WGM, gsz = (nM - fm) < WGM ? (nM - fm) : WGM;
        u.pm = pm0 + fm + ((wgid % nig) % gsz); u.pn = (wgid % nig) / gsz; return true;
    }
    __device__ __forceinline__ int a_row(const Unit& u, int r) const { return u.pm * BM + r; }
    __device__ __forceinline__ size_t b_base(const Unit&) const { return 0; }
};
struct MoeGather {
    static constexpr bool GATHER = true;
    StaticOrder so; const int* rowtok; const int* pane; size_t estride;
    __device__ bool next(int i, Unit& u) const { return so.next(i, u); }
    __device__ __forceinline__ int a_row(const Unit& u, int r) const { const int t = rowtok[u.pm * BM + r]; return t < 0 ? 0 : (t >> 1); }
    __device__ __forceinline__ size_t b_base(const Unit& u) const { return (size_t)pane[u.pm] * estride; }
};
struct MoeDense {
    static constexpr bool GATHER = false;
    StaticOrder so; const int* pane; size_t estride; int arow0;
    __device__ bool next(int i, Unit& u) const { return so.next(i, u); }
    __device__ __forceinline__ int a_row(const Unit& u, int r) const { return (u.pm - arow0) * BM + r; }
    __device__ __forceinline__ size_t b_base(const Unit& u) const { return (size_t)pane[u.pm] * estride; }
};

struct EpiF16 {
    static constexpr bool PERM = true;
    f16* O; int ldc;
    __device__ __forceinline__ void operator()(const f32x4 (&acc)[2][2][4][2], const Unit& u, int wr, int wc, int fr, int fq) const {
        const int row0 = u.pm * BM + wr * 64 + fr, col0 = u.pn * BM + wc * 32 + 8 * fq;
#pragma unroll
        for (int ai = 0; ai < 2; ++ai)
#pragma unroll
            for (int m = 0; m < 4; ++m) { f16* rowp = O + (size_t)(row0 + ai * HALF + m * 16) * ldc + col0;
#pragma unroll
                for (int bj = 0; bj < 2; ++bj) { const f32x4 v0 = acc[ai][bj][m][0], v1 = acc[ai][bj][m][1];
                    u32x4 w; w.x = pk_f16(v0[0], v0[1]); w.y = pk_f16(v0[2], v0[3]); w.z = pk_f16(v1[0], v1[1]); w.w = pk_f16(v1[2], v1[3]);
                    *(u32x4*)(rowp + bj * HALF) = w; } }
    }
};
struct EpiResF32 {
    static constexpr bool PERM = false;
    const f16* X; float* Y; int ldc; float alpha;
    __device__ __forceinline__ void operator()(const f32x4 (&acc)[2][2][4][2], const Unit& u, int wr, int wc, int fr, int fq) const {
        const int row0 = u.pm * BM + wr * 64 + fr, col0 = u.pn * BM + wc * 32 + 4 * fq;
#pragma unroll
        for (int ai = 0; ai < 2; ++ai)
#pragma unroll
            for (int m = 0; m < 4; ++m) { const size_t off = (size_t)(row0 + ai * HALF + m * 16) * ldc + col0;
#pragma unroll
                for (int bj = 0; bj < 2; ++bj)
#pragma unroll
                    for (int n = 0; n < 2; ++n) { const f16x4 xv = *(const f16x4*)(X + off + bj * HALF + n * 16); const f32x4 a = acc[ai][bj][m][n];
                        f32x4 o; o[0] = alpha * (float)xv[0] + a[0]; o[1] = alpha * (float)xv[1] + a[1]; o[2] = alpha * (float)xv[2] + a[2]; o[3] = alpha * (float)xv[3] + a[3];
                        *(f32x4*)(Y + off + bj * HALF + n * 16) = o; } }
    }
};
struct EpiSwiGLU {
    static constexpr bool PERM = true;
    f16* O; int ldc; int pm0;
    __device__ __forceinline__ void operator()(const f32x4 (&acc)[2][2][4][2], const Unit& u, int wr, int wc, int fr, int fq) const {
        const int row0 = (u.pm - pm0) * BM + wr * 64 + fr, col0 = u.pn * HALF + wc * 32 + 8 * fq;
#pragma unroll
        for (int ai = 0; ai < 2; ++ai)
#pragma unroll
            for (int m = 0; m < 4; ++m) { f16* rowp = O + (size_t)(row0 + ai * HALF + m * 16) * ldc + col0;
                float r[8];
#pragma unroll
                for (int n = 0; n < 2; ++n)
#pragma unroll
                    for (int e = 0; e < 4; ++e) r[n * 4 + e] = silu_f(acc[ai][0][m][n][e]) * acc[ai][1][m][n][e];
                u32x4 w; w.x = pk_f16(r[0], r[1]); w.y = pk_f16(r[2], r[3]); w.z = pk_f16(r[4], r[5]); w.w = pk_f16(r[6], r[7]);
                *(u32x4*)rowp = w; }
    }
};
struct EpiScatter {
    static constexpr bool PERM = true;
    f16* C0; size_t slot_stride; const int* rowtok; const float* roww;
    __device__ __forceinline__ void operator()(const f32x4 (&acc)[2][2][4][2], const Unit& u, int wr, int wc, int fr, int fq) const {
        const int row0 = u.pm * BM + wr * 64 + fr, col0 = u.pn * BM + wc * 32 + 8 * fq;
#pragma unroll
        for (int ai = 0; ai < 2; ++ai)
#pragma unroll
            for (int m = 0; m < 4; ++m) { const int prow = row0 + ai * HALF + m * 16; const int ts = rowtok[prow]; const float w = roww[prow];
                if (ts >= 0) { f16* rowp = C0 + (size_t)(ts & 1) * slot_stride + (size_t)(ts >> 1) * D + col0;
#pragma unroll
                    for (int bj = 0; bj < 2; ++bj) { const f32x4 v0 = acc[ai][bj][m][0] * w, v1 = acc[ai][bj][m][1] * w;
                        u32x4 o; o.x = pk_f16(v0[0], v0[1]); o.y = pk_f16(v0[2], v0[3]); o.z = pk_f16(v1[0], v1[1]); o.w = pk_f16(v1[2], v1[3]);
                        *(u32x4*)(rowp + bj * HALF) = o; } } }
    }
};

template <class Sched>
__device__ __forceinline__ void a_offsets(const Sched& S, const Unit& u, int lda, int tid, unsigned (&ao)[2][2]) {
#pragma unroll
    for (int h = 0; h < 2; ++h)
#pragma unroll
        for (int i = 0; i < 2; ++i) { int R, C; stage_rc(tid * 16 + i * 8192, R, C); ao[h][i] = ((unsigned)S.a_row(u, h * HALF + R) * (unsigned)lda + (unsigned)C) * 2u; }
}

template <class Epi, class Sched, bool ALIGN_EPI>
__device__ __forceinline__ void gemm_phase(LAS unsigned char* lds, const Gemm g, const Sched& S, const Epi& E) {
    constexpr bool GATHER = Sched::GATHER;
    int tid_ = threadIdx.x; asm volatile("" : "+v"(tid_));
    const int tid = tid_, wid = __builtin_amdgcn_readfirstlane(tid >> 6), lane = tid & 63, wr = wid >> 2, wc = wid & 3, fr = lane & 15, fq = lane >> 4;
    const int K = g.K, nt = K / BK;
    unsigned voffB[2], voffA[2];
#pragma unroll
    for (int i = 0; i < 2; ++i) { int R, C; stage_rc(tid * 16 + i * 8192, R, C); const int Rb = Epi::PERM ? ((R & ~31) + perm32(R & 31)) : R; voffB[i] = (unsigned)(Rb * g.ldb + C) * 2u; voffA[i] = (unsigned)(R * g.lda + C) * 2u; }
    const size_t kstep = (size_t)(BK * 2);
    const size_t hstepB = (size_t)HALF * g.ldb * 2, tstepB = 2 * hstepB;
    const size_t hstepA = (size_t)HALF * g.lda * 2;
    const unsigned ldsw = (unsigned)wid * 1024u;
    const int aoff = lds_byte(wr * 64 + fr, fq * 8), boff = lds_byte(wc * 32 + fr, fq * 8);
#define PG8_SA(b, h) (((b) * 2 + (h)) * HTB)
#define PG8_SB(b, h) ((4 + (b) * 2 + (h)) * HTB)
#define PG8_STAGEB(bufoff, gbase) do { _Pragma("unroll") for (int _i = 0; _i < 2; ++_i) \
        __builtin_amdgcn_global_load_lds((const unsigned*)((const char*)(gbase) + voffB[_i]), (LAS unsigned*)(lds + (bufoff) + ldsw + _i * 8192), 16, 0, 0); } while (0)
#define PG8_STAGEA(bufoff, ub, kb, h) do { _Pragma("unroll") for (int _i = 0; _i < 2; ++_i) \
        __builtin_amdgcn_global_load_lds((const unsigned*)((ub) + (kb) + (GATHER ? (size_t)0 : (size_t)(h) * hstepA) + (GATHER ? cao[h][_i] : voffA[_i])), (LAS unsigned*)(lds + (bufoff) + ldsw + _i * 8192), 16, 0, 0); } while (0)
#define PG8_LDA(dst, b, h) do { _Pragma("unroll") for (int m = 0; m < 4; ++m) _Pragma("unroll") for (int k = 0; k < 2; ++k) dst[m][k] = *(const LAS f16x8*)(lds + PG8_SA(b, h) + aoff + m * 2048 + k * 1024); } while (0)
#define PG8_LDB(dst, b, h) do { _Pragma("unroll") for (int n = 0; n < 2; ++n) _Pragma("unroll") for (int k = 0; k < 2; ++k) dst[n][k] = *(const LAS f16x8*)(lds + PG8_SB(b, h) + boff + n * 2048 + k * 1024); } while (0)
#define PG8_MMA(ai, bj, At, Bt) do { __builtin_amdgcn_s_setprio(1); _Pragma("unroll") for (int m = 0; m < 4; ++m) _Pragma("unroll") for (int n = 0; n < 2; ++n) _Pragma("unroll") for (int k = 0; k < 2; ++k) \
        acc[ai][bj][m][n] = __builtin_amdgcn_mfma_f32_16x16x32_f16(Bt[n][k], At[m][k], acc[ai][bj][m][n], 0, 0, 0); __builtin_amdgcn_s_setprio(0); } while (0)
#define PG8_WAIT_V(n) asm volatile("s_waitcnt vmcnt(" #n ")" ::: "memory")
#define PG8_WAIT_L(n) asm volatile("s_waitcnt lgkmcnt(" #n ")" ::: "memory")
#define PG8_BAR __builtin_amdgcn_s_barrier()
#define PG8_SCHED __builtin_amdgcn_sched_barrier(0)
    Unit cur, nxt; int ui = 0;
    if (!S.next(0, cur)) return;
    f32x4 acc[2][2][4][2];
#pragma unroll
    for (int a = 0; a < 2; ++a)
#pragma unroll
        for (int b = 0; b < 2; ++b)
#pragma unroll
            for (int m = 0; m < 4; ++m)
#pragma unroll
                for (int n = 0; n < 2; ++n) acc[a][b][m][n] = (f32x4){0.f, 0.f, 0.f, 0.f};
    f16x8 At[4][2], B0[2][2], B1[2][2];
    unsigned cao[2][2];
    if constexpr (GATHER) a_offsets(S, cur, g.lda, tid, cao);
    const char* cA = (const char*)g.A + (GATHER ? (size_t)0 : (size_t)S.a_row(cur, 0) * g.lda * 2);
    const char* cB = (const char*)g.Bt + S.b_base(cur) + (size_t)cur.pn * tstepB;
    PG8_STAGEB(PG8_SB(0, 0), cB); PG8_STAGEB(PG8_SB(0, 1), cB + hstepB); PG8_STAGEA(PG8_SA(0, 0), cA, 0, 0); PG8_STAGEA(PG8_SA(0, 1), cA, 0, 1);
    if (wr == 1) PG8_BAR;
    PG8_WAIT_V(2); PG8_BAR;
    PG8_STAGEB(PG8_SB(1, 0), cB + kstep); PG8_STAGEA(PG8_SA(1, 0), cA, kstep, 0); PG8_STAGEB(PG8_SB(1, 1), cB + hstepB + kstep);
    PG8_WAIT_V(6); PG8_BAR;
    for (;;) {
        const bool has_next = S.next(ui + 1, nxt);
        const char* nB = cB; const char* nA = cA;
        if (has_next) { nB = (const char*)g.Bt + S.b_base(nxt) + (size_t)nxt.pn * tstepB; nA = (const char*)g.A + (GATHER ? (size_t)0 : (size_t)S.a_row(nxt, 0) * g.lda * 2); }
        for (int t = 0; t < nt; t += 2) {
            const bool last = (t == nt - 2);
            const size_t ka1 = (size_t)(t + 1) * kstep;
            const size_t ka2 = last ? 0 : (size_t)(t + 2) * kstep, ka3 = ka2 + kstep;
            const char* a2 = last ? nA : cA;
            const char* b2 = last ? nB : cB + (size_t)(t + 2) * kstep; const char* b3 = b2 + kstep;
            PG8_LDB(B0, 0, 0); PG8_LDB(B1, 0, 1); PG8_SCHED; PG8_LDA(At, 0, 0); PG8_STAGEA(PG8_SA(1, 1), cA, ka1, 1);
            if constexpr (GATHER) { if (last && has_next) a_offsets(S, nxt, g.lda, tid, cao); }
            PG8_WAIT_V(8); PG8_WAIT_L(0); PG8_BAR; PG8_MMA(0, 0, At, B0); PG8_MMA(0, 1, At, B1); PG8_BAR; PG8_SCHED;
            PG8_LDA(At, 0, 1); PG8_STAGEB(PG8_SB(0, 0), b2); PG8_STAGEB(PG8_SB(0, 1), b2 + hstepB); PG8_STAGEA(PG8_SA(0, 0), a2, ka2, 0);
            PG8_WAIT_V(8); PG8_WAIT_L(0); PG8_BAR; PG8_MMA(1, 0, At, B0); PG8_MMA(1, 1, At, B1); PG8_BAR; PG8_SCHED;
            PG8_LDB(B0, 1, 0); PG8_LDB(B1, 1, 1); PG8_SCHED; PG8_LDA(At, 1, 0); PG8_STAGEA(PG8_SA(0, 1), a2, ka2, 1);
            PG8_WAIT_V(8); PG8_WAIT_L(0); PG8_BAR; PG8_MMA(0, 0, At, B0); PG8_MMA(0, 1, At, B1); PG8_BAR; PG8_SCHED;
            PG8_LDA(At, 1, 1); PG8_STAGEB(PG8_SB(1, 0), b3); PG8_STAGEB(PG8_SB(1, 1), b3 + hstepB); PG8_STAGEA(PG8_SA(1, 0), a2, ka3, 0);
            PG8_WAIT_V(8); PG8_WAIT_L(0); PG8_BAR; PG8_MMA(1, 0, At, B0); PG8_MMA(1, 1, At, B1); PG8_BAR; PG8_SCHED;
        }
        if constexpr (ALIGN_EPI) { if (wr == 0) PG8_BAR; }
        { int t2 = threadIdx.x; asm volatile("" : "+v"(t2)); const int l2 = t2 & 63; E(acc, cur, wr, wc, l2 & 15, l2 >> 4); }
        if (!has_next) break;
#pragma unroll
        for (int a = 0; a < 2; ++a)
#pragma unroll
            for (int b = 0; b < 2; ++b)
#pragma unroll
                for (int m = 0; m < 4; ++m)
#pragma unroll
                    for (int n = 0; n < 2; ++n) acc[a][b][m][n] = (f32x4){0.f, 0.f, 0.f, 0.f};
        cur = nxt; cB = nB; cA = nA; ++ui;
        if constexpr (ALIGN_EPI) { if (wr == 1) PG8_BAR; }
    }
    PG8_WAIT_V(0);
    if constexpr (!ALIGN_EPI) { if (wr == 0) PG8_BAR; }
    PG8_BAR;
#undef PG8_SA
#undef PG8_SB
#undef PG8_STAGEA
#undef PG8_STAGEB
#undef PG8_LDA
#undef PG8_LDB
#undef PG8_MMA
#undef PG8_WAIT_V
#undef PG8_WAIT_L
#undef PG8_BAR
#undef PG8_SCHED
}
}

struct Args {
    const float* x; const float* ln_emb_g; const float* ln_emb_b; const float* w_in; const float* q_norm_g; const float* kv_norm_g;
    const float* w_uq; const float* w_ukv; const float* beta_mla; const float* beta_moba; const float* w_o; const float* ln1_g; const float* ln1_b;
    const float* ffn_w_gate; const float* ffn_w_up; const float* ffn_w_down; const float* router; const float* exp_w_gate; const float* exp_w_up;
    const float* exp_w_down; const float* ln2_g; const float* ln2_b;
    float* out; unsigned char* ws; int ph_lo, ph_hi;
};
struct Frame {
    LAS unsigned char* lds; int tid, lane, wave, bid, G;
};

enum { CM_ID = 0, CM_WIN = 1, CM_UQ = 2, CM_UKV = 3, CM_GU = 4 };
__device__ __forceinline__ int colmap(int kind, int n, int aux) {
    switch (kind) {
    case CM_WIN: {
        if (n >= HC_END) return -1;
        if (n >= HC_RQ && n < HC_RV) { const int base = n < HC_RK ? HC_RQ : HC_RK, r = n - base, hh = r >> 6, p = r & 63; const int d = ((p >> 5) << 4) + (p & 15) + ((p & 16) ? 32 : 0); return base + hh * 64 + d; }
        return n; }
    case CM_UQ: {
        if (n < 384) return (n >> 6) * 96 + (n & 63);
        if (n < 576) { const int r = n - 384; return (r >> 5) * 96 + 64 + (r & 31); }
        return -1; }
    case CM_UKV: {
        if (n < 384) return (n >> 6) * 128 + (n & 63);
        { const int r = n - 384; return (r >> 6) * 128 + 64 + (r & 63); } }
    case CM_GU: {
        const int j = n >> 8, w = n & 255; return j * 128 + (w & 127) + ((w >> 7) ? aux : 0); }
    default: return n;
    }
}
__device__ __forceinline__ void transpose_item(const float* W0, const float* W1, int K, int N, f16* WT, int kind, const float* kscale, const float* kscale2, LAS float* scr, int item, int nblk, int lane) {
    const int kb = item / nblk, nb = item % nblk, k0 = 64 * kb, n0 = 32 * nb;
    const int nn = lane & 31; int sc = colmap(kind, n0 + nn, N); const float* W = W0;
    if (kind == CM_GU && sc >= N) { sc -= N; W = W1; }
#pragma unroll 8
    for (int i = 0; i < 32; ++i) { const int kk = 2 * i + (lane >> 5); float v = 0.f; if (sc >= 0) v = W[(size_t)(k0 + kk) * N + sc]; if (kscale2) { const int k = k0 + kk; v *= k < 384 ? kscale[k] : (k >= 704 ? kscale2[k - 704] : 1.0f); } else if (kscale) v *= kscale[k0 + kk]; scr[kk * 33 + nn] = v; }
    asm volatile("s_waitcnt lgkmcnt(0)" ::: "memory");
    const int c = lane & 7;
#pragma unroll
    for (int j = 0; j < 4; ++j) { const int n = (lane >> 3) + 8 * j; const LAS float* s = scr + (8 * c) * 33 + n;
        u32x4 o; o.x = pk_f16(s[0 * 33], s[1 * 33]); o.y = pk_f16(s[2 * 33], s[3 * 33]); o.z = pk_f16(s[4 * 33], s[5 * 33]); o.w = pk_f16(s[6 * 33], s[7 * 33]);
        *(u32x4*)(WT + (size_t)(n0 + n) * K + k0 + 8 * c) = o; }
    asm volatile("s_waitcnt lgkmcnt(0)" ::: "memory");
}

__device__ __forceinline__ void ln_stats(const f32x4 (&v)[4], float& mean, float& rstd) {
    float s = 0.f;
#pragma unroll
    for (int j = 0; j < 4; ++j) s += (v[j][0] + v[j][1]) + (v[j][2] + v[j][3]);
    mean = wave_sum(s) * (1.f / D); float s2 = 0.f;
#pragma unroll
    for (int j = 0; j < 4; ++j) { const f32x4 d = v[j] - mean; s2 += (d[0] * d[0] + d[1] * d[1]) + (d[2] * d[2] + d[3] * d[3]); }
    rstd = 1.0f / sqrtf(wave_sum(s2) * (1.f / D) + LN_EPS);
}

template <int DK>
__device__ __forceinline__ void stage_kv(LAS float* Ks, LAS float* Vs, const f16* kp, int kld, const f16* k2p, int k2ld, const f16* vp, int vld, size_t row0, int tid) {
    constexpr int KCH = DK / 8;
    for (int t = tid; t < 32 * KCH + 32 * 8; t += 512) {
        if (t < 32 * KCH) { const int key = t / KCH, ch = t % KCH; const f16* src = (ch < 8) ? kp + (row0 + key) * kld + ch * 8 : k2p + (row0 + key) * k2ld + (ch - 8) * 8;
            const f16x8 v = *(const f16x8*)src; LAS float* d = Ks + key * DK + ch * 8;
#pragma unroll
            for (int e = 0; e < 8; ++e) d[e] = (float)v[e]; }
        else { const int t2 = t - 32 * KCH, key = t2 >> 3, ch = t2 & 7; const f16x8 v = *(const f16x8*)(vp + (row0 + key) * vld + ch * 8); LAS float* d = Vs + key * 64 + ch * 8;
#pragma unroll
            for (int e = 0; e < 8; ++e) d[e] = (float)v[e]; }
    }
}

template <int MODE>
__device__ __forceinline__ void attn_softmax_simple(const Frame& F, const f16* qb, const f16* kvb, const f16* hb, const float* kmean, f16* ob, float* ssq_o) {
    constexpr int DK = MODE == 0 ? 96 : 64, NHD = MODE == 0 ? 6 : 5;
    LAS float* Ks = (LAS float*)F.lds; LAS float* Vs = Ks + 32 * DK; LAS float* KM = Vs + 32 * 64;
    const int tid = F.tid;
    for (int unit = F.bid; unit < BATCH * NHD * 4; unit += F.G) {
        const int qt = 3 - (unit % 4), hh = (unit / 4) % NHD, b = unit / (4 * NHD);
        const size_t brow = (size_t)b * SEQ; const int qpos = qt * 512 + tid; const size_t row = brow + qpos;
        float q[DK];
        if (MODE == 0) {
#pragma unroll
            for (int c = 0; c < 8; ++c) { const f16x8 v = *(const f16x8*)(qb + row * QW + hh * 64 + c * 8);
#pragma unroll
                for (int e = 0; e < 8; ++e) q[c * 8 + e] = (float)v[e]; }
#pragma unroll
            for (int c = 0; c < 4; ++c) { const f16x8 v = *(const f16x8*)(qb + row * QW + 384 + hh * 32 + c * 8);
#pragma unroll
                for (int e = 0; e < 8; ++e) q[64 + c * 8 + e] = (float)v[e]; }
        } else {
#pragma unroll
            for (int c = 0; c < 8; ++c) { const f16x8 v = *(const f16x8*)(hb + row * HW + HC_MQ + hh * 64 + c * 8);
#pragma unroll
                for (int e = 0; e < 8; ++e) q[c * 8 + e] = (float)v[e]; }
        }
        const int blk = qpos >> 8; unsigned sel = 0u; float slope2 = 0.f;
        if (MODE == 1) {
            __syncthreads();
            { const int n = tid >> 6, d = tid & 63; KM[n * 64 + d] = kmean[(size_t)(b * 8 + n) * 320 + hh * 64 + d]; }
            __syncthreads();
            float gt[8];
#pragma unroll
            for (int n = 0; n < 8; ++n) { float s = 0.f;
#pragma unroll
                for (int d = 0; d < 64; ++d) s += q[d] * KM[n * 64 + d];
                gt[n] = s; }
#pragma unroll
            for (int n = 0; n < 8; ++n) { int rank = 0;
#pragma unroll
                for (int m = 0; m < 8; ++m) if (m < blk && m != n) rank += (gt[m] > gt[n] || (gt[m] == gt[n] && m < n)) ? 1 : 0;
                if (n < blk && rank < 3) sel |= 1u << n; }
            slope2 = exp2f(-8.0f * (float)(hh + 1) / 5.0f) * LOG2E;
        }
        float o[64];
#pragma unroll
        for (int d = 0; d < 64; ++d) o[d] = 0.f;
        float mrun = -INFINITY, lrun = 0.f;
        const int nkeys = (qt + 1) * 512;
        for (int k0 = 0; k0 < nkeys; k0 += 32) {
            __syncthreads();
            if (MODE == 0) stage_kv<96>(Ks, Vs, kvb + hh * 64, KVW, hb + HC_KR, HW, kvb + 384 + hh * 64, KVW, brow + k0, tid);
            else stage_kv<64>(Ks, Vs, hb + HC_MK + hh * 64, HW, nullptr, 0, hb + HC_MV + hh * 64, HW, brow + k0, tid);
            __syncthreads();
            bool part;
            if (MODE == 0) part = k0 <= qpos;
            else { const int n = k0 >> 8; part = (n == blk) ? (k0 <= qpos) : (n < blk && ((sel >> n) & 1u)); }
            if (part) {
#pragma unroll 1
                for (int j = 0; j < 32; ++j) {
                    if (k0 + j > qpos) break;
                    const LAS float* Kj = Ks + j * DK; const LAS float* Vj = Vs + j * 64;
                    float a = 0.f;
#pragma unroll
                    for (int d = 0; d < DK; d += 4) { const f32x4 kv4 = *(const LAS f32x4*)(Kj + d); a += q[d] * kv4[0] + q[d + 1] * kv4[1] + q[d + 2] * kv4[2] + q[d + 3] * kv4[3]; }
                    if (MODE == 1) a -= slope2 * (float)(qpos - (k0 + j));
                    if (a > mrun) { const float alpha = exp2f(mrun - a); lrun *= alpha;
#pragma unroll
                        for (int d = 0; d < 64; ++d) o[d] *= alpha;
                        mrun = a; }
                    const float p = exp2f(a - mrun); lrun += p;
#pragma unroll
                    for (int d = 0; d < 64; d += 4) { const f32x4 v4 = *(const LAS f32x4*)(Vj + d); o[d] += p * v4[0]; o[d + 1] += p * v4[1]; o[d + 2] += p * v4[2]; o[d + 3] += p * v4[3]; }
                }
            }
        }
        const float inv = 1.0f / lrun; float ss = 0.f;
#pragma unroll
        for (int d = 0; d < 64; ++d) { o[d] *= inv; ss += o[d] * o[d]; }
        f16* op = ob + row * D + (MODE == 0 ? 0 : OC_MOBA) + hh * 64;
#pragma unroll
        for (int c = 0; c < 8; ++c) { u32x4 w; w.x = pk_f16(o[c * 8], o[c * 8 + 1]); w.y = pk_f16(o[c * 8 + 2], o[c * 8 + 3]); w.z = pk_f16(o[c * 8 + 4], o[c * 8 + 5]); w.w = pk_f16(o[c * 8 + 6], o[c * 8 + 7]); *(u32x4*)(op + c * 8) = w; }
        ssq_o[row * 16 + (MODE == 0 ? 0 : 6) + hh] = ss;
    }
}
__device__ __forceinline__ void attn_ret_simple(const Frame& F, const f16* hb, f16* ob) {
    LAS float* Ks = (LAS float*)F.lds; LAS float* Vs = Ks + 32 * 64;
    const int tid = F.tid;
    for (int unit = F.bid; unit < BATCH * 5 * 4; unit += F.G) {
        const int qt = 3 - (unit % 4), hh = (unit / 4) % 5, b = unit / 20;
        const size_t brow = (size_t)b * SEQ; const int qpos = qt * 512 + tid; const size_t row = brow + qpos;
        float q[64];
#pragma unroll
        for (int c = 0; c < 8; ++c) { const f16x8 v = *(const f16x8*)(hb + row * HW + HC_RQ + hh * 64 + c * 8);
#pragma unroll
            for (int e = 0; e < 8; ++e) q[c * 8 + e] = (float)v[e]; }
        const float lg2 = log2f(1.0f - exp2f(-5.0f - (float)hh));
        float o[64];
#pragma unroll
        for (int d = 0; d < 64; ++d) o[d] = 0.f;
        const int nkeys = (qt + 1) * 512;
        for (int k0 = 0; k0 < nkeys; k0 += 32) {
            __syncthreads();
            stage_kv<64>(Ks, Vs, hb + HC_RK + hh * 64, HW, nullptr, 0, hb + HC_RV + hh * 64, HW, brow + k0, tid);
            __syncthreads();
            if (k0 <= qpos) {
#pragma unroll 1
                for (int j = 0; j < 32; ++j) {
                    const int dl = qpos - (k0 + j); if (dl < 0) break;
                    const LAS float* Kj = Ks + j * 64; const LAS float* Vj = Vs + j * 64;
                    float a = 0.f;
#pragma unroll
                    for (int d = 0; d < 64; d += 4) { const f32x4 kv4 = *(const LAS f32x4*)(Kj + d); a += q[d] * kv4[0] + q[d + 1] * kv4[1] + q[d + 2] * kv4[2] + q[d + 3] * kv4[3]; }
                    const float p = a * exp2f(lg2 * (float)dl);
#pragma unroll
                    for (int d = 0; d < 64; d += 4) { const f32x4 v4 = *(const LAS f32x4*)(Vj + d); o[d] += p * v4[0]; o[d + 1] += p * v4[1]; o[d + 2] += p * v4[2]; o[d + 3] += p * v4[3]; }
                }
            }
        }
        float mu = 0.f;
#pragma unroll
        for (int d = 0; d < 64; ++d) mu += o[d];
        mu *= (1.f / 64.f); float var = 0.f;
#pragma unroll
        for (int d = 0; d < 64; ++d) { const float t = o[d] - mu; var += t * t; }
        const float rs = 1.0f / sqrtf(var * (1.f / 64.f) + RMS_EPS);
        f16* op = ob + row * D + OC_RET + hh * 64; const f16* gp = hb + row * HW + HC_RG + hh * 64;
#pragma unroll
        for (int c = 0; c < 8; ++c) { const f16x8 gv = *(const f16x8*)(gp + c * 8); float r[8];
#pragma unroll
            for (int e = 0; e < 8; ++e) r[e] = silu_f((float)gv[e]) * ((o[c * 8 + e] - mu) * rs);
            u32x4 w; w.x = pk_f16(r[0], r[1]); w.y = pk_f16(r[2], r[3]); w.z = pk_f16(r[4], r[5]); w.w = pk_f16(r[6], r[7]); *(u32x4*)(op + c * 8) = w; }
    }
}

constexpr int NWAVES = 8;
constexpr int PH_L0 = 1, PPL0 = 11, PH_L1 = PH_L0 + PPL0, PPL1 = 20, NPHASE = PH_L1 + PPL1;
typedef const __attribute__((address_space(4))) Args* KArgs;
__device__ __forceinline__ KArgs kargs() { KArgs p = (KArgs)__builtin_amdgcn_kernarg_segment_ptr(); asm volatile("" : "+s"(p)); return p; }
__device__ __forceinline__ Frame mkframe() {
    extern __shared__ __attribute__((aligned(16))) unsigned char lds_raw[];
    Frame F; F.lds = (LAS unsigned char*)lds_raw; int t = threadIdx.x; asm volatile("" : "+v"(t)); F.tid = t; F.lane = t & 63; F.wave = __builtin_amdgcn_readfirstlane(t >> 6); F.bid = blockIdx.x; F.G = gridDim.x; return F;
}
#define WSP(T_, off) ((T_*)(ws + (off)))

__device__ __forceinline__ void ph_prologue() {
    const Frame F = mkframe(); KArgs a = kargs(); unsigned char* ws = a->ws;
    const int gw = F.bid * NWAVES + F.wave, NGW = F.G * NWAVES;
    f16* Win = WSP(f16, WS_WIN); f16* Wuq = WSP(f16, WS_WUQ); f16* Wukv = WSP(f16, WS_WUKV); f16* Wo = WSP(f16, WS_WO); f16* Wgu = WSP(f16, WS_WGU); f16* Wdn = WSP(f16, WS_WDN);
    f16* Egu = WSP(f16, WS_EGU); f16* Edn = WSP(f16, WS_EDN); f16* xb = WSP(f16, WS_XB);
    float* cosA = WSP(float, WS_ROPE); float* sinA = cosA + SEQ * 16; float* cosB = sinA + SEQ * 16; float* sinB = cosB + SEQ * 32;
    LAS float* scr = (LAS float*)(F.lds + F.wave * 16384);
    constexpr int I_WIN = (D / 64) * (HW / 32), I_UQ = (256 / 64) * (768 / 32), I_UKV = (128 / 64) * (768 / 32), I_WO = (D / 64) * (D / 32);
    constexpr int I_GU = (D / 64) * (2 * FF / 32), I_DN = (FF / 64) * (D / 32), I_EGU = (D / 64) * (2 * FE / 32), I_EDN = (FE / 64) * (D / 32);
    constexpr int N_SMALL = 2 * (I_WIN + I_UQ + I_UKV + I_WO) + I_GU + I_DN, N_ALL = N_SMALL + NE * (I_EGU + I_EDN);
    for (int it = gw; it < N_ALL; it += NGW) {
        int r = it;
        if (r < 2 * I_WIN) { const int l = r / I_WIN; r %= I_WIN; transpose_item(a->w_in + (size_t)l * D * HC_END, nullptr, D, HC_END, Win + (size_t)l * HW * D, CM_WIN, nullptr, nullptr, scr, r, HW / 32, F.lane); continue; } r -= 2 * I_WIN;
        if (r < 2 * I_UQ) { const int l = r / I_UQ; r %= I_UQ; transpose_item(a->w_uq + (size_t)l * 256 * 576, nullptr, 256, 576, Wuq + (size_t)l * 768 * 256, CM_UQ, a->q_norm_g + l * 256, nullptr, scr, r, 768 / 32, F.lane); continue; } r -= 2 * I_UQ;
        if (r < 2 * I_UKV) { const int l = r / I_UKV; r %= I_UKV; transpose_item(a->w_ukv + (size_t)l * 128 * 768, nullptr, 128, 768, Wukv + (size_t)l * 768 * 128, CM_UKV, a->kv_norm_g + l * 128, nullptr, scr, r, 768 / 32, F.lane); continue; } r -= 2 * I_UKV;
        if (r < 2 * I_WO) { const int l = r / I_WO; r %= I_WO; transpose_item(a->w_o + (size_t)l * D * D, nullptr, D, D, Wo + (size_t)l * D * D, CM_ID, a->beta_mla + l * 384, a->beta_moba + l * 320, scr, r, D / 32, F.lane); continue; } r -= 2 * I_WO;
        if (r < I_GU) { transpose_item(a->ffn_w_gate, a->ffn_w_up, D, FF, Wgu, CM_GU, nullptr, nullptr, scr, r, 2 * FF / 32, F.lane); continue; } r -= I_GU;
        if (r < I_DN) { transpose_item(a->ffn_w_down, nullptr, FF, D, Wdn, CM_ID, nullptr, nullptr, scr, r, D / 32, F.lane); continue; } r -= I_DN;
        { const int e = r / (I_EGU + I_EDN); r %= (I_EGU + I_EDN);
          if (r < I_EGU) transpose_item(a->exp_w_gate + (size_t)e * D * FE, a->exp_w_up + (size_t)e * D * FE, D, FE, Egu + (size_t)e * 2 * FE * D, CM_GU, nullptr, nullptr, scr, r, 2 * FE / 32, F.lane);
          else transpose_item(a->exp_w_down + (size_t)e * FE * D, nullptr, FE, D, Edn + (size_t)e * D * FE, CM_ID, nullptr, nullptr, scr, r - I_EGU, D / 32, F.lane); }
    }
    for (int i = F.bid * 512 + F.tid; i < SEQ * 48; i += F.G * 512) {
        if (i < SEQ * 16) { const int pos = i >> 4, j = i & 15; const float inv = powf(10000.0f, -(float)(2 * j) / 32.0f); const float ang = (float)pos * inv; cosA[i] = cosf(ang); sinA[i] = sinf(ang); }
        else { const int k = i - SEQ * 16, pos = k >> 5, j = k & 31; const float inv = powf(10000.0f, -(float)(2 * j) / 64.0f); const float ang = (float)pos * inv; cosB[k] = cosf(ang); sinB[k] = sinf(ang); }
    }
    const float* xin = a->x; const float* gp = a->ln_emb_g; const float* bp = a->ln_emb_b;
    for (int m = gw; m < T; m += NGW) {
        const f32x4* xr = (const f32x4*)(xin + (size_t)m * D) + F.lane; f32x4 v[4];
#pragma unroll
        for (int j = 0; j < 4; ++j) v[j] = xr[64 * j];
        float mean, rstd; ln_stats(v, mean, rstd);
        u32x2* o8 = (u32x2*)(xb + (size_t)m * D) + F.lane;
#pragma unroll
        for (int j = 0; j < 4; ++j) { const f32x4 g = *((const f32x4*)gp + F.lane + 64 * j), bb = *((const f32x4*)bp + F.lane + 64 * j); const f32x4 y = (v[j] - mean) * rstd * g + bb;
            u32x2 w; w.x = pk_f16(y[0], y[1]); w.y = pk_f16(y[2], y[3]); o8[64 * j] = w; }
    }
}
__device__ __forceinline__ void ph_A(int l) {
    const Frame F = mkframe(); KArgs a = kargs(); unsigned char* ws = a->ws;
    pg8::Gemm g{WSP(f16, WS_XB), D, WSP(f16, WS_WIN) + (size_t)l * HW * D, D, D}; pg8::StaticOrder S; S.init(T / 256, HW / 256, F.G, F.bid);
    pg8::EpiF16 E{WSP(f16, WS_H), HW};
    pg8::gemm_phase<pg8::EpiF16, pg8::StaticOrder, true>(F.lds, g, S, E);
}
__device__ __forceinline__ void ph_A2() {
    const Frame F = mkframe(); KArgs a = kargs(); unsigned char* ws = a->ws;
    const int gw = F.bid * NWAVES + F.wave, NGW = F.G * NWAVES;
    f16* hbuf = WSP(f16, WS_H); float* ssq_q = WSP(float, WS_SSQ_Q); float* ssq_kv = WSP(float, WS_SSQ_KV); float* kmean = WSP(float, WS_KMEAN);
    const float* cosA = WSP(float, WS_ROPE); const float* sinA = cosA + SEQ * 16; const float* cosB = sinA + SEQ * 16; const float* sinB = cosB + SEQ * 32;
    for (int m = gw; m < T; m += NGW) {
        f16* hr = hbuf + (size_t)m * HW; const int pos = m & (SEQ - 1); const int lane = F.lane;
        { const f16x4 v = *(const f16x4*)(hr + HC_CQ + 4 * lane); float s = (float)v[0] * (float)v[0] + (float)v[1] * (float)v[1] + (float)v[2] * (float)v[2] + (float)v[3] * (float)v[3];
          s = wave_sum(s); if (lane < 4) ssq_q[(size_t)m * 4 + lane] = lane == 0 ? s : 0.f; }
        { const f16x2 v = *(const f16x2*)(hr + HC_CKV + 2 * lane); float s = (float)v[0] * (float)v[0] + (float)v[1] * (float)v[1];
          s = wave_sum(s); if (lane < 4) ssq_kv[(size_t)m * 4 + lane] = lane == 0 ? s : 0.f; }
        if (lane < 16) { const float c = cosA[pos * 16 + lane], s = sinA[pos * 16 + lane]; const float x1 = (float)hr[HC_KR + lane], x2 = (float)hr[HC_KR + 16 + lane];
            hr[HC_KR + lane] = (f16)(x1 * c - x2 * s); hr[HC_KR + 16 + lane] = (f16)(x1 * s + x2 * c); }
        if (lane < 32) { const float c = cosB[pos * 32 + lane], s = sinB[pos * 32 + lane]; const int p1 = ((lane >> 4) << 5) + (lane & 15);
#pragma unroll
            for (int hh = 0; hh < 5; ++hh) {
                { f16* p = hr + HC_RQ + hh * 64 + p1; const float x1 = (float)p[0], x2 = (float)p[16]; p[0] = (f16)(x1 * c - x2 * s); p[16] = (f16)(x1 * s + x2 * c); }
                { f16* p = hr + HC_RK + hh * 64 + p1; const float x1 = (float)p[0], x2 = (float)p[16]; p[0] = (f16)((x1 * c - x2 * s) * 0.125f); p[16] = (f16)((x1 * s + x2 * c) * 0.125f); } } }
#pragma unroll
        for (int j = 0; j < 5; ++j) { f16* p = hr + HC_MQ + lane + 64 * j; *p = (f16)((float)*p * (0.125f * LOG2E)); }
    }
    for (int i = F.bid * 512 + F.tid; i < 128 * 320; i += F.G * 512) { const int bk = i / 320, c = i % 320; const f16* p = hbuf + (size_t)bk * 256 * HW + HC_MK + c; float s = 0.f;
        for (int r = 0; r < 256; ++r) s += (float)p[(size_t)r * HW];
        kmean[i] = s * (1.f / 256.f); }
}
__device__ __forceinline__ void ph_B(int l) {
    { const Frame F = mkframe(); KArgs a = kargs(); unsigned char* ws = a->ws;
      pg8::Gemm g{WSP(f16, WS_H) + HC_CQ, HW, WSP(f16, WS_WUQ) + (size_t)l * 768 * 256, 256, 256}; pg8::StaticOrder S; S.init(T / 256, QW / 256, F.G, F.bid);
      pg8::EpiF16 E{(f16*)a->out, QW}; pg8::gemm_phase<pg8::EpiF16, pg8::StaticOrder, true>(F.lds, g, S, E); }
    { const Frame F = mkframe(); KArgs a = kargs(); unsigned char* ws = a->ws;
      pg8::Gemm g{WSP(f16, WS_H) + HC_CKV, HW, WSP(f16, WS_WUKV) + (size_t)l * 768 * 128, 128, 128}; pg8::StaticOrder S; S.init(T / 256, KVW / 256, F.G, F.bid);
      pg8::EpiF16 E{(f16*)((unsigned char*)a->out + 48 * MiB), KVW}; pg8::gemm_phase<pg8::EpiF16, pg8::StaticOrder, true>(F.lds, g, S, E); }
}
__device__ __forceinline__ void ph_B2() {
    const Frame F = mkframe(); KArgs a = kargs(); unsigned char* ws = a->ws;
    const int gw = F.bid * NWAVES + F.wave, NGW = F.G * NWAVES;
    const float* ssq_q = WSP(float, WS_SSQ_Q); const float* ssq_kv = WSP(float, WS_SSQ_KV); const float* cosA = WSP(float, WS_ROPE); const float* sinA = cosA + SEQ * 16;
    f16* qbuf = (f16*)a->out; f16* kvbuf = (f16*)((unsigned char*)a->out + 48 * MiB);
    for (int m = gw; m < T; m += NGW) {
        const int pos = m & (SEQ - 1), lane = F.lane;
        const float sq = (1.0f / sqrtf((ssq_q[(size_t)m * 4] + ssq_q[(size_t)m * 4 + 1] + ssq_q[(size_t)m * 4 + 2] + ssq_q[(size_t)m * 4 + 3]) * (1.f / 256.f) + RMS_EPS)) * (0.10206207261596575f * LOG2E);
        const float skv = 1.0f / sqrtf((ssq_kv[(size_t)m * 4] + ssq_kv[(size_t)m * 4 + 1] + ssq_kv[(size_t)m * 4 + 2] + ssq_kv[(size_t)m * 4 + 3]) * (1.f / 128.f) + RMS_EPS);
        f16* qr = qbuf + (size_t)m * QW; f16* kr = kvbuf + (size_t)m * KVW;
#pragma unroll
        for (int j = 0; j < 6; ++j) { f16* p = qr + lane + 64 * j; *p = (f16)((float)*p * sq); }
#pragma unroll
        for (int j = 0; j < 2; ++j) { const int pi = lane + 64 * j; if (pi < 96) { const int hh = pi >> 4, jj = pi & 15; const float c = cosA[pos * 16 + jj], s = sinA[pos * 16 + jj];
            f16* p = qr + 384 + hh * 32 + jj; const float x1 = (float)p[0] * sq, x2 = (float)p[16] * sq; p[0] = (f16)(x1 * c - x2 * s); p[16] = (f16)(x1 * s + x2 * c); } }
#pragma unroll
        for (int j = 0; j < 12; ++j) { f16* p = kr + lane + 64 * j; *p = (f16)((float)*p * skv); }
    }
}
__device__ __forceinline__ void ph_C() {
#ifndef SKIP_A0
    { const Frame F = mkframe(); KArgs a = kargs(); unsigned char* ws = a->ws;
      attn_softmax_simple<0>(F, (const f16*)a->out, (const f16*)((unsigned char*)a->out + 48 * MiB), WSP(f16, WS_H), WSP(float, WS_KMEAN), WSP(f16, WS_O), WSP(float, WS_SSQ_O)); }
#endif
#ifndef SKIP_A1
    { const Frame F = mkframe(); KArgs a = kargs(); unsigned char* ws = a->ws;
      attn_softmax_simple<1>(F, (const f16*)a->out, (const f16*)((unsigned char*)a->out + 48 * MiB), WSP(f16, WS_H), WSP(float, WS_KMEAN), WSP(f16, WS_O), WSP(float, WS_SSQ_O)); }
#endif
#ifndef SKIP_A2
    { const Frame F = mkframe(); KArgs a = kargs(); unsigned char* ws = a->ws;
      attn_ret_simple(F, WSP(f16, WS_H), WSP(f16, WS_O)); }
#endif
}
__device__ __forceinline__ void ph_C2() {
    const Frame F = mkframe(); KArgs a = kargs(); unsigned char* ws = a->ws;
    const int gw = F.bid * NWAVES + F.wave, NGW = F.G * NWAVES;
    const float* ssq_o = WSP(float, WS_SSQ_O); f16* obuf = WSP(f16, WS_O);
    for (int m = gw; m < T; m += NGW) {
        const int lane = F.lane; const float* sp = ssq_o + (size_t)m * 16;
        const float sa = 1.0f / sqrtf((sp[0] + sp[1] + sp[2] + sp[3] + sp[4] + sp[5]) * (1.f / 384.f) + RMS_EPS);
        const float sc = 1.0f / sqrtf((sp[6] + sp[7] + sp[8] + sp[9] + sp[10]) * (1.f / 320.f) + RMS_EPS);
        f16* orow = obuf + (size_t)m * D;
#pragma unroll
        for (int j = 0; j < 6; ++j) { f16* p = orow + lane + 64 * j; *p = (f16)((float)*p * sa); }
#pragma unroll
        for (int j = 0; j < 5; ++j) { f16* p = orow + OC_MOBA + lane + 64 * j; *p = (f16)((float)*p * sc); }
    }
}
__device__ __forceinline__ void ph_D(int l) {
    const Frame F = mkframe(); KArgs a = kargs(); unsigned char* ws = a->ws;
    pg8::Gemm g{WSP(f16, WS_O), D, WSP(f16, WS_WO) + (size_t)l * D * D, D, D}; pg8::StaticOrder S; S.init(T / 256, D / 256, F.G, F.bid);
    pg8::EpiResF32 E{WSP(f16, WS_XB), a->out, D, DN_ALPHA};
    pg8::gemm_phase<pg8::EpiResF32, pg8::StaticOrder, true>(F.lds, g, S, E);
}
__device__ __forceinline__ void ph_D2(int l) {
    const Frame F = mkframe(); KArgs a = kargs(); unsigned char* ws = a->ws;
    const float* ybuf = a->out; f16* xb = WSP(f16, WS_XB); int* topi = WSP(int, WS_TOPI); float* topw = WSP(float, WS_TOPW); int* cnt = WSP(int, WS_CNT);
    const float* gp = a->ln1_g + l * D; const float* bp = a->ln1_b + l * D; const float* router = a->router;
    LAS int* lcnt = (LAS int*)(F.lds);
    for (int vw = F.bid; vw < 256; vw += F.G) {
        if (l == 1) { __syncthreads(); if (F.tid < 8) lcnt[F.tid] = 0; __syncthreads(); }
        for (int rr = F.wave; rr < 128; rr += NWAVES) {
            const int m = vw * 128 + rr; const int lane = F.lane;
            const f32x4* yr = (const f32x4*)(ybuf + (size_t)m * D) + lane; f32x4 v[4];
#pragma unroll
            for (int j = 0; j < 4; ++j) v[j] = yr[64 * j];
            float mean, rstd; ln_stats(v, mean, rstd);
            u32x2* o8 = (u32x2*)(xb + (size_t)m * D) + lane;
#pragma unroll
            for (int j = 0; j < 4; ++j) { const f32x4 g = *((const f32x4*)gp + lane + 64 * j), bb = *((const f32x4*)bp + lane + 64 * j); v[j] = (v[j] - mean) * rstd * g + bb;
                u32x2 w; w.x = pk_f16(v[j][0], v[j][1]); w.y = pk_f16(v[j][2], v[j][3]); o8[64 * j] = w; }
            if (l == 1) {
                float lg[8];
#pragma unroll
                for (int e = 0; e < 8; ++e) lg[e] = 0.f;
#pragma unroll
                for (int j = 0; j < 4; ++j)
#pragma unroll
                    for (int e4 = 0; e4 < 4; ++e4) { const int c = 4 * lane + 256 * j + e4; const f32x4 r0 = *(const f32x4*)(router + (size_t)c * 8), r1 = *(const f32x4*)(router + (size_t)c * 8 + 4); const float xv = v[j][e4];
                        lg[0] += xv * r0[0]; lg[1] += xv * r0[1]; lg[2] += xv * r0[2]; lg[3] += xv * r0[3]; lg[4] += xv * r1[0]; lg[5] += xv * r1[1]; lg[6] += xv * r1[2]; lg[7] += xv * r1[3]; }
#pragma unroll
                for (int e = 0; e < 8; ++e) lg[e] = wave_sum(lg[e]);
                if (lane == 0) {
                    int i0 = 0; float v0 = lg[0];
#pragma unroll
                    for (int e = 1; e < 8; ++e) if (lg[e] > v0) { v0 = lg[e]; i0 = e; }
                    int i1 = -1; float v1 = -INFINITY;
#pragma unroll
                    for (int e = 0; e < 8; ++e) if (e != i0 && lg[e] > v1) { v1 = lg[e]; i1 = e; }
                    const float e1 = __expf(v1 - v0), w0 = 1.0f / (1.0f + e1), w1 = e1 * w0;
                    topi[(size_t)m * 2] = i0; topi[(size_t)m * 2 + 1] = i1; topw[(size_t)m * 2] = w0; topw[(size_t)m * 2 + 1] = w1;
                    __hip_atomic_fetch_add(&lcnt[i0], 1, __ATOMIC_RELAXED, __HIP_MEMORY_SCOPE_WORKGROUP); __hip_atomic_fetch_add(&lcnt[i1], 1, __ATOMIC_RELAXED, __HIP_MEMORY_SCOPE_WORKGROUP);
                }
            }
        }
        if (l == 1) { __syncthreads(); if (F.tid < 8) cnt[vw * 8 + F.tid] = lcnt[F.tid]; }
    }
}
__device__ __forceinline__ void ph_E() {
    const Frame F = mkframe(); KArgs a = kargs(); unsigned char* ws = a->ws;
    pg8::Gemm g{WSP(f16, WS_XB), D, WSP(f16, WS_WGU), D, D}; pg8::StaticOrder S; S.init(T / 256, 2 * FF / 256, F.G, F.bid);
    pg8::EpiSwiGLU E{WSP(f16, WS_H), FF, 0};
    pg8::gemm_phase<pg8::EpiSwiGLU, pg8::StaticOrder, true>(F.lds, g, S, E);
}
__device__ __forceinline__ void ph_F() {
    const Frame F = mkframe(); KArgs a = kargs(); unsigned char* ws = a->ws;
    pg8::Gemm g{WSP(f16, WS_H), FF, WSP(f16, WS_WDN), FF, FF}; pg8::StaticOrder S; S.init(T / 256, D / 256, F.G, F.bid);
    pg8::EpiResF32 E{WSP(f16, WS_XB), a->out, D, DN_ALPHA};
    pg8::gemm_phase<pg8::EpiResF32, pg8::StaticOrder, true>(F.lds, g, S, E);
}
__device__ __forceinline__ void ph_F2d() {
    const Frame F = mkframe(); KArgs a = kargs(); unsigned char* ws = a->ws;
    const int gw = F.bid * NWAVES + F.wave, NGW = F.G * NWAVES;
    const float* ybuf = a->out; f16* xb = WSP(f16, WS_XB); const float* gp = a->ln2_g; const float* bp = a->ln2_b;
    for (int m = gw; m < T; m += NGW) {
        const int lane = F.lane; const f32x4* yr = (const f32x4*)(ybuf + (size_t)m * D) + lane; f32x4 v[4];
#pragma unroll
        for (int j = 0; j < 4; ++j) v[j] = yr[64 * j];
        float mean, rstd; ln_stats(v, mean, rstd);
        u32x2* o8 = (u32x2*)(xb + (size_t)m * D) + lane;
#pragma unroll
        for (int j = 0; j < 4; ++j) { const f32x4 g = *((const f32x4*)gp + lane + 64 * j), bb = *((const f32x4*)bp + lane + 64 * j); const f32x4 y = (v[j] - mean) * rstd * g + bb;
            u32x2 w; w.x = pk_f16(y[0], y[1]); w.y = pk_f16(y[2], y[3]); o8[64 * j] = w; }
    }
}
__device__ __forceinline__ void ph_R3() {
    const Frame F = mkframe(); KArgs a = kargs(); unsigned char* ws = a->ws;
    const int* topi = WSP(int, WS_TOPI); const float* topw = WSP(float, WS_TOPW); const int* cnt = WSP(int, WS_CNT); int* rowtok = WSP(int, WS_ROWTOK); float* roww = WSP(float, WS_ROWW); int* pane = WSP(int, WS_PANE);
    LAS int* L = (LAS int*)F.lds;
    for (int vw = F.bid; vw < 256; vw += F.G) {
        __syncthreads();
        if (F.tid < 8) { const int e = F.tid; int tot = 0, mine = 0; for (int w = 0; w < 256; ++w) { const int c = cnt[w * 8 + e]; if (w < vw) mine += c; tot += c; } L[e] = tot; L[16 + e] = mine; }
        __syncthreads();
        if (F.tid == 0) { int b = 0; for (int e = 0; e < 8; ++e) { L[8 + e] = b; b += (L[e] + 255) & ~255; } L[24] = b; }
        __syncthreads();
        if (F.tid < 8) { const int e = F.tid; int p = L[8 + e] + L[16 + e];
            for (int t = 0; t < 128; ++t) { const int tok = vw * 128 + t;
#pragma unroll
                for (int s = 0; s < 2; ++s) if (topi[(size_t)tok * 2 + s] == e) { rowtok[p] = tok * 2 + s; roww[p] = topw[(size_t)tok * 2 + s]; ++p; } } }
        if (vw == 0) {
            for (int e = 0; e < 8; ++e) { const int s0 = L[8 + e] + L[e], s1 = L[8 + e] + ((L[e] + 255) & ~255);
                for (int p = s0 + F.tid; p < s1; p += 512) { rowtok[p] = -1; roww[p] = 0.f; }
                for (int p = (L[8 + e] >> 8) + F.tid; p < (s1 >> 8); p += 512) pane[p] = e; }
            if (F.tid == 0) pane[MOE_MAXP] = L[24] >> 8;
        }
    }
}
__device__ __forceinline__ void ph_M1(int c) {
    const Frame F = mkframe(); KArgs a = kargs(); unsigned char* ws = a->ws;
    const int* pane = WSP(int, WS_PANE);
    const int np = pane[MOE_MAXP]; int nm = np - c * MOE_CHUNK; nm = nm < 0 ? 0 : (nm > MOE_CHUNK ? MOE_CHUNK : nm);
    pg8::Gemm g{WSP(f16, WS_XB), D, WSP(f16, WS_EGU), D, D}; pg8::MoeGather S; S.so.init(nm, 2 * FE / 256, F.G, F.bid, c * MOE_CHUNK); S.rowtok = WSP(int, WS_ROWTOK); S.pane = pane; S.estride = (size_t)2 * FE * D * 2;
    pg8::EpiSwiGLU E{(f16*)a->out, FE, c * MOE_CHUNK};
    pg8::gemm_phase<pg8::EpiSwiGLU, pg8::MoeGather, true>(F.lds, g, S, E);
}
__device__ __forceinline__ void ph_M2(int c) {
    const Frame F = mkframe(); KArgs a = kargs(); unsigned char* ws = a->ws;
    const int* pane = WSP(int, WS_PANE);
    const int np = pane[MOE_MAXP]; int nm = np - c * MOE_CHUNK; nm = nm < 0 ? 0 : (nm > MOE_CHUNK ? MOE_CHUNK : nm);
    pg8::Gemm g{(const f16*)a->out, FE, WSP(f16, WS_EDN), FE, FE}; pg8::MoeDense S; S.so.init(nm, D / 256, F.G, F.bid, c * MOE_CHUNK); S.pane = pane; S.estride = (size_t)D * FE * 2; S.arow0 = c * MOE_CHUNK;
    pg8::EpiScatter E{WSP(f16, WS_H), (size_t)T * D, WSP(int, WS_ROWTOK), WSP(float, WS_ROWW)};
    pg8::gemm_phase<pg8::EpiScatter, pg8::MoeDense, true>(F.lds, g, S, E);
}
__device__ __forceinline__ void ph_F2m() {
    const Frame F = mkframe(); KArgs a = kargs(); unsigned char* ws = a->ws;
    const int gw = F.bid * NWAVES + F.wave, NGW = F.G * NWAVES;
    const f16* xb = WSP(f16, WS_XB); const f16* c0buf = WSP(f16, WS_H); const f16* c1buf = c0buf + (size_t)T * D; float* out = a->out; const float* gp = a->ln2_g + D; const float* bp = a->ln2_b + D;
    for (int m = gw; m < T; m += NGW) {
        const int lane = F.lane; f32x4 v[4];
        const f16x4* xr = (const f16x4*)(xb + (size_t)m * D) + lane; const f16x4* c0r = (const f16x4*)(c0buf + (size_t)m * D) + lane; const f16x4* c1r = (const f16x4*)(c1buf + (size_t)m * D) + lane;
#pragma unroll
        for (int j = 0; j < 4; ++j) { const f16x4 xv = xr[64 * j], p0 = c0r[64 * j], p1 = c1r[64 * j];
#pragma unroll
            for (int e = 0; e < 4; ++e) v[j][e] = DN_ALPHA * (float)xv[e] + ((float)p0[e] + (float)p1[e]); }
        float mean, rstd; ln_stats(v, mean, rstd);
        f32x4* orow = (f32x4*)(out + (size_t)m * D) + lane;
#pragma unroll
        for (int j = 0; j < 4; ++j) { const f32x4 g = *((const f32x4*)gp + lane + 64 * j), bb = *((const f32x4*)bp + lane + 64 * j); orow[64 * j] = (v[j] - mean) * rstd * g + bb; }
    }
}

#ifndef SITE_MASK
#define SITE_MASK 0xFFFFFFFFu
#endif
#define SITE(n) (((SITE_MASK) >> (n)) & 1u)
__global__ void __launch_bounds__(NWAVES * 64, 2) mega_fwd(Args args_unused) {
    extern __shared__ __attribute__((aligned(16))) unsigned char lds_raw[];
    volatile LAS unsigned* MISC = (volatile LAS unsigned*)((LAS unsigned char*)lds_raw + MISC_OFF);
    if (threadIdx.x < 64) MISC[threadIdx.x] = 0u;
    __syncthreads();
#if MK_ONE_LAUNCH
    XcdBarrier bar = xcd_barrier_post((unsigned*)(kargs()->ws + WS_CTL) + CW_BAR, MISC + 8);
#define GRID_BAR() xcd_barrier(bar)
#else
#define GRID_BAR() do {} while (0)
#endif
    const int lo = kargs()->ph_lo, hi = kargs()->ph_hi;
#define IN(k) (lo <= (k) && (k) < hi)
#define SEAM(k) do { if (IN(k) && IN((k) + 1)) GRID_BAR(); } while (0)
    if (SITE(0) && IN(0)) ph_prologue();
    SEAM(0);
    for (int l = 0; l < 2; ++l) {
        const int pb = l == 0 ? PH_L0 : PH_L1;
        if (SITE(1) && IN(pb + 0)) ph_A(l);
        SEAM(pb + 0);
        if (SITE(2) && IN(pb + 1)) ph_A2();
        SEAM(pb + 1);
        if (SITE(3) && IN(pb + 2)) ph_B(l);
        SEAM(pb + 2);
        if (SITE(4) && IN(pb + 3)) ph_B2();
        SEAM(pb + 3);
        if (SITE(5) && IN(pb + 4)) ph_C();
        SEAM(pb + 4);
        if (SITE(6) && IN(pb + 5)) ph_C2();
        SEAM(pb + 5);
        if (SITE(7) && IN(pb + 6)) ph_D(l);
        SEAM(pb + 6);
        if (SITE(8) && IN(pb + 7)) ph_D2(l);
        SEAM(pb + 7);
        if (l == 0) {
            if (SITE(9) && IN(pb + 8)) ph_E();
            SEAM(pb + 8);
            if (SITE(10) && IN(pb + 9)) ph_F();
            SEAM(pb + 9);
            if (SITE(11) && IN(pb + 10)) ph_F2d();
            SEAM(pb + 10);
        } else {
            if (SITE(12) && IN(pb + 8)) ph_R3();
            SEAM(pb + 8);
            for (int c = 0; c < MOE_NCHUNK; ++c) {
                if (SITE(13) && IN(pb + 9 + 2 * c)) ph_M1(c);
                SEAM(pb + 9 + 2 * c);
                if (SITE(14) && IN(pb + 10 + 2 * c)) ph_M2(c);
                SEAM(pb + 10 + 2 * c);
            }
            if (SITE(15) && IN(pb + 19)) ph_F2m();
        }
    }
#undef IN
#undef SEAM
}

extern "C" void kernel_launch(void* const* d_in, const int* in_sizes, int n_in, void* d_out, int out_size, void* d_ws, size_t ws_size, hipStream_t stream) {
    static int grid = 0;
    if (grid == 0) {
        if (n_in != 22 || in_sizes[0] != T * D || out_size != T * D || ws_size < WS_END) { fprintf(stderr, "kernel_launch: unexpected shapes / workspace (n_in %d, ws %zu)\n", n_in, ws_size); grid = -1; return; }
        int dev = 0, cus = 0;
        if (hipGetDevice(&dev) != hipSuccess || hipDeviceGetAttribute(&cus, hipDeviceAttributeMultiprocessorCount, dev) != hipSuccess) { grid = -1; return; }
        if (hipFuncSetAttribute((const void*)mega_fwd, hipFuncAttributeMaxDynamicSharedMemorySize, LDS_BYTES) != hipSuccess) { fprintf(stderr, "kernel_launch: hipFuncSetAttribute failed\n"); grid = -1; return; }
        int per_cu = 0;
        if (hipOccupancyMaxActiveBlocksPerMultiprocessor(&per_cu, (const void*)mega_fwd, NWAVES * 64, LDS_BYTES) != hipSuccess || per_cu < 1) { fprintf(stderr, "kernel_launch: occupancy query says %d\n", per_cu); }
        (void)hipGetLastError();
        grid = cus > 256 ? 256 : cus;
    }
    if (grid < 0) return;
    (void)hipMemsetAsync((char*)d_ws + WS_CTL, 0, CTL_ZERO_BYTES, stream);
    Args a{};
    a.x = (const float*)d_in[0]; a.ln_emb_g = (const float*)d_in[1]; a.ln_emb_b = (const float*)d_in[2]; a.w_in = (const float*)d_in[3]; a.q_norm_g = (const float*)d_in[4]; a.kv_norm_g = (const float*)d_in[5];
    a.w_uq = (const float*)d_in[6]; a.w_ukv = (const float*)d_in[7]; a.beta_mla = (const float*)d_in[8]; a.beta_moba = (const float*)d_in[9]; a.w_o = (const float*)d_in[10]; a.ln1_g = (const float*)d_in[11]; a.ln1_b = (const float*)d_in[12];
    a.ffn_w_gate = (const float*)d_in[13]; a.ffn_w_up = (const float*)d_in[14]; a.ffn_w_down = (const float*)d_in[15]; a.router = (const float*)d_in[16]; a.exp_w_gate = (const float*)d_in[17]; a.exp_w_up = (const float*)d_in[18];
    a.exp_w_down = (const float*)d_in[19]; a.ln2_g = (const float*)d_in[20]; a.ln2_b = (const float*)d_in[21];
    a.out = (float*)d_out; a.ws = (unsigned char*)d_ws;
#if MK_ONE_LAUNCH
    a.ph_lo = 0; a.ph_hi = NPHASE;
    hipLaunchKernelGGL(mega_fwd, dim3(grid), dim3(NWAVES * 64), LDS_BYTES, stream, a);
#else
    for (int p = 0; p < NPHASE; ++p) { a.ph_lo = p; a.ph_hi = p + 1; hipLaunchKernelGGL(mega_fwd, dim3(grid), dim3(NWAVES * 64), LDS_BYTES, stream, a); }
#endif
}
```

```cpp
#include <hip/hip_runtime.h>
#include <cstdio>
#include <cstdint>
#include <cmath>

#ifndef MK_ONE_LAUNCH
#define MK_ONE_LAUNCH 1
#endif

#define LAS __attribute__((address_space(3)))
#define GAS __attribute__((address_space(1)))
typedef _Float16 f16;
typedef _Float16 f16x2 __attribute__((ext_vector_type(2)));
typedef _Float16 f16x4 __attribute__((ext_vector_type(4)));
typedef _Float16 f16x8 __attribute__((ext_vector_type(8)));
typedef float f32x2 __attribute__((ext_vector_type(2)));
typedef float f32x4 __attribute__((ext_vector_type(4)));
typedef unsigned u32x2 __attribute__((ext_vector_type(2)));
typedef unsigned u32x4 __attribute__((ext_vector_type(4)));
typedef GAS unsigned gu32;

constexpr int BATCH = 16, SEQ = 2048, T = BATCH * SEQ, D = 1024;
constexpr int HW = 2816;
constexpr int HC_CQ = 0, HC_CKV = 256, HC_KR = 384, HC_RQ = 416, HC_RK = 736, HC_RV = 1056, HC_RG = 1376, HC_MQ = 1696, HC_MK = 2016, HC_MV = 2336, HC_END = 2656;
constexpr int QW = 768, KVW = 768;
constexpr int OC_RET = 384, OC_MOBA = 704;
constexpr int FF = 2816, FE = 3584, NE = 8;
constexpr float LN_EPS = 1e-5f, RMS_EPS = 1e-6f;
constexpr float DN_ALPHA = 1.41421356237f;
constexpr float LOG2E = 1.4426950408889634f;
constexpr int MOE_CHUNK = 64, MOE_NCHUNK = 5, MOE_MAXP = 264;

constexpr size_t MiB = 1u << 20;
constexpr size_t WS_CTL = 0, CTL_ZERO_BYTES = 256 * 1024;
constexpr size_t WS_ROPE = 256 * 1024;
constexpr size_t WS_SSQ_Q = 1 * MiB;
constexpr size_t WS_SSQ_KV = WS_SSQ_Q + (size_t)T * 16;
constexpr size_t WS_SSQ_O = 2 * MiB;
constexpr size_t WS_KMEAN = 4 * MiB;
constexpr size_t WS_TOPI = WS_KMEAN + 256 * 1024;
constexpr size_t WS_TOPW = WS_TOPI + (size_t)T * 8;
constexpr size_t WS_CNT = WS_TOPW + (size_t)T * 8;
constexpr size_t WS_ROWTOK = WS_CNT + 8192;
constexpr size_t WS_ROWW = WS_ROWTOK + (size_t)MOE_MAXP * 256 * 4;
constexpr size_t WS_PANE = WS_ROWW + (size_t)MOE_MAXP * 256 * 4;
constexpr size_t WS_WIN = 6 * MiB;
constexpr size_t WS_WUQ = 17 * MiB;
constexpr size_t WS_WUKV = 18 * MiB;
constexpr size_t WS_WO = 19 * MiB;
constexpr size_t WS_WGU = 23 * MiB;
constexpr size_t WS_WDN = 34 * MiB;
constexpr size_t WS_EGU = 40 * MiB;
constexpr size_t WS_EDN = 152 * MiB;
constexpr size_t WS_XB = 208 * MiB;
constexpr size_t WS_H = 272 * MiB;
constexpr size_t WS_O = 448 * MiB;
constexpr size_t WS_END = 512 * MiB;
static_assert(WS_PANE + (MOE_MAXP + 8) * 4 <= WS_WIN, "ws map");

constexpr int CW_TMO = 0, CW_BAR = 1024;

constexpr int RING_BYTES = 131072;
constexpr int MISC_OFF = RING_BYTES;
constexpr int LDS_BYTES = 147456;

__device__ __forceinline__ unsigned pk_f16(float lo, float hi) { f16x2 v = {(f16)lo, (f16)hi}; return __builtin_bit_cast(unsigned, v); }
template <int X> __device__ __forceinline__ float swz_xor(float v) { return __int_as_float(__builtin_amdgcn_ds_swizzle(__float_as_int(v), (X << 10) | 0x1f)); }
__device__ __forceinline__ float wave_sum(float v) {
    v += swz_xor<1>(v); v += swz_xor<2>(v); v += swz_xor<4>(v); v += swz_xor<8>(v); v += swz_xor<16>(v);
    const auto rr = __builtin_amdgcn_permlane32_swap(__float_as_uint(v), __float_as_uint(v), false, false);
    return __uint_as_float(rr[0]) + __uint_as_float(rr[1]);
}
__device__ __forceinline__ float silu_f(float x) { return x * __builtin_amdgcn_rcpf(1.f + __expf(-x)); }

#define XB_TMO      128
#define XB_XCNT(j)  (256  + 64 * (j))
#define XB_XSUB(j)  (1280 + 64 * (j))
#define XB_XGEN(j)  (2304 + 64 * (j))
#define XB_TOP      3328
#define XB_TOPGEN   3392
#define XCD_BAR_WORDS 3456
#define XB_SPIN_CAP (1u << 18)
__device__ __forceinline__ unsigned xb_ld(unsigned* p)              { return __hip_atomic_load(p, __ATOMIC_RELAXED, __HIP_MEMORY_SCOPE_AGENT); }
__device__ __forceinline__ unsigned xb_add(unsigned* p, unsigned v) { return __hip_atomic_fetch_add(p, v, __ATOMIC_RELAXED, __HIP_MEMORY_SCOPE_AGENT); }
__device__ __forceinline__ unsigned xb_xcc_id() { return (unsigned)__builtin_amdgcn_s_getreg((3 << 11) | 20) & 0xFu; }
#define XB_SPIN(cond, bar) do { unsigned _sp = 0; while (cond) { __builtin_amdgcn_s_sleep(1); \
    if ((++_sp & 255u) == 0u) { if (xb_ld(&(bar)[XB_TMO])) break; if (_sp > XB_SPIN_CAP) { atomicAdd(&(bar)[XB_TMO], 1u); break; } } } } while (0)
struct XcdBarrier { unsigned* bar; unsigned x; volatile LAS unsigned* st; };
__device__ __forceinline__ XcdBarrier xcd_barrier_post(unsigned* bar, volatile LAS unsigned* st) {
    XcdBarrier b; b.bar = bar; b.x = xb_xcc_id(); b.st = st;
    if (threadIdx.x == 0) (void)xb_add(&bar[XB_XCNT(b.x)], 1u);
    return b;
}
__device__ __forceinline__ void xcd_barrier_complete(unsigned* bar, unsigned x, unsigned& nloc, unsigned& nx) {
    const unsigned G = gridDim.x * gridDim.y * gridDim.z;
    unsigned sum, cnt, mine, sp = 0u;
    for (;;) {
        sum = 0u; cnt = 0u; mine = 0u;
#pragma unroll
        for (unsigned j = 0; j < 16; ++j) { const unsigned c = xb_ld(&bar[XB_XCNT(j)]); sum += c; cnt += (c > 0u) ? 1u : 0u; mine = (j == x) ? c : mine; }
        if (sum == G) break;
        __builtin_amdgcn_s_sleep(1);
        if ((++sp & 255u) == 0u) { if (xb_ld(&bar[XB_TMO])) break; if (sp > XB_SPIN_CAP) { atomicAdd(&bar[XB_TMO], 1u); break; } }
    }
    nloc = mine > 0u ? mine : 1u; nx = cnt > 0u ? cnt : 1u;
}
__device__ __forceinline__ void xcd_barrier(const XcdBarrier& b) {
    asm volatile("s_waitcnt vmcnt(0)" ::: "memory");
    __syncthreads();
    if (threadIdx.x == 0) {
        unsigned* bar = b.bar;
        __builtin_amdgcn_s_waitcnt(0);
        unsigned nloc = b.st[0], nx = b.st[1];
        if (nloc == 0u) { xcd_barrier_complete(bar, b.x, nloc, nx); b.st[0] = nloc; b.st[1] = nx; }
        const unsigned old = xb_add(&bar[XB_XSUB(b.x)], 1u);
        const unsigned gen = old / nloc;
        if (old + 1u == (gen + 1u) * nloc) {
            __builtin_amdgcn_fence(__ATOMIC_RELEASE, "agent");
            asm volatile("s_waitcnt vmcnt(0)" ::: "memory");
            const unsigned og = xb_add(&bar[XB_TOP], 1u);
            const unsigned tg = og / nx;
            if (og + 1u == (tg + 1u) * nx) xb_add(&bar[XB_TOPGEN], 1u);
            else XB_SPIN(xb_ld(&bar[XB_TOPGEN]) == tg, bar);
            __builtin_amdgcn_fence(__ATOMIC_ACQUIRE, "agent");
            xb_add(&bar[XB_XGEN(b.x)], 1u);
            asm volatile("s_waitcnt vmcnt(0)" ::: "memory");
        } else {
            XB_SPIN(xb_ld(&bar[XB_XGEN(b.x)]) == gen, bar);
            __builtin_amdgcn_fence(__ATOMIC_ACQUIRE, "agent");
            asm volatile("s_waitcnt vmcnt(0)" ::: "memory");
        }
    }
    __syncthreads();
}

namespace pg8 {
constexpr int BM = 256, BK = 64, HALF = 128, HTB = HALF * BK * 2, STAGE_BYTES = 8 * HTB, NXCD = 8, WGM = 8;
__host__ __device__ __forceinline__ int lds_byte(int r, int c) { const int st = (r >> 4) * 2 + (c >> 5), rr = r & 15, cc = c & 31, ob = rr * 64 + cc * 2; return st * 1024 + (ob ^ (((ob >> 9) & 1) << 5)); }
__host__ __device__ __forceinline__ void stage_rc(int b, int& R, int& C) { const int st = b / 1024, sb = b % 1024, swz = sb ^ (((sb >> 9) & 1) << 5); R = (st >> 1) * 16 + swz / 64; C = (st & 1) * 32 + (swz % 64) / 2; }
__host__ __device__ __forceinline__ int perm32(int rho) { const int n = rho >> 4, i = rho & 15; return 8 * (i >> 2) + 4 * n + (i & 3); }

struct Unit { int pm, pn; };
struct Gemm { const f16* A; int lda; const f16* Bt; int ldb; int K; };

struct StaticOrder {
    static constexpr bool GATHER = false;
    int nM, nN, nwg, G, c, pm0;
    __device__ void init(int nM_, int nN_, int G_, int c_, int pm0_ = 0) { nM = nM_; nN = nN_; nwg = nM * nN; G = G_; c = c_; pm0 = pm0_; }
    __device__ bool next(int i, Unit& u) const {
        const long L = (long)i * G + c; if (L >= nwg) return false;
        int wgid = (int)L; { const int q = nwg / NXCD, r = nwg % NXCD, xcd = wgid % NXCD, off = wgid / NXCD; wgid = (xcd < r ? xcd * (q + 1) : r * (q + 1) + (xcd - r) * q) + off; }
        const int nig = WGM * nN, gid = wgid / nig, fm = gid * WGM, gsz = (nM - fm) < WGM ? (nM - fm) : WGM;
        u.pm = pm0 + fm + ((wgid % nig) % gsz); u.pn = (wgid % nig) / gsz; return true;
    }
    __device__ __forceinline__ int a_row(const Unit& u, int r) const { return u.pm * BM + r; }
    __device__ __forceinline__ size_t b_base(const Unit&) const { return 0; }
};
struct MoeGather {
    static constexpr bool GATHER = true;
    StaticOrder so; const int* rowtok; const int* pane; size_t estride;
    __device__ bool next(int i, Unit& u) const { return so.next(i, u); }
    __device__ __forceinline__ int a_row(const Unit& u, int r) const { const int t = rowtok[u.pm * BM + r]; return t < 0 ? 0 : (t >> 1); }
    __device__ __forceinline__ size_t b_base(const Unit& u) const { return (size_t)pane[u.pm] * estride; }
};
struct MoeDense {
    static constexpr bool GATHER = false;
    StaticOrder so; const int* pane; size_t estride; int arow0;
    __device__ bool next(int i, Unit& u) const { return so.next(i, u); }
    __device__ __forceinline__ int a_row(const Unit& u, int r) const { return (u.pm - arow0) * BM + r; }
    __device__ __forceinline__ size_t b_base(const Unit& u) const { return (size_t)pane[u.pm] * estride; }
};

struct EpiF16 {
    static constexpr bool PERM = true;
    f16* O; int ldc;
    __device__ __forceinline__ void operator()(const f32x4 (&acc)[2][2][4][2], const Unit& u, int wr, int wc, int fr, int fq) const {
        const int row0 = u.pm * BM + wr * 64 + fr, col0 = u.pn * BM + wc * 32 + 8 * fq;
#pragma unroll
        for (int ai = 0; ai < 2; ++ai)
#pragma unroll
            for (int m = 0; m < 4; ++m) { f16* rowp = O + (size_t)(row0 + ai * HALF + m * 16) * ldc + col0;
#pragma unroll
                for (int bj = 0; bj < 2; ++bj) { const f32x4 v0 = acc[ai][bj][m][0], v1 = acc[ai][bj][m][1];
                    u32x4 w; w.x = pk_f16(v0[0], v0[1]); w.y = pk_f16(v0[2], v0[3]); w.z = pk_f16(v1[0], v1[1]); w.w = pk_f16(v1[2], v1[3]);
                    *(u32x4*)(rowp + bj * HALF) = w; } }
    }
};
struct EpiResF32 {
    static constexpr bool PERM = false;
    const f16* X; float* Y; int ldc; float alpha;
    __device__ __forceinline__ void operator()(const f32x4 (&acc)[2][2][4][2], const Unit& u, int wr, int wc, int fr, int fq) const {
        const int row0 = u.pm * BM + wr * 64 + fr, col0 = u.pn * BM + wc * 32 + 4 * fq;
#pragma unroll
        for (int ai = 0; ai < 2; ++ai)
#pragma unroll
            for (int m = 0; m < 4; ++m) { const size_t off = (size_t)(row0 + ai * HALF + m * 16) * ldc + col0;
#pragma unroll
                for (int bj = 0; bj < 2; ++bj)
#pragma unroll
                    for (int n = 0; n < 2; ++n) { const f16x4 xv = *(const f16x4*)(X + off + bj * HALF + n * 16); const f32x4 a = acc[ai][bj][m][n];
                        f32x4 o; o[0] = alpha * (float)xv[0] + a[0]; o[1] = alpha * (float)xv[1] + a[1]; o[2] = alpha * (float)xv[2] + a[2]; o[3] = alpha * (float)xv[3] + a[3];
                        *(f32x4*)(Y + off + bj * HALF + n * 16) = o; } }
    }
};
struct EpiSwiGLU {
    static constexpr bool PERM = true;
    f16* O; int ldc; int pm0;
    __device__ __forceinline__ void operator()(const f32x4 (&acc)[2][2][4][2], const Unit& u, int wr, int wc, int fr, int fq) const {
        const int row0 = (u.pm - pm0) * BM + wr * 64 + fr, col0 = u.pn * HALF + wc * 32 + 8 * fq;
#pragma unroll
        for (int ai = 0; ai < 2; ++ai)
#pragma unroll
            for (int m = 0; m < 4; ++m) { f16* rowp = O + (size_t)(row0 + ai * HALF + m * 16) * ldc + col0;
                float r[8];
#pragma unroll
                for (int n = 0; n < 2; ++n)
#pragma unroll
                    for (int e = 0; e < 4; ++e) r[n * 4 + e] = silu_f(acc[ai][0][m][n][e]) * acc[ai][1][m][n][e];
                u32x4 w; w.x = pk_f16(r[0], r[1]); w.y = pk_f16(r[2], r[3]); w.z = pk_f16(r[4], r[5]); w.w = pk_f16(r[6], r[7]);
                *(u32x4*)rowp = w; }
    }
};
struct EpiScatter {
    static constexpr bool PERM = true;
    f16* C0; size_t slot_stride; const int* rowtok; const float* roww;
    __device__ __forceinline__ void operator()(const f32x4 (&acc)[2][2][4][2], const Unit& u, int wr, int wc, int fr, int fq) const {
        const int row0 = u.pm * BM + wr * 64 + fr, col0 = u.pn * BM + wc * 32 + 8 * fq;
#pragma unroll
        for (int ai = 0; ai < 2; ++ai)
#pragma unroll
            for (int m = 0; m < 4; ++m) { const int prow = row0 + ai * HALF + m * 16; const int ts = rowtok[prow]; const float w = roww[prow];
                if (ts >= 0) { f16* rowp = C0 + (size_t)(ts & 1) * slot_stride + (size_t)(ts >> 1) * D + col0;
#pragma unroll
                    for (int bj = 0; bj < 2; ++bj) { const f32x4 v0 = acc[ai][bj][m][0] * w, v1 = acc[ai][bj][m][1] * w;
                        u32x4 o; o.x = pk_f16(v0[0], v0[1]); o.y = pk_f16(v0[2], v0[3]); o.z = pk_f16(v1[0], v1[1]); o.w = pk_f16(v1[2], v1[3]);
                        *(u32x4*)(rowp + bj * HALF) = o; } } }
    }
};

template <class Sched>
__device__ __forceinline__ void a_offsets(const Sched& S, const Unit& u, int lda, int tid, unsigned (&ao)[2][2]) {
#pragma unroll
    for (int h = 0; h < 2; ++h)
#pragma unroll
        for (int i = 0; i < 2; ++i) { int R, C; stage_rc(tid * 16 + i * 8192, R, C); ao[h][i] = ((unsigned)S.a_row(u, h * HALF + R) * (unsigned)lda + (unsigned)C) * 2u; }
}

template <class Epi, class Sched, bool ALIGN_EPI>
__device__ __forceinline__ void gemm_phase(LAS unsigned char* lds, const Gemm g, const Sched& S, const Epi& E) {
    constexpr bool GATHER = Sched::GATHER;
    int tid_ = threadIdx.x; asm volatile("" : "+v"(tid_));
    const int tid = tid_, wid = __builtin_amdgcn_readfirstlane(tid >> 6), lane = tid & 63, wr = wid >> 2, wc = wid & 3, fr = lane & 15, fq = lane >> 4;
    const int K = g.K, nt = K / BK;
    unsigned voffB[2], voffA[2];
#pragma unroll
    for (int i = 0; i < 2; ++i) { int R, C; stage_rc(tid * 16 + i * 8192, R, C); const int Rb = Epi::PERM ? ((R & ~31) + perm32(R & 31)) : R; voffB[i] = (unsigned)(Rb * g.ldb + C) * 2u; voffA[i] = (unsigned)(R * g.lda + C) * 2u; }
    const size_t kstep = (size_t)(BK * 2);
    const size_t hstepB = (size_t)HALF * g.ldb * 2, tstepB = 2 * hstepB;
    const size_t hstepA = (size_t)HALF * g.lda * 2;
    const unsigned ldsw = (unsigned)wid * 1024u;
    const int aoff = lds_byte(wr * 64 + fr, fq * 8), boff = lds_byte(wc * 32 + fr, fq * 8);
#define PG8_SA(b, h) (((b) * 2 + (h)) * HTB)
#define PG8_SB(b, h) ((4 + (b) * 2 + (h)) * HTB)
#define PG8_STAGEB(bufoff, gbase) do { _Pragma("unroll") for (int _i = 0; _i < 2; ++_i) \
        __builtin_amdgcn_global_load_lds((const unsigned*)((const char*)(gbase) + voffB[_i]), (LAS unsigned*)(lds + (bufoff) + ldsw + _i * 8192), 16, 0, 0); } while (0)
#define PG8_STAGEA(bufoff, ub, kb, h) do { _Pragma("unroll") for (int _i = 0; _i < 2; ++_i) \
        __builtin_amdgcn_global_load_lds((const unsigned*)((ub) + (kb) + (GATHER ? (size_t)0 : (size_t)(h) * hstepA) + (GATHER ? cao[h][_i] : voffA[_i])), (LAS unsigned*)(lds + (bufoff) + ldsw + _i * 8192), 16, 0, 0); } while (0)
#define PG8_LDA(dst, b, h) do { _Pragma("unroll") for (int m = 0; m < 4; ++m) _Pragma("unroll") for (int k = 0; k < 2; ++k) dst[m][k] = *(const LAS f16x8*)(lds + PG8_SA(b, h) + aoff + m * 2048 + k * 1024); } while (0)
#define PG8_LDB(dst, b, h) do { _Pragma("unroll") for (int n = 0; n < 2; ++n) _Pragma("unroll") for (int k = 0; k < 2; ++k) dst[n][k] = *(const LAS f16x8*)(lds + PG8_SB(b, h) + boff + n * 2048 + k * 1024); } while (0)
#define PG8_MMA(ai, bj, At, Bt) do { __builtin_amdgcn_s_setprio(1); _Pragma("unroll") for (int m = 0; m < 4; ++m) _Pragma("unroll") for (int n = 0; n < 2; ++n) _Pragma("unroll") for (int k = 0; k < 2; ++k) \
        acc[ai][bj][m][n] = __builtin_amdgcn_mfma_f32_16x16x32_f16(Bt[n][k], At[m][k], acc[ai][bj][m][n], 0, 0, 0); __builtin_amdgcn_s_setprio(0); } while (0)
#define PG8_WAIT_V(n) asm volatile("s_waitcnt vmcnt(" #n ")" ::: "memory")
#define PG8_WAIT_L(n) asm volatile("s_waitcnt lgkmcnt(" #n ")" ::: "memory")
#define PG8_BAR __builtin_amdgcn_s_barrier()
#define PG8_SCHED __builtin_amdgcn_sched_barrier(0)
    Unit cur, nxt; int ui = 0;
    if (!S.next(0, cur)) return;
    f32x4 acc[2][2][4][2];
#pragma unroll
    for (int a = 0; a < 2; ++a)
#pragma unroll
        for (int b = 0; b < 2; ++b)
#pragma unroll
            for (int m = 0; m < 4; ++m)
#pragma unroll
                for (int n = 0; n < 2; ++n) acc[a][b][m][n] = (f32x4){0.f, 0.f, 0.f, 0.f};
    f16x8 At[4][2], B0[2][2], B1[2][2];
    unsigned cao[2][2];
    if constexpr (GATHER) a_offsets(S, cur, g.lda, tid, cao);
    const char* cA = (const char*)g.A + (GATHER ? (size_t)0 : (size_t)S.a_row(cur, 0) * g.lda * 2);
    const char* cB = (const char*)g.Bt + S.b_base(cur) + (size_t)cur.pn * tstepB;
    PG8_STAGEB(PG8_SB(0, 0), cB); PG8_STAGEB(PG8_SB(0, 1), cB + hstepB); PG8_STAGEA(PG8_SA(0, 0), cA, 0, 0); PG8_STAGEA(PG8_SA(0, 1), cA, 0, 1);
    if (wr == 1) PG8_BAR;
    PG8_WAIT_V(2); PG8_BAR;
    PG8_STAGEB(PG8_SB(1, 0), cB + kstep); PG8_STAGEA(PG8_SA(1, 0), cA, kstep, 0); PG8_STAGEB(PG8_SB(1, 1), cB + hstepB + kstep);
    PG8_WAIT_V(6); PG8_BAR;
    for (;;) {
        const bool has_next = S.next(ui + 1, nxt);
        const char* nB = cB; const char* nA = cA;
        if (has_next) { nB = (const char*)g.Bt + S.b_base(nxt) + (size_t)nxt.pn * tstepB; nA = (const char*)g.A + (GATHER ? (size_t)0 : (size_t)S.a_row(nxt, 0) * g.lda * 2); }
        for (int t = 0; t < nt; t += 2) {
            const bool last = (t == nt - 2);
            const size_t ka1 = (size_t)(t + 1) * kstep;
            const size_t ka2 = last ? 0 : (size_t)(t + 2) * kstep, ka3 = ka2 + kstep;
            const char* a2 = last ? nA : cA;
            const char* b2 = last ? nB : cB + (size_t)(t + 2) * kstep; const char* b3 = b2 + kstep;
            PG8_LDB(B0, 0, 0); PG8_LDB(B1, 0, 1); PG8_SCHED; PG8_LDA(At, 0, 0); PG8_STAGEA(PG8_SA(1, 1), cA, ka1, 1);
            if constexpr (GATHER) { if (last && has_next) a_offsets(S, nxt, g.lda, tid, cao); }
            PG8_WAIT_V(8); PG8_WAIT_L(0); PG8_BAR; PG8_MMA(0, 0, At, B0); PG8_MMA(0, 1, At, B1); PG8_BAR; PG8_SCHED;
            PG8_LDA(At, 0, 1); PG8_STAGEB(PG8_SB(0, 0), b2); PG8_STAGEB(PG8_SB(0, 1), b2 + hstepB); PG8_STAGEA(PG8_SA(0, 0), a2, ka2, 0);
            PG8_WAIT_V(8); PG8_WAIT_L(0); PG8_BAR; PG8_MMA(1, 0, At, B0); PG8_MMA(1, 1, At, B1); PG8_BAR; PG8_SCHED;
            PG8_LDB(B0, 1, 0); PG8_LDB(B1, 1, 1); PG8_SCHED; PG8_LDA(At, 1, 0); PG8_STAGEA(PG8_SA(0, 1), a2, ka2, 1);
            PG8_WAIT_V(8); PG8_WAIT_L(0); PG8_BAR; PG8_MMA(0, 0, At, B0); PG8_MMA(0, 1, At, B1); PG8_BAR; PG8_SCHED;
            PG8_LDA(At, 1, 1); PG8_STAGEB(PG8_SB(1, 0), b3); PG8_STAGEB(PG8_SB(1, 1), b3 + hstepB); PG8_STAGEA(PG8_SA(1, 0), a2, ka3, 0);
            PG8_WAIT_V(8); PG8_WAIT_L(0); PG8_BAR; PG8_MMA(1, 0, At, B0); PG8_MMA(1, 1, At, B1); PG8_BAR; PG8_SCHED;
        }
        if constexpr (ALIGN_EPI) { if (wr == 0) PG8_BAR; }
        { int t2 = threadIdx.x; asm volatile("" : "+v"(t2)); const int l2 = t2 & 63; E(acc, cur, wr, wc, l2 & 15, l2 >> 4); }
        if (!has_next) break;
#pragma unroll
        for (int a = 0; a < 2; ++a)
#pragma unroll
            for (int b = 0; b < 2; ++b)
#pragma unroll
                for (int m = 0; m < 4; ++m)
#pragma unroll
                    for (int n = 0; n < 2; ++n) acc[a][b][m][n] = (f32x4){0.f, 0.f, 0.f, 0.f};
        cur = nxt; cB = nB; cA = nA; ++ui;
        if constexpr (ALIGN_EPI) { if (wr == 1) PG8_BAR; }
    }
    PG8_WAIT_V(0);
    if constexpr (!ALIGN_EPI) { if (wr == 0) PG8_BAR; }
    PG8_BAR;
#undef PG8_SA
#undef PG8_SB
#undef PG8_STAGEA
#undef PG8_STAGEB
#undef PG8_LDA
#undef PG8_LDB
#undef PG8_MMA
#undef PG8_WAIT_V
#undef PG8_WAIT_L
#undef PG8_BAR
#undef PG8_SCHED
}
}

struct Args {
    const float* x; const float* ln_emb_g; const float* ln_emb_b; const float* w_in; const float* q_norm_g; const float* kv_norm_g;
    const float* w_uq; const float* w_ukv; const float* beta_mla; const float* beta_moba; const float* w_o; const float* ln1_g; const float* ln1_b;
    const float* ffn_w_gate; const float* ffn_w_up; const float* ffn_w_down; const float* router; const float* exp_w_gate; const float* exp_w_up;
    const float* exp_w_down; const float* ln2_g; const float* ln2_b;
    float* out; unsigned char* ws; int ph_lo, ph_hi;
};
struct Frame {
    LAS unsigned char* lds; int tid, lane, wave, bid, G;
};

enum { CM_ID = 0, CM_WIN = 1, CM_UQ = 2, CM_UKV = 3, CM_GU = 4 };
__device__ __forceinline__ int colmap(int kind, int n, int aux) {
    switch (kind) {
    case CM_WIN: {
        if (n >= HC_END) return -1;
        if (n >= HC_RQ && n < HC_RV) { const int base = n < HC_RK ? HC_RQ : HC_RK, r = n - base, hh = r >> 6, p = r & 63; const int d = ((p >> 5) << 4) + (p & 15) + ((p & 16) ? 32 : 0); return base + hh * 64 + d; }
        return n; }
    case CM_UQ: {
        if (n < 384) return (n >> 6) * 96 + (n & 63);
        if (n < 576) { const int r = n - 384; return (r >> 5) * 96 + 64 + (r & 31); }
        return -1; }
    case CM_UKV: {
        if (n < 384) return (n >> 6) * 128 + (n & 63);
        { const int r = n - 384; return (r >> 6) * 128 + 64 + (r & 63); } }
    case CM_GU: {
        const int j = n >> 8, w = n & 255; return j * 128 + (w & 127) + ((w >> 7) ? aux : 0); }
    default: return n;
    }
}
__device__ __forceinline__ void transpose_item(const float* W0, const float* W1, int K, int N, f16* WT, int kind, const float* kscale, const float* kscale2, LAS float* scr, int item, int nblk, int lane) {
    const int kb = item / nblk, nb = item % nblk, k0 = 64 * kb, n0 = 32 * nb;
    const int nn = lane & 31; int sc = colmap(kind, n0 + nn, N); const float* W = W0;
    if (kind == CM_GU && sc >= N) { sc -= N; W = W1; }
#pragma unroll 8
    for (int i = 0; i < 32; ++i) { const int kk = 2 * i + (lane >> 5); float v = 0.f; if (sc >= 0) v = W[(size_t)(k0 + kk) * N + sc]; if (kscale2) { const int k = k0 + kk; v *= k < 384 ? kscale[k] : (k >= 704 ? kscale2[k - 704] : 1.0f); } else if (kscale) v *= kscale[k0 + kk]; scr[kk * 33 + nn] = v; }
    asm volatile("s_waitcnt lgkmcnt(0)" ::: "memory");
    const int c = lane & 7;
#pragma unroll
    for (int j = 0; j < 4; ++j) { const int n = (lane >> 3) + 8 * j; const LAS float* s = scr + (8 * c) * 33 + n;
        u32x4 o; o.x = pk_f16(s[0 * 33], s[1 * 33]); o.y = pk_f16(s[2 * 33], s[3 * 33]); o.z = pk_f16(s[4 * 33], s[5 * 33]); o.w = pk_f16(s[6 * 33], s[7 * 33]);
        *(u32x4*)(WT + (size_t)(n0 + n) * K + k0 + 8 * c) = o; }
    asm volatile("s_waitcnt lgkmcnt(0)" ::: "memory");
}

__device__ __forceinline__ void ln_stats(const f32x4 (&v)[4], float& mean, float& rstd) {
    float s = 0.f;
#pragma unroll
    for (int j = 0; j < 4; ++j) s += (v[j][0] + v[j][1]) + (v[j][2] + v[j][3]);
    mean = wave_sum(s) * (1.f / D); float s2 = 0.f;
#pragma unroll
    for (int j = 0; j < 4; ++j) { const f32x4 d = v[j] - mean; s2 += (d[0] * d[0] + d[1] * d[1]) + (d[2] * d[2] + d[3] * d[3]); }
    rstd = 1.0f / sqrtf(wave_sum(s2) * (1.f / D) + LN_EPS);
}

template <int DK>
__device__ __forceinline__ void stage_kv(LAS float* Ks, LAS float* Vs, const f16* kp, int kld, const f16* k2p, int k2ld, const f16* vp, int vld, size_t row0, int tid) {
    constexpr int KCH = DK / 8;
    for (int t = tid; t < 32 * KCH + 32 * 8; t += 512) {
        if (t < 32 * KCH) { const int key = t / KCH, ch = t % KCH; const f16* src = (ch < 8) ? kp + (row0 + key) * kld + ch * 8 : k2p + (row0 + key) * k2ld + (ch - 8) * 8;
            const f16x8 v = *(const f16x8*)src; LAS float* d = Ks + key * DK + ch * 8;
#pragma unroll
            for (int e = 0; e < 8; ++e) d[e] = (float)v[e]; }
        else { const int t2 = t - 32 * KCH, key = t2 >> 3, ch = t2 & 7; const f16x8 v = *(const f16x8*)(vp + (row0 + key) * vld + ch * 8); LAS float* d = Vs + key * 64 + ch * 8;
#pragma unroll
            for (int e = 0; e < 8; ++e) d[e] = (float)v[e]; }
    }
}

template <int MODE>
__device__ __forceinline__ void attn_softmax_simple(const Frame& F, const f16* qb, const f16* kvb, const f16* hb, const float* kmean, f16* ob, float* ssq_o) {
    constexpr int DK = MODE == 0 ? 96 : 64, NHD = MODE == 0 ? 6 : 5;
    LAS float* Ks = (LAS float*)F.lds; LAS float* Vs = Ks + 32 * DK; LAS float* KM = Vs + 32 * 64;
    const int tid = F.tid;
    for (int unit = F.bid; unit < BATCH * NHD * 4; unit += F.G) {
        const int qt = 3 - (unit % 4), hh = (unit / 4) % NHD, b = unit / (4 * NHD);
        const size_t brow = (size_t)b * SEQ; const int qpos = qt * 512 + tid; const size_t row = brow + qpos;
        float q[DK];
        if (MODE == 0) {
#pragma unroll
            for (int c = 0; c < 8; ++c) { const f16x8 v = *(const f16x8*)(qb + row * QW + hh * 64 + c * 8);
#pragma unroll
                for (int e = 0; e < 8; ++e) q[c * 8 + e] = (float)v[e]; }
#pragma unroll
            for (int c = 0; c < 4; ++c) { const f16x8 v = *(const f16x8*)(qb + row * QW + 384 + hh * 32 + c * 8);
#pragma unroll
                for (int e = 0; e < 8; ++e) q[64 + c * 8 + e] = (float)v[e]; }
        } else {
#pragma unroll
            for (int c = 0; c < 8; ++c) { const f16x8 v = *(const f16x8*)(hb + row * HW + HC_MQ + hh * 64 + c * 8);
#pragma unroll
                for (int e = 0; e < 8; ++e) q[c * 8 + e] = (float)v[e]; }
        }
        const int blk = qpos >> 8; unsigned sel = 0u; float slope2 = 0.f;
        if (MODE == 1) {
            __syncthreads();
            { const int n = tid >> 6, d = tid & 63; KM[n * 64 + d] = kmean[(size_t)(b * 8 + n) * 320 + hh * 64 + d]; }
            __syncthreads();
            float gt[8];
#pragma unroll
            for (int n = 0; n < 8; ++n) { float s = 0.f;
#pragma unroll
                for (int d = 0; d < 64; ++d) s += q[d] * KM[n * 64 + d];
                gt[n] = s; }
#pragma unroll
            for (int n = 0; n < 8; ++n) { int rank = 0;
#pragma unroll
                for (int m = 0; m < 8; ++m) if (m < blk && m != n) rank += (gt[m] > gt[n] || (gt[m] == gt[n] && m < n)) ? 1 : 0;
                if (n < blk && rank < 3) sel |= 1u << n; }
            slope2 = exp2f(-8.0f * (float)(hh + 1) / 5.0f) * LOG2E;
        }
        float o[64];
#pragma unroll
        for (int d = 0; d < 64; ++d) o[d] = 0.f;
        float mrun = -INFINITY, lrun = 0.f;
        const int nkeys = (qt + 1) * 512;
        for (int k0 = 0; k0 < nkeys; k0 += 32) {
            __syncthreads();
            if (MODE == 0) stage_kv<96>(Ks, Vs, kvb + hh * 64, KVW, hb + HC_KR, HW, kvb + 384 + hh * 64, KVW, brow + k0, tid);
            else stage_kv<64>(Ks, Vs, hb + HC_MK + hh * 64, HW, nullptr, 0, hb + HC_MV + hh * 64, HW, brow + k0, tid);
            __syncthreads();
            bool part;
            if (MODE == 0) part = k0 <= qpos;
            else { const int n = k0 >> 8; part = (n == blk) ? (k0 <= qpos) : (n < blk && ((sel >> n) & 1u)); }
            if (part) {
#pragma unroll 1
                for (int j = 0; j < 32; ++j) {
                    if (k0 + j > qpos) break;
                    const LAS float* Kj = Ks + j * DK; const LAS float* Vj = Vs + j * 64;
                    float a = 0.f;
#pragma unroll
                    for (int d = 0; d < DK; d += 4) { const f32x4 kv4 = *(const LAS f32x4*)(Kj + d); a += q[d] * kv4[0] + q[d + 1] * kv4[1] + q[d + 2] * kv4[2] + q[d + 3] * kv4[3]; }
                    if (MODE == 1) a -= slope2 * (float)(qpos - (k0 + j));
                    if (a > mrun) { const float alpha = exp2f(mrun - a); lrun *= alpha;
#pragma unroll
                        for (int d = 0; d < 64; ++d) o[d] *= alpha;
                        mrun = a; }
                    const float p = exp2f(a - mrun); lrun += p;
#pragma unroll
                    for (int d = 0; d < 64; d += 4) { const f32x4 v4 = *(const LAS f32x4*)(Vj + d); o[d] += p * v4[0]; o[d + 1] += p * v4[1]; o[d + 2] += p * v4[2]; o[d + 3] += p * v4[3]; }
                }
            }
        }
        const float inv = 1.0f / lrun; float ss = 0.f;
#pragma unroll
        for (int d = 0; d < 64; ++d) { o[d] *= inv; ss += o[d] * o[d]; }
        f16* op = ob + row * D + (MODE == 0 ? 0 : OC_MOBA) + hh * 64;
#pragma unroll
        for (int c = 0; c < 8; ++c) { u32x4 w; w.x = pk_f16(o[c * 8], o[c * 8 + 1]); w.y = pk_f16(o[c * 8 + 2], o[c * 8 + 3]); w.z = pk_f16(o[c * 8 + 4], o[c * 8 + 5]); w.w = pk_f16(o[c * 8 + 6], o[c * 8 + 7]); *(u32x4*)(op + c * 8) = w; }
        ssq_o[row * 16 + (MODE == 0 ? 0 : 6) + hh] = ss;
    }
}
__device__ __forceinline__ void attn_ret_simple(const Frame& F, const f16* hb, f16* ob) {
    LAS float* Ks = (LAS float*)F.lds; LAS float* Vs = Ks + 32 * 64;
    const int tid = F.tid;
    for (int unit = F.bid; unit < BATCH * 5 * 4; unit += F.G) {
        const int qt = 3 - (unit % 4), hh = (unit / 4) % 5, b = unit / 20;
        const size_t brow = (size_t)b * SEQ; const int qpos = qt * 512 + tid; const size_t row = brow + qpos;
        float q[64];
#pragma unroll
        for (int c = 0; c < 8; ++c) { const f16x8 v = *(const f16x8*)(hb + row * HW + HC_RQ + hh * 64 + c * 8);
#pragma unroll
            for (int e = 0; e < 8; ++e) q[c * 8 + e] = (float)v[e]; }
        const float lg2 = log2f(1.0f - exp2f(-5.0f - (float)hh));
        float o[64];
#pragma unroll
        for (int d = 0; d < 64; ++d) o[d] = 0.f;
        const int nkeys = (qt + 1) * 512;
        for (int k0 = 0; k0 < nkeys; k0 += 32) {
            __syncthreads();
            stage_kv<64>(Ks, Vs, hb + HC_RK + hh * 64, HW, nullptr, 0, hb + HC_RV + hh * 64, HW, brow + k0, tid);
            __syncthreads();
            if (k0 <= qpos) {
#pragma unroll 1
                for (int j = 0; j < 32; ++j) {
                    const int dl = qpos - (k0 + j); if (dl < 0) break;
                    const LAS float* Kj = Ks + j * 64; const LAS float* Vj = Vs + j * 64;
                    float a = 0.f;
#pragma unroll
                    for (int d = 0; d < 64; d += 4) { const f32x4 kv4 = *(const LAS f32x4*)(Kj + d); a += q[d] * kv4[0] + q[d + 1] * kv4[1] + q[d + 2] * kv4[2] + q[d + 3] * kv4[3]; }
                    const float p = a * exp2f(lg2 * (float)dl);
#pragma unroll
                    for (int d = 0; d < 64; d += 4) { const f32x4 v4 = *(const LAS f32x4*)(Vj + d); o[d] += p * v4[0]; o[d + 1] += p * v4[1]; o[d + 2] += p * v4[2]; o[d + 3] += p * v4[3]; }
                }
            }
        }
        float mu = 0.f;
#pragma unroll
        for (int d = 0; d < 64; ++d) mu += o[d];
        mu *= (1.f / 64.f); float var = 0.f;
#pragma unroll
        for (int d = 0; d < 64; ++d) { const float t = o[d] - mu; var += t * t; }
        const float rs = 1.0f / sqrtf(var * (1.f / 64.f) + RMS_EPS);
        f16* op = ob + row * D + OC_RET + hh * 64; const f16* gp = hb + row * HW + HC_RG + hh * 64;
#pragma unroll
        for (int c = 0; c < 8; ++c) { const f16x8 gv = *(const f16x8*)(gp + c * 8); float r[8];
#pragma unroll
            for (int e = 0; e < 8; ++e) r[e] = silu_f((float)gv[e]) * ((o[c * 8 + e] - mu) * rs);
            u32x4 w; w.x = pk_f16(r[0], r[1]); w.y = pk_f16(r[2], r[3]); w.z = pk_f16(r[4], r[5]); w.w = pk_f16(r[6], r[7]); *(u32x4*)(op + c * 8) = w; }
    }
}

namespace att {
typedef float f32x16 __attribute__((ext_vector_type(16)));
typedef short s16x4 __attribute__((ext_vector_type(4)));
constexpr int BUF_STRIDE = 20480, OFF_V = 8192, OFF_PE = 16384, OFF_OSTG = 40960, OSTG_WAVE = 32 * 272, OFF_L = OFF_OSTG + 8 * OSTG_WAVE, OFF_F = OFF_L + 1024, OFF_QW = OFF_F + 1024;
constexpr float THR = 8.0f;
__device__ __forceinline__ int crowc(int r) { return (r & 3) + 8 * (r >> 2); }
__device__ __forceinline__ float pswap_max(float v) { const auto rr = __builtin_amdgcn_permlane32_swap(__float_as_uint(v), __float_as_uint(v), false, false); return fmaxf(__uint_as_float(rr[0]), __uint_as_float(rr[1])); }
__device__ __forceinline__ float pswap_sum(float v) { const auto rr = __builtin_amdgcn_permlane32_swap(__float_as_uint(v), __float_as_uint(v), false, false); return __uint_as_float(rr[0]) + __uint_as_float(rr[1]); }
#define ATT_WAIT_BAR() asm volatile("s_waitcnt vmcnt(0) lgkmcnt(0)\n\ts_barrier" ::: "memory")
__device__ __forceinline__ f16x8 vfrag(const LAS unsigned char* p0, const LAS unsigned char* p1) {
    const s16x4 lo = __builtin_bit_cast(s16x4, __builtin_amdgcn_ds_read_tr16_b64_v4i16((LAS s16x4*)p0));
    const s16x4 hi = __builtin_bit_cast(s16x4, __builtin_amdgcn_ds_read_tr16_b64_v4i16((LAS s16x4*)p1));
    typedef short s16x8 __attribute__((ext_vector_type(8)));
    const s16x8 v = {lo[0], lo[1], lo[2], lo[3], hi[0], hi[1], hi[2], hi[3]};
    return __builtin_bit_cast(f16x8, v);
}
template <int KIND>
__device__ __forceinline__ void attn_unit(LAS unsigned char* lds, int b, int hh, int qt, const f16* qbuf, const f16* kvbuf, const f16* hbuf, const float* kmean, f16* obuf, float* ssq_o) {
    int tid_ = threadIdx.x; asm volatile("" : "+v"(tid_));
    const int tid = tid_, lane = tid & 63, wid = __builtin_amdgcn_readfirstlane(tid >> 6), r32 = lane & 31, hi = lane >> 5;
    constexpr int NQK = KIND == 0 ? 6 : 4;
    const size_t brow = (size_t)b * SEQ;
    const int q0w = qt * 256 + wid * 32, qpos = q0w + r32;
    const f16* kbase; int kld; const f16* vbase; int vld; const f16* qrow;
    if (KIND == 0) { kbase = kvbuf + hh * 64; kld = KVW; vbase = kvbuf + 384 + hh * 64; vld = KVW; qrow = qbuf + (brow + qpos) * QW + hh * 64; }
    else if (KIND == 1) { kbase = hbuf + HC_MK + hh * 64; kld = HW; vbase = hbuf + HC_MV + hh * 64; vld = HW; qrow = hbuf + (brow + qpos) * HW + HC_MQ + hh * 64; }
    else { kbase = hbuf + HC_RK + hh * 64; kld = HW; vbase = hbuf + HC_RV + hh * 64; vld = HW; qrow = hbuf + (brow + qpos) * HW + HC_RQ + hh * 64; }
    const int dkey = 8 * wid + (lane >> 3), dcs = lane & 7;
    const char* ksrc = (const char*)(kbase + (brow + dkey) * kld + ((dcs ^ ((dkey >> 1) & 7)) << 3));
    const char* vsrc = (const char*)(vbase + (brow + dkey) * vld + (((((dcs >> 2) ^ ((dkey >> 1) & 1)) << 2) | (dcs & 3)) << 3));
    const int pkey = 16 * wid + (lane >> 2), pcs = lane & 3;
    const char* psrc = (const char*)(hbuf + (brow + pkey) * HW + HC_KR + ((pcs ^ ((pkey >> 2) & 3)) << 3));
    const size_t ktile = (size_t)64 * kld * 2, vtile = (size_t)64 * vld * 2, ptile = (size_t)64 * HW * 2;
#define ATT_DMA(t, buf) do { \
        __builtin_amdgcn_global_load_lds((const unsigned*)(ksrc + (size_t)(t) * ktile), (LAS unsigned*)(lds + (buf) * BUF_STRIDE + wid * 1024), 16, 0, 0); \
        __builtin_amdgcn_global_load_lds((const unsigned*)(vsrc + (size_t)(t) * vtile), (LAS unsigned*)(lds + (buf) * BUF_STRIDE + OFF_V + wid * 1024), 16, 0, 0); \
        if (KIND == 0) { if (wid < 4) __builtin_amdgcn_global_load_lds((const unsigned*)(psrc + (size_t)(t) * ptile), (LAS unsigned*)(lds + (buf) * BUF_STRIDE + OFF_PE + wid * 1024), 16, 0, 0); } } while (0)
    const int NT = 4 * (qt + 1);
    ATT_DMA(0, 0);
    f16x8 qf[NQK];
#pragma unroll
    for (int d0 = 0; d0 < 4; ++d0) qf[d0] = *(const f16x8*)(qrow + 16 * d0 + 8 * hi);
    if (KIND == 0) { const f16* qpe = qbuf + (brow + qpos) * QW + 384 + hh * 32; qf[4] = *(const f16x8*)(qpe + 8 * hi); qf[5] = *(const f16x8*)(qpe + 16 + 8 * hi); }
    const int ksw = (r32 >> 1) & 7, psw = (r32 >> 2) & 3;
    int koff[4];
#pragma unroll
    for (int d0 = 0; d0 < 4; ++d0) koff[d0] = r32 * 128 + (((2 * d0 + hi) ^ ksw) << 4);
    int poff[2];
#pragma unroll
    for (int d0 = 0; d0 < 2; ++d0) poff[d0] = r32 * 64 + (((2 * d0 + hi) ^ psw) << 4);
    const int vq = (lane & 15) >> 2, vp = lane & 3, vg = (lane >> 4) & 1, vsw = (vq >> 1) & 1;
    int voff[2];
#pragma unroll
    for (int d0 = 0; d0 < 2; ++d0) voff[d0] = (4 * hi + vq) * 128 + ((d0 ^ vsw) << 6) + ((2 * vg + (vp >> 1)) << 4) + 8 * (vp & 1);
    unsigned sel = 0u; float slope2 = 0.f;
    if (KIND == 1) {
        slope2 = exp2f(-8.0f * (float)(hh + 1) / 5.0f) * LOG2E;
        if (qt >= 4) {
            if (tid < 64) { const int n = tid >> 3, cs = tid & 7, c = cs ^ ((n >> 1) & 7); const float* src = kmean + (size_t)(b * 8 + n) * 320 + hh * 64 + c * 8;
                const f32x4 a0 = *(const f32x4*)src, a1 = *(const f32x4*)(src + 4);
                u32x4 w; w.x = pk_f16(a0[0], a0[1]); w.y = pk_f16(a0[2], a0[3]); w.z = pk_f16(a1[0], a1[1]); w.w = pk_f16(a1[2], a1[3]);
                *(LAS u32x4*)(lds + BUF_STRIDE + n * 128 + cs * 16) = w; }
            asm volatile("s_waitcnt lgkmcnt(0)\n\ts_barrier" ::: "memory");
            f32x16 pg = {};
#pragma unroll
            for (int d0 = 0; d0 < 4; ++d0) { const f16x8 kf = *(const LAS f16x8*)(lds + BUF_STRIDE + koff[d0]); pg = __builtin_amdgcn_mfma_f32_32x32x16_f16(kf, qf[d0], pg, 0, 0, 0); }
            float gt[8];
#pragma unroll
            for (int r = 0; r < 4; ++r) { const auto rr = __builtin_amdgcn_permlane32_swap(__float_as_uint(pg[r]), __float_as_uint(pg[r]), false, false); gt[r] = __uint_as_float(rr[0]); gt[4 + r] = __uint_as_float(rr[1]); }
#pragma unroll
            for (int n = 0; n < 8; ++n) { int rank = 0;
#pragma unroll
                for (int m = 0; m < 8; ++m) if (m != n) rank += (m < qt && (gt[m] > gt[n] || (gt[m] == gt[n] && m < n))) ? 1 : 0;
                if (n < qt && rank < 3) sel |= 1u << n; }
        } else sel = 0xffu;
    }
    float lg2 = 0.f, e32 = 0.f; float dc[16];
    if (KIND == 2) { lg2 = log2f(1.0f - exp2f(-5.0f - (float)hh)); e32 = exp2f(-32.0f * lg2);
#pragma unroll
        for (int r = 0; r < 16; ++r) dc[r] = exp2f(-lg2 * (float)crowc(r)); }
    f32x16 o0 = {}, o1 = {};
    float mref = -1.0e30f, lsum = 0.f;
    LAS float* wsf = (LAS float*)(lds + OFF_F) + wid * 32;
    for (int t = 0; t < NT; ++t) {
        ATT_WAIT_BAR();
        if (t + 1 < NT) ATT_DMA(t + 1, (t + 1) & 1);
        const int k0 = 64 * t;
        bool active = k0 <= q0w + 31;
        if (KIND == 1) { const int n = t >> 2; if (n < qt) active = __any((sel >> n) & 1u) != 0; }
        if (!active) continue;
        const LAS unsigned char* kb = lds + (t & 1) * BUF_STRIDE;
        f32x16 p0, p1;
        if (KIND == 1) { const float cb = slope2 * (float)(k0 + 4 * hi - qpos);
#pragma unroll
            for (int r = 0; r < 16; ++r) { p0[r] = fmaf(slope2, (float)crowc(r), cb); p1[r] = fmaf(slope2, (float)(crowc(r) + 32), cb); } }
        else { p0 = (f32x16){}; p1 = (f32x16){}; }
#pragma unroll
        for (int d0 = 0; d0 < 4; ++d0) { const f16x8 k0f = *(const LAS f16x8*)(kb + koff[d0]), k1f = *(const LAS f16x8*)(kb + koff[d0] + 4096);
            p0 = __builtin_amdgcn_mfma_f32_32x32x16_f16(k0f, qf[d0], p0, 0, 0, 0); p1 = __builtin_amdgcn_mfma_f32_32x32x16_f16(k1f, qf[d0], p1, 0, 0, 0); }
        if (KIND == 0) {
#pragma unroll
            for (int d0 = 0; d0 < 2; ++d0) { const f16x8 k0f = *(const LAS f16x8*)(kb + OFF_PE + poff[d0]), k1f = *(const LAS f16x8*)(kb + OFF_PE + poff[d0] + 2048);
                p0 = __builtin_amdgcn_mfma_f32_32x32x16_f16(k0f, qf[4 + d0], p0, 0, 0, 0); p1 = __builtin_amdgcn_mfma_f32_32x32x16_f16(k1f, qf[4 + d0], p1, 0, 0, 0); } }
        const bool diag = k0 + 63 > q0w;
        const int kk = qpos - k0 - 4 * hi;
        u32x4 pw[4];
        if (KIND != 2) {
            if (diag) {
#pragma unroll
                for (int r = 0; r < 16; ++r) { if (crowc(r) > kk) p0[r] = -INFINITY; if (crowc(r) + 32 > kk) p1[r] = -INFINITY; } }
            if (KIND == 1) { const int n = t >> 2; if (n < qt && !((sel >> n) & 1u)) {
#pragma unroll
                for (int r = 0; r < 16; ++r) { p0[r] = -INFINITY; p1[r] = -INFINITY; } } }
            float rm = fmaxf(p0[0], p1[0]);
#pragma unroll
            for (int r = 1; r < 16; ++r) rm = fmaxf(rm, fmaxf(p0[r], p1[r]));
            rm = pswap_max(rm);
            if (__any(rm > mref + THR)) {
                const float mnew = fmaxf(mref, rm), f = __builtin_amdgcn_exp2f(mref - mnew);
                lsum *= f; mref = mnew;
                if (hi == 0) wsf[r32] = f;
                asm volatile("s_waitcnt lgkmcnt(0)" ::: "memory");
#pragma unroll
                for (int r = 0; r < 16; ++r) { const float fr = wsf[crowc(r) + 4 * hi]; o0[r] *= fr; o1[r] *= fr; }
            }
            float ls = 0.f;
#pragma unroll
            for (int r = 0; r < 16; ++r) { p0[r] = __builtin_amdgcn_exp2f(p0[r] - mref); p1[r] = __builtin_amdgcn_exp2f(p1[r] - mref); ls += p0[r] + p1[r]; }
            lsum += ls;
        } else {
            const float et = __builtin_amdgcn_exp2f(lg2 * (float)kk);
#pragma unroll
            for (int r = 0; r < 16; ++r) { const float w = et * dc[r]; p0[r] *= w; p1[r] *= w * e32; }
            if (diag) {
#pragma unroll
                for (int r = 0; r < 16; ++r) { if (crowc(r) > kk) p0[r] = 0.f; if (crowc(r) + 32 > kk) p1[r] = 0.f; } }
        }
#pragma unroll
        for (int i = 0; i < 4; ++i) { pw[0][i] = pk_f16(p0[2 * i], p0[2 * i + 1]); pw[1][i] = pk_f16(p0[8 + 2 * i], p0[8 + 2 * i + 1]); pw[2][i] = pk_f16(p1[2 * i], p1[2 * i + 1]); pw[3][i] = pk_f16(p1[8 + 2 * i], p1[8 + 2 * i + 1]); }
        const LAS unsigned char* vb = kb + OFF_V;
#pragma unroll
        for (int ks = 0; ks < 4; ++ks) {
            const f16x8 pa = __builtin_bit_cast(f16x8, pw[ks]);
            const f16x8 v0 = vfrag(vb + voff[0] + ks * 2048, vb + voff[0] + ks * 2048 + 1024);
            const f16x8 v1 = vfrag(vb + voff[1] + ks * 2048, vb + voff[1] + ks * 2048 + 1024);
            o0 = __builtin_amdgcn_mfma_f32_32x32x16_f16(pa, v0, o0, 0, 0, 0);
            o1 = __builtin_amdgcn_mfma_f32_32x32x16_f16(pa, v1, o1, 0, 0, 0);
        }
    }
    LAS float* stg = (LAS float*)(lds + OFF_OSTG + wid * OSTG_WAVE);
#pragma unroll
    for (int r = 0; r < 16; ++r) { const int row = crowc(r) + 4 * hi; stg[row * 68 + r32] = o0[r]; stg[row * 68 + 32 + r32] = o1[r]; }
    LAS float* lrow = (LAS float*)(lds + OFF_L) + wid * 32;
    if (KIND != 2) { const float lt = pswap_sum(lsum); if (hi == 0) lrow[r32] = lt; }
    asm volatile("s_waitcnt lgkmcnt(0)" ::: "memory");
    {
        const int row = lane >> 1, half = lane & 1; float v[32];
#pragma unroll
        for (int i = 0; i < 8; ++i) { const f32x4 x = *(const LAS f32x4*)(stg + row * 68 + half * 32 + i * 4); v[4 * i] = x[0]; v[4 * i + 1] = x[1]; v[4 * i + 2] = x[2]; v[4 * i + 3] = x[3]; }
        const size_t grow = brow + q0w + row;
        if (KIND != 2) {
            const float inv = 1.0f / lrow[row]; float ss = 0.f;
#pragma unroll
            for (int i = 0; i < 32; ++i) { v[i] *= inv; ss += v[i] * v[i]; }
            ss += swz_xor<1>(ss);
            if (half == 0) ssq_o[grow * 16 + (KIND == 0 ? 0 : 6) + hh] = ss;
        } else {
            float s1 = 0.f;
#pragma unroll
            for (int i = 0; i < 32; ++i) s1 += v[i];
            s1 += swz_xor<1>(s1); const float mu = s1 * (1.f / 64.f); float s2 = 0.f;
#pragma unroll
            for (int i = 0; i < 32; ++i) { v[i] -= mu; s2 += v[i] * v[i]; }
            s2 += swz_xor<1>(s2); const float rs = 1.0f / sqrtf(s2 * (1.f / 64.f) + RMS_EPS);
            const f16* gp = hbuf + grow * HW + HC_RG + hh * 64 + half * 32;
#pragma unroll
            for (int c = 0; c < 4; ++c) { const f16x8 gv = *(const f16x8*)(gp + c * 8);
#pragma unroll
                for (int e = 0; e < 8; ++e) v[c * 8 + e] = silu_f((float)gv[e]) * (v[c * 8 + e] * rs); }
        }
        f16* op = obuf + grow * D + (KIND == 0 ? 0 : (KIND == 1 ? OC_MOBA : OC_RET)) + hh * 64 + half * 32;
#pragma unroll
        for (int c = 0; c < 4; ++c) { u32x4 w; w.x = pk_f16(v[c * 8], v[c * 8 + 1]); w.y = pk_f16(v[c * 8 + 2], v[c * 8 + 3]); w.z = pk_f16(v[c * 8 + 4], v[c * 8 + 5]); w.w = pk_f16(v[c * 8 + 6], v[c * 8 + 7]); *(u32x4*)(op + c * 8) = w; }
    }
#undef ATT_DMA
}
__device__ __forceinline__ void attn_phase(LAS unsigned char* lds, unsigned* qctr, const f16* qbuf, const f16* kvbuf, const f16* hbuf, const float* kmean, f16* obuf, float* ssq_o) {
    volatile LAS int* qw = (volatile LAS int*)(lds + OFF_QW);
    for (;;) {
        asm volatile("s_waitcnt vmcnt(0) lgkmcnt(0)\n\ts_barrier" ::: "memory");
        if (threadIdx.x == 0) qw[0] = (int)__hip_atomic_fetch_add(qctr, 1u, __ATOMIC_RELAXED, __HIP_MEMORY_SCOPE_AGENT);
        asm volatile("s_waitcnt vmcnt(0) lgkmcnt(0)\n\ts_barrier" ::: "memory");
        const int idx = __builtin_amdgcn_readfirstlane(qw[0]);
        if (idx >= 2048) break;
        const int qt = 7 - (idx >> 8), j = idx & 255;
        if (j < 96) attn_unit<0>(lds, j / 6, j % 6, qt, qbuf, kvbuf, hbuf, kmean, obuf, ssq_o);
        else if (j < 176) attn_unit<1>(lds, (j - 96) / 5, (j - 96) % 5, qt, qbuf, kvbuf, hbuf, kmean, obuf, ssq_o);
        else attn_unit<2>(lds, (j - 176) / 5, (j - 176) % 5, qt, qbuf, kvbuf, hbuf, kmean, obuf, ssq_o);
    }
}
#undef ATT_WAIT_BAR
}

constexpr int NWAVES = 8;
constexpr int PH_L0 = 1, PPL0 = 11, PH_L1 = PH_L0 + PPL0, PPL1 = 20, NPHASE = PH_L1 + PPL1;
typedef const __attribute__((address_space(4))) Args* KArgs;
__device__ __forceinline__ KArgs kargs() { KArgs p = (KArgs)__builtin_amdgcn_kernarg_segment_ptr(); asm volatile("" : "+s"(p)); return p; }
__device__ __forceinline__ Frame mkframe() {
    extern __shared__ __attribute__((aligned(16))) unsigned char lds_raw[];
    Frame F; F.lds = (LAS unsigned char*)lds_raw; int t = threadIdx.x; asm volatile("" : "+v"(t)); F.tid = t; F.lane = t & 63; F.wave = __builtin_amdgcn_readfirstlane(t >> 6); F.bid = blockIdx.x; F.G = gridDim.x; return F;
}
#define WSP(T_, off) ((T_*)(ws + (off)))

__device__ __forceinline__ void ph_prologue() {
    const Frame F = mkframe(); KArgs a = kargs(); unsigned char* ws = a->ws;
    const int gw = F.bid * NWAVES + F.wave, NGW = F.G * NWAVES;
    f16* Win = WSP(f16, WS_WIN); f16* Wuq = WSP(f16, WS_WUQ); f16* Wukv = WSP(f16, WS_WUKV); f16* Wo = WSP(f16, WS_WO); f16* Wgu = WSP(f16, WS_WGU); f16* Wdn = WSP(f16, WS_WDN);
    f16* Egu = WSP(f16, WS_EGU); f16* Edn = WSP(f16, WS_EDN); f16* xb = WSP(f16, WS_XB);
    float* cosA = WSP(float, WS_ROPE); float* sinA = cosA + SEQ * 16; float* cosB = sinA + SEQ * 16; float* sinB = cosB + SEQ * 32;
    LAS float* scr = (LAS float*)(F.lds + F.wave * 16384);
    constexpr int I_WIN = (D / 64) * (HW / 32), I_UQ = (256 / 64) * (768 / 32), I_UKV = (128 / 64) * (768 / 32), I_WO = (D / 64) * (D / 32);
    constexpr int I_GU = (D / 64) * (2 * FF / 32), I_DN = (FF / 64) * (D / 32), I_EGU = (D / 64) * (2 * FE / 32), I_EDN = (FE / 64) * (D / 32);
    constexpr int N_SMALL = 2 * (I_WIN + I_UQ + I_UKV + I_WO) + I_GU + I_DN, N_ALL = N_SMALL + NE * (I_EGU + I_EDN);
    for (int it = gw; it < N_ALL; it += NGW) {
        int r = it;
        if (r < 2 * I_WIN) { const int l = r / I_WIN; r %= I_WIN; transpose_item(a->w_in + (size_t)l * D * HC_END, nullptr, D, HC_END, Win + (size_t)l * HW * D, CM_WIN, nullptr, nullptr, scr, r, HW / 32, F.lane); continue; } r -= 2 * I_WIN;
        if (r < 2 * I_UQ) { const int l = r / I_UQ; r %= I_UQ; transpose_item(a->w_uq + (size_t)l * 256 * 576, nullptr, 256, 576, Wuq + (size_t)l * 768 * 256, CM_UQ, a->q_norm_g + l * 256, nullptr, scr, r, 768 / 32, F.lane); continue; } r -= 2 * I_UQ;
        if (r < 2 * I_UKV) { const int l = r / I_UKV; r %= I_UKV; transpose_item(a->w_ukv + (size_t)l * 128 * 768, nullptr, 128, 768, Wukv + (size_t)l * 768 * 128, CM_UKV, a->kv_norm_g + l * 128, nullptr, scr, r, 768 / 32, F.lane); continue; } r -= 2 * I_UKV;
        if (r < 2 * I_WO) { const int l = r / I_WO; r %= I_WO; transpose_item(a->w_o + (size_t)l * D * D, nullptr, D, D, Wo + (size_t)l * D * D, CM_ID, a->beta_mla + l * 384, a->beta_moba + l * 320, scr, r, D / 32, F.lane); continue; } r -= 2 * I_WO;
        if (r < I_GU) { transpose_item(a->ffn_w_gate, a->ffn_w_up, D, FF, Wgu, CM_GU, nullptr, nullptr, scr, r, 2 * FF / 32, F.lane); continue; } r -= I_GU;
        if (r < I_DN) { transpose_item(a->ffn_w_down, nullptr, FF, D, Wdn, CM_ID, nullptr, nullptr, scr, r, D / 32, F.lane); continue; } r -= I_DN;
        { const int e = r / (I_EGU + I_EDN); r %= (I_EGU + I_EDN);
          if (r < I_EGU) transpose_item(a->exp_w_gate + (size_t)e * D * FE, a->exp_w_up + (size_t)e * D * FE, D, FE, Egu + (size_t)e * 2 * FE * D, CM_GU, nullptr, nullptr, scr, r, 2 * FE / 32, F.lane);
          else transpose_item(a->exp_w_down + (size_t)e * FE * D, nullptr, FE, D, Edn + (size_t)e * D * FE, CM_ID, nullptr, nullptr, scr, r - I_EGU, D / 32, F.lane); }
    }
    for (int i = F.bid * 512 + F.tid; i < SEQ * 48; i += F.G * 512) {
        if (i < SEQ * 16) { const int pos = i >> 4, j = i & 15; const float inv = powf(10000.0f, -(float)(2 * j) / 32.0f); const float ang = (float)pos * inv; cosA[i] = cosf(ang); sinA[i] = sinf(ang); }
        else { const int k = i - SEQ * 16, pos = k >> 5, j = k & 31; const float inv = powf(10000.0f, -(float)(2 * j) / 64.0f); const float ang = (float)pos * inv; cosB[k] = cosf(ang); sinB[k] = sinf(ang); }
    }
    const float* xin = a->x; const float* gp = a->ln_emb_g; const float* bp = a->ln_emb_b;
    for (int m = gw; m < T; m += NGW) {
        const f32x4* xr = (const f32x4*)(xin + (size_t)m * D) + F.lane; f32x4 v[4];
#pragma unroll
        for (int j = 0; j < 4; ++j) v[j] = xr[64 * j];
        float mean, rstd; ln_stats(v, mean, rstd);
        u32x2* o8 = (u32x2*)(xb + (size_t)m * D) + F.lane;
#pragma unroll
        for (int j = 0; j < 4; ++j) { const f32x4 g = *((const f32x4*)gp + F.lane + 64 * j), bb = *((const f32x4*)bp + F.lane + 64 * j); const f32x4 y = (v[j] - mean) * rstd * g + bb;
            u32x2 w; w.x = pk_f16(y[0], y[1]); w.y = pk_f16(y[2], y[3]); o8[64 * j] = w; }
    }
}
__device__ __forceinline__ void ph_A(int l) {
    const Frame F = mkframe(); KArgs a = kargs(); unsigned char* ws = a->ws;
    pg8::Gemm g{WSP(f16, WS_XB), D, WSP(f16, WS_WIN) + (size_t)l * HW * D, D, D}; pg8::StaticOrder S; S.init(T / 256, HW / 256, F.G, F.bid);
    pg8::EpiF16 E{WSP(f16, WS_H), HW};
    pg8::gemm_phase<pg8::EpiF16, pg8::StaticOrder, true>(F.lds, g, S, E);
}
__device__ __forceinline__ void ph_A2() {
    const Frame F = mkframe(); KArgs a = kargs(); unsigned char* ws = a->ws;
    const int gw = F.bid * NWAVES + F.wave, NGW = F.G * NWAVES;
    f16* hbuf = WSP(f16, WS_H); float* ssq_q = WSP(float, WS_SSQ_Q); float* ssq_kv = WSP(float, WS_SSQ_KV); float* kmean = WSP(float, WS_KMEAN);
    const float* cosA = WSP(float, WS_ROPE); const float* sinA = cosA + SEQ * 16; const float* cosB = sinA + SEQ * 16; const float* sinB = cosB + SEQ * 32;
    for (int m = gw; m < T; m += NGW) {
        f16* hr = hbuf + (size_t)m * HW; const int pos = m & (SEQ - 1); const int lane = F.lane;
        { const f16x4 v = *(const f16x4*)(hr + HC_CQ + 4 * lane); float s = (float)v[0] * (float)v[0] + (float)v[1] * (float)v[1] + (float)v[2] * (float)v[2] + (float)v[3] * (float)v[3];
          s = wave_sum(s); if (lane < 4) ssq_q[(size_t)m * 4 + lane] = lane == 0 ? s : 0.f; }
        { const f16x2 v = *(const f16x2*)(hr + HC_CKV + 2 * lane); float s = (float)v[0] * (float)v[0] + (float)v[1] * (float)v[1];
          s = wave_sum(s); if (lane < 4) ssq_kv[(size_t)m * 4 + lane] = lane == 0 ? s : 0.f; }
        if (lane < 16) { const float c = cosA[pos * 16 + lane], s = sinA[pos * 16 + lane]; const float x1 = (float)hr[HC_KR + lane], x2 = (float)hr[HC_KR + 16 + lane];
            hr[HC_KR + lane] = (f16)(x1 * c - x2 * s); hr[HC_KR + 16 + lane] = (f16)(x1 * s + x2 * c); }
        if (lane < 32) { const float c = cosB[pos * 32 + lane], s = sinB[pos * 32 + lane]; const int p1 = ((lane >> 4) << 5) + (lane & 15);
#pragma unroll
            for (int hh = 0; hh < 5; ++hh) {
                { f16* p = hr + HC_RQ + hh * 64 + p1; const float x1 = (float)p[0], x2 = (float)p[16]; p[0] = (f16)(x1 * c - x2 * s); p[16] = (f16)(x1 * s + x2 * c); }
                { f16* p = hr + HC_RK + hh * 64 + p1; const float x1 = (float)p[0], x2 = (float)p[16]; p[0] = (f16)((x1 * c - x2 * s) * 0.125f); p[16] = (f16)((x1 * s + x2 * c) * 0.125f); } } }
#pragma unroll
        for (int j = 0; j < 5; ++j) { f16* p = hr + HC_MQ + lane + 64 * j; *p = (f16)((float)*p * (0.125f * LOG2E)); }
    }
    for (int i = F.bid * 512 + F.tid; i < 128 * 320; i += F.G * 512) { const int bk = i / 320, c = i % 320; const f16* p = hbuf + (size_t)bk * 256 * HW + HC_MK + c; float s = 0.f;
        for (int r = 0; r < 256; ++r) s += (float)p[(size_t)r * HW];
        kmean[i] = s * (1.f / 256.f); }
}
__device__ __forceinline__ void ph_B(int l) {
    { const Frame F = mkframe(); KArgs a = kargs(); unsigned char* ws = a->ws;
      pg8::Gemm g{WSP(f16, WS_H) + HC_CQ, HW, WSP(f16, WS_WUQ) + (size_t)l * 768 * 256, 256, 256}; pg8::StaticOrder S; S.init(T / 256, QW / 256, F.G, F.bid);
      pg8::EpiF16 E{(f16*)a->out, QW}; pg8::gemm_phase<pg8::EpiF16, pg8::StaticOrder, true>(F.lds, g, S, E); }
    { const Frame F = mkframe(); KArgs a = kargs(); unsigned char* ws = a->ws;
      pg8::Gemm g{WSP(f16, WS_H) + HC_CKV, HW, WSP(f16, WS_WUKV) + (size_t)l * 768 * 128, 128, 128}; pg8::StaticOrder S; S.init(T / 256, KVW / 256, F.G, F.bid);
      pg8::EpiF16 E{(f16*)((unsigned char*)a->out + 48 * MiB), KVW}; pg8::gemm_phase<pg8::EpiF16, pg8::StaticOrder, true>(F.lds, g, S, E); }
}
__device__ __forceinline__ void ph_B2() {
    const Frame F = mkframe(); KArgs a = kargs(); unsigned char* ws = a->ws;
    const int gw = F.bid * NWAVES + F.wave, NGW = F.G * NWAVES;
    const float* ssq_q = WSP(float, WS_SSQ_Q); const float* ssq_kv = WSP(float, WS_SSQ_KV); const float* cosA = WSP(float, WS_ROPE); const float* sinA = cosA + SEQ * 16;
    f16* qbuf = (f16*)a->out; f16* kvbuf = (f16*)((unsigned char*)a->out + 48 * MiB);
    for (int m = gw; m < T; m += NGW) {
        const int pos = m & (SEQ - 1), lane = F.lane;
        const float sq = (1.0f / sqrtf((ssq_q[(size_t)m * 4] + ssq_q[(size_t)m * 4 + 1] + ssq_q[(size_t)m * 4 + 2] + ssq_q[(size_t)m * 4 + 3]) * (1.f / 256.f) + RMS_EPS)) * (0.10206207261596575f * LOG2E);
        const float skv = 1.0f / sqrtf((ssq_kv[(size_t)m * 4] + ssq_kv[(size_t)m * 4 + 1] + ssq_kv[(size_t)m * 4 + 2] + ssq_kv[(size_t)m * 4 + 3]) * (1.f / 128.f) + RMS_EPS);
        f16* qr = qbuf + (size_t)m * QW; f16* kr = kvbuf + (size_t)m * KVW;
#pragma unroll
        for (int j = 0; j < 6; ++j) { f16* p = qr + lane + 64 * j; *p = (f16)((float)*p * sq); }
#pragma unroll
        for (int j = 0; j < 2; ++j) { const int pi = lane + 64 * j; if (pi < 96) { const int hh = pi >> 4, jj = pi & 15; const float c = cosA[pos * 16 + jj], s = sinA[pos * 16 + jj];
            f16* p = qr + 384 + hh * 32 + jj; const float x1 = (float)p[0] * sq, x2 = (float)p[16] * sq; p[0] = (f16)(x1 * c - x2 * s); p[16] = (f16)(x1 * s + x2 * c); } }
#pragma unroll
        for (int j = 0; j < 12; ++j) { f16* p = kr + lane + 64 * j; *p = (f16)((float)*p * skv); }
    }
}
constexpr int CW_ATTQ = 8192;
__device__ __forceinline__ void ph_C(int l) {
#if defined(ATTN_SIMPLE)
    { const Frame F = mkframe(); KArgs a = kargs(); unsigned char* ws = a->ws;
      attn_softmax_simple<0>(F, (const f16*)a->out, (const f16*)((unsigned char*)a->out + 48 * MiB), WSP(f16, WS_H), WSP(float, WS_KMEAN), WSP(f16, WS_O), WSP(float, WS_SSQ_O)); }
    { const Frame F = mkframe(); KArgs a = kargs(); unsigned char* ws = a->ws;
      attn_softmax_simple<1>(F, (const f16*)a->out, (const f16*)((unsigned char*)a->out + 48 * MiB), WSP(f16, WS_H), WSP(float, WS_KMEAN), WSP(f16, WS_O), WSP(float, WS_SSQ_O)); }
    { const Frame F = mkframe(); KArgs a = kargs(); unsigned char* ws = a->ws;
      attn_ret_simple(F, WSP(f16, WS_H), WSP(f16, WS_O)); }
#else
    const Frame F = mkframe(); KArgs a = kargs(); unsigned char* ws = a->ws;
    att::attn_phase(F.lds, WSP(unsigned, WS_CTL) + CW_ATTQ + 64 * l, (const f16*)a->out, (const f16*)((unsigned char*)a->out + 48 * MiB), WSP(f16, WS_H), WSP(float, WS_KMEAN), WSP(f16, WS_O), WSP(float, WS_SSQ_O));
#endif
}
__device__ __forceinline__ void ph_C2() {
    const Frame F = mkframe(); KArgs a = kargs(); unsigned char* ws = a->ws;
    const int gw = F.bid * NWAVES + F.wave, NGW = F.G * NWAVES;
    const float* ssq_o = WSP(float, WS_SSQ_O); f16* obuf = WSP(f16, WS_O);
    for (int m = gw; m < T; m += NGW) {
        const int lane = F.lane; const float* sp = ssq_o + (size_t)m * 16;
        const float sa = 1.0f / sqrtf((sp[0] + sp[1] + sp[2] + sp[3] + sp[4] + sp[5]) * (1.f / 384.f) + RMS_EPS);
        const float sc = 1.0f / sqrtf((sp[6] + sp[7] + sp[8] + sp[9] + sp[10]) * (1.f / 320.f) + RMS_EPS);
        f16* orow = obuf + (size_t)m * D;
#pragma unroll
        for (int j = 0; j < 6; ++j) { f16* p = orow + lane + 64 * j; *p = (f16)((float)*p * sa); }
#pragma unroll
        for (int j = 0; j < 5; ++j) { f16* p = orow + OC_MOBA + lane + 64 * j; *p = (f16)((float)*p * sc); }
    }
}
__device__ __forceinline__ void ph_D(int l) {
    const Frame F = mkframe(); KArgs a = kargs(); unsigned char* ws = a->ws;
    pg8::Gemm g{WSP(f16, WS_O), D, WSP(f16, WS_WO) + (size_t)l * D * D, D, D}; pg8::StaticOrder S; S.init(T / 256, D / 256, F.G, F.bid);
    pg8::EpiResF32 E{WSP(f16, WS_XB), a->out, D, DN_ALPHA};
    pg8::gemm_phase<pg8::EpiResF32, pg8::StaticOrder, true>(F.lds, g, S, E);
}
__device__ __forceinline__ void ph_D2(int l) {
    const Frame F = mkframe(); KArgs a = kargs(); unsigned char* ws = a->ws;
    const float* ybuf = a->out; f16* xb = WSP(f16, WS_XB); int* topi = WSP(int, WS_TOPI); float* topw = WSP(float, WS_TOPW); int* cnt = WSP(int, WS_CNT);
    const float* gp = a->ln1_g + l * D; const float* bp = a->ln1_b + l * D; const float* router = a->router;
    LAS int* lcnt = (LAS int*)(F.lds);
    for (int vw = F.bid; vw < 256; vw += F.G) {
        if (l == 1) { __syncthreads(); if (F.tid < 8) lcnt[F.tid] = 0; __syncthreads(); }
        for (int rr = F.wave; rr < 128; rr += NWAVES) {
            const int m = vw * 128 + rr; const int lane = F.lane;
            const f32x4* yr = (const f32x4*)(ybuf + (size_t)m * D) + lane; f32x4 v[4];
#pragma unroll
            for (int j = 0; j < 4; ++j) v[j] = yr[64 * j];
            float mean, rstd; ln_stats(v, mean, rstd);
            u32x2* o8 = (u32x2*)(xb + (size_t)m * D) + lane;
#pragma unroll
            for (int j = 0; j < 4; ++j) { const f32x4 g = *((const f32x4*)gp + lane + 64 * j), bb = *((const f32x4*)bp + lane + 64 * j); v[j] = (v[j] - mean) * rstd * g + bb;
                u32x2 w; w.x = pk_f16(v[j][0], v[j][1]); w.y = pk_f16(v[j][2], v[j][3]); o8[64 * j] = w; }
            if (l == 1) {
                float lg[8];
#pragma unroll
                for (int e = 0; e < 8; ++e) lg[e] = 0.f;
#pragma unroll
                for (int j = 0; j < 4; ++j)
#pragma unroll
                    for (int e4 = 0; e4 < 4; ++e4) { const int c = 4 * lane + 256 * j + e4; const f32x4 r0 = *(const f32x4*)(router + (size_t)c * 8), r1 = *(const f32x4*)(router + (size_t)c * 8 + 4); const float xv = v[j][e4];
                        lg[0] += xv * r0[0]; lg[1] += xv * r0[1]; lg[2] += xv * r0[2]; lg[3] += xv * r0[3]; lg[4] += xv * r1[0]; lg[5] += xv * r1[1]; lg[6] += xv * r1[2]; lg[7] += xv * r1[3]; }
#pragma unroll
                for (int e = 0; e < 8; ++e) lg[e] = wave_sum(lg[e]);
                if (lane == 0) {
                    int i0 = 0; float v0 = lg[0];
#pragma unroll
                    for (int e = 1; e < 8; ++e) if (lg[e] > v0) { v0 = lg[e]; i0 = e; }
                    int i1 = -1; float v1 = -INFINITY;
#pragma unroll
                    for (int e = 0; e < 8; ++e) if (e != i0 && lg[e] > v1) { v1 = lg[e]; i1 = e; }
                    const float e1 = __expf(v1 - v0), w0 = 1.0f / (1.0f + e1), w1 = e1 * w0;
                    topi[(size_t)m * 2] = i0; topi[(size_t)m * 2 + 1] = i1; topw[(size_t)m * 2] = w0; topw[(size_t)m * 2 + 1] = w1;
                    __hip_atomic_fetch_add(&lcnt[i0], 1, __ATOMIC_RELAXED, __HIP_MEMORY_SCOPE_WORKGROUP); __hip_atomic_fetch_add(&lcnt[i1], 1, __ATOMIC_RELAXED, __HIP_MEMORY_SCOPE_WORKGROUP);
                }
            }
        }
        if (l == 1) { __syncthreads(); if (F.tid < 8) cnt[vw * 8 + F.tid] = lcnt[F.tid]; }
    }
}
__device__ __forceinline__ void ph_E() {
    const Frame F = mkframe(); KArgs a = kargs(); unsigned char* ws = a->ws;
    pg8::Gemm g{WSP(f16, WS_XB), D, WSP(f16, WS_WGU), D, D}; pg8::StaticOrder S; S.init(T / 256, 2 * FF / 256, F.G, F.bid);
    pg8::EpiSwiGLU E{WSP(f16, WS_H), FF, 0};
    pg8::gemm_phase<pg8::EpiSwiGLU, pg8::StaticOrder, true>(F.lds, g, S, E);
}
__device__ __forceinline__ void ph_F() {
    const Frame F = mkframe(); KArgs a = kargs(); unsigned char* ws = a->ws;
    pg8::Gemm g{WSP(f16, WS_H), FF, WSP(f16, WS_WDN), FF, FF}; pg8::StaticOrder S; S.init(T / 256, D / 256, F.G, F.bid);
    pg8::EpiResF32 E{WSP(f16, WS_XB), a->out, D, DN_ALPHA};
    pg8::gemm_phase<pg8::EpiResF32, pg8::StaticOrder, true>(F.lds, g, S, E);
}
__device__ __forceinline__ void ph_F2d() {
    const Frame F = mkframe(); KArgs a = kargs(); unsigned char* ws = a->ws;
    const int gw = F.bid * NWAVES + F.wave, NGW = F.G * NWAVES;
    const float* ybuf = a->out; f16* xb = WSP(f16, WS_XB); const float* gp = a->ln2_g; const float* bp = a->ln2_b;
    for (int m = gw; m < T; m += NGW) {
        const int lane = F.lane; const f32x4* yr = (const f32x4*)(ybuf + (size_t)m * D) + lane; f32x4 v[4];
#pragma unroll
        for (int j = 0; j < 4; ++j) v[j] = yr[64 * j];
        float mean, rstd; ln_stats(v, mean, rstd);
        u32x2* o8 = (u32x2*)(xb + (size_t)m * D) + lane;
#pragma unroll
        for (int j = 0; j < 4; ++j) { const f32x4 g = *((const f32x4*)gp + lane + 64 * j), bb = *((const f32x4*)bp + lane + 64 * j); const f32x4 y = (v[j] - mean) * rstd * g + bb;
            u32x2 w; w.x = pk_f16(y[0], y[1]); w.y = pk_f16(y[2], y[3]); o8[64 * j] = w; }
    }
}
__device__ __forceinline__ void ph_R3() {
    const Frame F = mkframe(); KArgs a = kargs(); unsigned char* ws = a->ws;
    const int* topi = WSP(int, WS_TOPI); const float* topw = WSP(float, WS_TOPW); const int* cnt = WSP(int, WS_CNT); int* rowtok = WSP(int, WS_ROWTOK); float* roww = WSP(float, WS_ROWW); int* pane = WSP(int, WS_PANE);
    LAS int* L = (LAS int*)F.lds;
    for (int vw = F.bid; vw < 256; vw += F.G) {
        __syncthreads();
        if (F.tid < 8) { const int e = F.tid; int tot = 0, mine = 0; for (int w = 0; w < 256; ++w) { const int c = cnt[w * 8 + e]; if (w < vw) mine += c; tot += c; } L[e] = tot; L[16 + e] = mine; }
        __syncthreads();
        if (F.tid == 0) { int b = 0; for (int e = 0; e < 8; ++e) { L[8 + e] = b; b += (L[e] + 255) & ~255; } L[24] = b; }
        __syncthreads();
        if (F.tid < 8) { const int e = F.tid; int p = L[8 + e] + L[16 + e];
            for (int t = 0; t < 128; ++t) { const int tok = vw * 128 + t;
#pragma unroll
                for (int s = 0; s < 2; ++s) if (topi[(size_t)tok * 2 + s] == e) { rowtok[p] = tok * 2 + s; roww[p] = topw[(size_t)tok * 2 + s]; ++p; } } }
        if (vw == 0) {
            for (int e = 0; e < 8; ++e) { const int s0 = L[8 + e] + L[e], s1 = L[8 + e] + ((L[e] + 255) & ~255);
                for (int p = s0 + F.tid; p < s1; p += 512) { rowtok[p] = -1; roww[p] = 0.f; }
                for (int p = (L[8 + e] >> 8) + F.tid; p < (s1 >> 8); p += 512) pane[p] = e; }
            if (F.tid == 0) pane[MOE_MAXP] = L[24] >> 8;
        }
    }
}
__device__ __forceinline__ void ph_M1(int c) {
    const Frame F = mkframe(); KArgs a = kargs(); unsigned char* ws = a->ws;
    const int* pane = WSP(int, WS_PANE);
    const int np = pane[MOE_MAXP]; int nm = np - c * MOE_CHUNK; nm = nm < 0 ? 0 : (nm > MOE_CHUNK ? MOE_CHUNK : nm);
    pg8::Gemm g{WSP(f16, WS_XB), D, WSP(f16, WS_EGU), D, D}; pg8::MoeGather S; S.so.init(nm, 2 * FE / 256, F.G, F.bid, c * MOE_CHUNK); S.rowtok = WSP(int, WS_ROWTOK); S.pane = pane; S.estride = (size_t)2 * FE * D * 2;
    pg8::EpiSwiGLU E{(f16*)a->out, FE, c * MOE_CHUNK};
    pg8::gemm_phase<pg8::EpiSwiGLU, pg8::MoeGather, true>(F.lds, g, S, E);
}
__device__ __forceinline__ void ph_M2(int c) {
    const Frame F = mkframe(); KArgs a = kargs(); unsigned char* ws = a->ws;
    const int* pane = WSP(int, WS_PANE);
    const int np = pane[MOE_MAXP]; int nm = np - c * MOE_CHUNK; nm = nm < 0 ? 0 : (nm > MOE_CHUNK ? MOE_CHUNK : nm);
    pg8::Gemm g{(const f16*)a->out, FE, WSP(f16, WS_EDN), FE, FE}; pg8::MoeDense S; S.so.init(nm, D / 256, F.G, F.bid, c * MOE_CHUNK); S.pane = pane; S.estride = (size_t)D * FE * 2; S.arow0 = c * MOE_CHUNK;
    pg8::EpiScatter E{WSP(f16, WS_H), (size_t)T * D, WSP(int, WS_ROWTOK), WSP(float, WS_ROWW)};
    pg8::gemm_phase<pg8::EpiScatter, pg8::MoeDense, true>(F.lds, g, S, E);
}
__device__ __forceinline__ void ph_F2m() {
    const Frame F = mkframe(); KArgs a = kargs(); unsigned char* ws = a->ws;
    const int gw = F.bid * NWAVES + F.wave, NGW = F.G * NWAVES;
    const f16* xb = WSP(f16, WS_XB); const f16* c0buf = WSP(f16, WS_H); const f16* c1buf = c0buf + (size_t)T * D; float* out = a->out; const float* gp = a->ln2_g + D; const float* bp = a->ln2_b + D;
    for (int m = gw; m < T; m += NGW) {
        const int lane = F.lane; f32x4 v[4];
        const f16x4* xr = (const f16x4*)(xb + (size_t)m * D) + lane; const f16x4* c0r = (const f16x4*)(c0buf + (size_t)m * D) + lane; const f16x4* c1r = (const f16x4*)(c1buf + (size_t)m * D) + lane;
#pragma unroll
        for (int j = 0; j < 4; ++j) { const f16x4 xv = xr[64 * j], p0 = c0r[64 * j], p1 = c1r[64 * j];
#pragma unroll
            for (int e = 0; e < 4; ++e) v[j][e] = DN_ALPHA * (float)xv[e] + ((float)p0[e] + (float)p1[e]); }
        float mean, rstd; ln_stats(v, mean, rstd);
        f32x4* orow = (f32x4*)(out + (size_t)m * D) + lane;
#pragma unroll
        for (int j = 0; j < 4; ++j) { const f32x4 g = *((const f32x4*)gp + lane + 64 * j), bb = *((const f32x4*)bp + lane + 64 * j); orow[64 * j] = (v[j] - mean) * rstd * g + bb; }
    }
}

#ifndef SITE_MASK
#define SITE_MASK 0xFFFFFFFFu
#endif
#define SITE(n) (((SITE_MASK) >> (n)) & 1u)
__global__ void __launch_bounds__(NWAVES * 64, 2) mega_fwd(Args args_unused) {
    extern __shared__ __attribute__((aligned(16))) unsigned char lds_raw[];
    volatile LAS unsigned* MISC = (volatile LAS unsigned*)((LAS unsigned char*)lds_raw + MISC_OFF);
    if (threadIdx.x < 64) MISC[threadIdx.x] = 0u;
    __syncthreads();
#if MK_ONE_LAUNCH
    XcdBarrier bar = xcd_barrier_post((unsigned*)(kargs()->ws + WS_CTL) + CW_BAR, MISC + 8);
#define GRID_BAR() xcd_barrier(bar)
#else
#define GRID_BAR() do {} while (0)
#endif
    const int lo = kargs()->ph_lo, hi = kargs()->ph_hi;
#define IN(k) (lo <= (k) && (k) < hi)
#define SEAM(k) do { if (IN(k) && IN((k) + 1)) GRID_BAR(); } while (0)
    if (SITE(0) && IN(0)) ph_prologue();
    SEAM(0);
    for (int l = 0; l < 2; ++l) {
        const int pb = l == 0 ? PH_L0 : PH_L1;
        if (SITE(1) && IN(pb + 0)) ph_A(l);
        SEAM(pb + 0);
        if (SITE(2) && IN(pb + 1)) ph_A2();
        SEAM(pb + 1);
        if (SITE(3) && IN(pb + 2)) ph_B(l);
        SEAM(pb + 2);
        if (SITE(4) && IN(pb + 3)) ph_B2();
        SEAM(pb + 3);
        if (SITE(5) && IN(pb + 4)) ph_C(l);
        SEAM(pb + 4);
        if (SITE(6) && IN(pb + 5)) ph_C2();
        SEAM(pb + 5);
        if (SITE(7) && IN(pb + 6)) ph_D(l);
        SEAM(pb + 6);
        if (SITE(8) && IN(pb + 7)) ph_D2(l);
        SEAM(pb + 7);
        if (l == 0) {
            if (SITE(9) && IN(pb + 8)) ph_E();
            SEAM(pb + 8);
            if (SITE(10) && IN(pb + 9)) ph_F();
            SEAM(pb + 9);
            if (SITE(11) && IN(pb + 10)) ph_F2d();
            SEAM(pb + 10);
        } else {
            if (SITE(12) && IN(pb + 8)) ph_R3();
            SEAM(pb + 8);
            for (int c = 0; c < MOE_NCHUNK; ++c) {
                if (SITE(13) && IN(pb + 9 + 2 * c)) ph_M1(c);
                SEAM(pb + 9 + 2 * c);
                if (SITE(14) && IN(pb + 10 + 2 * c)) ph_M2(c);
                SEAM(pb + 10 + 2 * c);
            }
            if (SITE(15) && IN(pb + 19)) ph_F2m();
        }
    }
#undef IN
#undef SEAM
}

extern "C" void kernel_launch(void* const* d_in, const int* in_sizes, int n_in, void* d_out, int out_size, void* d_ws, size_t ws_size, hipStream_t stream) {
    static int grid = 0;
    if (grid == 0) {
        if (n_in != 22 || in_sizes[0] != T * D || out_size != T * D || ws_size < WS_END) { fprintf(stderr, "kernel_launch: unexpected shapes / workspace (n_in %d, ws %zu)\n", n_in, ws_size); grid = -1; return; }
        int dev = 0, cus = 0;
        if (hipGetDevice(&dev) != hipSuccess || hipDeviceGetAttribute(&cus, hipDeviceAttributeMultiprocessorCount, dev) != hipSuccess) { grid = -1; return; }
        if (hipFuncSetAttribute((const void*)mega_fwd, hipFuncAttributeMaxDynamicSharedMemorySize, LDS_BYTES) != hipSuccess) { fprintf(stderr, "kernel_launch: hipFuncSetAttribute failed\n"); grid = -1; return; }
        int per_cu = 0;
        if (hipOccupancyMaxActiveBlocksPerMultiprocessor(&per_cu, (const void*)mega_fwd, NWAVES * 64, LDS_BYTES) != hipSuccess || per_cu < 1) { fprintf(stderr, "kernel_launch: occupancy query says %d\n", per_cu); }
        (void)hipGetLastError();
        grid = cus > 256 ? 256 : cus;
    }
    if (grid < 0) return;
    (void)hipMemsetAsync((char*)d_ws + WS_CTL, 0, CTL_ZERO_BYTES, stream);
    Args a{};
    a.x = (const float*)d_in[0]; a.ln_emb_g = (const float*)d_in[1]; a.ln_emb_b = (const float*)d_in[2]; a.w_in = (const float*)d_in[3]; a.q_norm_g = (const float*)d_in[4]; a.kv_norm_g = (const float*)d_in[5];
    a.w_uq = (const float*)d_in[6]; a.w_ukv = (const float*)d_in[7]; a.beta_mla = (const float*)d_in[8]; a.beta_moba = (const float*)d_in[9]; a.w_o = (const float*)d_in[10]; a.ln1_g = (const float*)d_in[11]; a.ln1_b = (const float*)d_in[12];
    a.ffn_w_gate = (const float*)d_in[13]; a.ffn_w_up = (const float*)d_in[14]; a.ffn_w_down = (const float*)d_in[15]; a.router = (const float*)d_in[16]; a.exp_w_gate = (const float*)d_in[17]; a.exp_w_up = (const float*)d_in[18];
    a.exp_w_down = (const float*)d_in[19]; a.ln2_g = (const float*)d_in[20]; a.ln2_b = (const float*)d_in[21];
    a.out = (float*)d_out; a.ws = (unsigned char*)d_ws;
#if MK_ONE_LAUNCH
    a.ph_lo = 0; a.ph_hi = NPHASE;
    hipLaunchKernelGGL(mega_fwd, dim3(grid), dim3(NWAVES * 64), LDS_BYTES, stream, a);
#else
    for (int p = 0; p < NPHASE; ++p) { a.ph_lo = p; a.ph_hi = p + 1; hipLaunchKernelGGL(mega_fwd, dim3(grid), dim3(NWAVES * 64), LDS_BYTES, stream, a); }
#endif
}
```

```cpp
#include <hip/hip_runtime.h>
#include <cstdio>
#include <cstdint>
#include <cmath>

#ifndef MK_ONE_LAUNCH
#define MK_ONE_LAUNCH 1
#endif

#define LAS __attribute__((address_space(3)))
#define GAS __attribute__((address_space(1)))
typedef _Float16 f16;
typedef _Float16 f16x2 __attribute__((ext_vector_type(2)));
typedef _Float16 f16x4 __attribute__((ext_vector_type(4)));
typedef _Float16 f16x8 __attribute__((ext_vector_type(8)));
typedef float f32x2 __attribute__((ext_vector_type(2)));
typedef float f32x4 __attribute__((ext_vector_type(4)));
typedef unsigned u32x2 __attribute__((ext_vector_type(2)));
typedef unsigned u32x4 __attribute__((ext_vector_type(4)));
typedef GAS unsigned gu32;

constexpr int BATCH = 16, SEQ = 2048, T = BATCH * SEQ, D = 1024;
constexpr int HW = 2816;
constexpr int HC_CQ = 0, HC_CKV = 256, HC_KR = 384, HC_RQ = 416, HC_RK = 736, HC_RV = 1056, HC_RG = 1376, HC_MQ = 1696, HC_MK = 2016, HC_MV = 2336, HC_END = 2656;
constexpr int QW = 768, KVW = 768;
constexpr int OC_RET = 384, OC_MOBA = 704;
constexpr int FF = 2816, FE = 3584, NE = 8;
constexpr float LN_EPS = 1e-5f, RMS_EPS = 1e-6f;
constexpr float DN_ALPHA = 1.41421356237f;
constexpr float LOG2E = 1.4426950408889634f;
constexpr int MOE_CHUNK = 64, MOE_NCHUNK = 5, MOE_MAXP = 264;

constexpr size_t MiB = 1u << 20;
constexpr size_t WS_CTL = 0, CTL_ZERO_BYTES = 256 * 1024;
constexpr size_t WS_ROPE = 256 * 1024;
constexpr size_t WS_SSQ_Q = 1 * MiB;
constexpr size_t WS_SSQ_O = 2 * MiB;
constexpr size_t WS_KMEAN = 4 * MiB;
constexpr size_t WS_SSQ_KV = 18 * MiB + 512 * 1024;
constexpr size_t WS_TOPI = WS_KMEAN + 512 * 1024;
constexpr size_t WS_TOPW = WS_TOPI + (size_t)T * 8;
constexpr size_t WS_CNT = WS_TOPW + (size_t)T * 8;
constexpr size_t WS_ROWTOK = WS_CNT + 8192;
constexpr size_t WS_ROWW = WS_ROWTOK + (size_t)MOE_MAXP * 256 * 4;
constexpr size_t WS_PANE = WS_ROWW + (size_t)MOE_MAXP * 256 * 4;
constexpr size_t WS_WIN = 6 * MiB;
constexpr size_t WS_WUQ = 17 * MiB;
constexpr size_t WS_WO = 19 * MiB;
constexpr size_t WS_WGU = 23 * MiB;
constexpr size_t WS_WDN = 34 * MiB;
constexpr size_t WS_EGU = 40 * MiB;
constexpr size_t WS_EDN = 152 * MiB;
constexpr size_t WS_XB = 208 * MiB;
constexpr size_t WS_H = 272 * MiB;
constexpr size_t WS_O = 448 * MiB;
constexpr size_t WS_END = 512 * MiB;
static_assert(WS_PANE + (MOE_MAXP + 8) * 4 <= 6 * MiB && (size_t)128 * 2 * 320 * 4 <= 512 * 1024, "ws map");

constexpr int CW_TMO = 0, CW_BAR = 1024;

constexpr int RING_BYTES = 131072;
constexpr int MISC_OFF = RING_BYTES;
constexpr int LDS_BYTES = 147456;

__device__ __forceinline__ unsigned pk_f16(float lo, float hi) { f16x2 v = {(f16)lo, (f16)hi}; return __builtin_bit_cast(unsigned, v); }
template <int X> __device__ __forceinline__ float swz_xor(float v) { return __int_as_float(__builtin_amdgcn_ds_swizzle(__float_as_int(v), (X << 10) | 0x1f)); }
__device__ __forceinline__ float wave_sum(float v) {
    v += swz_xor<1>(v); v += swz_xor<2>(v); v += swz_xor<4>(v); v += swz_xor<8>(v); v += swz_xor<16>(v);
    const auto rr = __builtin_amdgcn_permlane32_swap(__float_as_uint(v), __float_as_uint(v), false, false);
    return __uint_as_float(rr[0]) + __uint_as_float(rr[1]);
}
__device__ __forceinline__ float silu_f(float x) { return x * __builtin_amdgcn_rcpf(1.f + __expf(-x)); }

#define XB_TMO      128
#define XB_XCNT(j)  (256  + 64 * (j))
#define XB_XSUB(j)  (1280 + 64 * (j))
#define XB_XGEN(j)  (2304 + 64 * (j))
#define XB_TOP      3328
#define XB_TOPGEN   3392
#define XCD_BAR_WORDS 3456
#define XB_SPIN_CAP (1u << 18)
__device__ __forceinline__ unsigned xb_ld(unsigned* p)              { return __hip_atomic_load(p, __ATOMIC_RELAXED, __HIP_MEMORY_SCOPE_AGENT); }
__device__ __forceinline__ unsigned xb_add(unsigned* p, unsigned v) { return __hip_atomic_fetch_add(p, v, __ATOMIC_RELAXED, __HIP_MEMORY_SCOPE_AGENT); }
__device__ __forceinline__ unsigned xb_xcc_id() { return (unsigned)__builtin_amdgcn_s_getreg((3 << 11) | 20) & 0xFu; }
#define XB_SPIN(cond, bar) do { unsigned _sp = 0; while (cond) { __builtin_amdgcn_s_sleep(1); \
    if ((++_sp & 255u) == 0u) { if (xb_ld(&(bar)[XB_TMO])) break; if (_sp > XB_SPIN_CAP) { atomicAdd(&(bar)[XB_TMO], 1u); break; } } } } while (0)
struct XcdBarrier { unsigned* bar; unsigned x; volatile LAS unsigned* st; };
__device__ __forceinline__ XcdBarrier xcd_barrier_post(unsigned* bar, volatile LAS unsigned* st) {
    XcdBarrier b; b.bar = bar; b.x = xb_xcc_id(); b.st = st;
    if (threadIdx.x == 0) (void)xb_add(&bar[XB_XCNT(b.x)], 1u);
    return b;
}
__device__ __forceinline__ void xcd_barrier_complete(unsigned* bar, unsigned x, unsigned& nloc, unsigned& nx) {
    const unsigned G = gridDim.x * gridDim.y * gridDim.z;
    unsigned sum, cnt, mine, sp = 0u;
    for (;;) {
        sum = 0u; cnt = 0u; mine = 0u;
#pragma unroll
        for (unsigned j = 0; j < 16; ++j) { const unsigned c = xb_ld(&bar[XB_XCNT(j)]); sum += c; cnt += (c > 0u) ? 1u : 0u; mine = (j == x) ? c : mine; }
        if (sum == G) break;
        __builtin_amdgcn_s_sleep(1);
        if ((++sp & 255u) == 0u) { if (xb_ld(&bar[XB_TMO])) break; if (sp > XB_SPIN_CAP) { atomicAdd(&bar[XB_TMO], 1u); break; } }
    }
    nloc = mine > 0u ? mine : 1u; nx = cnt > 0u ? cnt : 1u;
}
__device__ __forceinline__ void xcd_barrier(const XcdBarrier& b) {
    asm volatile("s_waitcnt vmcnt(0)" ::: "memory");
    __syncthreads();
    if (threadIdx.x == 0) {
        unsigned* bar = b.bar;
        __builtin_amdgcn_s_waitcnt(0);
        unsigned nloc = b.st[0], nx = b.st[1];
        if (nloc == 0u) { xcd_barrier_complete(bar, b.x, nloc, nx); b.st[0] = nloc; b.st[1] = nx; }
        const unsigned old = xb_add(&bar[XB_XSUB(b.x)], 1u);
        const unsigned gen = old / nloc;
        if (old + 1u == (gen + 1u) * nloc) {
            __builtin_amdgcn_fence(__ATOMIC_RELEASE, "agent");
            asm volatile("s_waitcnt vmcnt(0)" ::: "memory");
            const unsigned og = xb_add(&bar[XB_TOP], 1u);
            const unsigned tg = og / nx;
            if (og + 1u == (tg + 1u) * nx) xb_add(&bar[XB_TOPGEN], 1u);
            else XB_SPIN(xb_ld(&bar[XB_TOPGEN]) == tg, bar);
            __builtin_amdgcn_fence(__ATOMIC_ACQUIRE, "agent");
            xb_add(&bar[XB_XGEN(b.x)], 1u);
            asm volatile("s_waitcnt vmcnt(0)" ::: "memory");
        } else {
            XB_SPIN(xb_ld(&bar[XB_XGEN(b.x)]) == gen, bar);
            __builtin_amdgcn_fence(__ATOMIC_ACQUIRE, "agent");
            asm volatile("s_waitcnt vmcnt(0)" ::: "memory");
        }
    }
    __syncthreads();
}

namespace pg8 {
constexpr int BM = 256, BK = 64, HALF = 128, HTB = HALF * BK * 2, STAGE_BYTES = 8 * HTB, NXCD = 8, WGM = 8;
__host__ __device__ __forceinline__ int lds_byte(int r, int c) { const int st = (r >> 4) * 2 + (c >> 5), rr = r & 15, cc = c & 31, ob = rr * 64 + cc * 2; return st * 1024 + (ob ^ (((ob >> 9) & 1) << 5)); }
__host__ __device__ __forceinline__ void stage_rc(int b, int& R, int& C) { const int st = b / 1024, sb = b % 1024, swz = sb ^ (((sb >> 9) & 1) << 5); R = (st >> 1) * 16 + swz / 64; C = (st & 1) * 32 + (swz % 64) / 2; }
__host__ __device__ __forceinline__ int perm32(int rho) { const int n = rho >> 4, i = rho & 15; return 8 * (i >> 2) + 4 * n + (i & 3); }

struct Unit { int pm, pn; };
struct Gemm { const f16* A; int lda; const f16* Bt; int ldb; int K; };

struct StaticOrder {
    static constexpr bool GATHER = false;
    int nM, nN, nwg, G, c, pm0;
    __device__ void init(int nM_, int nN_, int G_, int c_, int pm0_ = 0) { nM = nM_; nN = nN_; nwg = nM * nN; G = G_; c = c_; pm0 = pm0_; }
    __device__ bool next(int i, Unit& u) const {
        const long L = (long)i * G + c; if (L >= nwg) return false;
        int wgid = (int)L; { const int q = nwg / NXCD, r = nwg % NXCD, xcd = wgid % NXCD, off = wgid / NXCD; wgid = (xcd < r ? xcd * (q + 1) : r * (q + 1) + (xcd - r) * q) + off; }
        const int nig = WGM * nN, gid = wgid / nig, fm = gid * WGM, gsz = (nM - fm) < WGM ? (nM - fm) : WGM;
        u.pm = pm0 + fm + ((wgid % nig) % gsz); u.pn = (wgid % nig) / gsz; return true;
    }
    __device__ __forceinline__ int a_row(const Unit& u, int r) const { return u.pm * BM + r; }
    __device__ __forceinline__ size_t b_base(const Unit&) const { return 0; }
    __device__ __forceinline__ size_t a_col(const Unit&) const { return 0; }
};
struct UpOrder {
    static constexpr bool GATHER = false;
    StaticOrder so;
    __device__ bool next(int i, Unit& u) const { return so.next(i, u); }
    __device__ __forceinline__ int a_row(const Unit& u, int r) const { return u.pm * BM + r; }
    __device__ __forceinline__ size_t b_base(const Unit&) const { return 0; }
    __device__ __forceinline__ size_t a_col(const Unit& u) const { return u.pn >= 3 ? (size_t)(HC_CKV * 2) : (size_t)0; }
};
struct MoeGather {
    static constexpr bool GATHER = true;
    StaticOrder so; const int* rowtok; const int* pane; size_t estride;
    __device__ bool next(int i, Unit& u) const { return so.next(i, u); }
    __device__ __forceinline__ int a_row(const Unit& u, int r) const { const int t = rowtok[u.pm * BM + r]; return t < 0 ? 0 : (t >> 1); }
    __device__ __forceinline__ size_t b_base(const Unit& u) const { return (size_t)pane[u.pm] * estride; }
    __device__ __forceinline__ size_t a_col(const Unit&) const { return 0; }
};
struct MoeDense {
    static constexpr bool GATHER = false;
    StaticOrder so; const int* pane; size_t estride; int arow0;
    __device__ bool next(int i, Unit& u) const { return so.next(i, u); }
    __device__ __forceinline__ int a_row(const Unit& u, int r) const { return (u.pm - arow0) * BM + r; }
    __device__ __forceinline__ size_t b_base(const Unit& u) const { return (size_t)pane[u.pm] * estride; }
    __device__ __forceinline__ size_t a_col(const Unit&) const { return 0; }
};

struct EpiF16 {
    static constexpr bool PERM = true;
    f16* O; int ldc;
    __device__ __forceinline__ void operator()(const f32x4 (&acc)[2][2][4][2], const Unit& u, int wr, int wc, int fr, int fq) const {
        const int row0 = u.pm * BM + wr * 64 + fr, col0 = u.pn * BM + wc * 32 + 8 * fq;
#pragma unroll
        for (int ai = 0; ai < 2; ++ai)
#pragma unroll
            for (int m = 0; m < 4; ++m) { f16* rowp = O + (size_t)(row0 + ai * HALF + m * 16) * ldc + col0;
#pragma unroll
                for (int bj = 0; bj < 2; ++bj) { const f32x4 v0 = acc[ai][bj][m][0], v1 = acc[ai][bj][m][1];
                    u32x4 w; w.x = pk_f16(v0[0], v0[1]); w.y = pk_f16(v0[2], v0[3]); w.z = pk_f16(v1[0], v1[1]); w.w = pk_f16(v1[2], v1[3]);
                    *(u32x4*)(rowp + bj * HALF) = w; } }
    }
};
__device__ __forceinline__ void rope8(float (&v)[8], const float* cs, const float* sn, int fq, float scale) {
    const f32x4 c0 = *(const f32x4*)cs, c1 = *(const f32x4*)(cs + 4), s0 = *(const f32x4*)sn, s1 = *(const f32x4*)(sn + 4);
    const float sg = fq < 2 ? -scale : scale;
#pragma unroll
    for (int e = 0; e < 8; ++e) { const auto rr = __builtin_amdgcn_permlane32_swap(__float_as_uint(v[e]), __float_as_uint(v[e]), false, false);
        const float other = fq < 2 ? __uint_as_float(rr[1]) : __uint_as_float(rr[0]);
        const float c = e < 4 ? c0[e & 3] : c1[e & 3], sn_ = e < 4 ? s0[e & 3] : s1[e & 3];
        v[e] = v[e] * (c * scale) + other * (sn_ * sg); }
}
__device__ __forceinline__ float sum_fq(float s) { s += swz_xor<16>(s); const auto rr = __builtin_amdgcn_permlane32_swap(__float_as_uint(s), __float_as_uint(s), false, false); return __uint_as_float(rr[0]) + __uint_as_float(rr[1]); }
struct EpiWin {
    static constexpr bool PERM = true;
    f16* H; float* ssq_q; float* ssq_kv; float* kpart; const float* cosA; const float* sinA; const float* cosB; const float* sinB;
    __device__ __forceinline__ void operator()(const f32x4 (&acc)[2][2][4][2], const Unit& u, int wr, int wc, int fr, int fq) const {
        const int row0 = u.pm * BM + wr * 64 + fr;
#pragma unroll
        for (int bj = 0; bj < 2; ++bj) {
            const int cg = u.pn * 8 + bj * 4 + wc;
            if (cg >= 83) continue;
            const int col0 = cg * 32 + 8 * fq;
            float ksum[8];
#pragma unroll
            for (int e = 0; e < 8; ++e) ksum[e] = 0.f;
#pragma unroll
            for (int ai = 0; ai < 2; ++ai)
#pragma unroll
                for (int m = 0; m < 4; ++m) {
                    const int row = row0 + ai * HALF + m * 16; const int pos = row & (SEQ - 1);
                    float v[8];
#pragma unroll
                    for (int e = 0; e < 4; ++e) { v[e] = acc[ai][bj][m][0][e]; v[4 + e] = acc[ai][bj][m][1][e]; }
                    if (cg < 12) {
                        float ss = 0.f;
#pragma unroll
                        for (int e = 0; e < 8; ++e) ss += v[e] * v[e];
                        ss = sum_fq(ss);
                        if (fq == 0) { if (cg < 8) ssq_q[(size_t)row * 8 + cg] = ss; else ssq_kv[(size_t)row * 4 + (cg - 8)] = ss; }
                    } else if (cg == 12) rope8(v, cosA + pos * 16 + 8 * (fq & 1), sinA + pos * 16 + 8 * (fq & 1), fq, 1.0f);
                    else if (cg < 23) rope8(v, cosB + pos * 32 + 16 * ((cg - 13) & 1) + 8 * (fq & 1), sinB + pos * 32 + 16 * ((cg - 13) & 1) + 8 * (fq & 1), fq, 1.0f);
                    else if (cg < 33) rope8(v, cosB + pos * 32 + 16 * ((cg - 23) & 1) + 8 * (fq & 1), sinB + pos * 32 + 16 * ((cg - 23) & 1) + 8 * (fq & 1), fq, 0.125f);
                    else if (cg >= 53 && cg < 63) {
#pragma unroll
                        for (int e = 0; e < 8; ++e) v[e] *= 0.125f * LOG2E; }
                    else if (cg >= 63 && cg < 73) {
#pragma unroll
                        for (int e = 0; e < 8; ++e) ksum[e] += v[e]; }
                    u32x4 w; w.x = pk_f16(v[0], v[1]); w.y = pk_f16(v[2], v[3]); w.z = pk_f16(v[4], v[5]); w.w = pk_f16(v[6], v[7]);
                    *(u32x4*)(H + (size_t)row * HW + col0) = w;
                }
            if (cg >= 63 && cg < 73) {
#pragma unroll
                for (int e = 0; e < 8; ++e) { float x = ksum[e]; x += swz_xor<1>(x); x += swz_xor<2>(x); x += swz_xor<4>(x); x += swz_xor<8>(x); ksum[e] = x; }
                if (fr == 0) { float* kp = kpart + ((size_t)u.pm * 2 + wr) * 320 + (cg - 63) * 32 + 8 * fq;
                    *(f32x4*)kp = (f32x4){ksum[0], ksum[1], ksum[2], ksum[3]}; *(f32x4*)(kp + 4) = (f32x4){ksum[4], ksum[5], ksum[6], ksum[7]}; }
            }
        }
    }
};
struct EpiUp {
    static constexpr bool PERM = true;
    f16* Oq; f16* Okv; const float* ssq_q; const float* ssq_kv; const float* cosA; const float* sinA;
    __device__ __forceinline__ void operator()(const f32x4 (&acc)[2][2][4][2], const Unit& u, int wr, int wc, int fr, int fq) const {
        const int row0 = u.pm * BM + wr * 64 + fr; const bool isq = u.pn < 3; const int pn = isq ? u.pn : u.pn - 3;
        f16* O = isq ? Oq : Okv; const int cg_end = isq ? 18 : 24;
#pragma unroll
        for (int ai = 0; ai < 2; ++ai)
#pragma unroll
            for (int m = 0; m < 4; ++m) {
                const int row = row0 + ai * HALF + m * 16; const int pos = row & (SEQ - 1);
                float rs;
                if (isq) { const f32x4 a = *(const f32x4*)(ssq_q + (size_t)row * 8), b = *(const f32x4*)(ssq_q + (size_t)row * 8 + 4); rs = (0.10206207261596575f * LOG2E) / sqrtf(((a[0] + a[1]) + (a[2] + a[3]) + (b[0] + b[1]) + (b[2] + b[3])) * (1.f / 256.f) + RMS_EPS); }
                else { const f32x4 a = *(const f32x4*)(ssq_kv + (size_t)row * 4); rs = 1.0f / sqrtf(((a[0] + a[1]) + (a[2] + a[3])) * (1.f / 128.f) + RMS_EPS); }
#pragma unroll
                for (int bj = 0; bj < 2; ++bj) {
                    const int cg = pn * 8 + bj * 4 + wc; if (cg >= cg_end) continue;
                    float v[8];
#pragma unroll
                    for (int e = 0; e < 4; ++e) { v[e] = acc[ai][bj][m][0][e] * rs; v[4 + e] = acc[ai][bj][m][1][e] * rs; }
                    if (isq && cg >= 12) rope8(v, cosA + pos * 16 + 8 * (fq & 1), sinA + pos * 16 + 8 * (fq & 1), fq, 1.0f);
                    u32x4 w; w.x = pk_f16(v[0], v[1]); w.y = pk_f16(v[2], v[3]); w.z = pk_f16(v[4], v[5]); w.w = pk_f16(v[6], v[7]);
                    *(u32x4*)(O + (size_t)row * QW + cg * 32 + 8 * fq) = w;
                }
            }
    }
};
struct EpiResF32 {
    static constexpr bool PERM = false;
    const f16* X; float* Y; int ldc; float alpha;
    __device__ __forceinline__ void operator()(const f32x4 (&acc)[2][2][4][2], const Unit& u, int wr, int wc, int fr, int fq) const {
        const int row0 = u.pm * BM + wr * 64 + fr, col0 = u.pn * BM + wc * 32 + 4 * fq;
#pragma unroll
        for (int ai = 0; ai < 2; ++ai)
#pragma unroll
            for (int m = 0; m < 4; ++m) { const size_t off = (size_t)(row0 + ai * HALF + m * 16) * ldc + col0;
#pragma unroll
                for (int bj = 0; bj < 2; ++bj)
#pragma unroll
                    for (int n = 0; n < 2; ++n) { const f16x4 xv = *(const f16x4*)(X + off + bj * HALF + n * 16); const f32x4 a = acc[ai][bj][m][n];
                        f32x4 o; o[0] = alpha * (float)xv[0] + a[0]; o[1] = alpha * (float)xv[1] + a[1]; o[2] = alpha * (float)xv[2] + a[2]; o[3] = alpha * (float)xv[3] + a[3];
                        *(f32x4*)(Y + off + bj * HALF + n * 16) = o; } }
    }
};
struct EpiSwiGLU {
    static constexpr bool PERM = true;
    f16* O; int ldc; int pm0;
    __device__ __forceinline__ void operator()(const f32x4 (&acc)[2][2][4][2], const Unit& u, int wr, int wc, int fr, int fq) const {
        const int row0 = (u.pm - pm0) * BM + wr * 64 + fr, col0 = u.pn * HALF + wc * 32 + 8 * fq;
#pragma unroll
        for (int ai = 0; ai < 2; ++ai)
#pragma unroll
            for (int m = 0; m < 4; ++m) { f16* rowp = O + (size_t)(row0 + ai * HALF + m * 16) * ldc + col0;
                float r[8];
#pragma unroll
                for (int n = 0; n < 2; ++n)
#pragma unroll
                    for (int e = 0; e < 4; ++e) r[n * 4 + e] = silu_f(acc[ai][0][m][n][e]) * acc[ai][1][m][n][e];
                u32x4 w; w.x = pk_f16(r[0], r[1]); w.y = pk_f16(r[2], r[3]); w.z = pk_f16(r[4], r[5]); w.w = pk_f16(r[6], r[7]);
                *(u32x4*)rowp = w; }
    }
};
struct EpiScatter {
    static constexpr bool PERM = true;
    f16* C0; size_t slot_stride; const int* rowtok; const float* roww;
    __device__ __forceinline__ void operator()(const f32x4 (&acc)[2][2][4][2], const Unit& u, int wr, int wc, int fr, int fq) const {
        const int row0 = u.pm * BM + wr * 64 + fr, col0 = u.pn * BM + wc * 32 + 8 * fq;
#pragma unroll
        for (int ai = 0; ai < 2; ++ai)
#pragma unroll
            for (int m = 0; m < 4; ++m) { const int prow = row0 + ai * HALF + m * 16; const int ts = rowtok[prow]; const float w = roww[prow];
                if (ts >= 0) { f16* rowp = C0 + (size_t)(ts & 1) * slot_stride + (size_t)(ts >> 1) * D + col0;
#pragma unroll
                    for (int bj = 0; bj < 2; ++bj) { const f32x4 v0 = acc[ai][bj][m][0] * w, v1 = acc[ai][bj][m][1] * w;
                        u32x4 o; o.x = pk_f16(v0[0], v0[1]); o.y = pk_f16(v0[2], v0[3]); o.z = pk_f16(v1[0], v1[1]); o.w = pk_f16(v1[2], v1[3]);
                        *(u32x4*)(rowp + bj * HALF) = o; } } }
    }
};

__device__ __forceinline__ const char* sgpr_ptr(const char* p) { const unsigned long long v = (unsigned long long)p; const unsigned lo = __builtin_amdgcn_readfirstlane((unsigned)v), hi = __builtin_amdgcn_readfirstlane((unsigned)(v >> 32)); return (const char*)(((unsigned long long)hi << 32) | lo); }
template <class Sched>
__device__ __forceinline__ void a_offsets(const Sched& S, const Unit& u, int lda, int tid, unsigned (&ao)[2][2]) {
#pragma unroll
    for (int h = 0; h < 2; ++h)
#pragma unroll
        for (int i = 0; i < 2; ++i) { int R, C; stage_rc(tid * 16 + i * 8192, R, C); ao[h][i] = ((unsigned)S.a_row(u, h * HALF + R) * (unsigned)lda + (unsigned)C) * 2u; }
}

template <class Epi, class Sched, bool ALIGN_EPI>
__device__ __forceinline__ void gemm_phase(LAS unsigned char* lds, const Gemm g, const Sched& S, const Epi& E) {
    constexpr bool GATHER = Sched::GATHER;
    int tid_ = threadIdx.x; asm volatile("" : "+v"(tid_));
    const int tid = tid_, wid = __builtin_amdgcn_readfirstlane(tid >> 6), lane = tid & 63, wr = wid >> 2, wc = wid & 3, fr = lane & 15, fq = lane >> 4;
    const int K = g.K, nt = K / BK;
    unsigned voffB[2], voffA[2];
#pragma unroll
    for (int i = 0; i < 2; ++i) { int R, C; stage_rc(tid * 16 + i * 8192, R, C); const int Rb = Epi::PERM ? ((R & ~31) + perm32(R & 31)) : R; voffB[i] = (unsigned)(Rb * g.ldb + C) * 2u; voffA[i] = (unsigned)(R * g.lda + C) * 2u; }
    const size_t kstep = (size_t)(BK * 2);
    const size_t hstepB = (size_t)HALF * g.ldb * 2, tstepB = 2 * hstepB;
    const size_t hstepA = (size_t)HALF * g.lda * 2;
    const unsigned ldsw = (unsigned)wid * 1024u;
    const int aoff = lds_byte(wr * 64 + fr, fq * 8), boff = lds_byte(wc * 32 + fr, fq * 8);
#define PG8_SA(b, h) (((b) * 2 + (h)) * HTB)
#define PG8_SB(b, h) ((4 + (b) * 2 + (h)) * HTB)
#define PG8_STAGEB(bufoff, gbase) do { _Pragma("unroll") for (int _i = 0; _i < 2; ++_i) \
        __builtin_amdgcn_global_load_lds((const unsigned*)(sgpr_ptr((const char*)(gbase)) + voffB[_i]), (LAS unsigned*)(lds + (bufoff) + ldsw + _i * 8192), 16, 0, 0); } while (0)
#define PG8_STAGEA(bufoff, ub, kb, h) do { _Pragma("unroll") for (int _i = 0; _i < 2; ++_i) \
        __builtin_amdgcn_global_load_lds((const unsigned*)(sgpr_ptr((ub) + (kb) + (GATHER ? (size_t)0 : (size_t)(h) * hstepA)) + (GATHER ? cao[h][_i] : voffA[_i])), (LAS unsigned*)(lds + (bufoff) + ldsw + _i * 8192), 16, 0, 0); } while (0)
#define PG8_LDA(dst, b, h) do { _Pragma("unroll") for (int m = 0; m < 4; ++m) _Pragma("unroll") for (int k = 0; k < 2; ++k) dst[m][k] = *(const LAS f16x8*)(lds + PG8_SA(b, h) + aoff + m * 2048 + k * 1024); } while (0)
#define PG8_LDB(dst, b, h) do { _Pragma("unroll") for (int n = 0; n < 2; ++n) _Pragma("unroll") for (int k = 0; k < 2; ++k) dst[n][k] = *(const LAS f16x8*)(lds + PG8_SB(b, h) + boff + n * 2048 + k * 1024); } while (0)
#define PG8_MMA(ai, bj, At, Bt) do { __builtin_amdgcn_s_setprio(1); _Pragma("unroll") for (int m = 0; m < 4; ++m) _Pragma("unroll") for (int n = 0; n < 2; ++n) _Pragma("unroll") for (int k = 0; k < 2; ++k) \
        acc[ai][bj][m][n] = __builtin_amdgcn_mfma_f32_16x16x32_f16(Bt[n][k], At[m][k], acc[ai][bj][m][n], 0, 0, 0); __builtin_amdgcn_s_setprio(0); } while (0)
#define PG8_WAIT_V(n) asm volatile("s_waitcnt vmcnt(" #n ")" ::: "memory")
#define PG8_WAIT_L(n) asm volatile("s_waitcnt lgkmcnt(" #n ")" ::: "memory")
#define PG8_BAR __builtin_amdgcn_s_barrier()
#define PG8_SCHED __builtin_amdgcn_sched_barrier(0)
    Unit cur, nxt; int ui = 0;
    if (!S.next(0, cur)) return;
    unsigned cao[2][2];
    if constexpr (GATHER) a_offsets(S, cur, g.lda, tid, cao);
    const char* cA = (const char*)g.A + S.a_col(cur) + (GATHER ? (size_t)0 : (size_t)S.a_row(cur, 0) * g.lda * 2);
    const char* cB = (const char*)g.Bt + S.b_base(cur) + (size_t)cur.pn * tstepB;
    PG8_STAGEB(PG8_SB(0, 0), cB); PG8_STAGEB(PG8_SB(0, 1), cB + hstepB); PG8_STAGEA(PG8_SA(0, 0), cA, 0, 0); PG8_STAGEA(PG8_SA(0, 1), cA, 0, 1);
    if (wr == 1) PG8_BAR;
    PG8_WAIT_V(2); PG8_BAR;
    PG8_STAGEB(PG8_SB(1, 0), cB + kstep); PG8_STAGEA(PG8_SA(1, 0), cA, kstep, 0); PG8_STAGEB(PG8_SB(1, 1), cB + hstepB + kstep);
    PG8_WAIT_V(6); PG8_BAR;
    f32x4 acc[2][2][4][2];
#pragma unroll
    for (int a = 0; a < 2; ++a)
#pragma unroll
        for (int b = 0; b < 2; ++b)
#pragma unroll
            for (int m = 0; m < 4; ++m)
#pragma unroll
                for (int n = 0; n < 2; ++n) acc[a][b][m][n] = (f32x4){0.f, 0.f, 0.f, 0.f};
    f16x8 At[4][2], B0[2][2], B1[2][2];
    for (;;) {
        const bool has_next = S.next(ui + 1, nxt);
        const char* nB = cB; const char* nA = cA;
        if (has_next) { nB = (const char*)g.Bt + S.b_base(nxt) + (size_t)nxt.pn * tstepB; nA = (const char*)g.A + S.a_col(nxt) + (GATHER ? (size_t)0 : (size_t)S.a_row(nxt, 0) * g.lda * 2); }
#pragma unroll 1
        for (int t = 0; t < nt; t += 2) {
            const bool last = (t == nt - 2);
            const size_t ka1 = (size_t)(t + 1) * kstep;
            const size_t ka2 = last ? 0 : (size_t)(t + 2) * kstep, ka3 = ka2 + kstep;
            const char* a2 = last ? nA : cA;
            const char* b2 = last ? nB : cB + (size_t)(t + 2) * kstep; const char* b3 = b2 + kstep;
            PG8_LDB(B0, 0, 0); PG8_LDB(B1, 0, 1); PG8_SCHED; PG8_LDA(At, 0, 0); PG8_STAGEA(PG8_SA(1, 1), cA, ka1, 1);
            if constexpr (GATHER) { if (last && has_next) a_offsets(S, nxt, g.lda, tid, cao); }
            PG8_WAIT_V(8); PG8_WAIT_L(0); PG8_BAR; PG8_MMA(0, 0, At, B0); PG8_MMA(0, 1, At, B1); PG8_BAR; PG8_SCHED;
            PG8_LDA(At, 0, 1); PG8_STAGEB(PG8_SB(0, 0), b2); PG8_STAGEB(PG8_SB(0, 1), b2 + hstepB); PG8_STAGEA(PG8_SA(0, 0), a2, ka2, 0);
            PG8_WAIT_V(8); PG8_WAIT_L(0); PG8_BAR; PG8_MMA(1, 0, At, B0); PG8_MMA(1, 1, At, B1); PG8_BAR; PG8_SCHED;
            PG8_LDB(B0, 1, 0); PG8_LDB(B1, 1, 1); PG8_SCHED; PG8_LDA(At, 1, 0); PG8_STAGEA(PG8_SA(0, 1), a2, ka2, 1);
            PG8_WAIT_V(8); PG8_WAIT_L(0); PG8_BAR; PG8_MMA(0, 0, At, B0); PG8_MMA(0, 1, At, B1); PG8_BAR; PG8_SCHED;
            PG8_LDA(At, 1, 1); PG8_STAGEB(PG8_SB(1, 0), b3); PG8_STAGEB(PG8_SB(1, 1), b3 + hstepB); PG8_STAGEA(PG8_SA(1, 0), a2, ka3, 0);
            PG8_WAIT_V(8); PG8_WAIT_L(0); PG8_BAR; PG8_MMA(1, 0, At, B0); PG8_MMA(1, 1, At, B1); PG8_BAR; PG8_SCHED;
        }
        if constexpr (ALIGN_EPI) { if (wr == 0) PG8_BAR; }
        { int t2 = threadIdx.x; asm volatile("" : "+v"(t2)); const int l2 = t2 & 63; E(acc, cur, wr, wc, l2 & 15, l2 >> 4); }
        if (!has_next) break;
#pragma unroll
        for (int a = 0; a < 2; ++a)
#pragma unroll
            for (int b = 0; b < 2; ++b)
#pragma unroll
                for (int m = 0; m < 4; ++m)
#pragma unroll
                    for (int n = 0; n < 2; ++n) acc[a][b][m][n] = (f32x4){0.f, 0.f, 0.f, 0.f};
        cur = nxt; cB = nB; cA = nA; ++ui;
        if constexpr (ALIGN_EPI) { if (wr == 1) PG8_BAR; }
    }
    PG8_WAIT_V(0);
    if constexpr (!ALIGN_EPI) { if (wr == 0) PG8_BAR; }
    PG8_BAR;
#undef PG8_SA
#undef PG8_SB
#undef PG8_STAGEA
#undef PG8_STAGEB
#undef PG8_LDA
#undef PG8_LDB
#undef PG8_MMA
#undef PG8_WAIT_V
#undef PG8_WAIT_L
#undef PG8_BAR
#undef PG8_SCHED
}
}

struct Args {
    const float* x; const float* ln_emb_g; const float* ln_emb_b; const float* w_in; const float* q_norm_g; const float* kv_norm_g;
    const float* w_uq; const float* w_ukv; const float* beta_mla; const float* beta_moba; const float* w_o; const float* ln1_g; const float* ln1_b;
    const float* ffn_w_gate; const float* ffn_w_up; const float* ffn_w_down; const float* router; const float* exp_w_gate; const float* exp_w_up;
    const float* exp_w_down; const float* ln2_g; const float* ln2_b;
    float* out; unsigned char* ws; int ph_lo, ph_hi;
};
struct Frame {
    LAS unsigned char* lds; int tid, lane, wave, bid, G;
};

enum { CM_ID = 0, CM_WIN = 1, CM_UQ = 2, CM_UKV = 3, CM_GU = 4 };
__device__ __forceinline__ int colmap(int kind, int n, int aux) {
    switch (kind) {
    case CM_WIN: {
        if (n >= HC_END) return -1;
        if (n >= HC_RQ && n < HC_RV) { const int base = n < HC_RK ? HC_RQ : HC_RK, r = n - base, hh = r >> 6, p = r & 63; const int d = ((p >> 5) << 4) + (p & 15) + ((p & 16) ? 32 : 0); return base + hh * 64 + d; }
        return n; }
    case CM_UQ: {
        if (n < 384) return (n >> 6) * 96 + (n & 63);
        if (n < 576) { const int r = n - 384; return (r >> 5) * 96 + 64 + (r & 31); }
        return -1; }
    case CM_UKV: {
        if (n < 384) return (n >> 6) * 128 + (n & 63);
        { const int r = n - 384; return (r >> 6) * 128 + 64 + (r & 63); } }
    case CM_GU: {
        const int j = n >> 8, w = n & 255; return j * 128 + (w & 127) + ((w >> 7) ? aux : 0); }
    default: return n;
    }
}
__device__ __forceinline__ void transpose_item(const float* W0, const float* W1, int K, int N, f16* WT, int kind, const float* kscale, const float* kscale2, LAS float* scr, int item, int nblk, int lane, int ldt = 0) {
    if (ldt == 0) ldt = K;
    const int kb = item / nblk, nb = item % nblk, k0 = 64 * kb, n0 = 32 * nb;
    const int nn = lane & 31; int sc = colmap(kind, n0 + nn, N); const float* W = W0;
    if (kind == CM_GU && sc >= N) { sc -= N; W = W1; }
#pragma unroll 8
    for (int i = 0; i < 32; ++i) { const int kk = 2 * i + (lane >> 5); float v = 0.f; if (sc >= 0) v = W[(size_t)(k0 + kk) * N + sc]; if (kscale2) { const int k = k0 + kk; v *= k < 384 ? kscale[k] : (k >= 704 ? kscale2[k - 704] : 1.0f); } else if (kscale) v *= kscale[k0 + kk]; scr[kk * 33 + nn] = v; }
    asm volatile("s_waitcnt lgkmcnt(0)" ::: "memory");
    const int c = lane & 7;
#pragma unroll
    for (int j = 0; j < 4; ++j) { const int n = (lane >> 3) + 8 * j; const LAS float* s = scr + (8 * c) * 33 + n;
        u32x4 o; o.x = pk_f16(s[0 * 33], s[1 * 33]); o.y = pk_f16(s[2 * 33], s[3 * 33]); o.z = pk_f16(s[4 * 33], s[5 * 33]); o.w = pk_f16(s[6 * 33], s[7 * 33]);
        *(u32x4*)(WT + (size_t)(n0 + n) * ldt + k0 + 8 * c) = o; }
    asm volatile("s_waitcnt lgkmcnt(0)" ::: "memory");
}

__device__ __forceinline__ void ln_stats(const f32x4 (&v)[4], float& mean, float& rstd) {
    float s = 0.f;
#pragma unroll
    for (int j = 0; j < 4; ++j) s += (v[j][0] + v[j][1]) + (v[j][2] + v[j][3]);
    mean = wave_sum(s) * (1.f / D); float s2 = 0.f;
#pragma unroll
    for (int j = 0; j < 4; ++j) { const f32x4 d = v[j] - mean; s2 += (d[0] * d[0] + d[1] * d[1]) + (d[2] * d[2] + d[3] * d[3]); }
    rstd = 1.0f / sqrtf(wave_sum(s2) * (1.f / D) + LN_EPS);
}

template <int DK>
__device__ __forceinline__ void stage_kv(LAS float* Ks, LAS float* Vs, const f16* kp, int kld, const f16* k2p, int k2ld, const f16* vp, int vld, size_t row0, int tid) {
    constexpr int KCH = DK / 8;
    for (int t = tid; t < 32 * KCH + 32 * 8; t += 512) {
        if (t < 32 * KCH) { const int key = t / KCH, ch = t % KCH; const f16* src = (ch < 8) ? kp + (row0 + key) * kld + ch * 8 : k2p + (row0 + key) * k2ld + (ch - 8) * 8;
            const f16x8 v = *(const f16x8*)src; LAS float* d = Ks + key * DK + ch * 8;
#pragma unroll
            for (int e = 0; e < 8; ++e) d[e] = (float)v[e]; }
        else { const int t2 = t - 32 * KCH, key = t2 >> 3, ch = t2 & 7; const f16x8 v = *(const f16x8*)(vp + (row0 + key) * vld + ch * 8); LAS float* d = Vs + key * 64 + ch * 8;
#pragma unroll
            for (int e = 0; e < 8; ++e) d[e] = (float)v[e]; }
    }
}

template <int MODE>
__device__ __forceinline__ void attn_softmax_simple(const Frame& F, const f16* qb, const f16* kvb, const f16* hb, const float* kmean, f16* ob, float* ssq_o) {
    constexpr int DK = MODE == 0 ? 96 : 64, NHD = MODE == 0 ? 6 : 5;
    LAS float* Ks = (LAS float*)F.lds; LAS float* Vs = Ks + 32 * DK; LAS float* KM = Vs + 32 * 64;
    const int tid = F.tid;
    for (int unit = F.bid; unit < BATCH * NHD * 4; unit += F.G) {
        const int qt = 3 - (unit % 4), hh = (unit / 4) % NHD, b = unit / (4 * NHD);
        const size_t brow = (size_t)b * SEQ; const int qpos = qt * 512 + tid; const size_t row = brow + qpos;
        float q[DK];
        if (MODE == 0) {
#pragma unroll
            for (int c = 0; c < 8; ++c) { const f16x8 v = *(const f16x8*)(qb + row * QW + hh * 64 + c * 8);
#pragma unroll
                for (int e = 0; e < 8; ++e) q[c * 8 + e] = (float)v[e]; }
#pragma unroll
            for (int c = 0; c < 4; ++c) { const f16x8 v = *(const f16x8*)(qb + row * QW + 384 + hh * 32 + c * 8);
#pragma unroll
                for (int e = 0; e < 8; ++e) q[64 + c * 8 + e] = (float)v[e]; }
        } else {
#pragma unroll
            for (int c = 0; c < 8; ++c) { const f16x8 v = *(const f16x8*)(hb + row * HW + HC_MQ + hh * 64 + c * 8);
#pragma unroll
                for (int e = 0; e < 8; ++e) q[c * 8 + e] = (float)v[e]; }
        }
        const int blk = qpos >> 8; unsigned sel = 0u; float slope2 = 0.f;
        if (MODE == 1) {
            __syncthreads();
            { const int n = tid >> 6, d = tid & 63; KM[n * 64 + d] = kmean[(size_t)(b * 8 + n) * 320 + hh * 64 + d]; }
            __syncthreads();
            float gt[8];
#pragma unroll
            for (int n = 0; n < 8; ++n) { float s = 0.f;
#pragma unroll
                for (int d = 0; d < 64; ++d) s += q[d] * KM[n * 64 + d];
                gt[n] = s; }
#pragma unroll
            for (int n = 0; n < 8; ++n) { int rank = 0;
#pragma unroll
                for (int m = 0; m < 8; ++m) if (m < blk && m != n) rank += (gt[m] > gt[n] || (gt[m] == gt[n] && m < n)) ? 1 : 0;
                if (n < blk && rank < 3) sel |= 1u << n; }
            slope2 = exp2f(-8.0f * (float)(hh + 1) / 5.0f) * LOG2E;
        }
        float o[64];
#pragma unroll
        for (int d = 0; d < 64; ++d) o[d] = 0.f;
        float mrun = -INFINITY, lrun = 0.f;
        const int nkeys = (qt + 1) * 512;
        for (int k0 = 0; k0 < nkeys; k0 += 32) {
            __syncthreads();
            if (MODE == 0) stage_kv<96>(Ks, Vs, kvb + hh * 64, KVW, hb + HC_KR, HW, kvb + 384 + hh * 64, KVW, brow + k0, tid);
            else stage_kv<64>(Ks, Vs, hb + HC_MK + hh * 64, HW, nullptr, 0, hb + HC_MV + hh * 64, HW, brow + k0, tid);
            __syncthreads();
            bool part;
            if (MODE == 0) part = k0 <= qpos;
            else { const int n = k0 >> 8; part = (n == blk) ? (k0 <= qpos) : (n < blk && ((sel >> n) & 1u)); }
            if (part) {
#pragma unroll 1
                for (int j = 0; j < 32; ++j) {
                    if (k0 + j > qpos) break;
                    const LAS float* Kj = Ks + j * DK; const LAS float* Vj = Vs + j * 64;
                    float a = 0.f;
#pragma unroll
                    for (int d = 0; d < DK; d += 4) { const f32x4 kv4 = *(const LAS f32x4*)(Kj + d); a += q[d] * kv4[0] + q[d + 1] * kv4[1] + q[d + 2] * kv4[2] + q[d + 3] * kv4[3]; }
                    if (MODE == 1) a -= slope2 * (float)(qpos - (k0 + j));
                    if (a > mrun) { const float alpha = exp2f(mrun - a); lrun *= alpha;
#pragma unroll
                        for (int d = 0; d < 64; ++d) o[d] *= alpha;
                        mrun = a; }
                    const float p = exp2f(a - mrun); lrun += p;
#pragma unroll
                    for (int d = 0; d < 64; d += 4) { const f32x4 v4 = *(const LAS f32x4*)(Vj + d); o[d] += p * v4[0]; o[d + 1] += p * v4[1]; o[d + 2] += p * v4[2]; o[d + 3] += p * v4[3]; }
                }
            }
        }
        const float inv = 1.0f / lrun; float ss = 0.f;
#pragma unroll
        for (int d = 0; d < 64; ++d) { o[d] *= inv; ss += o[d] * o[d]; }
        f16* op = ob + row * D + (MODE == 0 ? 0 : OC_MOBA) + hh * 64;
#pragma unroll
        for (int c = 0; c < 8; ++c) { u32x4 w; w.x = pk_f16(o[c * 8], o[c * 8 + 1]); w.y = pk_f16(o[c * 8 + 2], o[c * 8 + 3]); w.z = pk_f16(o[c * 8 + 4], o[c * 8 + 5]); w.w = pk_f16(o[c * 8 + 6], o[c * 8 + 7]); *(u32x4*)(op + c * 8) = w; }
        ssq_o[row * 16 + (MODE == 0 ? 0 : 6) + hh] = ss;
    }
}
__device__ __forceinline__ void attn_ret_simple(const Frame& F, const f16* hb, f16* ob) {
    LAS float* Ks = (LAS float*)F.lds; LAS float* Vs = Ks + 32 * 64;
    const int tid = F.tid;
    for (int unit = F.bid; unit < BATCH * 5 * 4; unit += F.G) {
        const int qt = 3 - (unit % 4), hh = (unit / 4) % 5, b = unit / 20;
        const size_t brow = (size_t)b * SEQ; const int qpos = qt * 512 + tid; const size_t row = brow + qpos;
        float q[64];
#pragma unroll
        for (int c = 0; c < 8; ++c) { const f16x8 v = *(const f16x8*)(hb + row * HW + HC_RQ + hh * 64 + c * 8);
#pragma unroll
            for (int e = 0; e < 8; ++e) q[c * 8 + e] = (float)v[e]; }
        const float lg2 = log2f(1.0f - exp2f(-5.0f - (float)hh));
        float o[64];
#pragma unroll
        for (int d = 0; d < 64; ++d) o[d] = 0.f;
        const int nkeys = (qt + 1) * 512;
        for (int k0 = 0; k0 < nkeys; k0 += 32) {
            __syncthreads();
            stage_kv<64>(Ks, Vs, hb + HC_RK + hh * 64, HW, nullptr, 0, hb + HC_RV + hh * 64, HW, brow + k0, tid);
            __syncthreads();
            if (k0 <= qpos) {
#pragma unroll 1
                for (int j = 0; j < 32; ++j) {
                    const int dl = qpos - (k0 + j); if (dl < 0) break;
                    const LAS float* Kj = Ks + j * 64; const LAS float* Vj = Vs + j * 64;
                    float a = 0.f;
#pragma unroll
                    for (int d = 0; d < 64; d += 4) { const f32x4 kv4 = *(const LAS f32x4*)(Kj + d); a += q[d] * kv4[0] + q[d + 1] * kv4[1] + q[d + 2] * kv4[2] + q[d + 3] * kv4[3]; }
                    const float p = a * exp2f(lg2 * (float)dl);
#pragma unroll
                    for (int d = 0; d < 64; d += 4) { const f32x4 v4 = *(const LAS f32x4*)(Vj + d); o[d] += p * v4[0]; o[d + 1] += p * v4[1]; o[d + 2] += p * v4[2]; o[d + 3] += p * v4[3]; }
                }
            }
        }
        float mu = 0.f;
#pragma unroll
        for (int d = 0; d < 64; ++d) mu += o[d];
        mu *= (1.f / 64.f); float var = 0.f;
#pragma unroll
        for (int d = 0; d < 64; ++d) { const float t = o[d] - mu; var += t * t; }
        const float rs = 1.0f / sqrtf(var * (1.f / 64.f) + RMS_EPS);
        f16* op = ob + row * D + OC_RET + hh * 64; const f16* gp = hb + row * HW + HC_RG + hh * 64;
#pragma unroll
        for (int c = 0; c < 8; ++c) { const f16x8 gv = *(const f16x8*)(gp + c * 8); float r[8];
#pragma unroll
            for (int e = 0; e < 8; ++e) r[e] = silu_f((float)gv[e]) * ((o[c * 8 + e] - mu) * rs);
            u32x4 w; w.x = pk_f16(r[0], r[1]); w.y = pk_f16(r[2], r[3]); w.z = pk_f16(r[4], r[5]); w.w = pk_f16(r[6], r[7]); *(u32x4*)(op + c * 8) = w; }
    }
}

namespace att {
typedef float f32x16 __attribute__((ext_vector_type(16)));
typedef short s16x4 __attribute__((ext_vector_type(4)));
constexpr int BUF_STRIDE = 20480, OFF_V = 8192, OFF_PE = 16384, OFF_OSTG = 40960, OSTG_WAVE = 32 * 272, OFF_L = OFF_OSTG + 8 * OSTG_WAVE, OFF_F = OFF_L + 1024, OFF_QW = OFF_F + 1024;
constexpr float THR = 8.0f;
__device__ __forceinline__ int crowc(int r) { return (r & 3) + 8 * (r >> 2); }
__device__ __forceinline__ float pswap_max(float v) { const auto rr = __builtin_amdgcn_permlane32_swap(__float_as_uint(v), __float_as_uint(v), false, false); return fmaxf(__uint_as_float(rr[0]), __uint_as_float(rr[1])); }
__device__ __forceinline__ float pswap_sum(float v) { const auto rr = __builtin_amdgcn_permlane32_swap(__float_as_uint(v), __float_as_uint(v), false, false); return __uint_as_float(rr[0]) + __uint_as_float(rr[1]); }
#define ATT_WAIT_BAR() asm volatile("s_waitcnt vmcnt(0) lgkmcnt(0)\n\ts_barrier" ::: "memory")
__device__ __forceinline__ f16x8 vfrag(const LAS unsigned char* p0, const LAS unsigned char* p1) {
    const s16x4 lo = __builtin_bit_cast(s16x4, __builtin_amdgcn_ds_read_tr16_b64_v4i16((LAS s16x4*)p0));
    const s16x4 hi = __builtin_bit_cast(s16x4, __builtin_amdgcn_ds_read_tr16_b64_v4i16((LAS s16x4*)p1));
    typedef short s16x8 __attribute__((ext_vector_type(8)));
    const s16x8 v = {lo[0], lo[1], lo[2], lo[3], hi[0], hi[1], hi[2], hi[3]};
    return __builtin_bit_cast(f16x8, v);
}
template <int KIND>
__device__ __forceinline__ void attn_unit(LAS unsigned char* lds, int b, int hh, int qt, const f16* qbuf, const f16* kvbuf, const f16* hbuf, const float* kmean, f16* obuf, float* ssq_o) {
    int tid_ = threadIdx.x; asm volatile("" : "+v"(tid_));
    const int tid = tid_, lane = tid & 63, wid = __builtin_amdgcn_readfirstlane(tid >> 6), r32 = lane & 31, hi = lane >> 5;
    constexpr int NQK = KIND == 0 ? 6 : 4;
    const size_t brow = (size_t)b * SEQ;
    const int q0w = qt * 256 + wid * 32, qpos = q0w + r32;
    const f16* kbase; int kld; const f16* vbase; int vld; const f16* qrow;
    if (KIND == 0) { kbase = kvbuf + hh * 64; kld = KVW; vbase = kvbuf + 384 + hh * 64; vld = KVW; qrow = qbuf + (brow + qpos) * QW + hh * 64; }
    else if (KIND == 1) { kbase = hbuf + HC_MK + hh * 64; kld = HW; vbase = hbuf + HC_MV + hh * 64; vld = HW; qrow = hbuf + (brow + qpos) * HW + HC_MQ + hh * 64; }
    else { kbase = hbuf + HC_RK + hh * 64; kld = HW; vbase = hbuf + HC_RV + hh * 64; vld = HW; qrow = hbuf + (brow + qpos) * HW + HC_RQ + hh * 64; }
    const int dkey = 8 * wid + (lane >> 3), dcs = lane & 7;
    const char* ksrc = (const char*)(kbase + (brow + dkey) * kld + ((dcs ^ ((dkey >> 1) & 7)) << 3));
    const char* vsrc = (const char*)(vbase + (brow + dkey) * vld + (((((dcs >> 2) ^ ((dkey >> 1) & 1)) << 2) | (dcs & 3)) << 3));
    const int pkey = 16 * wid + (lane >> 2), pcs = lane & 3;
    const char* psrc = (const char*)(hbuf + (brow + pkey) * HW + HC_KR + ((pcs ^ ((pkey >> 2) & 3)) << 3));
    const size_t ktile = (size_t)64 * kld * 2, vtile = (size_t)64 * vld * 2, ptile = (size_t)64 * HW * 2;
#define ATT_DMA(t, buf) do { \
        __builtin_amdgcn_global_load_lds((const unsigned*)(ksrc + (size_t)(t) * ktile), (LAS unsigned*)(lds + (buf) * BUF_STRIDE + wid * 1024), 16, 0, 0); \
        __builtin_amdgcn_global_load_lds((const unsigned*)(vsrc + (size_t)(t) * vtile), (LAS unsigned*)(lds + (buf) * BUF_STRIDE + OFF_V + wid * 1024), 16, 0, 0); \
        if (KIND == 0) { if (wid < 4) __builtin_amdgcn_global_load_lds((const unsigned*)(psrc + (size_t)(t) * ptile), (LAS unsigned*)(lds + (buf) * BUF_STRIDE + OFF_PE + wid * 1024), 16, 0, 0); } } while (0)
    const int NT = 4 * (qt + 1);
    ATT_DMA(0, 0);
    f16x8 qf[NQK];
#pragma unroll
    for (int d0 = 0; d0 < 4; ++d0) qf[d0] = *(const f16x8*)(qrow + 16 * d0 + 8 * hi);
    if (KIND == 0) { const f16* qpe = qbuf + (brow + qpos) * QW + 384 + hh * 32; qf[4] = *(const f16x8*)(qpe + 8 * hi); qf[5] = *(const f16x8*)(qpe + 16 + 8 * hi); }
    const int ksw = (r32 >> 1) & 7, psw = (r32 >> 2) & 3;
    int koff[4];
#pragma unroll
    for (int d0 = 0; d0 < 4; ++d0) koff[d0] = r32 * 128 + (((2 * d0 + hi) ^ ksw) << 4);
    int poff[2];
#pragma unroll
    for (int d0 = 0; d0 < 2; ++d0) poff[d0] = r32 * 64 + (((2 * d0 + hi) ^ psw) << 4);
    const int vq = (lane & 15) >> 2, vp = lane & 3, vg = (lane >> 4) & 1, vsw = (vq >> 1) & 1;
    int voff[2];
#pragma unroll
    for (int d0 = 0; d0 < 2; ++d0) voff[d0] = (4 * hi + vq) * 128 + ((d0 ^ vsw) << 6) + ((2 * vg + (vp >> 1)) << 4) + 8 * (vp & 1);
    unsigned sel = 0u; float slope2 = 0.f;
    if (KIND == 1) {
        slope2 = exp2f(-8.0f * (float)(hh + 1) / 5.0f) * LOG2E;
        if (qt >= 4) {
            if (tid < 64) { const int n = tid >> 3, cs = tid & 7, c = cs ^ ((n >> 1) & 7); const float* src = kmean + (size_t)(b * 8 + n) * 640 + hh * 64 + c * 8;
                const f32x4 a0 = (*(const f32x4*)src + *(const f32x4*)(src + 320)) * (1.f / 256.f), a1 = (*(const f32x4*)(src + 4) + *(const f32x4*)(src + 324)) * (1.f / 256.f);
                u32x4 w; w.x = pk_f16(a0[0], a0[1]); w.y = pk_f16(a0[2], a0[3]); w.z = pk_f16(a1[0], a1[1]); w.w = pk_f16(a1[2], a1[3]);
                *(LAS u32x4*)(lds + BUF_STRIDE + n * 128 + cs * 16) = w; }
            asm volatile("s_waitcnt lgkmcnt(0)\n\ts_barrier" ::: "memory");
            f32x16 pg = {};
#pragma unroll
            for (int d0 = 0; d0 < 4; ++d0) { const f16x8 kf = *(const LAS f16x8*)(lds + BUF_STRIDE + koff[d0]); pg = __builtin_amdgcn_mfma_f32_32x32x16_f16(kf, qf[d0], pg, 0, 0, 0); }
            float gt[8];
#pragma unroll
            for (int r = 0; r < 4; ++r) { const auto rr = __builtin_amdgcn_permlane32_swap(__float_as_uint(pg[r]), __float_as_uint(pg[r]), false, false); gt[r] = __uint_as_float(rr[0]); gt[4 + r] = __uint_as_float(rr[1]); }
#pragma unroll
            for (int n = 0; n < 8; ++n) { int rank = 0;
#pragma unroll
                for (int m = 0; m < 8; ++m) if (m != n) rank += (m < qt && (gt[m] > gt[n] || (gt[m] == gt[n] && m < n))) ? 1 : 0;
                if (n < qt && rank < 3) sel |= 1u << n; }
        } else sel = 0xffu;
    }
    float lg2 = 0.f, e32 = 0.f; float dc[16];
    if (KIND == 2) { lg2 = log2f(1.0f - exp2f(-5.0f - (float)hh)); e32 = exp2f(-32.0f * lg2);
#pragma unroll
        for (int r = 0; r < 16; ++r) dc[r] = exp2f(-lg2 * (float)crowc(r)); }
    f32x16 o0 = {}, o1 = {};
    float mref = -1.0e30f, lsum = 0.f;
    LAS float* wsf = (LAS float*)(lds + OFF_F) + wid * 32;
    for (int t = 0; t < NT; ++t) {
        ATT_WAIT_BAR();
        if (t + 1 < NT) ATT_DMA(t + 1, (t + 1) & 1);
        const int k0 = 64 * t;
        bool active = k0 <= q0w + 31;
        if (KIND == 1) { const int n = t >> 2; if (n < qt) active = __any((sel >> n) & 1u) != 0; }
        if (!active) continue;
        const LAS unsigned char* kb = lds + (t & 1) * BUF_STRIDE;
        f32x16 p0, p1;
        if (KIND == 1) { const float cb = slope2 * (float)(k0 + 4 * hi - qpos);
#pragma unroll
            for (int r = 0; r < 16; ++r) { p0[r] = fmaf(slope2, (float)crowc(r), cb); p1[r] = fmaf(slope2, (float)(crowc(r) + 32), cb); } }
        else { p0 = (f32x16){}; p1 = (f32x16){}; }
#pragma unroll
        for (int d0 = 0; d0 < 4; ++d0) { const f16x8 k0f = *(const LAS f16x8*)(kb + koff[d0]), k1f = *(const LAS f16x8*)(kb + koff[d0] + 4096);
            p0 = __builtin_amdgcn_mfma_f32_32x32x16_f16(k0f, qf[d0], p0, 0, 0, 0); p1 = __builtin_amdgcn_mfma_f32_32x32x16_f16(k1f, qf[d0], p1, 0, 0, 0); }
        if (KIND == 0) {
#pragma unroll
            for (int d0 = 0; d0 < 2; ++d0) { const f16x8 k0f = *(const LAS f16x8*)(kb + OFF_PE + poff[d0]), k1f = *(const LAS f16x8*)(kb + OFF_PE + poff[d0] + 2048);
                p0 = __builtin_amdgcn_mfma_f32_32x32x16_f16(k0f, qf[4 + d0], p0, 0, 0, 0); p1 = __builtin_amdgcn_mfma_f32_32x32x16_f16(k1f, qf[4 + d0], p1, 0, 0, 0); } }
        const bool diag = k0 + 63 > q0w;
        const int kk = qpos - k0 - 4 * hi;
        u32x4 pw[4];
        if (KIND != 2) {
            if (diag) {
#pragma unroll
                for (int r = 0; r < 16; ++r) { if (crowc(r) > kk) p0[r] = -INFINITY; if (crowc(r) + 32 > kk) p1[r] = -INFINITY; } }
            if (KIND == 1) { const int n = t >> 2; if (n < qt && !((sel >> n) & 1u)) {
#pragma unroll
                for (int r = 0; r < 16; ++r) { p0[r] = -INFINITY; p1[r] = -INFINITY; } } }
            float rm = fmaxf(p0[0], p1[0]);
#pragma unroll
            for (int r = 1; r < 16; ++r) rm = fmaxf(rm, fmaxf(p0[r], p1[r]));
            rm = pswap_max(rm);
            if (__any(rm > mref + THR)) {
                const float mnew = fmaxf(mref, rm), f = __builtin_amdgcn_exp2f(mref - mnew);
                lsum *= f; mref = mnew;
                if (hi == 0) wsf[r32] = f;
                asm volatile("s_waitcnt lgkmcnt(0)" ::: "memory");
#pragma unroll
                for (int r = 0; r < 16; ++r) { const float fr = wsf[crowc(r) + 4 * hi]; o0[r] *= fr; o1[r] *= fr; }
            }
            float ls = 0.f;
#pragma unroll
            for (int r = 0; r < 16; ++r) { p0[r] = __builtin_amdgcn_exp2f(p0[r] - mref); p1[r] = __builtin_amdgcn_exp2f(p1[r] - mref); ls += p0[r] + p1[r]; }
            lsum += ls;
        } else {
            const float et = __builtin_amdgcn_exp2f(lg2 * (float)kk);
#pragma unroll
            for (int r = 0; r < 16; ++r) { const float w = et * dc[r]; p0[r] *= w; p1[r] *= w * e32; }
            if (diag) {
#pragma unroll
                for (int r = 0; r < 16; ++r) { if (crowc(r) > kk) p0[r] = 0.f; if (crowc(r) + 32 > kk) p1[r] = 0.f; } }
        }
#pragma unroll
        for (int i = 0; i < 4; ++i) { pw[0][i] = pk_f16(p0[2 * i], p0[2 * i + 1]); pw[1][i] = pk_f16(p0[8 + 2 * i], p0[8 + 2 * i + 1]); pw[2][i] = pk_f16(p1[2 * i], p1[2 * i + 1]); pw[3][i] = pk_f16(p1[8 + 2 * i], p1[8 + 2 * i + 1]); }
        const LAS unsigned char* vb = kb + OFF_V;
#pragma unroll
        for (int ks = 0; ks < 4; ++ks) {
            const f16x8 pa = __builtin_bit_cast(f16x8, pw[ks]);
            const f16x8 v0 = vfrag(vb + voff[0] + ks * 2048, vb + voff[0] + ks * 2048 + 1024);
            const f16x8 v1 = vfrag(vb + voff[1] + ks * 2048, vb + voff[1] + ks * 2048 + 1024);
            o0 = __builtin_amdgcn_mfma_f32_32x32x16_f16(pa, v0, o0, 0, 0, 0);
            o1 = __builtin_amdgcn_mfma_f32_32x32x16_f16(pa, v1, o1, 0, 0, 0);
        }
    }
    LAS float* stg = (LAS float*)(lds + OFF_OSTG + wid * OSTG_WAVE);
#pragma unroll
    for (int r = 0; r < 16; ++r) { const int row = crowc(r) + 4 * hi; stg[row * 68 + r32] = o0[r]; stg[row * 68 + 32 + r32] = o1[r]; }
    LAS float* lrow = (LAS float*)(lds + OFF_L) + wid * 32;
    if (KIND != 2) { const float lt = pswap_sum(lsum); if (hi == 0) lrow[r32] = lt; }
    asm volatile("s_waitcnt lgkmcnt(0)" ::: "memory");
    {
        const int row = lane >> 1, half = lane & 1; float v[32];
#pragma unroll
        for (int i = 0; i < 8; ++i) { const f32x4 x = *(const LAS f32x4*)(stg + row * 68 + half * 32 + i * 4); v[4 * i] = x[0]; v[4 * i + 1] = x[1]; v[4 * i + 2] = x[2]; v[4 * i + 3] = x[3]; }
        const size_t grow = brow + q0w + row;
        if (KIND != 2) {
            const float inv = 1.0f / lrow[row]; float ss = 0.f;
#pragma unroll
            for (int i = 0; i < 32; ++i) { v[i] *= inv; ss += v[i] * v[i]; }
            ss += swz_xor<1>(ss);
            if (half == 0) ssq_o[grow * 16 + (KIND == 0 ? 0 : 6) + hh] = ss;
        } else {
            float s1 = 0.f;
#pragma unroll
            for (int i = 0; i < 32; ++i) s1 += v[i];
            s1 += swz_xor<1>(s1); const float mu = s1 * (1.f / 64.f); float s2 = 0.f;
#pragma unroll
            for (int i = 0; i < 32; ++i) { v[i] -= mu; s2 += v[i] * v[i]; }
            s2 += swz_xor<1>(s2); const float rs = 1.0f / sqrtf(s2 * (1.f / 64.f) + RMS_EPS);
            const f16* gp = hbuf + grow * HW + HC_RG + hh * 64 + half * 32;
#pragma unroll
            for (int c = 0; c < 4; ++c) { const f16x8 gv = *(const f16x8*)(gp + c * 8);
#pragma unroll
                for (int e = 0; e < 8; ++e) v[c * 8 + e] = silu_f((float)gv[e]) * (v[c * 8 + e] * rs); }
        }
        f16* op = obuf + grow * D + (KIND == 0 ? 0 : (KIND == 1 ? OC_MOBA : OC_RET)) + hh * 64 + half * 32;
#pragma unroll
        for (int c = 0; c < 4; ++c) { u32x4 w; w.x = pk_f16(v[c * 8], v[c * 8 + 1]); w.y = pk_f16(v[c * 8 + 2], v[c * 8 + 3]); w.z = pk_f16(v[c * 8 + 4], v[c * 8 + 5]); w.w = pk_f16(v[c * 8 + 6], v[c * 8 + 7]); *(u32x4*)(op + c * 8) = w; }
    }
#undef ATT_DMA
}
__device__ __forceinline__ void attn_phase(LAS unsigned char* lds, unsigned* qctr, const f16* qbuf, const f16* kvbuf, const f16* hbuf, const float* kmean, f16* obuf, float* ssq_o) {
    volatile LAS int* qw = (volatile LAS int*)(lds + OFF_QW);
    for (;;) {
        asm volatile("s_waitcnt vmcnt(0) lgkmcnt(0)\n\ts_barrier" ::: "memory");
        if (threadIdx.x == 0) qw[0] = (int)__hip_atomic_fetch_add(qctr, 1u, __ATOMIC_RELAXED, __HIP_MEMORY_SCOPE_AGENT);
        asm volatile("s_waitcnt vmcnt(0) lgkmcnt(0)\n\ts_barrier" ::: "memory");
        const int idx = __builtin_amdgcn_readfirstlane(qw[0]);
        if (idx >= 2048) break;
        const int qt = 7 - (idx >> 8), j = idx & 255;
        if (j < 96) attn_unit<0>(lds, j / 6, j % 6, qt, qbuf, kvbuf, hbuf, kmean, obuf, ssq_o);
        else if (j < 176) attn_unit<1>(lds, (j - 96) / 5, (j - 96) % 5, qt, qbuf, kvbuf, hbuf, kmean, obuf, ssq_o);
        else attn_unit<2>(lds, (j - 176) / 5, (j - 176) % 5, qt, qbuf, kvbuf, hbuf, kmean, obuf, ssq_o);
    }
}
#undef ATT_WAIT_BAR
}

constexpr int NWAVES = 8;
constexpr int PH_L0 = 1, PPL0 = 9, PH_L1 = PH_L0 + PPL0, PPL1 = 18, NPHASE = PH_L1 + PPL1;
typedef const __attribute__((address_space(4))) Args* KArgs;
__device__ __forceinline__ KArgs kargs() { KArgs p = (KArgs)__builtin_amdgcn_kernarg_segment_ptr(); asm volatile("" : "+s"(p)); return p; }
__device__ __forceinline__ Frame mkframe() {
    extern __shared__ __attribute__((aligned(16))) unsigned char lds_raw[];
    Frame F; F.lds = (LAS unsigned char*)lds_raw; int t = threadIdx.x; asm volatile("" : "+v"(t)); F.tid = t; F.lane = t & 63; F.wave = __builtin_amdgcn_readfirstlane(t >> 6); F.bid = blockIdx.x; F.G = gridDim.x; return F;
}
#define WSP(T_, off) ((T_*)(ws + (off)))

__device__ __forceinline__ void ph_prologue() {
    const Frame F = mkframe(); KArgs a = kargs(); unsigned char* ws = a->ws;
    const int gw = F.bid * NWAVES + F.wave, NGW = F.G * NWAVES;
    f16* Win = WSP(f16, WS_WIN); f16* Wuq = WSP(f16, WS_WUQ); f16* Wo = WSP(f16, WS_WO); f16* Wgu = WSP(f16, WS_WGU); f16* Wdn = WSP(f16, WS_WDN);
    f16* Egu = WSP(f16, WS_EGU); f16* Edn = WSP(f16, WS_EDN); f16* xb = WSP(f16, WS_XB);
    float* cosA = WSP(float, WS_ROPE); float* sinA = cosA + SEQ * 16; float* cosB = sinA + SEQ * 16; float* sinB = cosB + SEQ * 32;
    LAS float* scr = (LAS float*)(F.lds + F.wave * 16384);
    constexpr int I_WIN = (D / 64) * (HW / 32), I_UQ = (256 / 64) * (768 / 32), I_UKV = (128 / 64) * (768 / 32), I_WO = (D / 64) * (D / 32);
    constexpr int I_GU = (D / 64) * (2 * FF / 32), I_DN = (FF / 64) * (D / 32), I_EGU = (D / 64) * (2 * FE / 32), I_EDN = (FE / 64) * (D / 32);
    constexpr int N_SMALL = 2 * (I_WIN + I_UQ + I_UKV + I_WO) + I_GU + I_DN, N_ALL = N_SMALL + NE * (I_EGU + I_EDN);
    for (int it = gw; it < N_ALL; it += NGW) {
        int r = it;
        if (r < 2 * I_WIN) { const int l = r / I_WIN; r %= I_WIN; transpose_item(a->w_in + (size_t)l * D * HC_END, nullptr, D, HC_END, Win + (size_t)l * HW * D, CM_WIN, nullptr, nullptr, scr, r, HW / 32, F.lane); continue; } r -= 2 * I_WIN;
        if (r < 2 * I_UQ) { const int l = r / I_UQ; r %= I_UQ; transpose_item(a->w_uq + (size_t)l * 256 * 576, nullptr, 256, 576, Wuq + (size_t)l * 1536 * 256, CM_UQ, a->q_norm_g + l * 256, nullptr, scr, r, 768 / 32, F.lane); continue; } r -= 2 * I_UQ;
        if (r < 2 * I_UKV) { const int l = r / I_UKV; r %= I_UKV; transpose_item(a->w_ukv + (size_t)l * 128 * 768, nullptr, 128, 768, Wuq + (size_t)l * 1536 * 256 + (size_t)768 * 256, CM_UKV, a->kv_norm_g + l * 128, nullptr, scr, r, 768 / 32, F.lane, 256); continue; } r -= 2 * I_UKV;
        if (r < 2 * I_WO) { const int l = r / I_WO; r %= I_WO; transpose_item(a->w_o + (size_t)l * D * D, nullptr, D, D, Wo + (size_t)l * D * D, CM_ID, a->beta_mla + l * 384, a->beta_moba + l * 320, scr, r, D / 32, F.lane); continue; } r -= 2 * I_WO;
        if (r < I_GU) { transpose_item(a->ffn_w_gate, a->ffn_w_up, D, FF, Wgu, CM_GU, nullptr, nullptr, scr, r, 2 * FF / 32, F.lane); continue; } r -= I_GU;
        if (r < I_DN) { transpose_item(a->ffn_w_down, nullptr, FF, D, Wdn, CM_ID, nullptr, nullptr, scr, r, D / 32, F.lane); continue; } r -= I_DN;
        { const int e = r / (I_EGU + I_EDN); r %= (I_EGU + I_EDN);
          if (r < I_EGU) transpose_item(a->exp_w_gate + (size_t)e * D * FE, a->exp_w_up + (size_t)e * D * FE, D, FE, Egu + (size_t)e * 2 * FE * D, CM_GU, nullptr, nullptr, scr, r, 2 * FE / 32, F.lane);
          else transpose_item(a->exp_w_down + (size_t)e * FE * D, nullptr, FE, D, Edn + (size_t)e * D * FE, CM_ID, nullptr, nullptr, scr, r - I_EGU, D / 32, F.lane); }
    }
    for (int i = F.bid * 512 + F.tid; i < 2 * 768 * 16; i += F.G * 512) { const int l = i / (768 * 16), r = (i / 16) % 768, c = i % 16; *(u32x4*)(Wuq + (size_t)l * 1536 * 256 + (size_t)(768 + r) * 256 + 128 + c * 8) = (u32x4){0u, 0u, 0u, 0u}; }
    for (int i = F.bid * 512 + F.tid; i < SEQ * 48; i += F.G * 512) {
        if (i < SEQ * 16) { const int pos = i >> 4, j = i & 15; const float inv = powf(10000.0f, -(float)(2 * j) / 32.0f); const float ang = (float)pos * inv; cosA[i] = cosf(ang); sinA[i] = sinf(ang); }
        else { const int k = i - SEQ * 16, pos = k >> 5, j = k & 31; const float inv = powf(10000.0f, -(float)(2 * j) / 64.0f); const float ang = (float)pos * inv; cosB[k] = cosf(ang); sinB[k] = sinf(ang); }
    }
    const float* xin = a->x; const float* gp = a->ln_emb_g; const float* bp = a->ln_emb_b;
    for (int m = gw; m < T; m += NGW) {
        const f32x4* xr = (const f32x4*)(xin + (size_t)m * D) + F.lane; f32x4 v[4];
#pragma unroll
        for (int j = 0; j < 4; ++j) v[j] = xr[64 * j];
        float mean, rstd; ln_stats(v, mean, rstd);
        u32x2* o8 = (u32x2*)(xb + (size_t)m * D) + F.lane;
#pragma unroll
        for (int j = 0; j < 4; ++j) { const f32x4 g = *((const f32x4*)gp + F.lane + 64 * j), bb = *((const f32x4*)bp + F.lane + 64 * j); const f32x4 y = (v[j] - mean) * rstd * g + bb;
            u32x2 w; w.x = pk_f16(y[0], y[1]); w.y = pk_f16(y[2], y[3]); o8[64 * j] = w; }
    }
}
__device__ __forceinline__ void ph_A(int l) {
    const Frame F = mkframe(); KArgs a = kargs(); unsigned char* ws = a->ws;
    pg8::Gemm g{WSP(f16, WS_XB), D, WSP(f16, WS_WIN) + (size_t)l * HW * D, D, D}; pg8::StaticOrder S; S.init(T / 256, HW / 256, F.G, F.bid);
    const float* cosA = WSP(float, WS_ROPE);
    pg8::EpiWin E{WSP(f16, WS_H), WSP(float, WS_SSQ_Q), WSP(float, WS_SSQ_KV), WSP(float, WS_KMEAN), cosA, cosA + SEQ * 16, cosA + SEQ * 32, cosA + SEQ * 64};
    pg8::gemm_phase<pg8::EpiWin, pg8::StaticOrder, true>(F.lds, g, S, E);
}
__device__ __forceinline__ void ph_B(int l) {
    const Frame F = mkframe(); KArgs a = kargs(); unsigned char* ws = a->ws;
    pg8::Gemm g{WSP(f16, WS_H), HW, WSP(f16, WS_WUQ) + (size_t)l * 1536 * 256, 256, 256}; pg8::UpOrder S; S.so.init(T / 256, 6, F.G, F.bid);
    const float* cosA = WSP(float, WS_ROPE);
    pg8::EpiUp E{(f16*)a->out, (f16*)((unsigned char*)a->out + 48 * MiB), WSP(float, WS_SSQ_Q), WSP(float, WS_SSQ_KV), cosA, cosA + SEQ * 16};
    pg8::gemm_phase<pg8::EpiUp, pg8::UpOrder, true>(F.lds, g, S, E);
}
constexpr int CW_ATTQ = 8192;
__device__ __forceinline__ void ph_C(int l) {
    const Frame F = mkframe(); KArgs a = kargs(); unsigned char* ws = a->ws;
    att::attn_phase(F.lds, WSP(unsigned, WS_CTL) + CW_ATTQ + 64 * l, (const f16*)a->out, (const f16*)((unsigned char*)a->out + 48 * MiB), WSP(f16, WS_H), WSP(float, WS_KMEAN), WSP(f16, WS_O), WSP(float, WS_SSQ_O));
}
__device__ __forceinline__ void ph_C2() {
    const Frame F = mkframe(); KArgs a = kargs(); unsigned char* ws = a->ws;
    const int gw = F.bid * NWAVES + F.wave, NGW = F.G * NWAVES;
    const float* ssq_o = WSP(float, WS_SSQ_O); f16* obuf = WSP(f16, WS_O);
    for (int m = gw; m < T; m += NGW) {
        const int lane = F.lane; const float* sp = ssq_o + (size_t)m * 16;
        const float sa = 1.0f / sqrtf((sp[0] + sp[1] + sp[2] + sp[3] + sp[4] + sp[5]) * (1.f / 384.f) + RMS_EPS);
        const float sc = 1.0f / sqrtf((sp[6] + sp[7] + sp[8] + sp[9] + sp[10]) * (1.f / 320.f) + RMS_EPS);
        f16* orow = obuf + (size_t)m * D;
#pragma unroll
        for (int j = 0; j < 6; ++j) { f16* p = orow + lane + 64 * j; *p = (f16)((float)*p * sa); }
#pragma unroll
        for (int j = 0; j < 5; ++j) { f16* p = orow + OC_MOBA + lane + 64 * j; *p = (f16)((float)*p * sc); }
    }
}
__device__ __forceinline__ void ph_D(int l) {
    const Frame F = mkframe(); KArgs a = kargs(); unsigned char* ws = a->ws;
    pg8::Gemm g{WSP(f16, WS_O), D, WSP(f16, WS_WO) + (size_t)l * D * D, D, D}; pg8::StaticOrder S; S.init(T / 256, D / 256, F.G, F.bid);
    pg8::EpiResF32 E{WSP(f16, WS_XB), a->out, D, DN_ALPHA};
    pg8::gemm_phase<pg8::EpiResF32, pg8::StaticOrder, true>(F.lds, g, S, E);
}
__device__ __forceinline__ void ph_D2(int l) {
    const Frame F = mkframe(); KArgs a = kargs(); unsigned char* ws = a->ws;
    const float* ybuf = a->out; f16* xb = WSP(f16, WS_XB); int* topi = WSP(int, WS_TOPI); float* topw = WSP(float, WS_TOPW); int* cnt = WSP(int, WS_CNT);
    const float* gp = a->ln1_g + l * D; const float* bp = a->ln1_b + l * D; const float* router = a->router;
    LAS int* lcnt = (LAS int*)(F.lds);
    for (int vw = F.bid; vw < 256; vw += F.G) {
        if (l == 1) { __syncthreads(); if (F.tid < 8) lcnt[F.tid] = 0; __syncthreads(); }
        for (int rr = F.wave; rr < 128; rr += NWAVES) {
            const int m = vw * 128 + rr; const int lane = F.lane;
            const f32x4* yr = (const f32x4*)(ybuf + (size_t)m * D) + lane; f32x4 v[4];
#pragma unroll
            for (int j = 0; j < 4; ++j) v[j] = yr[64 * j];
            float mean, rstd; ln_stats(v, mean, rstd);
            u32x2* o8 = (u32x2*)(xb + (size_t)m * D) + lane;
#pragma unroll
            for (int j = 0; j < 4; ++j) { const f32x4 g = *((const f32x4*)gp + lane + 64 * j), bb = *((const f32x4*)bp + lane + 64 * j); v[j] = (v[j] - mean) * rstd * g + bb;
                u32x2 w; w.x = pk_f16(v[j][0], v[j][1]); w.y = pk_f16(v[j][2], v[j][3]); o8[64 * j] = w; }
            if (l == 1) {
                float lg[8];
#pragma unroll
                for (int e = 0; e < 8; ++e) lg[e] = 0.f;
#pragma unroll
                for (int j = 0; j < 4; ++j)
#pragma unroll
                    for (int e4 = 0; e4 < 4; ++e4) { const int c = 4 * lane + 256 * j + e4; const f32x4 r0 = *(const f32x4*)(router + (size_t)c * 8), r1 = *(const f32x4*)(router + (size_t)c * 8 + 4); const float xv = v[j][e4];
                        lg[0] += xv * r0[0]; lg[1] += xv * r0[1]; lg[2] += xv * r0[2]; lg[3] += xv * r0[3]; lg[4] += xv * r1[0]; lg[5] += xv * r1[1]; lg[6] += xv * r1[2]; lg[7] += xv * r1[3]; }
#pragma unroll
                for (int e = 0; e < 8; ++e) lg[e] = wave_sum(lg[e]);
                if (lane == 0) {
                    int i0 = 0; float v0 = lg[0];
#pragma unroll
                    for (int e = 1; e < 8; ++e) if (lg[e] > v0) { v0 = lg[e]; i0 = e; }
                    int i1 = -1; float v1 = -INFINITY;
#pragma unroll
                    for (int e = 0; e < 8; ++e) if (e != i0 && lg[e] > v1) { v1 = lg[e]; i1 = e; }
                    const float e1 = __expf(v1 - v0), w0 = 1.0f / (1.0f + e1), w1 = e1 * w0;
                    topi[(size_t)m * 2] = i0; topi[(size_t)m * 2 + 1] = i1; topw[(size_t)m * 2] = w0; topw[(size_t)m * 2 + 1] = w1;
                    __hip_atomic_fetch_add(&lcnt[i0], 1, __ATOMIC_RELAXED, __HIP_MEMORY_SCOPE_WORKGROUP); __hip_atomic_fetch_add(&lcnt[i1], 1, __ATOMIC_RELAXED, __HIP_MEMORY_SCOPE_WORKGROUP);
                }
            }
        }
        if (l == 1) { __syncthreads(); if (F.tid < 8) cnt[vw * 8 + F.tid] = lcnt[F.tid]; }
    }
}
__device__ __forceinline__ void ph_E() {
    const Frame F = mkframe(); KArgs a = kargs(); unsigned char* ws = a->ws;
    pg8::Gemm g{WSP(f16, WS_XB), D, WSP(f16, WS_WGU), D, D}; pg8::StaticOrder S; S.init(T / 256, 2 * FF / 256, F.G, F.bid);
    pg8::EpiSwiGLU E{WSP(f16, WS_H), FF, 0};
    pg8::gemm_phase<pg8::EpiSwiGLU, pg8::StaticOrder, true>(F.lds, g, S, E);
}
__device__ __forceinline__ void ph_F() {
    const Frame F = mkframe(); KArgs a = kargs(); unsigned char* ws = a->ws;
    pg8::Gemm g{WSP(f16, WS_H), FF, WSP(f16, WS_WDN), FF, FF}; pg8::StaticOrder S; S.init(T / 256, D / 256, F.G, F.bid);
    pg8::EpiResF32 E{WSP(f16, WS_XB), a->out, D, DN_ALPHA};
    pg8::gemm_phase<pg8::EpiResF32, pg8::StaticOrder, true>(F.lds, g, S, E);
}
__device__ __forceinline__ void ph_F2d() {
    const Frame F = mkframe(); KArgs a = kargs(); unsigned char* ws = a->ws;
    const int gw = F.bid * NWAVES + F.wave, NGW = F.G * NWAVES;
    const float* ybuf = a->out; f16* xb = WSP(f16, WS_XB); const float* gp = a->ln2_g; const float* bp = a->ln2_b;
    for (int m = gw; m < T; m += NGW) {
        const int lane = F.lane; const f32x4* yr = (const f32x4*)(ybuf + (size_t)m * D) + lane; f32x4 v[4];
#pragma unroll
        for (int j = 0; j < 4; ++j) v[j] = yr[64 * j];
        float mean, rstd; ln_stats(v, mean, rstd);
        u32x2* o8 = (u32x2*)(xb + (size_t)m * D) + lane;
#pragma unroll
        for (int j = 0; j < 4; ++j) { const f32x4 g = *((const f32x4*)gp + lane + 64 * j), bb = *((const f32x4*)bp + lane + 64 * j); const f32x4 y = (v[j] - mean) * rstd * g + bb;
            u32x2 w; w.x = pk_f16(y[0], y[1]); w.y = pk_f16(y[2], y[3]); o8[64 * j] = w; }
    }
}
__device__ __forceinline__ void ph_R3() {
    const Frame F = mkframe(); KArgs a = kargs(); unsigned char* ws = a->ws;
    const int* topi = WSP(int, WS_TOPI); const float* topw = WSP(float, WS_TOPW); const int* cnt = WSP(int, WS_CNT); int* rowtok = WSP(int, WS_ROWTOK); float* roww = WSP(float, WS_ROWW); int* pane = WSP(int, WS_PANE);
    LAS int* L = (LAS int*)F.lds;
    for (int vw = F.bid; vw < 256; vw += F.G) {
        __syncthreads();
        if (F.tid < 8) { const int e = F.tid; int tot = 0, mine = 0; for (int w = 0; w < 256; ++w) { const int c = cnt[w * 8 + e]; if (w < vw) mine += c; tot += c; } L[e] = tot; L[16 + e] = mine; }
        __syncthreads();
        if (F.tid == 0) { int b = 0; for (int e = 0; e < 8; ++e) { L[8 + e] = b; b += (L[e] + 255) & ~255; } L[24] = b; }
        __syncthreads();
        if (F.tid < 8) { const int e = F.tid; int p = L[8 + e] + L[16 + e];
            for (int t = 0; t < 128; ++t) { const int tok = vw * 128 + t;
#pragma unroll
                for (int s = 0; s < 2; ++s) if (topi[(size_t)tok * 2 + s] == e) { rowtok[p] = tok * 2 + s; roww[p] = topw[(size_t)tok * 2 + s]; ++p; } } }
        if (vw == 0) {
            for (int e = 0; e < 8; ++e) { const int s0 = L[8 + e] + L[e], s1 = L[8 + e] + ((L[e] + 255) & ~255);
                for (int p = s0 + F.tid; p < s1; p += 512) { rowtok[p] = -1; roww[p] = 0.f; }
                for (int p = (L[8 + e] >> 8) + F.tid; p < (s1 >> 8); p += 512) pane[p] = e; }
            if (F.tid == 0) pane[MOE_MAXP] = L[24] >> 8;
        }
    }
}
__device__ __forceinline__ void ph_M1(int c) {
    const Frame F = mkframe(); KArgs a = kargs(); unsigned char* ws = a->ws;
    const int* pane = WSP(int, WS_PANE);
    const int np = pane[MOE_MAXP]; int nm = np - c * MOE_CHUNK; nm = nm < 0 ? 0 : (nm > MOE_CHUNK ? MOE_CHUNK : nm);
    pg8::Gemm g{WSP(f16, WS_XB), D, WSP(f16, WS_EGU), D, D}; pg8::MoeGather S; S.so.init(nm, 2 * FE / 256, F.G, F.bid, c * MOE_CHUNK); S.rowtok = WSP(int, WS_ROWTOK); S.pane = pane; S.estride = (size_t)2 * FE * D * 2;
    pg8::EpiSwiGLU E{(f16*)a->out, FE, c * MOE_CHUNK};
    pg8::gemm_phase<pg8::EpiSwiGLU, pg8::MoeGather, true>(F.lds, g, S, E);
}
__device__ __forceinline__ void ph_M2(int c) {
    const Frame F = mkframe(); KArgs a = kargs(); unsigned char* ws = a->ws;
    const int* pane = WSP(int, WS_PANE);
    const int np = pane[MOE_MAXP]; int nm = np - c * MOE_CHUNK; nm = nm < 0 ? 0 : (nm > MOE_CHUNK ? MOE_CHUNK : nm);
    pg8::Gemm g{(const f16*)a->out, FE, WSP(f16, WS_EDN), FE, FE}; pg8::MoeDense S; S.so.init(nm, D / 256, F.G, F.bid, c * MOE_CHUNK); S.pane = pane; S.estride = (size_t)D * FE * 2; S.arow0 = c * MOE_CHUNK;
    pg8::EpiScatter E{WSP(f16, WS_H), (size_t)T * D, WSP(int, WS_ROWTOK), WSP(float, WS_ROWW)};
    pg8::gemm_phase<pg8::EpiScatter, pg8::MoeDense, true>(F.lds, g, S, E);
}
__device__ __forceinline__ void ph_F2m() {
    const Frame F = mkframe(); KArgs a = kargs(); unsigned char* ws = a->ws;
    const int gw = F.bid * NWAVES + F.wave, NGW = F.G * NWAVES;
    const f16* xb = WSP(f16, WS_XB); const f16* c0buf = WSP(f16, WS_H); const f16* c1buf = c0buf + (size_t)T * D; float* out = a->out; const float* gp = a->ln2_g + D; const float* bp = a->ln2_b + D;
    for (int m = gw; m < T; m += NGW) {
        const int lane = F.lane; f32x4 v[4];
        const f16x4* xr = (const f16x4*)(xb + (size_t)m * D) + lane; const f16x4* c0r = (const f16x4*)(c0buf + (size_t)m * D) + lane; const f16x4* c1r = (const f16x4*)(c1buf + (size_t)m * D) + lane;
#pragma unroll
        for (int j = 0; j < 4; ++j) { const f16x4 xv = xr[64 * j], p0 = c0r[64 * j], p1 = c1r[64 * j];
#pragma unroll
            for (int e = 0; e < 4; ++e) v[j][e] = DN_ALPHA * (float)xv[e] + ((float)p0[e] + (float)p1[e]); }
        float mean, rstd; ln_stats(v, mean, rstd);
        f32x4* orow = (f32x4*)(out + (size_t)m * D) + lane;
#pragma unroll
        for (int j = 0; j < 4; ++j) { const f32x4 g = *((const f32x4*)gp + lane + 64 * j), bb = *((const f32x4*)bp + lane + 64 * j); orow[64 * j] = (v[j] - mean) * rstd * g + bb; }
    }
}

#ifndef SITE_MASK
#define SITE_MASK 0xFFFFFFFFu
#endif
#define SITE(n) (((SITE_MASK) >> (n)) & 1u)
__global__ void __launch_bounds__(NWAVES * 64, 2) mega_fwd(Args args_unused) {
    extern __shared__ __attribute__((aligned(16))) unsigned char lds_raw[];
    volatile LAS unsigned* MISC = (volatile LAS unsigned*)((LAS unsigned char*)lds_raw + MISC_OFF);
    if (threadIdx.x < 64) MISC[threadIdx.x] = 0u;
    __syncthreads();
#if MK_ONE_LAUNCH
    (void)xcd_barrier_post((unsigned*)(kargs()->ws + WS_CTL) + CW_BAR, MISC + 8);
#define GRID_BAR() do { XcdBarrier bar_; bar_.bar = (unsigned*)(kargs()->ws + WS_CTL) + CW_BAR; bar_.x = xb_xcc_id(); bar_.st = (volatile LAS unsigned*)((LAS unsigned char*)lds_raw + MISC_OFF) + 8; xcd_barrier(bar_); } while (0)
#else
#define GRID_BAR() do {} while (0)
#endif
    const int lo = kargs()->ph_lo, hi = kargs()->ph_hi;
#define IN(k) (lo <= (k) && (k) < hi)
#define SEAM(k) do { if (IN(k) && IN((k) + 1)) GRID_BAR(); } while (0)
    if (SITE(0) && IN(0)) ph_prologue();
    SEAM(0);
#pragma unroll
    for (int l = 0; l < 2; ++l) {
        const int pb = l == 0 ? PH_L0 : PH_L1;
        if (SITE(1) && IN(pb + 0)) ph_A(l);
        SEAM(pb + 0);
        if (SITE(3) && IN(pb + 1)) ph_B(l);
        SEAM(pb + 1);
        if (SITE(5) && IN(pb + 2)) ph_C(l);
        SEAM(pb + 2);
        if (SITE(6) && IN(pb + 3)) ph_C2();
        SEAM(pb + 3);
        if (SITE(7) && IN(pb + 4)) ph_D(l);
        SEAM(pb + 4);
        if (SITE(8) && IN(pb + 5)) ph_D2(l);
        SEAM(pb + 5);
        if (l == 0) {
            if (SITE(9) && IN(pb + 6)) ph_E();
            SEAM(pb + 6);
            if (SITE(10) && IN(pb + 7)) ph_F();
            SEAM(pb + 7);
            if (SITE(11) && IN(pb + 8)) ph_F2d();
            SEAM(pb + 8);
        } else {
            if (SITE(12) && IN(pb + 6)) ph_R3();
            SEAM(pb + 6);
            for (int c = 0; c < MOE_NCHUNK; ++c) {
                if (SITE(13) && IN(pb + 7 + 2 * c)) ph_M1(c);
                SEAM(pb + 7 + 2 * c);
                if (SITE(14) && IN(pb + 8 + 2 * c)) ph_M2(c);
                SEAM(pb + 8 + 2 * c);
            }
            if (SITE(15) && IN(pb + 17)) ph_F2m();
        }
    }
#undef IN
#undef SEAM
}

extern "C" void kernel_launch(void* const* d_in, const int* in_sizes, int n_in, void* d_out, int out_size, void* d_ws, size_t ws_size, hipStream_t stream) {
    static int grid = 0;
    if (grid == 0) {
        if (n_in != 22 || in_sizes[0] != T * D || out_size != T * D || ws_size < WS_END) { fprintf(stderr, "kernel_launch: unexpected shapes / workspace (n_in %d, ws %zu)\n", n_in, ws_size); grid = -1; return; }
        int dev = 0, cus = 0;
        if (hipGetDevice(&dev) != hipSuccess || hipDeviceGetAttribute(&cus, hipDeviceAttributeMultiprocessorCount, dev) != hipSuccess) { grid = -1; return; }
        if (hipFuncSetAttribute((const void*)mega_fwd, hipFuncAttributeMaxDynamicSharedMemorySize, LDS_BYTES) != hipSuccess) { fprintf(stderr, "kernel_launch: hipFuncSetAttribute failed\n"); grid = -1; return; }
        int per_cu = 0;
        if (hipOccupancyMaxActiveBlocksPerMultiprocessor(&per_cu, (const void*)mega_fwd, NWAVES * 64, LDS_BYTES) != hipSuccess || per_cu < 1) { fprintf(stderr, "kernel_launch: occupancy query says %d\n", per_cu); }
        (void)hipGetLastError();
        grid = cus > 256 ? 256 : cus;
    }
    if (grid < 0) return;
    (void)hipMemsetAsync((char*)d_ws + WS_CTL, 0, CTL_ZERO_BYTES, stream);
    Args a{};
    a.x = (const float*)d_in[0]; a.ln_emb_g = (const float*)d_in[1]; a.ln_emb_b = (const float*)d_in[2]; a.w_in = (const float*)d_in[3]; a.q_norm_g = (const float*)d_in[4]; a.kv_norm_g = (const float*)d_in[5];
    a.w_uq = (const float*)d_in[6]; a.w_ukv = (const float*)d_in[7]; a.beta_mla = (const float*)d_in[8]; a.beta_moba = (const float*)d_in[9]; a.w_o = (const float*)d_in[10]; a.ln1_g = (const float*)d_in[11]; a.ln1_b = (const float*)d_in[12];
    a.ffn_w_gate = (const float*)d_in[13]; a.ffn_w_up = (const float*)d_in[14]; a.ffn_w_down = (const float*)d_in[15]; a.router = (const float*)d_in[16]; a.exp_w_gate = (const float*)d_in[17]; a.exp_w_up = (const float*)d_in[18];
    a.exp_w_down = (const float*)d_in[19]; a.ln2_g = (const float*)d_in[20]; a.ln2_b = (const float*)d_in[21];
    a.out = (float*)d_out; a.ws = (unsigned char*)d_ws;
#if MK_ONE_LAUNCH
    a.ph_lo = 0; a.ph_hi = NPHASE;
    hipLaunchKernelGGL(mega_fwd, dim3(grid), dim3(NWAVES * 64), LDS_BYTES, stream, a);
#else
    for (int p = 0; p < NPHASE; ++p) { a.ph_lo = p; a.ph_hi = p + 1; hipLaunchKernelGGL(mega_fwd, dim3(grid), dim3(NWAVES * 64), LDS_BYTES, stream, a); }
#endif
}
```

```cpp
#include <hip/hip_runtime.h>
#include <cstdio>
#include <cstdint>
#include <cmath>

#ifndef MK_ONE_LAUNCH
#define MK_ONE_LAUNCH 1
#endif

#define LAS __attribute__((address_space(3)))
#define GAS __attribute__((address_space(1)))
typedef _Float16 f16;
typedef _Float16 f16x2 __attribute__((ext_vector_type(2)));
typedef _Float16 f16x4 __attribute__((ext_vector_type(4)));
typedef _Float16 f16x8 __attribute__((ext_vector_type(8)));
typedef float f32x2 __attribute__((ext_vector_type(2)));
typedef float f32x4 __attribute__((ext_vector_type(4)));
typedef unsigned u32x2 __attribute__((ext_vector_type(2)));
typedef unsigned u32x4 __attribute__((ext_vector_type(4)));
typedef GAS unsigned gu32;
typedef int i32x4 __attribute__((ext_vector_type(4)));
typedef int i32x8 __attribute__((ext_vector_type(8)));

constexpr int BATCH = 16, SEQ = 2048, T = BATCH * SEQ, D = 1024;
constexpr int HW = 2816;
constexpr int HC_CQ = 0, HC_CKV = 256, HC_KR = 384, HC_RQ = 416, HC_RK = 736, HC_RV = 1056, HC_RG = 1376, HC_MQ = 1696, HC_MK = 2016, HC_MV = 2336, HC_END = 2656;
constexpr int QW = 768, KVW = 768;
constexpr int OC_RET = 384, OC_MOBA = 704;
constexpr int FF = 2816, FE = 3584, NE = 8;
constexpr float LN_EPS = 1e-5f, RMS_EPS = 1e-6f;
constexpr float DN_ALPHA = 1.41421356237f;
constexpr float LOG2E = 1.4426950408889634f;
constexpr float F8_XS = 8.0f, F8_HS = 16.0f, F8_WS = 256.0f; constexpr int F8_XE = 127 - 3, F8_HE = 127 - 4, F8_WE = 127 - 8;
constexpr int MOE_MAXP = 264;

constexpr size_t MiB = 1u << 20;
constexpr size_t WS_CTL = 0, CTL_ZERO_BYTES = 256 * 1024;
constexpr size_t WS_ROPE = 256 * 1024;
constexpr size_t WS_SSQ_Q = 1 * MiB;
constexpr size_t WS_SSQ_O = 2 * MiB;
constexpr size_t WS_KMEAN = 4 * MiB;
constexpr size_t WS_SSQ_KV = 18 * MiB + 512 * 1024;
constexpr size_t WS_TOPI = WS_KMEAN + 512 * 1024;
constexpr size_t WS_TOPW = WS_TOPI + (size_t)T * 8;
constexpr size_t WS_CNT = WS_TOPW + (size_t)T * 8;
constexpr size_t WS_ROWTOK = WS_CNT + 8192;
constexpr size_t WS_ROWW = WS_ROWTOK + (size_t)MOE_MAXP * 256 * 4;
constexpr size_t WS_PANE = WS_ROWW + (size_t)MOE_MAXP * 256 * 4;
constexpr size_t WS_WIN = 6 * MiB;
constexpr size_t WS_WUQ = 17 * MiB;
constexpr size_t WS_WO = 19 * MiB;
constexpr size_t WS_WGU = 23 * MiB;
constexpr size_t WS_WDN = 29 * MiB;
constexpr size_t WS_EGU = 32 * MiB;
constexpr size_t WS_EDN = 88 * MiB;
constexpr size_t WS_XB = 116 * MiB;
constexpr size_t WS_XQ = 180 * MiB;
constexpr size_t WS_H = 212 * MiB;
constexpr size_t WS_O = 388 * MiB;
constexpr size_t WS_C = 324 * MiB;
constexpr size_t WS_END = 452 * MiB;
constexpr int MOE_SPLIT = 146;
static_assert((size_t)MOE_SPLIT * 256 * FE <= 128 * MiB && WS_H + (size_t)(MOE_MAXP - MOE_SPLIT) * 256 * FE <= WS_C && WS_C + (size_t)2 * T * D * 2 <= WS_END, "MoE buffers");

constexpr int CW_TMO = 0, CW_BAR = 1024;

constexpr int RING_BYTES = 131072;
constexpr int MISC_OFF = RING_BYTES;
constexpr int LDS_BYTES = 147456;

__device__ __forceinline__ unsigned pk_f16(float lo, float hi) { f16x2 v = {(f16)lo, (f16)hi}; return __builtin_bit_cast(unsigned, v); }
template <int X> __device__ __forceinline__ float swz_xor(float v) { return __int_as_float(__builtin_amdgcn_ds_swizzle(__float_as_int(v), (X << 10) | 0x1f)); }
__device__ __forceinline__ float wave_sum(float v) {
    v += swz_xor<1>(v); v += swz_xor<2>(v); v += swz_xor<4>(v); v += swz_xor<8>(v); v += swz_xor<16>(v);
    const auto rr = __builtin_amdgcn_permlane32_swap(__float_as_uint(v), __float_as_uint(v), false, false);
    return __uint_as_float(rr[0]) + __uint_as_float(rr[1]);
}
__device__ __forceinline__ float clamp8(float x) { return fminf(fmaxf(x, -448.0f), 448.0f); }
__device__ __forceinline__ unsigned pk_fp8x4(float a, float b, float c, float d) { int w = 0; w = __builtin_amdgcn_cvt_pk_fp8_f32(clamp8(a), clamp8(b), w, false); w = __builtin_amdgcn_cvt_pk_fp8_f32(clamp8(c), clamp8(d), w, true); return (unsigned)w; }
__device__ __forceinline__ float silu_f(float x) { return x * __builtin_amdgcn_rcpf(1.f + __expf(-x)); }

#define XB_TMO      128
#define XB_XCNT(j)  (256  + 64 * (j))
#define XB_XSUB(j)  (1280 + 64 * (j))
#define XB_XGEN(j)  (2304 + 64 * (j))
#define XB_TOP      3328
#define XB_TOPGEN   3392
#define XCD_BAR_WORDS 3456
#define XB_SPIN_CAP (1u << 18)
__device__ __forceinline__ unsigned xb_ld(unsigned* p)              { return __hip_atomic_load(p, __ATOMIC_RELAXED, __HIP_MEMORY_SCOPE_AGENT); }
__device__ __forceinline__ unsigned xb_add(unsigned* p, unsigned v) { return __hip_atomic_fetch_add(p, v, __ATOMIC_RELAXED, __HIP_MEMORY_SCOPE_AGENT); }
__device__ __forceinline__ unsigned xb_xcc_id() { return (unsigned)__builtin_amdgcn_s_getreg((3 << 11) | 20) & 0xFu; }
#define XB_SPIN(cond, bar) do { unsigned _sp = 0; while (cond) { __builtin_amdgcn_s_sleep(1); \
    if ((++_sp & 255u) == 0u) { if (xb_ld(&(bar)[XB_TMO])) break; if (_sp > XB_SPIN_CAP) { atomicAdd(&(bar)[XB_TMO], 1u); break; } } } } while (0)
struct XcdBarrier { unsigned* bar; unsigned x; volatile LAS unsigned* st; };
__device__ __forceinline__ XcdBarrier xcd_barrier_post(unsigned* bar, volatile LAS unsigned* st) {
    XcdBarrier b; b.bar = bar; b.x = xb_xcc_id(); b.st = st;
    if (threadIdx.x == 0) (void)xb_add(&bar[XB_XCNT(b.x)], 1u);
    return b;
}
__device__ __forceinline__ void xcd_barrier_complete(unsigned* bar, unsigned x, unsigned& nloc, unsigned& nx) {
    const unsigned G = gridDim.x * gridDim.y * gridDim.z;
    unsigned sum, cnt, mine, sp = 0u;
    for (;;) {
        sum = 0u; cnt = 0u; mine = 0u;
#pragma unroll
        for (unsigned j = 0; j < 16; ++j) { const unsigned c = xb_ld(&bar[XB_XCNT(j)]); sum += c; cnt += (c > 0u) ? 1u : 0u; mine = (j == x) ? c : mine; }
        if (sum == G) break;
        __builtin_amdgcn_s_sleep(1);
        if ((++sp & 255u) == 0u) { if (xb_ld(&bar[XB_TMO])) break; if (sp > XB_SPIN_CAP) { atomicAdd(&bar[XB_TMO], 1u); break; } }
    }
    nloc = mine > 0u ? mine : 1u; nx = cnt > 0u ? cnt : 1u;
}
__device__ __forceinline__ void xcd_barrier(const XcdBarrier& b) {
    asm volatile("s_waitcnt vmcnt(0)" ::: "memory");
    __syncthreads();
    if (threadIdx.x == 0) {
        unsigned* bar = b.bar;
        __builtin_amdgcn_s_waitcnt(0);
        unsigned nloc = b.st[0], nx = b.st[1];
        if (nloc == 0u) { xcd_barrier_complete(bar, b.x, nloc, nx); b.st[0] = nloc; b.st[1] = nx; }
        const unsigned old = xb_add(&bar[XB_XSUB(b.x)], 1u);
        const unsigned gen = old / nloc;
        if (old + 1u == (gen + 1u) * nloc) {
            __builtin_amdgcn_fence(__ATOMIC_RELEASE, "agent");
            asm volatile("s_waitcnt vmcnt(0)" ::: "memory");
            const unsigned og = xb_add(&bar[XB_TOP], 1u);
            const unsigned tg = og / nx;
            if (og + 1u == (tg + 1u) * nx) xb_add(&bar[XB_TOPGEN], 1u);
            else XB_SPIN(xb_ld(&bar[XB_TOPGEN]) == tg, bar);
            __builtin_amdgcn_fence(__ATOMIC_ACQUIRE, "agent");
            xb_add(&bar[XB_XGEN(b.x)], 1u);
            asm volatile("s_waitcnt vmcnt(0)" ::: "memory");
        } else {
            XB_SPIN(xb_ld(&bar[XB_XGEN(b.x)]) == gen, bar);
            __builtin_amdgcn_fence(__ATOMIC_ACQUIRE, "agent");
            asm volatile("s_waitcnt vmcnt(0)" ::: "memory");
        }
    }
    __syncthreads();
}

namespace pg8 {
constexpr int BM = 256, BK = 64, HALF = 128, HTB = HALF * BK * 2, STAGE_BYTES = 8 * HTB, NXCD = 8, WGM = 8;
__host__ __device__ __forceinline__ int lds_byte(int r, int c) { const int st = (r >> 4) * 2 + (c >> 5), rr = r & 15, cc = c & 31, ob = rr * 64 + cc * 2; return st * 1024 + (ob ^ (((ob >> 9) & 1) << 5)); }
__host__ __device__ __forceinline__ void stage_rc(int b, int& R, int& C) { const int st = b / 1024, sb = b % 1024, swz = sb ^ (((sb >> 9) & 1) << 5); R = (st >> 1) * 16 + swz / 64; C = (st & 1) * 32 + (swz % 64) / 2; }
__host__ __device__ __forceinline__ int perm32(int rho) { const int n = rho >> 4, i = rho & 15; return 8 * (i >> 2) + 4 * n + (i & 3); }

struct Unit { int pm, pn; };
struct Gemm { const void* A; int lda; const void* Bt; int ldb; int K; int sa, sb; };

struct StaticOrder {
    static constexpr bool GATHER = false;
    int nM, nN, nwg, G, c, pm0;
    __device__ void init(int nM_, int nN_, int G_, int c_, int pm0_ = 0) { nM = nM_; nN = nN_; nwg = nM * nN; G = G_; c = c_; pm0 = pm0_; }
    __device__ bool next(int i, Unit& u) const {
        const long L = (long)i * G + c; if (L >= nwg) return false;
        int wgid = (int)L; { const int q = nwg / NXCD, r = nwg % NXCD, xcd = wgid % NXCD, off = wgid / NXCD; wgid = (xcd < r ? xcd * (q + 1) : r * (q + 1) + (xcd - r) * q) + off; }
        const int nig = WGM * nN, gid = wgid / nig, fm = gid * WGM, gsz = (nM - fm) < WGM ? (nM - fm) : WGM;
        u.pm = pm0 + fm + ((wgid % nig) % gsz); u.pn = (wgid % nig) / gsz; return true;
    }
    __device__ __forceinline__ int a_row(const Unit& u, int r) const { return u.pm * BM + r; }
    __device__ __forceinline__ size_t b_base(const Unit&) const { return 0; }
    __device__ __forceinline__ const char* a_tile(const Unit& u, const char* A, size_t rowb) const { return A + (size_t)u.pm * BM * rowb; }
};
struct UpOrder {
    static constexpr bool GATHER = false;
    StaticOrder so;
    __device__ bool next(int i, Unit& u) const { return so.next(i, u); }
    __device__ __forceinline__ int a_row(const Unit& u, int r) const { return u.pm * BM + r; }
    __device__ __forceinline__ size_t b_base(const Unit&) const { return 0; }
    __device__ __forceinline__ const char* a_tile(const Unit& u, const char* A, size_t rowb) const { return A + (size_t)u.pm * BM * rowb + (u.pn >= 3 ? (size_t)(HC_CKV * 2) : (size_t)0); }
};
struct MoeGather {
    static constexpr bool GATHER = true;
    StaticOrder so; const int* rowtok; const int* pane; size_t estride;
    __device__ bool next(int i, Unit& u) const { return so.next(i, u); }
    __device__ __forceinline__ int a_row(const Unit& u, int r) const { const int t = rowtok[u.pm * BM + r]; return t < 0 ? 0 : (t >> 1); }
    __device__ __forceinline__ size_t b_base(const Unit& u) const { return (size_t)pane[u.pm] * estride; }
    __device__ __forceinline__ const char* a_tile(const Unit&, const char* A, size_t) const { return A; }
};
struct MoeDense {
    static constexpr bool GATHER = false;
    StaticOrder so; const int* pane; size_t estride; const char* A2; int split;
    __device__ bool next(int i, Unit& u) const { return so.next(i, u); }
    __device__ __forceinline__ int a_row(const Unit& u, int r) const { return u.pm * BM + r; }
    __device__ __forceinline__ size_t b_base(const Unit& u) const { return (size_t)pane[u.pm] * estride; }
    __device__ __forceinline__ const char* a_tile(const Unit& u, const char* A, size_t rowb) const { return u.pm < split ? A + (size_t)u.pm * BM * rowb : A2 + (size_t)(u.pm - split) * BM * rowb; }
};

struct EpiF16 {
    static constexpr bool PERM = true;
    f16* O; int ldc;
    __device__ __forceinline__ void operator()(const f32x4 (&acc)[2][2][4][2], const Unit& u, int wr, int wc, int fr, int fq) const {
        const int row0 = u.pm * BM + wr * 64 + fr, col0 = u.pn * BM + wc * 32 + 8 * fq;
#pragma unroll
        for (int ai = 0; ai < 2; ++ai)
#pragma unroll
            for (int m = 0; m < 4; ++m) { f16* rowp = O + (size_t)(row0 + ai * HALF + m * 16) * ldc + col0;
#pragma unroll
                for (int bj = 0; bj < 2; ++bj) { const f32x4 v0 = acc[ai][bj][m][0], v1 = acc[ai][bj][m][1];
                    u32x4 w; w.x = pk_f16(v0[0], v0[1]); w.y = pk_f16(v0[2], v0[3]); w.z = pk_f16(v1[0], v1[1]); w.w = pk_f16(v1[2], v1[3]);
                    *(u32x4*)(rowp + bj * HALF) = w; } }
    }
};
__device__ __forceinline__ void rope8(float (&v)[8], const float* cs, const float* sn, int fq, float scale) {
    const f32x4 c0 = *(const f32x4*)cs, c1 = *(const f32x4*)(cs + 4), s0 = *(const f32x4*)sn, s1 = *(const f32x4*)(sn + 4);
    const float sg = fq < 2 ? -scale : scale;
#pragma unroll
    for (int e = 0; e < 8; ++e) { const auto rr = __builtin_amdgcn_permlane32_swap(__float_as_uint(v[e]), __float_as_uint(v[e]), false, false);
        const float other = fq < 2 ? __uint_as_float(rr[1]) : __uint_as_float(rr[0]);
        const float c = e < 4 ? c0[e & 3] : c1[e & 3], sn_ = e < 4 ? s0[e & 3] : s1[e & 3];
        v[e] = v[e] * (c * scale) + other * (sn_ * sg); }
}
__device__ __forceinline__ float sum_fq(float s) { s += swz_xor<16>(s); const auto rr = __builtin_amdgcn_permlane32_swap(__float_as_uint(s), __float_as_uint(s), false, false); return __uint_as_float(rr[0]) + __uint_as_float(rr[1]); }
struct EpiWin {
    static constexpr bool PERM = true;
    f16* H; float* ssq_q; float* ssq_kv; float* kpart; const float* cosA; const float* sinA; const float* cosB; const float* sinB;
    __device__ __forceinline__ void operator()(const f32x4 (&acc)[2][2][4][2], const Unit& u, int wr, int wc, int fr, int fq) const {
        const int row0 = u.pm * BM + wr * 64 + fr;
#pragma unroll
        for (int bj = 0; bj < 2; ++bj) {
            const int cg = u.pn * 8 + bj * 4 + wc;
            if (cg >= 83) continue;
            const int col0 = cg * 32 + 8 * fq;
            float ksum[8];
#pragma unroll
            for (int e = 0; e < 8; ++e) ksum[e] = 0.f;
#pragma unroll
            for (int ai = 0; ai < 2; ++ai)
#pragma unroll
                for (int m = 0; m < 4; ++m) {
                    const int row = row0 + ai * HALF + m * 16; const int pos = row & (SEQ - 1);
                    float v[8];
#pragma unroll
                    for (int e = 0; e < 4; ++e) { v[e] = acc[ai][bj][m][0][e]; v[4 + e] = acc[ai][bj][m][1][e]; }
                    if (cg < 12) {
                        float ss = 0.f;
#pragma unroll
                        for (int e = 0; e < 8; ++e) ss += v[e] * v[e];
                        ss = sum_fq(ss);
                        if (fq == 0) { if (cg < 8) ssq_q[(size_t)row * 8 + cg] = ss; else ssq_kv[(size_t)row * 4 + (cg - 8)] = ss; }
                    } else if (cg == 12) rope8(v, cosA + pos * 16 + 8 * (fq & 1), sinA + pos * 16 + 8 * (fq & 1), fq, 1.0f);
                    else if (cg < 23) rope8(v, cosB + pos * 32 + 16 * ((cg - 13) & 1) + 8 * (fq & 1), sinB + pos * 32 + 16 * ((cg - 13) & 1) + 8 * (fq & 1), fq, 1.0f);
                    else if (cg < 33) rope8(v, cosB + pos * 32 + 16 * ((cg - 23) & 1) + 8 * (fq & 1), sinB + pos * 32 + 16 * ((cg - 23) & 1) + 8 * (fq & 1), fq, 0.125f);
                    else if (cg >= 53 && cg < 63) {
#pragma unroll
                        for (int e = 0; e < 8; ++e) v[e] *= 0.125f * LOG2E; }
                    else if (cg >= 63 && cg < 73) {
#pragma unroll
                        for (int e = 0; e < 8; ++e) ksum[e] += v[e]; }
                    u32x4 w; w.x = pk_f16(v[0], v[1]); w.y = pk_f16(v[2], v[3]); w.z = pk_f16(v[4], v[5]); w.w = pk_f16(v[6], v[7]);
                    *(u32x4*)(H + (size_t)row * HW + col0) = w;
                }
            if (cg >= 63 && cg < 73) {
#pragma unroll
                for (int e = 0; e < 8; ++e) { float x = ksum[e]; x += swz_xor<1>(x); x += swz_xor<2>(x); x += swz_xor<4>(x); x += swz_xor<8>(x); ksum[e] = x; }
                if (fr == 0) { float* kp = kpart + ((size_t)u.pm * 2 + wr) * 320 + (cg - 63) * 32 + 8 * fq;
                    *(f32x4*)kp = (f32x4){ksum[0], ksum[1], ksum[2], ksum[3]}; *(f32x4*)(kp + 4) = (f32x4){ksum[4], ksum[5], ksum[6], ksum[7]}; }
            }
        }
    }
};
struct EpiUp {
    static constexpr bool PERM = true;
    f16* Oq; f16* Okv; const float* ssq_q; const float* ssq_kv; const float* cosA; const float* sinA;
    __device__ __forceinline__ void operator()(const f32x4 (&acc)[2][2][4][2], const Unit& u, int wr, int wc, int fr, int fq) const {
        const int row0 = u.pm * BM + wr * 64 + fr; const bool isq = u.pn < 3; const int pn = isq ? u.pn : u.pn - 3;
        f16* O = isq ? Oq : Okv; const int cg_end = isq ? 18 : 24;
#pragma unroll
        for (int ai = 0; ai < 2; ++ai)
#pragma unroll
            for (int m = 0; m < 4; ++m) {
                const int row = row0 + ai * HALF + m * 16; const int pos = row & (SEQ - 1);
                float rs;
                if (isq) { const f32x4 a = *(const f32x4*)(ssq_q + (size_t)row * 8), b = *(const f32x4*)(ssq_q + (size_t)row * 8 + 4); rs = (0.10206207261596575f * LOG2E) / sqrtf(((a[0] + a[1]) + (a[2] + a[3]) + (b[0] + b[1]) + (b[2] + b[3])) * (1.f / 256.f) + RMS_EPS); }
                else { const f32x4 a = *(const f32x4*)(ssq_kv + (size_t)row * 4); rs = 1.0f / sqrtf(((a[0] + a[1]) + (a[2] + a[3])) * (1.f / 128.f) + RMS_EPS); }
#pragma unroll
                for (int bj = 0; bj < 2; ++bj) {
                    const int cg = pn * 8 + bj * 4 + wc; if (cg >= cg_end) continue;
                    float v[8];
#pragma unroll
                    for (int e = 0; e < 4; ++e) { v[e] = acc[ai][bj][m][0][e] * rs; v[4 + e] = acc[ai][bj][m][1][e] * rs; }
                    if (isq && cg >= 12) rope8(v, cosA + pos * 16 + 8 * (fq & 1), sinA + pos * 16 + 8 * (fq & 1), fq, 1.0f);
                    u32x4 w; w.x = pk_f16(v[0], v[1]); w.y = pk_f16(v[2], v[3]); w.z = pk_f16(v[4], v[5]); w.w = pk_f16(v[6], v[7]);
                    *(u32x4*)(O + (size_t)row * QW + cg * 32 + 8 * fq) = w;
                }
            }
    }
};
struct EpiResF32 {
    static constexpr bool PERM = false;
    const f16* X; float* Y; int ldc; float alpha; float ascale;
    __device__ __forceinline__ void operator()(const f32x4 (&acc)[2][2][4][2], const Unit& u, int wr, int wc, int fr, int fq) const {
        const int row0 = u.pm * BM + wr * 64 + fr, col0 = u.pn * BM + wc * 32 + 4 * fq;
#pragma unroll
        for (int ai = 0; ai < 2; ++ai)
#pragma unroll
            for (int m = 0; m < 4; ++m) { const size_t off = (size_t)(row0 + ai * HALF + m * 16) * ldc + col0;
#pragma unroll
                for (int bj = 0; bj < 2; ++bj)
#pragma unroll
                    for (int n = 0; n < 2; ++n) { const f16x4 xv = *(const f16x4*)(X + off + bj * HALF + n * 16); const f32x4 a = acc[ai][bj][m][n] * ascale;
                        f32x4 o; o[0] = alpha * (float)xv[0] + a[0]; o[1] = alpha * (float)xv[1] + a[1]; o[2] = alpha * (float)xv[2] + a[2]; o[3] = alpha * (float)xv[3] + a[3];
                        *(f32x4*)(Y + off + bj * HALF + n * 16) = o; } }
    }
};
struct EpiSwiGLU {
    static constexpr bool PERM = true;
    unsigned char* O; unsigned char* O2; int split; int ldc; float ascale;
    __device__ __forceinline__ void operator()(const f32x4 (&acc)[2][2][4][2], const Unit& u, int wr, int wc, int fr, int fq) const {
        unsigned char* base = u.pm < split ? O + (size_t)u.pm * BM * ldc : O2 + (size_t)(u.pm - split) * BM * ldc;
        const int row0 = wr * 64 + fr, col0 = u.pn * HALF + wc * 32 + 8 * fq;
#pragma unroll
        for (int ai = 0; ai < 2; ++ai)
#pragma unroll
            for (int m = 0; m < 4; ++m) { unsigned char* rowp = base + (size_t)(row0 + ai * HALF + m * 16) * ldc + col0;
                float r[8];
#pragma unroll
                for (int n = 0; n < 2; ++n)
#pragma unroll
                    for (int e = 0; e < 4; ++e) r[n * 4 + e] = silu_f(acc[ai][0][m][n][e] * ascale) * (acc[ai][1][m][n][e] * (ascale * F8_HS));
                u32x2 w; w.x = pk_fp8x4(r[0], r[1], r[2], r[3]); w.y = pk_fp8x4(r[4], r[5], r[6], r[7]);
                *(u32x2*)rowp = w; }
    }
};
struct EpiScatter {
    static constexpr bool PERM = true;
    f16* C0; size_t slot_stride; const int* rowtok; const float* roww; float ascale;
    __device__ __forceinline__ void operator()(const f32x4 (&acc)[2][2][4][2], const Unit& u, int wr, int wc, int fr, int fq) const {
        const int row0 = u.pm * BM + wr * 64 + fr, col0 = u.pn * BM + wc * 32 + 8 * fq;
#pragma unroll
        for (int ai = 0; ai < 2; ++ai)
#pragma unroll
            for (int m = 0; m < 4; ++m) { const int prow = row0 + ai * HALF + m * 16; const int ts = rowtok[prow]; const float w = roww[prow] * ascale;
                if (ts >= 0) { f16* rowp = C0 + (size_t)(ts & 1) * slot_stride + (size_t)(ts >> 1) * D + col0;
#pragma unroll
                    for (int bj = 0; bj < 2; ++bj) { const f32x4 v0 = acc[ai][bj][m][0] * w, v1 = acc[ai][bj][m][1] * w;
                        u32x4 o; o.x = pk_f16(v0[0], v0[1]); o.y = pk_f16(v0[2], v0[3]); o.z = pk_f16(v1[0], v1[1]); o.w = pk_f16(v1[2], v1[3]);
                        *(u32x4*)(rowp + bj * HALF) = o; } } }
    }
};

__device__ __forceinline__ const char* sgpr_ptr(const char* p) { const unsigned long long v = (unsigned long long)p; const unsigned lo = __builtin_amdgcn_readfirstlane((unsigned)v), hi = __builtin_amdgcn_readfirstlane((unsigned)(v >> 32)); return (const char*)(((unsigned long long)hi << 32) | lo); }
template <class Sched>
__device__ __forceinline__ void a_offsets(const Sched& S, const Unit& u, int rowb, int tid, unsigned (&ao)[2][2]) {
#pragma unroll
    for (int h = 0; h < 2; ++h)
#pragma unroll
        for (int i = 0; i < 2; ++i) { int R, C; stage_rc(tid * 16 + i * 8192, R, C); ao[h][i] = (unsigned)S.a_row(u, h * HALF + R) * (unsigned)rowb + (unsigned)C * 2u; }
}

template <class Epi, class Sched, bool ALIGN_EPI, bool F8 = false>
__device__ __forceinline__ void gemm_phase(LAS unsigned char* lds, const Gemm g, const Sched& S, const Epi& E) {
    constexpr bool GATHER = Sched::GATHER; constexpr int ESZ = F8 ? 1 : 2;
    int tid_ = threadIdx.x; asm volatile("" : "+v"(tid_));
    const int tid = tid_, wid = __builtin_amdgcn_readfirstlane(tid >> 6), lane = tid & 63, wr = wid >> 2, wc = wid & 3, fr = lane & 15, fq = lane >> 4;
    const int nt = g.K * ESZ / (BK * 2); const int rowA = g.lda * ESZ, rowB = g.ldb * ESZ;
    unsigned voffB[2], voffA[2];
#pragma unroll
    for (int i = 0; i < 2; ++i) { int R, C; stage_rc(tid * 16 + i * 8192, R, C); const int Rb = Epi::PERM ? ((R & ~31) + perm32(R & 31)) : R; voffB[i] = (unsigned)(Rb * rowB + C * 2); voffA[i] = (unsigned)(R * rowA + C * 2); }
    const size_t kstep = (size_t)(BK * 2);
    const size_t hstepB = (size_t)HALF * rowB, tstepB = 2 * hstepB;
    const size_t hstepA = (size_t)HALF * rowA;
    const unsigned ldsw = (unsigned)wid * 1024u;
    const int aoff = lds_byte(wr * 64 + fr, fq * 8), boff = lds_byte(wc * 32 + fr, fq * 8);
#define PG8_SA(b, h) (((b) * 2 + (h)) * HTB)
#define PG8_SB(b, h) ((4 + (b) * 2 + (h)) * HTB)
#define PG8_STAGEB(bufoff, gbase) do { _Pragma("unroll") for (int _i = 0; _i < 2; ++_i) \
        __builtin_amdgcn_global_load_lds((const unsigned*)(sgpr_ptr((const char*)(gbase)) + voffB[_i]), (LAS unsigned*)(lds + (bufoff) + ldsw + _i * 8192), 16, 0, 0); } while (0)
#define PG8_STAGEA(bufoff, ub, kb, h) do { _Pragma("unroll") for (int _i = 0; _i < 2; ++_i) \
        __builtin_amdgcn_global_load_lds((const unsigned*)(sgpr_ptr((ub) + (kb) + (GATHER ? (size_t)0 : (size_t)(h) * hstepA)) + (GATHER ? cao[h][_i] : voffA[_i])), (LAS unsigned*)(lds + (bufoff) + ldsw + _i * 8192), 16, 0, 0); } while (0)
#define PG8_LD16(p) (*(const LAS i32x4*)(p))
#define PG8_LDA(dst, b, h) do { _Pragma("unroll") for (int m = 0; m < 4; ++m) { const LAS unsigned char* p_ = lds + PG8_SA(b, h) + aoff + m * 2048; const i32x4 lo_ = PG8_LD16(p_), hi_ = PG8_LD16(p_ + 1024); dst[m] = __builtin_shufflevector(lo_, hi_, 0, 1, 2, 3, 4, 5, 6, 7); } } while (0)
#define PG8_LDB(dst, b, h) do { _Pragma("unroll") for (int n = 0; n < 2; ++n) { const LAS unsigned char* p_ = lds + PG8_SB(b, h) + boff + n * 2048; const i32x4 lo_ = PG8_LD16(p_), hi_ = PG8_LD16(p_ + 1024); dst[n] = __builtin_shufflevector(lo_, hi_, 0, 1, 2, 3, 4, 5, 6, 7); } } while (0)
#define PG8_HALF(x, k) __builtin_bit_cast(f16x8, __builtin_shufflevector(x, x, 4 * (k), 4 * (k) + 1, 4 * (k) + 2, 4 * (k) + 3))
#define PG8_MMA(ai, bj, At, Bt) do { __builtin_amdgcn_s_setprio(1); _Pragma("unroll") for (int m = 0; m < 4; ++m) _Pragma("unroll") for (int n = 0; n < 2; ++n) { \
        if constexpr (F8) asm volatile("v_mfma_f32_16x16x128_f8f6f4 %0, %1, %2, %0" : "+v"(acc[ai][bj][m][n]) : "v"(Bt[n]), "v"(At[m])); \
        else { acc[ai][bj][m][n] = __builtin_amdgcn_mfma_f32_16x16x32_f16(PG8_HALF(Bt[n], 0), PG8_HALF(At[m], 0), acc[ai][bj][m][n], 0, 0, 0); \
               acc[ai][bj][m][n] = __builtin_amdgcn_mfma_f32_16x16x32_f16(PG8_HALF(Bt[n], 1), PG8_HALF(At[m], 1), acc[ai][bj][m][n], 0, 0, 0); } } __builtin_amdgcn_s_setprio(0); } while (0)
#define PG8_WAIT_V(n) asm volatile("s_waitcnt vmcnt(" #n ")" ::: "memory")
#define PG8_WAIT_L(n) asm volatile("s_waitcnt lgkmcnt(" #n ")" ::: "memory")
#define PG8_BAR __builtin_amdgcn_s_barrier()
#define PG8_SCHED __builtin_amdgcn_sched_barrier(0)
    Unit cur, nxt; int ui = 0;
    if (!S.next(0, cur)) return;
    unsigned cao[2][2];
    if constexpr (GATHER) a_offsets(S, cur, rowA, tid, cao);
    const char* cA = S.a_tile(cur, (const char*)g.A, (size_t)rowA);
    const char* cB = (const char*)g.Bt + S.b_base(cur) + (size_t)cur.pn * tstepB;
    PG8_STAGEB(PG8_SB(0, 0), cB); PG8_STAGEB(PG8_SB(0, 1), cB + hstepB); PG8_STAGEA(PG8_SA(0, 0), cA, 0, 0); PG8_STAGEA(PG8_SA(0, 1), cA, 0, 1);
    if (wr == 1) PG8_BAR;
    PG8_WAIT_V(2); PG8_BAR;
    PG8_STAGEB(PG8_SB(1, 0), cB + kstep); PG8_STAGEA(PG8_SA(1, 0), cA, kstep, 0); PG8_STAGEB(PG8_SB(1, 1), cB + hstepB + kstep);
    PG8_WAIT_V(6); PG8_BAR;
    f32x4 acc[2][2][4][2];
#pragma unroll
    for (int a = 0; a < 2; ++a)
#pragma unroll
        for (int b = 0; b < 2; ++b)
#pragma unroll
            for (int m = 0; m < 4; ++m)
#pragma unroll
                for (int n = 0; n < 2; ++n) acc[a][b][m][n] = (f32x4){0.f, 0.f, 0.f, 0.f};
    i32x8 At[4], B0[2], B1[2];
    for (;;) {
        const bool has_next = S.next(ui + 1, nxt);
        const char* nB = cB; const char* nA = cA;
        if (has_next) { nB = (const char*)g.Bt + S.b_base(nxt) + (size_t)nxt.pn * tstepB; nA = S.a_tile(nxt, (const char*)g.A, (size_t)rowA); }
#pragma unroll 1
        for (int t = 0; t < nt; t += 2) {
            const bool last = (t == nt - 2);
            const size_t ka1 = (size_t)(t + 1) * kstep;
            const size_t ka2 = last ? 0 : (size_t)(t + 2) * kstep, ka3 = ka2 + kstep;
            const char* a2 = last ? nA : cA;
            const char* b2 = last ? nB : cB + (size_t)(t + 2) * kstep; const char* b3 = b2 + kstep;
            PG8_LDB(B0, 0, 0); PG8_LDB(B1, 0, 1); PG8_SCHED; PG8_LDA(At, 0, 0); PG8_STAGEA(PG8_SA(1, 1), cA, ka1, 1);
            if constexpr (GATHER) { if (last && has_next) a_offsets(S, nxt, rowA, tid, cao); }
            PG8_WAIT_V(8); PG8_WAIT_L(0); PG8_BAR; PG8_MMA(0, 0, At, B0); PG8_MMA(0, 1, At, B1); PG8_BAR; PG8_SCHED;
            PG8_LDA(At, 0, 1); PG8_STAGEB(PG8_SB(0, 0), b2); PG8_STAGEB(PG8_SB(0, 1), b2 + hstepB); PG8_STAGEA(PG8_SA(0, 0), a2, ka2, 0);
            PG8_WAIT_V(8); PG8_WAIT_L(0); PG8_BAR; PG8_MMA(1, 0, At, B0); PG8_MMA(1, 1, At, B1); PG8_BAR; PG8_SCHED;
            PG8_LDB(B0, 1, 0); PG8_LDB(B1, 1, 1); PG8_SCHED; PG8_LDA(At, 1, 0); PG8_STAGEA(PG8_SA(0, 1), a2, ka2, 1);
            PG8_WAIT_V(8); PG8_WAIT_L(0); PG8_BAR; PG8_MMA(0, 0, At, B0); PG8_MMA(0, 1, At, B1); PG8_BAR; PG8_SCHED;
            PG8_LDA(At, 1, 1); PG8_STAGEB(PG8_SB(1, 0), b3); PG8_STAGEB(PG8_SB(1, 1), b3 + hstepB); PG8_STAGEA(PG8_SA(1, 0), a2, ka3, 0);
            PG8_WAIT_V(8); PG8_WAIT_L(0); PG8_BAR; PG8_MMA(1, 0, At, B0); PG8_MMA(1, 1, At, B1); PG8_BAR; PG8_SCHED;
        }
        if constexpr (ALIGN_EPI) { if (wr == 0) PG8_BAR; }
        if constexpr (F8) asm volatile("s_nop 15\n\ts_nop 15" ::: "memory");
        { int t2 = threadIdx.x; asm volatile("" : "+v"(t2)); const int l2 = t2 & 63; E(acc, cur, wr, wc, l2 & 15, l2 >> 4); }
        if (!has_next) break;
#pragma unroll
        for (int a = 0; a < 2; ++a)
#pragma unroll
            for (int b = 0; b < 2; ++b)
#pragma unroll
                for (int m = 0; m < 4; ++m)
#pragma unroll
                    for (int n = 0; n < 2; ++n) acc[a][b][m][n] = (f32x4){0.f, 0.f, 0.f, 0.f};
        cur = nxt; cB = nB; cA = nA; ++ui;
        if constexpr (ALIGN_EPI) { if (wr == 1) PG8_BAR; }
    }
    PG8_WAIT_V(0);
    if constexpr (!ALIGN_EPI) { if (wr == 0) PG8_BAR; }
    PG8_BAR;
#undef PG8_SA
#undef PG8_SB
#undef PG8_STAGEA
#undef PG8_STAGEB
#undef PG8_LDA
#undef PG8_LDB
#undef PG8_MMA
#undef PG8_HALF
#undef PG8_LD16
#undef PG8_WAIT_V
#undef PG8_WAIT_L
#undef PG8_BAR
#undef PG8_SCHED
}
}

struct Args {
    const float* x; const float* ln_emb_g; const float* ln_emb_b; const float* w_in; const float* q_norm_g; const float* kv_norm_g;
    const float* w_uq; const float* w_ukv; const float* beta_mla; const float* beta_moba; const float* w_o; const float* ln1_g; const float* ln1_b;
    const float* ffn_w_gate; const float* ffn_w_up; const float* ffn_w_down; const float* router; const float* exp_w_gate; const float* exp_w_up;
    const float* exp_w_down; const float* ln2_g; const float* ln2_b;
    float* out; unsigned char* ws; int ph_lo, ph_hi;
};
struct Frame {
    LAS unsigned char* lds; int tid, lane, wave, bid, G;
};

enum { CM_ID = 0, CM_WIN = 1, CM_UQ = 2, CM_UKV = 3, CM_GU = 4 };
__device__ __forceinline__ int colmap(int kind, int n, int aux) {
    switch (kind) {
    case CM_WIN: {
        if (n >= HC_END) return -1;
        if (n >= HC_RQ && n < HC_RV) { const int base = n < HC_RK ? HC_RQ : HC_RK, r = n - base, hh = r >> 6, p = r & 63; const int d = ((p >> 5) << 4) + (p & 15) + ((p & 16) ? 32 : 0); return base + hh * 64 + d; }
        return n; }
    case CM_UQ: {
        if (n < 384) return (n >> 6) * 96 + (n & 63);
        if (n < 576) { const int r = n - 384; return (r >> 5) * 96 + 64 + (r & 31); }
        return -1; }
    case CM_UKV: {
        if (n < 384) return (n >> 6) * 128 + (n & 63);
        { const int r = n - 384; return (r >> 6) * 128 + 64 + (r & 63); } }
    case CM_GU: {
        const int j = n >> 8, w = n & 255; return j * 128 + (w & 127) + ((w >> 7) ? aux : 0); }
    default: return n;
    }
}
__device__ __forceinline__ void transpose_item(const float* W0, const float* W1, int K, int N, f16* WT, int kind, const float* kscale, const float* kscale2, LAS float* scr, int item, int nblk, int lane, int ldt = 0) {
    if (ldt == 0) ldt = K;
    const int kb = item / nblk, nb = item % nblk, k0 = 64 * kb, n0 = 32 * nb;
    const int nn = lane & 31; int sc = colmap(kind, n0 + nn, N); const float* W = W0;
    if (kind == CM_GU && sc >= N) { sc -= N; W = W1; }
#pragma unroll 8
    for (int i = 0; i < 32; ++i) { const int kk = 2 * i + (lane >> 5); float v = 0.f; if (sc >= 0) v = W[(size_t)(k0 + kk) * N + sc]; if (kscale2) { const int k = k0 + kk; v *= k < 384 ? kscale[k] : (k >= 704 ? kscale2[k - 704] : 1.0f); } else if (kscale) v *= kscale[k0 + kk]; scr[kk * 33 + nn] = v; }
    asm volatile("s_waitcnt lgkmcnt(0)" ::: "memory");
    const int c = lane & 7;
#pragma unroll
    for (int j = 0; j < 4; ++j) { const int n = (lane >> 3) + 8 * j; const LAS float* s = scr + (8 * c) * 33 + n;
        u32x4 o; o.x = pk_f16(s[0 * 33], s[1 * 33]); o.y = pk_f16(s[2 * 33], s[3 * 33]); o.z = pk_f16(s[4 * 33], s[5 * 33]); o.w = pk_f16(s[6 * 33], s[7 * 33]);
        *(u32x4*)(WT + (size_t)(n0 + n) * ldt + k0 + 8 * c) = o; }
    asm volatile("s_waitcnt lgkmcnt(0)" ::: "memory");
}

__device__ __forceinline__ void transpose_item8(const float* W0, const float* W1, int K, int N, unsigned char* WT, int kind, LAS float* scr, int item, int nblk, int lane) {
    const int kb = item / nblk, nb = item % nblk, k0 = 64 * kb, n0 = 32 * nb;
    const int nn = lane & 31; int sc = colmap(kind, n0 + nn, N); const float* W = W0;
    if (kind == CM_GU && sc >= N) { sc -= N; W = W1; }
#pragma unroll 8
    for (int i = 0; i < 32; ++i) { const int kk = 2 * i + (lane >> 5); scr[kk * 33 + nn] = W[(size_t)(k0 + kk) * N + sc] * F8_WS; }
    asm volatile("s_waitcnt lgkmcnt(0)" ::: "memory");
    const int c = lane & 3;
#pragma unroll
    for (int j = 0; j < 2; ++j) { const int n = (lane >> 2) + 16 * j; const LAS float* sp = scr + (16 * c) * 33 + n;
        u32x4 o; o.x = pk_fp8x4(sp[0 * 33], sp[1 * 33], sp[2 * 33], sp[3 * 33]); o.y = pk_fp8x4(sp[4 * 33], sp[5 * 33], sp[6 * 33], sp[7 * 33]);
        o.z = pk_fp8x4(sp[8 * 33], sp[9 * 33], sp[10 * 33], sp[11 * 33]); o.w = pk_fp8x4(sp[12 * 33], sp[13 * 33], sp[14 * 33], sp[15 * 33]);
        *(u32x4*)(WT + (size_t)(n0 + n) * K + k0 + 16 * c) = o; }
    asm volatile("s_waitcnt lgkmcnt(0)" ::: "memory");
}

__device__ __forceinline__ void ln_stats(const f32x4 (&v)[4], float& mean, float& rstd) {
    float s = 0.f;
#pragma unroll
    for (int j = 0; j < 4; ++j) s += (v[j][0] + v[j][1]) + (v[j][2] + v[j][3]);
    mean = wave_sum(s) * (1.f / D); float s2 = 0.f;
#pragma unroll
    for (int j = 0; j < 4; ++j) { const f32x4 d = v[j] - mean; s2 += (d[0] * d[0] + d[1] * d[1]) + (d[2] * d[2] + d[3] * d[3]); }
    rstd = 1.0f / sqrtf(wave_sum(s2) * (1.f / D) + LN_EPS);
}

template <int DK>
__device__ __forceinline__ void stage_kv(LAS float* Ks, LAS float* Vs, const f16* kp, int kld, const f16* k2p, int k2ld, const f16* vp, int vld, size_t row0, int tid) {
    constexpr int KCH = DK / 8;
    for (int t = tid; t < 32 * KCH + 32 * 8; t += 512) {
        if (t < 32 * KCH) { const int key = t / KCH, ch = t % KCH; const f16* src = (ch < 8) ? kp + (row0 + key) * kld + ch * 8 : k2p + (row0 + key) * k2ld + (ch - 8) * 8;
            const f16x8 v = *(const f16x8*)src; LAS float* d = Ks + key * DK + ch * 8;
#pragma unroll
            for (int e = 0; e < 8; ++e) d[e] = (float)v[e]; }
        else { const int t2 = t - 32 * KCH, key = t2 >> 3, ch = t2 & 7; const f16x8 v = *(const f16x8*)(vp + (row0 + key) * vld + ch * 8); LAS float* d = Vs + key * 64 + ch * 8;
#pragma unroll
            for (int e = 0; e < 8; ++e) d[e] = (float)v[e]; }
    }
}

template <int MODE>
__device__ __forceinline__ void attn_softmax_simple(const Frame& F, const f16* qb, const f16* kvb, const f16* hb, const float* kmean, f16* ob, float* ssq_o) {
    constexpr int DK = MODE == 0 ? 96 : 64, NHD = MODE == 0 ? 6 : 5;
    LAS float* Ks = (LAS float*)F.lds; LAS float* Vs = Ks + 32 * DK; LAS float* KM = Vs + 32 * 64;
    const int tid = F.tid;
    for (int unit = F.bid; unit < BATCH * NHD * 4; unit += F.G) {
        const int qt = 3 - (unit % 4), hh = (unit / 4) % NHD, b = unit / (4 * NHD);
        const size_t brow = (size_t)b * SEQ; const int qpos = qt * 512 + tid; const size_t row = brow + qpos;
        float q[DK];
        if (MODE == 0) {
#pragma unroll
            for (int c = 0; c < 8; ++c) { const f16x8 v = *(const f16x8*)(qb + row * QW + hh * 64 + c * 8);
#pragma unroll
                for (int e = 0; e < 8; ++e) q[c * 8 + e] = (float)v[e]; }
#pragma unroll
            for (int c = 0; c < 4; ++c) { const f16x8 v = *(const f16x8*)(qb + row * QW + 384 + hh * 32 + c * 8);
#pragma unroll
                for (int e = 0; e < 8; ++e) q[64 + c * 8 + e] = (float)v[e]; }
        } else {
#pragma unroll
            for (int c = 0; c < 8; ++c) { const f16x8 v = *(const f16x8*)(hb + row * HW + HC_MQ + hh * 64 + c * 8);
#pragma unroll
                for (int e = 0; e < 8; ++e) q[c * 8 + e] = (float)v[e]; }
        }
        const int blk = qpos >> 8; unsigned sel = 0u; float slope2 = 0.f;
        if (MODE == 1) {
            __syncthreads();
            { const int n = tid >> 6, d = tid & 63; KM[n * 64 + d] = kmean[(size_t)(b * 8 + n) * 320 + hh * 64 + d]; }
            __syncthreads();
            float gt[8];
#pragma unroll
            for (int n = 0; n < 8; ++n) { float s = 0.f;
#pragma unroll
                for (int d = 0; d < 64; ++d) s += q[d] * KM[n * 64 + d];
                gt[n] = s; }
#pragma unroll
            for (int n = 0; n < 8; ++n) { int rank = 0;
#pragma unroll
                for (int m = 0; m < 8; ++m) if (m < blk && m != n) rank += (gt[m] > gt[n] || (gt[m] == gt[n] && m < n)) ? 1 : 0;
                if (n < blk && rank < 3) sel |= 1u << n; }
            slope2 = exp2f(-8.0f * (float)(hh + 1) / 5.0f) * LOG2E;
        }
        float o[64];
#pragma unroll
        for (int d = 0; d < 64; ++d) o[d] = 0.f;
        float mrun = -INFINITY, lrun = 0.f;
        const int nkeys = (qt + 1) * 512;
        for (int k0 = 0; k0 < nkeys; k0 += 32) {
            __syncthreads();
            if (MODE == 0) stage_kv<96>(Ks, Vs, kvb + hh * 64, KVW, hb + HC_KR, HW, kvb + 384 + hh * 64, KVW, brow + k0, tid);
            else stage_kv<64>(Ks, Vs, hb + HC_MK + hh * 64, HW, nullptr, 0, hb + HC_MV + hh * 64, HW, brow + k0, tid);
            __syncthreads();
            bool part;
            if (MODE == 0) part = k0 <= qpos;
            else { const int n = k0 >> 8; part = (n == blk) ? (k0 <= qpos) : (n < blk && ((sel >> n) & 1u)); }
            if (part) {
#pragma unroll 1
                for (int j = 0; j < 32; ++j) {
                    if (k0 + j > qpos) break;
                    const LAS float* Kj = Ks + j * DK; const LAS float* Vj = Vs + j * 64;
                    float a = 0.f;
#pragma unroll
                    for (int d = 0; d < DK; d += 4) { const f32x4 kv4 = *(const LAS f32x4*)(Kj + d); a += q[d] * kv4[0] + q[d + 1] * kv4[1] + q[d + 2] * kv4[2] + q[d + 3] * kv4[3]; }
                    if (MODE == 1) a -= slope2 * (float)(qpos - (k0 + j));
                    if (a > mrun) { const float alpha = exp2f(mrun - a); lrun *= alpha;
#pragma unroll
                        for (int d = 0; d < 64; ++d) o[d] *= alpha;
                        mrun = a; }
                    const float p = exp2f(a - mrun); lrun += p;
#pragma unroll
                    for (int d = 0; d < 64; d += 4) { const f32x4 v4 = *(const LAS f32x4*)(Vj + d); o[d] += p * v4[0]; o[d + 1] += p * v4[1]; o[d + 2] += p * v4[2]; o[d + 3] += p * v4[3]; }
                }
            }
        }
        const float inv = 1.0f / lrun; float ss = 0.f;
#pragma unroll
        for (int d = 0; d < 64; ++d) { o[d] *= inv; ss += o[d] * o[d]; }
        f16* op = ob + row * D + (MODE == 0 ? 0 : OC_MOBA) + hh * 64;
#pragma unroll
        for (int c = 0; c < 8; ++c) { u32x4 w; w.x = pk_f16(o[c * 8], o[c * 8 + 1]); w.y = pk_f16(o[c * 8 + 2], o[c * 8 + 3]); w.z = pk_f16(o[c * 8 + 4], o[c * 8 + 5]); w.w = pk_f16(o[c * 8 + 6], o[c * 8 + 7]); *(u32x4*)(op + c * 8) = w; }
        ssq_o[row * 16 + (MODE == 0 ? 0 : 6) + hh] = ss;
    }
}
__device__ __forceinline__ void attn_ret_simple(const Frame& F, const f16* hb, f16* ob) {
    LAS float* Ks = (LAS float*)F.lds; LAS float* Vs = Ks + 32 * 64;
    const int tid = F.tid;
    for (int unit = F.bid; unit < BATCH * 5 * 4; unit += F.G) {
        const int qt = 3 - (unit % 4), hh = (unit / 4) % 5, b = unit / 20;
        const size_t brow = (size_t)b * SEQ; const int qpos = qt * 512 + tid; const size_t row = brow + qpos;
        float q[64];
#pragma unroll
        for (int c = 0; c < 8; ++c) { const f16x8 v = *(const f16x8*)(hb + row * HW + HC_RQ + hh * 64 + c * 8);
#pragma unroll
            for (int e = 0; e < 8; ++e) q[c * 8 + e] = (float)v[e]; }
        const float lg2 = log2f(1.0f - exp2f(-5.0f - (float)hh));
        float o[64];
#pragma unroll
        for (int d = 0; d < 64; ++d) o[d] = 0.f;
        const int nkeys = (qt + 1) * 512;
        for (int k0 = 0; k0 < nkeys; k0 += 32) {
            __syncthreads();
            stage_kv<64>(Ks, Vs, hb + HC_RK + hh * 64, HW, nullptr, 0, hb + HC_RV + hh * 64, HW, brow + k0, tid);
            __syncthreads();
            if (k0 <= qpos) {
#pragma unroll 1
                for (int j = 0; j < 32; ++j) {
                    const int dl = qpos - (k0 + j); if (dl < 0) break;
                    const LAS float* Kj = Ks + j * 64; const LAS float* Vj = Vs + j * 64;
                    float a = 0.f;
#pragma unroll
                    for (int d = 0; d < 64; d += 4) { const f32x4 kv4 = *(const LAS f32x4*)(Kj + d); a += q[d] * kv4[0] + q[d + 1] * kv4[1] + q[d + 2] * kv4[2] + q[d + 3] * kv4[3]; }
                    const float p = a * exp2f(lg2 * (float)dl);
#pragma unroll
                    for (int d = 0; d < 64; d += 4) { const f32x4 v4 = *(const LAS f32x4*)(Vj + d); o[d] += p * v4[0]; o[d + 1] += p * v4[1]; o[d + 2] += p * v4[2]; o[d + 3] += p * v4[3]; }
                }
            }
        }
        float mu = 0.f;
#pragma unroll
        for (int d = 0; d < 64; ++d) mu += o[d];
        mu *= (1.f / 64.f); float var = 0.f;
#pragma unroll
        for (int d = 0; d < 64; ++d) { const float t = o[d] - mu; var += t * t; }
        const float rs = 1.0f / sqrtf(var * (1.f / 64.f) + RMS_EPS);
        f16* op = ob + row * D + OC_RET + hh * 64; const f16* gp = hb + row * HW + HC_RG + hh * 64;
#pragma unroll
        for (int c = 0; c < 8; ++c) { const f16x8 gv = *(const f16x8*)(gp + c * 8); float r[8];
#pragma unroll
            for (int e = 0; e < 8; ++e) r[e] = silu_f((float)gv[e]) * ((o[c * 8 + e] - mu) * rs);
            u32x4 w; w.x = pk_f16(r[0], r[1]); w.y = pk_f16(r[2], r[3]); w.z = pk_f16(r[4], r[5]); w.w = pk_f16(r[6], r[7]); *(u32x4*)(op + c * 8) = w; }
    }
}

namespace att {
typedef float f32x16 __attribute__((ext_vector_type(16)));
typedef short s16x4 __attribute__((ext_vector_type(4)));
constexpr int BUF_STRIDE = 20480, OFF_V = 8192, OFF_PE = 16384, OFF_OSTG = 40960, OSTG_WAVE = 32 * 272, OFF_L = OFF_OSTG + 8 * OSTG_WAVE, OFF_F = OFF_L + 1024, OFF_QW = OFF_F + 1024;
constexpr float THR = 8.0f;
__device__ __forceinline__ int crowc(int r) { return (r & 3) + 8 * (r >> 2); }
__device__ __forceinline__ float pswap_max(float v) { const auto rr = __builtin_amdgcn_permlane32_swap(__float_as_uint(v), __float_as_uint(v), false, false); return fmaxf(__uint_as_float(rr[0]), __uint_as_float(rr[1])); }
__device__ __forceinline__ float pswap_sum(float v) { const auto rr = __builtin_amdgcn_permlane32_swap(__float_as_uint(v), __float_as_uint(v), false, false); return __uint_as_float(rr[0]) + __uint_as_float(rr[1]); }
#define ATT_WAIT_BAR() asm volatile("s_waitcnt vmcnt(0) lgkmcnt(0)\n\ts_barrier" ::: "memory")
__device__ __forceinline__ f16x8 vfrag(const LAS unsigned char* p0, const LAS unsigned char* p1) {
    const s16x4 lo = __builtin_bit_cast(s16x4, __builtin_amdgcn_ds_read_tr16_b64_v4i16((LAS s16x4*)p0));
    const s16x4 hi = __builtin_bit_cast(s16x4, __builtin_amdgcn_ds_read_tr16_b64_v4i16((LAS s16x4*)p1));
    typedef short s16x8 __attribute__((ext_vector_type(8)));
    const s16x8 v = {lo[0], lo[1], lo[2], lo[3], hi[0], hi[1], hi[2], hi[3]};
    return __builtin_bit_cast(f16x8, v);
}
template <int KIND>
__device__ __forceinline__ void attn_unit(LAS unsigned char* lds, int b, int hh, int qt, const f16* qbuf, const f16* kvbuf, const f16* hbuf, const float* kmean, f16* obuf, float* ssq_o) {
    int tid_ = threadIdx.x; asm volatile("" : "+v"(tid_));
    const int tid = tid_, lane = tid & 63, wid = __builtin_amdgcn_readfirstlane(tid >> 6), r32 = lane & 31, hi = lane >> 5;
    constexpr int NQK = KIND == 0 ? 6 : 4;
    const size_t brow = (size_t)b * SEQ;
    const int q0w = qt * 256 + wid * 32, qpos = q0w + r32;
    const f16* kbase; int kld; const f16* vbase; int vld; const f16* qrow;
    if (KIND == 0) { kbase = kvbuf + hh * 64; kld = KVW; vbase = kvbuf + 384 + hh * 64; vld = KVW; qrow = qbuf + (brow + qpos) * QW + hh * 64; }
    else if (KIND == 1) { kbase = hbuf + HC_MK + hh * 64; kld = HW; vbase = hbuf + HC_MV + hh * 64; vld = HW; qrow = hbuf + (brow + qpos) * HW + HC_MQ + hh * 64; }
    else { kbase = hbuf + HC_RK + hh * 64; kld = HW; vbase = hbuf + HC_RV + hh * 64; vld = HW; qrow = hbuf + (brow + qpos) * HW + HC_RQ + hh * 64; }
    const int dkey = 8 * wid + (lane >> 3), dcs = lane & 7;
    const char* ksrc = (const char*)(kbase + (brow + dkey) * kld + ((dcs ^ ((dkey >> 1) & 7)) << 3));
    const char* vsrc = (const char*)(vbase + (brow + dkey) * vld + (((((dcs >> 2) ^ ((dkey >> 1) & 1)) << 2) | (dcs & 3)) << 3));
    const int pkey = 16 * wid + (lane >> 2), pcs = lane & 3;
    const char* psrc = (const char*)(hbuf + (brow + pkey) * HW + HC_KR + ((pcs ^ ((pkey >> 2) & 3)) << 3));
    const size_t ktile = (size_t)64 * kld * 2, vtile = (size_t)64 * vld * 2, ptile = (size_t)64 * HW * 2;
#define ATT_DMA(t, buf) do { \
        __builtin_amdgcn_global_load_lds((const unsigned*)(ksrc + (size_t)(t) * ktile), (LAS unsigned*)(lds + (buf) * BUF_STRIDE + wid * 1024), 16, 0, 0); \
        __builtin_amdgcn_global_load_lds((const unsigned*)(vsrc + (size_t)(t) * vtile), (LAS unsigned*)(lds + (buf) * BUF_STRIDE + OFF_V + wid * 1024), 16, 0, 0); \
        if (KIND == 0) { if (wid < 4) __builtin_amdgcn_global_load_lds((const unsigned*)(psrc + (size_t)(t) * ptile), (LAS unsigned*)(lds + (buf) * BUF_STRIDE + OFF_PE + wid * 1024), 16, 0, 0); } } while (0)
    const int NT = 4 * (qt + 1);
    ATT_DMA(0, 0);
    f16x8 qf[NQK];
#pragma unroll
    for (int d0 = 0; d0 < 4; ++d0) qf[d0] = *(const f16x8*)(qrow + 16 * d0 + 8 * hi);
    if (KIND == 0) { const f16* qpe = qbuf + (brow + qpos) * QW + 384 + hh * 32; qf[4] = *(const f16x8*)(qpe + 8 * hi); qf[5] = *(const f16x8*)(qpe + 16 + 8 * hi); }
    const int ksw = (r32 >> 1) & 7, psw = (r32 >> 2) & 3;
    int koff[4];
#pragma unroll
    for (int d0 = 0; d0 < 4; ++d0) koff[d0] = r32 * 128 + (((2 * d0 + hi) ^ ksw) << 4);
    int poff[2];
#pragma unroll
    for (int d0 = 0; d0 < 2; ++d0) poff[d0] = r32 * 64 + (((2 * d0 + hi) ^ psw) << 4);
    const int vq = (lane & 15) >> 2, vp = lane & 3, vg = (lane >> 4) & 1, vsw = (vq >> 1) & 1;
    int voff[2];
#pragma unroll
    for (int d0 = 0; d0 < 2; ++d0) voff[d0] = (4 * hi + vq) * 128 + ((d0 ^ vsw) << 6) + ((2 * vg + (vp >> 1)) << 4) + 8 * (vp & 1);
    unsigned sel = 0u; float slope2 = 0.f;
    if (KIND == 1) {
        slope2 = exp2f(-8.0f * (float)(hh + 1) / 5.0f) * LOG2E;
        if (qt >= 4) {
            if (tid < 64) { const int n = tid >> 3, cs = tid & 7, c = cs ^ ((n >> 1) & 7); const float* src = kmean + (size_t)(b * 8 + n) * 640 + hh * 64 + c * 8;
                const f32x4 a0 = (*(const f32x4*)src + *(const f32x4*)(src + 320)) * (1.f / 256.f), a1 = (*(const f32x4*)(src + 4) + *(const f32x4*)(src + 324)) * (1.f / 256.f);
                u32x4 w; w.x = pk_f16(a0[0], a0[1]); w.y = pk_f16(a0[2], a0[3]); w.z = pk_f16(a1[0], a1[1]); w.w = pk_f16(a1[2], a1[3]);
                *(LAS u32x4*)(lds + BUF_STRIDE + n * 128 + cs * 16) = w; }
            asm volatile("s_waitcnt lgkmcnt(0)\n\ts_barrier" ::: "memory");
            f32x16 pg = {};
#pragma unroll
            for (int d0 = 0; d0 < 4; ++d0) { const f16x8 kf = *(const LAS f16x8*)(lds + BUF_STRIDE + koff[d0]); pg = __builtin_amdgcn_mfma_f32_32x32x16_f16(kf, qf[d0], pg, 0, 0, 0); }
            float gt[8];
#pragma unroll
            for (int r = 0; r < 4; ++r) { const auto rr = __builtin_amdgcn_permlane32_swap(__float_as_uint(pg[r]), __float_as_uint(pg[r]), false, false); gt[r] = __uint_as_float(rr[0]); gt[4 + r] = __uint_as_float(rr[1]); }
#pragma unroll
            for (int n = 0; n < 8; ++n) { int rank = 0;
#pragma unroll
                for (int m = 0; m < 8; ++m) if (m != n) rank += (m < qt && (gt[m] > gt[n] || (gt[m] == gt[n] && m < n))) ? 1 : 0;
                if (n < qt && rank < 3) sel |= 1u << n; }
        } else sel = 0xffu;
    }
    float lg2 = 0.f, e32 = 0.f; float dc[16];
    if (KIND == 2) { lg2 = log2f(1.0f - exp2f(-5.0f - (float)hh)); e32 = exp2f(-32.0f * lg2);
#pragma unroll
        for (int r = 0; r < 16; ++r) dc[r] = exp2f(-lg2 * (float)crowc(r)); }
    f32x16 o0 = {}, o1 = {};
    float mref = -1.0e30f, lsum = 0.f;
    LAS float* wsf = (LAS float*)(lds + OFF_F) + wid * 32;
    for (int t = 0; t < NT; ++t) {
        ATT_WAIT_BAR();
        if (t + 1 < NT) ATT_DMA(t + 1, (t + 1) & 1);
        const int k0 = 64 * t;
        bool active = k0 <= q0w + 31;
        if (KIND == 1) { const int n = t >> 2; if (n < qt) active = __any((sel >> n) & 1u) != 0; }
        if (!active) continue;
        const LAS unsigned char* kb = lds + (t & 1) * BUF_STRIDE;
        f32x16 p0, p1;
        if (KIND == 1) { const float cb = slope2 * (float)(k0 + 4 * hi - qpos);
#pragma unroll
            for (int r = 0; r < 16; ++r) { p0[r] = fmaf(slope2, (float)crowc(r), cb); p1[r] = fmaf(slope2, (float)(crowc(r) + 32), cb); } }
        else { p0 = (f32x16){}; p1 = (f32x16){}; }
#pragma unroll
        for (int d0 = 0; d0 < 4; ++d0) { const f16x8 k0f = *(const LAS f16x8*)(kb + koff[d0]), k1f = *(const LAS f16x8*)(kb + koff[d0] + 4096);
            p0 = __builtin_amdgcn_mfma_f32_32x32x16_f16(k0f, qf[d0], p0, 0, 0, 0); p1 = __builtin_amdgcn_mfma_f32_32x32x16_f16(k1f, qf[d0], p1, 0, 0, 0); }
        if (KIND == 0) {
#pragma unroll
            for (int d0 = 0; d0 < 2; ++d0) { const f16x8 k0f = *(const LAS f16x8*)(kb + OFF_PE + poff[d0]), k1f = *(const LAS f16x8*)(kb + OFF_PE + poff[d0] + 2048);
                p0 = __builtin_amdgcn_mfma_f32_32x32x16_f16(k0f, qf[4 + d0], p0, 0, 0, 0); p1 = __builtin_amdgcn_mfma_f32_32x32x16_f16(k1f, qf[4 + d0], p1, 0, 0, 0); } }
        const bool diag = k0 + 63 > q0w;
        const int kk = qpos - k0 - 4 * hi;
        u32x4 pw[4];
        if (KIND != 2) {
            if (diag) {
#pragma unroll
                for (int r = 0; r < 16; ++r) { if (crowc(r) > kk) p0[r] = -INFINITY; if (crowc(r) + 32 > kk) p1[r] = -INFINITY; } }
            if (KIND == 1) { const int n = t >> 2; if (n < qt && !((sel >> n) & 1u)) {
#pragma unroll
                for (int r = 0; r < 16; ++r) { p0[r] = -INFINITY; p1[r] = -INFINITY; } } }
            float rm = fmaxf(p0[0], p1[0]);
#pragma unroll
            for (int r = 1; r < 16; ++r) rm = fmaxf(rm, fmaxf(p0[r], p1[r]));
            rm = pswap_max(rm);
            if (__any(rm > mref + THR)) {
                const float mnew = fmaxf(mref, rm), f = __builtin_amdgcn_exp2f(mref - mnew);
                lsum *= f; mref = mnew;
                if (hi == 0) wsf[r32] = f;
                asm volatile("s_waitcnt lgkmcnt(0)" ::: "memory");
#pragma unroll
                for (int r = 0; r < 16; ++r) { const float fr = wsf[crowc(r) + 4 * hi]; o0[r] *= fr; o1[r] *= fr; }
            }
            float ls = 0.f;
#pragma unroll
            for (int r = 0; r < 16; ++r) { p0[r] = __builtin_amdgcn_exp2f(p0[r] - mref); p1[r] = __builtin_amdgcn_exp2f(p1[r] - mref); ls += p0[r] + p1[r]; }
            lsum += ls;
        } else {
            const float et = __builtin_amdgcn_exp2f(lg2 * (float)kk);
#pragma unroll
            for (int r = 0; r < 16; ++r) { const float w = et * dc[r]; p0[r] *= w; p1[r] *= w * e32; }
            if (diag) {
#pragma unroll
                for (int r = 0; r < 16; ++r) { if (crowc(r) > kk) p0[r] = 0.f; if (crowc(r) + 32 > kk) p1[r] = 0.f; } }
        }
#pragma unroll
        for (int i = 0; i < 4; ++i) { pw[0][i] = pk_f16(p0[2 * i], p0[2 * i + 1]); pw[1][i] = pk_f16(p0[8 + 2 * i], p0[8 + 2 * i + 1]); pw[2][i] = pk_f16(p1[2 * i], p1[2 * i + 1]); pw[3][i] = pk_f16(p1[8 + 2 * i], p1[8 + 2 * i + 1]); }
        const LAS unsigned char* vb = kb + OFF_V;
#pragma unroll
        for (int ks = 0; ks < 4; ++ks) {
            const f16x8 pa = __builtin_bit_cast(f16x8, pw[ks]);
            const f16x8 v0 = vfrag(vb + voff[0] + ks * 2048, vb + voff[0] + ks * 2048 + 1024);
            const f16x8 v1 = vfrag(vb + voff[1] + ks * 2048, vb + voff[1] + ks * 2048 + 1024);
            o0 = __builtin_amdgcn_mfma_f32_32x32x16_f16(pa, v0, o0, 0, 0, 0);
            o1 = __builtin_amdgcn_mfma_f32_32x32x16_f16(pa, v1, o1, 0, 0, 0);
        }
    }
    LAS float* stg = (LAS float*)(lds + OFF_OSTG + wid * OSTG_WAVE);
#pragma unroll
    for (int r = 0; r < 16; ++r) { const int row = crowc(r) + 4 * hi; stg[row * 68 + r32] = o0[r]; stg[row * 68 + 32 + r32] = o1[r]; }
    LAS float* lrow = (LAS float*)(lds + OFF_L) + wid * 32;
    if (KIND != 2) { const float lt = pswap_sum(lsum); if (hi == 0) lrow[r32] = lt; }
    asm volatile("s_waitcnt lgkmcnt(0)" ::: "memory");
    {
        const int row = lane >> 1, half = lane & 1; float v[32];
#pragma unroll
        for (int i = 0; i < 8; ++i) { const f32x4 x = *(const LAS f32x4*)(stg + row * 68 + half * 32 + i * 4); v[4 * i] = x[0]; v[4 * i + 1] = x[1]; v[4 * i + 2] = x[2]; v[4 * i + 3] = x[3]; }
        const size_t grow = brow + q0w + row;
        if (KIND != 2) {
            const float inv = 1.0f / lrow[row]; float ss = 0.f;
#pragma unroll
            for (int i = 0; i < 32; ++i) { v[i] *= inv; ss += v[i] * v[i]; }
            ss += swz_xor<1>(ss);
            if (half == 0) ssq_o[grow * 16 + (KIND == 0 ? 0 : 6) + hh] = ss;
        } else {
            float s1 = 0.f;
#pragma unroll
            for (int i = 0; i < 32; ++i) s1 += v[i];
            s1 += swz_xor<1>(s1); const float mu = s1 * (1.f / 64.f); float s2 = 0.f;
#pragma unroll
            for (int i = 0; i < 32; ++i) { v[i] -= mu; s2 += v[i] * v[i]; }
            s2 += swz_xor<1>(s2); const float rs = 1.0f / sqrtf(s2 * (1.f / 64.f) + RMS_EPS);
            const f16* gp = hbuf + grow * HW + HC_RG + hh * 64 + half * 32;
#pragma unroll
            for (int c = 0; c < 4; ++c) { const f16x8 gv = *(const f16x8*)(gp + c * 8);
#pragma unroll
                for (int e = 0; e < 8; ++e) v[c * 8 + e] = silu_f((float)gv[e]) * (v[c * 8 + e] * rs); }
        }
        f16* op = obuf + grow * D + (KIND == 0 ? 0 : (KIND == 1 ? OC_MOBA : OC_RET)) + hh * 64 + half * 32;
#pragma unroll
        for (int c = 0; c < 4; ++c) { u32x4 w; w.x = pk_f16(v[c * 8], v[c * 8 + 1]); w.y = pk_f16(v[c * 8 + 2], v[c * 8 + 3]); w.z = pk_f16(v[c * 8 + 4], v[c * 8 + 5]); w.w = pk_f16(v[c * 8 + 6], v[c * 8 + 7]); *(u32x4*)(op + c * 8) = w; }
    }
#undef ATT_DMA
}
__device__ __forceinline__ void attn_phase(LAS unsigned char* lds, unsigned* qctr, const f16* qbuf, const f16* kvbuf, const f16* hbuf, const float* kmean, f16* obuf, float* ssq_o) {
    volatile LAS int* qw = (volatile LAS int*)(lds + OFF_QW);
    for (;;) {
        asm volatile("s_waitcnt vmcnt(0) lgkmcnt(0)\n\ts_barrier" ::: "memory");
        if (threadIdx.x == 0) qw[0] = (int)__hip_atomic_fetch_add(qctr, 1u, __ATOMIC_RELAXED, __HIP_MEMORY_SCOPE_AGENT);
        asm volatile("s_waitcnt vmcnt(0) lgkmcnt(0)\n\ts_barrier" ::: "memory");
        const int idx = __builtin_amdgcn_readfirstlane(qw[0]);
        if (idx >= 2048) break;
        const int qt = 7 - (idx >> 8), j = idx & 255;
        if (j < 96) attn_unit<0>(lds, j / 6, j % 6, qt, qbuf, kvbuf, hbuf, kmean, obuf, ssq_o);
        else if (j < 176) attn_unit<1>(lds, (j - 96) / 5, (j - 96) % 5, qt, qbuf, kvbuf, hbuf, kmean, obuf, ssq_o);
        else attn_unit<2>(lds, (j - 176) / 5, (j - 176) % 5, qt, qbuf, kvbuf, hbuf, kmean, obuf, ssq_o);
    }
}
#undef ATT_WAIT_BAR
}

constexpr int NWAVES = 8;
constexpr int PH_L0 = 1, PPL0 = 9, PH_L1 = PH_L0 + PPL0, PPL1 = 10, NPHASE = PH_L1 + PPL1;
typedef const __attribute__((address_space(4))) Args* KArgs;
__device__ __forceinline__ KArgs kargs() { KArgs p = (KArgs)__builtin_amdgcn_kernarg_segment_ptr(); asm volatile("" : "+s"(p)); return p; }
__device__ __forceinline__ Frame mkframe() {
    extern __shared__ __attribute__((aligned(16))) unsigned char lds_raw[];
    Frame F; F.lds = (LAS unsigned char*)lds_raw; int t = threadIdx.x; asm volatile("" : "+v"(t)); F.tid = t; F.lane = t & 63; F.wave = __builtin_amdgcn_readfirstlane(t >> 6); F.bid = blockIdx.x; F.G = gridDim.x; return F;
}
#define WSP(T_, off) ((T_*)(ws + (off)))

__device__ __forceinline__ void ph_prologue() {
    const Frame F = mkframe(); KArgs a = kargs(); unsigned char* ws = a->ws;
    const int gw = F.bid * NWAVES + F.wave, NGW = F.G * NWAVES;
    f16* Win = WSP(f16, WS_WIN); f16* Wuq = WSP(f16, WS_WUQ); f16* Wo = WSP(f16, WS_WO); unsigned char* Wgu = WSP(unsigned char, WS_WGU); unsigned char* Wdn = WSP(unsigned char, WS_WDN);
    unsigned char* Egu = WSP(unsigned char, WS_EGU); unsigned char* Edn = WSP(unsigned char, WS_EDN); f16* xb = WSP(f16, WS_XB);
    float* cosA = WSP(float, WS_ROPE); float* sinA = cosA + SEQ * 16; float* cosB = sinA + SEQ * 16; float* sinB = cosB + SEQ * 32;
    LAS float* scr = (LAS float*)(F.lds + F.wave * 16384);
    constexpr int I_WIN = (D / 64) * (HW / 32), I_UQ = (256 / 64) * (768 / 32), I_UKV = (128 / 64) * (768 / 32), I_WO = (D / 64) * (D / 32);
    constexpr int I_GU = (D / 64) * (2 * FF / 32), I_DN = (FF / 64) * (D / 32), I_EGU = (D / 64) * (2 * FE / 32), I_EDN = (FE / 64) * (D / 32);
    constexpr int N_SMALL = 2 * (I_WIN + I_UQ + I_UKV + I_WO) + I_GU + I_DN, N_ALL = N_SMALL + NE * (I_EGU + I_EDN);
    for (int it = gw; it < N_ALL; it += NGW) {
        int r = it;
        if (r < 2 * I_WIN) { const int l = r / I_WIN; r %= I_WIN; transpose_item(a->w_in + (size_t)l * D * HC_END, nullptr, D, HC_END, Win + (size_t)l * HW * D, CM_WIN, nullptr, nullptr, scr, r, HW / 32, F.lane); continue; } r -= 2 * I_WIN;
        if (r < 2 * I_UQ) { const int l = r / I_UQ; r %= I_UQ; transpose_item(a->w_uq + (size_t)l * 256 * 576, nullptr, 256, 576, Wuq + (size_t)l * 1536 * 256, CM_UQ, a->q_norm_g + l * 256, nullptr, scr, r, 768 / 32, F.lane); continue; } r -= 2 * I_UQ;
        if (r < 2 * I_UKV) { const int l = r / I_UKV; r %= I_UKV; transpose_item(a->w_ukv + (size_t)l * 128 * 768, nullptr, 128, 768, Wuq + (size_t)l * 1536 * 256 + (size_t)768 * 256, CM_UKV, a->kv_norm_g + l * 128, nullptr, scr, r, 768 / 32, F.lane, 256); continue; } r -= 2 * I_UKV;
        if (r < 2 * I_WO) { const int l = r / I_WO; r %= I_WO; transpose_item(a->w_o + (size_t)l * D * D, nullptr, D, D, Wo + (size_t)l * D * D, CM_ID, a->beta_mla + l * 384, a->beta_moba + l * 320, scr, r, D / 32, F.lane); continue; } r -= 2 * I_WO;
        if (r < I_GU) { transpose_item8(a->ffn_w_gate, a->ffn_w_up, D, FF, Wgu, CM_GU, scr, r, 2 * FF / 32, F.lane); continue; } r -= I_GU;
        if (r < I_DN) { transpose_item8(a->ffn_w_down, nullptr, FF, D, Wdn, CM_ID, scr, r, D / 32, F.lane); continue; } r -= I_DN;
        { const int e = r / (I_EGU + I_EDN); r %= (I_EGU + I_EDN);
          if (r < I_EGU) transpose_item8(a->exp_w_gate + (size_t)e * D * FE, a->exp_w_up + (size_t)e * D * FE, D, FE, Egu + (size_t)e * 2 * FE * D, CM_GU, scr, r, 2 * FE / 32, F.lane);
          else transpose_item8(a->exp_w_down + (size_t)e * FE * D, nullptr, FE, D, Edn + (size_t)e * D * FE, CM_ID, scr, r - I_EGU, D / 32, F.lane); }
    }
    for (int i = F.bid * 512 + F.tid; i < 2 * 768 * 16; i += F.G * 512) { const int l = i / (768 * 16), r = (i / 16) % 768, c = i % 16; *(u32x4*)(Wuq + (size_t)l * 1536 * 256 + (size_t)(768 + r) * 256 + 128 + c * 8) = (u32x4){0u, 0u, 0u, 0u}; }
    for (int i = F.bid * 512 + F.tid; i < SEQ * 48; i += F.G * 512) {
        if (i < SEQ * 16) { const int pos = i >> 4, j = i & 15; const float inv = powf(10000.0f, -(float)(2 * j) / 32.0f); const float ang = (float)pos * inv; cosA[i] = cosf(ang); sinA[i] = sinf(ang); }
        else { const int k = i - SEQ * 16, pos = k >> 5, j = k & 31; const float inv = powf(10000.0f, -(float)(2 * j) / 64.0f); const float ang = (float)pos * inv; cosB[k] = cosf(ang); sinB[k] = sinf(ang); }
    }
    const float* xin = a->x; const float* gp = a->ln_emb_g; const float* bp = a->ln_emb_b;
    for (int m = gw; m < T; m += NGW) {
        const f32x4* xr = (const f32x4*)(xin + (size_t)m * D) + F.lane; f32x4 v[4];
#pragma unroll
        for (int j = 0; j < 4; ++j) v[j] = xr[64 * j];
        float mean, rstd; ln_stats(v, mean, rstd);
        u32x2* o8 = (u32x2*)(xb + (size_t)m * D) + F.lane;
#pragma unroll
        for (int j = 0; j < 4; ++j) { const f32x4 g = *((const f32x4*)gp + F.lane + 64 * j), bb = *((const f32x4*)bp + F.lane + 64 * j); const f32x4 y = (v[j] - mean) * rstd * g + bb;
            u32x2 w; w.x = pk_f16(y[0], y[1]); w.y = pk_f16(y[2], y[3]); o8[64 * j] = w; }
    }
}
__device__ __forceinline__ void ph_A(int l) {
    const Frame F = mkframe(); KArgs a = kargs(); unsigned char* ws = a->ws;
    pg8::Gemm g{WSP(f16, WS_XB), D, WSP(f16, WS_WIN) + (size_t)l * HW * D, D, D, 0, 0}; pg8::StaticOrder S; S.init(T / 256, HW / 256, F.G, F.bid);
    const float* cosA = WSP(float, WS_ROPE);
    pg8::EpiWin E{WSP(f16, WS_H), WSP(float, WS_SSQ_Q), WSP(float, WS_SSQ_KV), WSP(float, WS_KMEAN), cosA, cosA + SEQ * 16, cosA + SEQ * 32, cosA + SEQ * 64};
    pg8::gemm_phase<pg8::EpiWin, pg8::StaticOrder, true>(F.lds, g, S, E);
}
__device__ __forceinline__ void ph_B(int l) {
    const Frame F = mkframe(); KArgs a = kargs(); unsigned char* ws = a->ws;
    pg8::Gemm g{WSP(f16, WS_H), HW, WSP(f16, WS_WUQ) + (size_t)l * 1536 * 256, 256, 256, 0, 0}; pg8::UpOrder S; S.so.init(T / 256, 6, F.G, F.bid);
    const float* cosA = WSP(float, WS_ROPE);
    pg8::EpiUp E{(f16*)a->out, (f16*)((unsigned char*)a->out + 48 * MiB), WSP(float, WS_SSQ_Q), WSP(float, WS_SSQ_KV), cosA, cosA + SEQ * 16};
    pg8::gemm_phase<pg8::EpiUp, pg8::UpOrder, true>(F.lds, g, S, E);
}
constexpr int CW_ATTQ = 8192;
__device__ __forceinline__ void ph_C(int l) {
    const Frame F = mkframe(); KArgs a = kargs(); unsigned char* ws = a->ws;
    att::attn_phase(F.lds, WSP(unsigned, WS_CTL) + CW_ATTQ + 64 * l, (const f16*)a->out, (const f16*)((unsigned char*)a->out + 48 * MiB), WSP(f16, WS_H), WSP(float, WS_KMEAN), WSP(f16, WS_O), WSP(float, WS_SSQ_O));
}
__device__ __forceinline__ void ph_C2() {
    const Frame F = mkframe(); KArgs a = kargs(); unsigned char* ws = a->ws;
    const int gw = F.bid * NWAVES + F.wave, NGW = F.G * NWAVES;
    const float* ssq_o = WSP(float, WS_SSQ_O); f16* obuf = WSP(f16, WS_O);
    for (int m = gw; m < T; m += NGW) {
        const int lane = F.lane; const float* sp = ssq_o + (size_t)m * 16;
        const float sa = 1.0f / sqrtf((sp[0] + sp[1] + sp[2] + sp[3] + sp[4] + sp[5]) * (1.f / 384.f) + RMS_EPS);
        const float sc = 1.0f / sqrtf((sp[6] + sp[7] + sp[8] + sp[9] + sp[10]) * (1.f / 320.f) + RMS_EPS);
        f16* orow = obuf + (size_t)m * D;
#pragma unroll
        for (int j = 0; j < 6; ++j) { f16* p = orow + lane + 64 * j; *p = (f16)((float)*p * sa); }
#pragma unroll
        for (int j = 0; j < 5; ++j) { f16* p = orow + OC_MOBA + lane + 64 * j; *p = (f16)((float)*p * sc); }
    }
}
__device__ __forceinline__ void ph_D(int l) {
    const Frame F = mkframe(); KArgs a = kargs(); unsigned char* ws = a->ws;
    pg8::Gemm g{WSP(f16, WS_O), D, WSP(f16, WS_WO) + (size_t)l * D * D, D, D, 0, 0}; pg8::StaticOrder S; S.init(T / 256, D / 256, F.G, F.bid);
    pg8::EpiResF32 E{WSP(f16, WS_XB), a->out, D, DN_ALPHA, 1.0f};
    pg8::gemm_phase<pg8::EpiResF32, pg8::StaticOrder, true>(F.lds, g, S, E);
}
__device__ __forceinline__ void ph_D2(int l) {
    const Frame F = mkframe(); KArgs a = kargs(); unsigned char* ws = a->ws;
    const float* ybuf = a->out; f16* xb = WSP(f16, WS_XB); unsigned* xq = WSP(unsigned, WS_XQ); int* topi = WSP(int, WS_TOPI); float* topw = WSP(float, WS_TOPW); int* cnt = WSP(int, WS_CNT);
    const float* gp = a->ln1_g + l * D; const float* bp = a->ln1_b + l * D; const float* router = a->router;
    LAS int* lcnt = (LAS int*)(F.lds);
    for (int vw = F.bid; vw < 256; vw += F.G) {
        if (l == 1) { __syncthreads(); if (F.tid < 8) lcnt[F.tid] = 0; __syncthreads(); }
        for (int rr = F.wave; rr < 128; rr += NWAVES) {
            const int m = vw * 128 + rr; const int lane = F.lane;
            const f32x4* yr = (const f32x4*)(ybuf + (size_t)m * D) + lane; f32x4 v[4];
#pragma unroll
            for (int j = 0; j < 4; ++j) v[j] = yr[64 * j];
            float mean, rstd; ln_stats(v, mean, rstd);
            u32x2* o8 = (u32x2*)(xb + (size_t)m * D) + lane;
#pragma unroll
            for (int j = 0; j < 4; ++j) { const f32x4 g = *((const f32x4*)gp + lane + 64 * j), bb = *((const f32x4*)bp + lane + 64 * j); v[j] = (v[j] - mean) * rstd * g + bb;
                u32x2 w; w.x = pk_f16(v[j][0], v[j][1]); w.y = pk_f16(v[j][2], v[j][3]); o8[64 * j] = w;
                xq[(size_t)m * (D / 4) + lane + 64 * j] = pk_fp8x4(v[j][0] * F8_XS, v[j][1] * F8_XS, v[j][2] * F8_XS, v[j][3] * F8_XS); }
            if (l == 1) {
                float lg[8];
#pragma unroll
                for (int e = 0; e < 8; ++e) lg[e] = 0.f;
#pragma unroll
                for (int j = 0; j < 4; ++j)
#pragma unroll
                    for (int e4 = 0; e4 < 4; ++e4) { const int c = 4 * lane + 256 * j + e4; const f32x4 r0 = *(const f32x4*)(router + (size_t)c * 8), r1 = *(const f32x4*)(router + (size_t)c * 8 + 4); const float xv = v[j][e4];
                        lg[0] += xv * r0[0]; lg[1] += xv * r0[1]; lg[2] += xv * r0[2]; lg[3] += xv * r0[3]; lg[4] += xv * r1[0]; lg[5] += xv * r1[1]; lg[6] += xv * r1[2]; lg[7] += xv * r1[3]; }
#pragma unroll
                for (int e = 0; e < 8; ++e) lg[e] = wave_sum(lg[e]);
                if (lane == 0) {
                    int i0 = 0; float v0 = lg[0];
#pragma unroll
                    for (int e = 1; e < 8; ++e) if (lg[e] > v0) { v0 = lg[e]; i0 = e; }
                    int i1 = -1; float v1 = -INFINITY;
#pragma unroll
                    for (int e = 0; e < 8; ++e) if (e != i0 && lg[e] > v1) { v1 = lg[e]; i1 = e; }
                    const float e1 = __expf(v1 - v0), w0 = 1.0f / (1.0f + e1), w1 = e1 * w0;
                    topi[(size_t)m * 2] = i0; topi[(size_t)m * 2 + 1] = i1; topw[(size_t)m * 2] = w0; topw[(size_t)m * 2 + 1] = w1;
                    __hip_atomic_fetch_add(&lcnt[i0], 1, __ATOMIC_RELAXED, __HIP_MEMORY_SCOPE_WORKGROUP); __hip_atomic_fetch_add(&lcnt[i1], 1, __ATOMIC_RELAXED, __HIP_MEMORY_SCOPE_WORKGROUP);
                }
            }
        }
        if (l == 1) { __syncthreads(); if (F.tid < 8) cnt[vw * 8 + F.tid] = lcnt[F.tid]; }
    }
}
__device__ __forceinline__ void ph_E() {
    const Frame F = mkframe(); KArgs a = kargs(); unsigned char* ws = a->ws;
    pg8::Gemm g{WSP(unsigned char, WS_XQ), D, WSP(unsigned char, WS_WGU), D, D, F8_XE, F8_WE}; pg8::StaticOrder S; S.init(T / 256, 2 * FF / 256, F.G, F.bid);
    pg8::EpiSwiGLU E{WSP(unsigned char, WS_H), WSP(unsigned char, WS_H), 1 << 30, FF, 1.0f / (F8_XS * F8_WS)};
    pg8::gemm_phase<pg8::EpiSwiGLU, pg8::StaticOrder, true, true>(F.lds, g, S, E);
}
__device__ __forceinline__ void ph_F() {
    const Frame F = mkframe(); KArgs a = kargs(); unsigned char* ws = a->ws;
    pg8::Gemm g{WSP(unsigned char, WS_H), FF, WSP(unsigned char, WS_WDN), FF, FF, F8_HE, F8_WE}; pg8::StaticOrder S; S.init(T / 256, D / 256, F.G, F.bid);
    pg8::EpiResF32 E{WSP(f16, WS_XB), a->out, D, DN_ALPHA, 1.0f / (F8_HS * F8_WS)};
    pg8::gemm_phase<pg8::EpiResF32, pg8::StaticOrder, true, true>(F.lds, g, S, E);
}
__device__ __forceinline__ void ph_F2d() {
    const Frame F = mkframe(); KArgs a = kargs(); unsigned char* ws = a->ws;
    const int gw = F.bid * NWAVES + F.wave, NGW = F.G * NWAVES;
    const float* ybuf = a->out; f16* xb = WSP(f16, WS_XB); const float* gp = a->ln2_g; const float* bp = a->ln2_b;
    for (int m = gw; m < T; m += NGW) {
        const int lane = F.lane; const f32x4* yr = (const f32x4*)(ybuf + (size_t)m * D) + lane; f32x4 v[4];
#pragma unroll
        for (int j = 0; j < 4; ++j) v[j] = yr[64 * j];
        float mean, rstd; ln_stats(v, mean, rstd);
        u32x2* o8 = (u32x2*)(xb + (size_t)m * D) + lane;
#pragma unroll
        for (int j = 0; j < 4; ++j) { const f32x4 g = *((const f32x4*)gp + lane + 64 * j), bb = *((const f32x4*)bp + lane + 64 * j); const f32x4 y = (v[j] - mean) * rstd * g + bb;
            u32x2 w; w.x = pk_f16(y[0], y[1]); w.y = pk_f16(y[2], y[3]); o8[64 * j] = w; }
    }
}
__device__ __forceinline__ void ph_R3() {
    const Frame F = mkframe(); KArgs a = kargs(); unsigned char* ws = a->ws;
    const int* topi = WSP(int, WS_TOPI); const float* topw = WSP(float, WS_TOPW); const int* cnt = WSP(int, WS_CNT); int* rowtok = WSP(int, WS_ROWTOK); float* roww = WSP(float, WS_ROWW); int* pane = WSP(int, WS_PANE);
    LAS int* L = (LAS int*)F.lds;
    for (int vw = F.bid; vw < 256; vw += F.G) {
        __syncthreads();
        if (F.tid < 8) { const int e = F.tid; int tot = 0, mine = 0; for (int w = 0; w < 256; ++w) { const int c = cnt[w * 8 + e]; if (w < vw) mine += c; tot += c; } L[e] = tot; L[16 + e] = mine; }
        __syncthreads();
        if (F.tid == 0) { int b = 0; for (int e = 0; e < 8; ++e) { L[8 + e] = b; b += (L[e] + 255) & ~255; } L[24] = b; }
        __syncthreads();
        if (F.tid < 8) { const int e = F.tid; int p = L[8 + e] + L[16 + e];
            for (int t = 0; t < 128; ++t) { const int tok = vw * 128 + t;
#pragma unroll
                for (int s = 0; s < 2; ++s) if (topi[(size_t)tok * 2 + s] == e) { rowtok[p] = tok * 2 + s; roww[p] = topw[(size_t)tok * 2 + s]; ++p; } } }
        if (vw == 0) {
            for (int e = 0; e < 8; ++e) { const int s0 = L[8 + e] + L[e], s1 = L[8 + e] + ((L[e] + 255) & ~255);
                for (int p = s0 + F.tid; p < s1; p += 512) { rowtok[p] = -1; roww[p] = 0.f; }
                for (int p = (L[8 + e] >> 8) + F.tid; p < (s1 >> 8); p += 512) pane[p] = e; }
            if (F.tid == 0) pane[MOE_MAXP] = L[24] >> 8;
        }
    }
}
__device__ __forceinline__ void ph_M1() {
    const Frame F = mkframe(); KArgs a = kargs(); unsigned char* ws = a->ws;
    const int* pane = WSP(int, WS_PANE); const int np = pane[MOE_MAXP];
    pg8::Gemm g{WSP(unsigned char, WS_XQ), D, WSP(unsigned char, WS_EGU), D, D, F8_XE, F8_WE}; pg8::MoeGather S; S.so.init(np, 2 * FE / 256, F.G, F.bid); S.rowtok = WSP(int, WS_ROWTOK); S.pane = pane; S.estride = (size_t)2 * FE * D;
    pg8::EpiSwiGLU E{(unsigned char*)a->out, WSP(unsigned char, WS_H), MOE_SPLIT, FE, 1.0f / (F8_XS * F8_WS)};
    pg8::gemm_phase<pg8::EpiSwiGLU, pg8::MoeGather, true, true>(F.lds, g, S, E);
}
__device__ __forceinline__ void ph_M2() {
    const Frame F = mkframe(); KArgs a = kargs(); unsigned char* ws = a->ws;
    const int* pane = WSP(int, WS_PANE); const int np = pane[MOE_MAXP];
    pg8::Gemm g{(const unsigned char*)a->out, FE, WSP(unsigned char, WS_EDN), FE, FE, F8_HE, F8_WE}; pg8::MoeDense S; S.so.init(np, D / 256, F.G, F.bid); S.pane = pane; S.estride = (size_t)D * FE; S.A2 = (const char*)WSP(unsigned char, WS_H); S.split = MOE_SPLIT;
    pg8::EpiScatter E{WSP(f16, WS_C), (size_t)T * D, WSP(int, WS_ROWTOK), WSP(float, WS_ROWW), 1.0f / (F8_HS * F8_WS)};
    pg8::gemm_phase<pg8::EpiScatter, pg8::MoeDense, true, true>(F.lds, g, S, E);
}
__device__ __forceinline__ void ph_F2m() {
    const Frame F = mkframe(); KArgs a = kargs(); unsigned char* ws = a->ws;
    const int gw = F.bid * NWAVES + F.wave, NGW = F.G * NWAVES;
    const f16* xb = WSP(f16, WS_XB); const f16* c0buf = WSP(f16, WS_C); const f16* c1buf = c0buf + (size_t)T * D; float* out = a->out; const float* gp = a->ln2_g + D; const float* bp = a->ln2_b + D;
    for (int m = gw; m < T; m += NGW) {
        const int lane = F.lane; f32x4 v[4];
        const f16x4* xr = (const f16x4*)(xb + (size_t)m * D) + lane; const f16x4* c0r = (const f16x4*)(c0buf + (size_t)m * D) + lane; const f16x4* c1r = (const f16x4*)(c1buf + (size_t)m * D) + lane;
#pragma unroll
        for (int j = 0; j < 4; ++j) { const f16x4 xv = xr[64 * j], p0 = c0r[64 * j], p1 = c1r[64 * j];
#pragma unroll
            for (int e = 0; e < 4; ++e) v[j][e] = DN_ALPHA * (float)xv[e] + ((float)p0[e] + (float)p1[e]); }
        float mean, rstd; ln_stats(v, mean, rstd);
        f32x4* orow = (f32x4*)(out + (size_t)m * D) + lane;
#pragma unroll
        for (int j = 0; j < 4; ++j) { const f32x4 g = *((const f32x4*)gp + lane + 64 * j), bb = *((const f32x4*)bp + lane + 64 * j); orow[64 * j] = (v[j] - mean) * rstd * g + bb; }
    }
}

#ifndef SITE_MASK
#define SITE_MASK 0xFFFFFFFFu
#endif
#define SITE(n) (((SITE_MASK) >> (n)) & 1u)
__global__ void __launch_bounds__(NWAVES * 64, 2) mega_fwd(Args args_unused) {
    extern __shared__ __attribute__((aligned(16))) unsigned char lds_raw[];
    volatile LAS unsigned* MISC = (volatile LAS unsigned*)((LAS unsigned char*)lds_raw + MISC_OFF);
    if (threadIdx.x < 64) MISC[threadIdx.x] = 0u;
    __syncthreads();
#if MK_ONE_LAUNCH
    (void)xcd_barrier_post((unsigned*)(kargs()->ws + WS_CTL) + CW_BAR, MISC + 8);
#define GRID_BAR() do { XcdBarrier bar_; bar_.bar = (unsigned*)(kargs()->ws + WS_CTL) + CW_BAR; bar_.x = xb_xcc_id(); bar_.st = (volatile LAS unsigned*)((LAS unsigned char*)lds_raw + MISC_OFF) + 8; xcd_barrier(bar_); } while (0)
#else
#define GRID_BAR() do {} while (0)
#endif
    const int lo = kargs()->ph_lo, hi = kargs()->ph_hi;
#define IN(k) (lo <= (k) && (k) < hi)
#define SEAM(k) do { if (IN(k) && IN((k) + 1)) GRID_BAR(); } while (0)
    if (SITE(0) && IN(0)) ph_prologue();
    SEAM(0);
#pragma unroll
    for (int l = 0; l < 2; ++l) {
        const int pb = l == 0 ? PH_L0 : PH_L1;
        if (SITE(1) && IN(pb + 0)) ph_A(l);
        SEAM(pb + 0);
        if (SITE(3) && IN(pb + 1)) ph_B(l);
        SEAM(pb + 1);
        if (SITE(5) && IN(pb + 2)) ph_C(l);
        SEAM(pb + 2);
        if (SITE(6) && IN(pb + 3)) ph_C2();
        SEAM(pb + 3);
        if (SITE(7) && IN(pb + 4)) ph_D(l);
        SEAM(pb + 4);
        if (SITE(8) && IN(pb + 5)) ph_D2(l);
        SEAM(pb + 5);
        if (l == 0) {
            if (SITE(9) && IN(pb + 6)) ph_E();
            SEAM(pb + 6);
            if (SITE(10) && IN(pb + 7)) ph_F();
            SEAM(pb + 7);
            if (SITE(11) && IN(pb + 8)) ph_F2d();
            SEAM(pb + 8);
        } else {
            if (SITE(12) && IN(pb + 6)) ph_R3();
            SEAM(pb + 6);
            if (SITE(13) && IN(pb + 7)) ph_M1();
            SEAM(pb + 7);
            if (SITE(14) && IN(pb + 8)) ph_M2();
            SEAM(pb + 8);
            if (SITE(15) && IN(pb + 9)) ph_F2m();
        }
    }
#undef IN
#undef SEAM
}

extern "C" void kernel_launch(void* const* d_in, const int* in_sizes, int n_in, void* d_out, int out_size, void* d_ws, size_t ws_size, hipStream_t stream) {
    static int grid = 0;
    if (grid == 0) {
        if (n_in != 22 || in_sizes[0] != T * D || out_size != T * D || ws_size < WS_END) { fprintf(stderr, "kernel_launch: unexpected shapes / workspace (n_in %d, ws %zu)\n", n_in, ws_size); grid = -1; return; }
        int dev = 0, cus = 0;
        if (hipGetDevice(&dev) != hipSuccess || hipDeviceGetAttribute(&cus, hipDeviceAttributeMultiprocessorCount, dev) != hipSuccess) { grid = -1; return; }
        if (hipFuncSetAttribute((const void*)mega_fwd, hipFuncAttributeMaxDynamicSharedMemorySize, LDS_BYTES) != hipSuccess) { fprintf(stderr, "kernel_launch: hipFuncSetAttribute failed\n"); grid = -1; return; }
        int per_cu = 0;
        if (hipOccupancyMaxActiveBlocksPerMultiprocessor(&per_cu, (const void*)mega_fwd, NWAVES * 64, LDS_BYTES) != hipSuccess || per_cu < 1) { fprintf(stderr, "kernel_launch: occupancy query says %d\n", per_cu); }
        (void)hipGetLastError();
        grid = cus > 256 ? 256 : cus;
    }
    if (grid < 0) return;
    (void)hipMemsetAsync((char*)d_ws + WS_CTL, 0, CTL_ZERO_BYTES, stream);
    Args a{};
    a.x = (const float*)d_in[0]; a.ln_emb_g = (const float*)d_in[1]; a.ln_emb_b = (const float*)d_in[2]; a.w_in = (const float*)d_in[3]; a.q_norm_g = (const float*)d_in[4]; a.kv_norm_g = (const float*)d_in[5];
    a.w_uq = (const float*)d_in[6]; a.w_ukv = (const float*)d_in[7]; a.beta_mla = (const float*)d_in[8]; a.beta_moba = (const float*)d_in[9]; a.w_o = (const float*)d_in[10]; a.ln1_g = (const float*)d_in[11]; a.ln1_b = (const float*)d_in[12];
    a.ffn_w_gate = (const float*)d_in[13]; a.ffn_w_up = (const float*)d_in[14]; a.ffn_w_down = (const float*)d_in[15]; a.router = (const float*)d_in[16]; a.exp_w_gate = (const float*)d_in[17]; a.exp_w_up = (const float*)d_in[18];
    a.exp_w_down = (const float*)d_in[19]; a.ln2_g = (const float*)d_in[20]; a.ln2_b = (const float*)d_in[21];
    a.out = (float*)d_out; a.ws = (unsigned char*)d_ws;
#if MK_ONE_LAUNCH
    a.ph_lo = 0; a.ph_hi = NPHASE;
    hipLaunchKernelGGL(mega_fwd, dim3(grid), dim3(NWAVES * 64), LDS_BYTES, stream, a);
#else
    for (int p = 0; p < NPHASE; ++p) { a.ph_lo = p; a.ph_hi = p + 1; hipLaunchKernelGGL(mega_fwd, dim3(grid), dim3(NWAVES * 64), LDS_BYTES, stream, a); }
#endif
}
```

```cpp
#include <hip/hip_runtime.h>
#include <cstdio>
#include <cstdint>
#include <cmath>

#ifndef MK_ONE_LAUNCH
#define MK_ONE_LAUNCH 1
#endif

#define LAS __attribute__((address_space(3)))
#define GAS __attribute__((address_space(1)))
typedef _Float16 f16;
typedef _Float16 f16x2 __attribute__((ext_vector_type(2)));
typedef _Float16 f16x4 __attribute__((ext_vector_type(4)));
typedef _Float16 f16x8 __attribute__((ext_vector_type(8)));
typedef float f32x2 __attribute__((ext_vector_type(2)));
typedef float f32x4 __attribute__((ext_vector_type(4)));
typedef unsigned u32x2 __attribute__((ext_vector_type(2)));
typedef unsigned u32x4 __attribute__((ext_vector_type(4)));
typedef GAS unsigned gu32;
typedef int i32x4 __attribute__((ext_vector_type(4)));
typedef int i32x8 __attribute__((ext_vector_type(8)));

constexpr int BATCH = 16, SEQ = 2048, T = BATCH * SEQ, D = 1024;
constexpr int HW = 2816;
constexpr int HC_CQ = 0, HC_CKV = 256, HC_KR = 384, HC_RQ = 416, HC_RK = 736, HC_RV = 1056, HC_RG = 1376, HC_MQ = 1696, HC_MK = 2016, HC_MV = 2336, HC_END = 2656;
constexpr int QW = 768, KVW = 768;
constexpr int OC_RET = 384, OC_MOBA = 704;
constexpr int FF = 2816, FE = 3584, NE = 8;
constexpr float LN_EPS = 1e-5f, RMS_EPS = 1e-6f;
constexpr float DN_ALPHA = 1.41421356237f;
constexpr float LOG2E = 1.4426950408889634f;
constexpr float F8_XS = 8.0f, F8_HS = 16.0f, F8_WS = 256.0f; constexpr int F8_XE = 127 - 3, F8_HE = 127 - 4, F8_WE = 127 - 8;
constexpr int MOE_MAXP = 264;

constexpr size_t MiB = 1u << 20;
constexpr size_t WS_CTL = 0, CTL_ZERO_BYTES = 256 * 1024;
constexpr size_t WS_ROPE = 256 * 1024;
constexpr size_t WS_SSQ_Q = 1 * MiB;
constexpr size_t WS_SSQ_O = 2 * MiB;
constexpr size_t WS_KMEAN = 4 * MiB;
constexpr size_t WS_SSQ_KV = 18 * MiB + 512 * 1024;
constexpr size_t WS_TOPI = WS_KMEAN + 512 * 1024;
constexpr size_t WS_TOPW = WS_TOPI + (size_t)T * 8;
constexpr size_t WS_CNT = WS_TOPW + (size_t)T * 8;
constexpr size_t WS_ROWTOK = WS_CNT + 8192;
constexpr size_t WS_ROWW = WS_ROWTOK + (size_t)MOE_MAXP * 256 * 4;
constexpr size_t WS_PANE = WS_ROWW + (size_t)MOE_MAXP * 256 * 4;
constexpr size_t WS_WIN = 6 * MiB;
constexpr size_t WS_WUQ = 17 * MiB;
constexpr size_t WS_WO = 19 * MiB;
constexpr size_t WS_WGU = 23 * MiB;
constexpr size_t WS_WDN = 29 * MiB;
constexpr size_t WS_EGU = 32 * MiB;
constexpr size_t WS_EDN = 88 * MiB;
constexpr size_t WS_XB = 116 * MiB;
constexpr size_t WS_XQ = 180 * MiB;
constexpr size_t WS_H = 212 * MiB;
constexpr size_t WS_O = 388 * MiB;
constexpr size_t WS_C = 324 * MiB;
constexpr size_t WS_END = 452 * MiB;
constexpr int MOE_SPLIT = 146;
static_assert((size_t)MOE_SPLIT * 256 * FE <= 128 * MiB && WS_H + (size_t)(MOE_MAXP - MOE_SPLIT) * 256 * FE <= WS_C && WS_C + (size_t)2 * T * D * 2 <= WS_END, "MoE buffers");

constexpr int CW_TMO = 0, CW_BAR = 1024;

constexpr int RING_BYTES = 131072;
constexpr int MISC_OFF = RING_BYTES;
constexpr int LDS_BYTES = 147456;

__device__ __forceinline__ unsigned pk_f16(float lo, float hi) { f16x2 v = {(f16)lo, (f16)hi}; return __builtin_bit_cast(unsigned, v); }
template <int X> __device__ __forceinline__ float swz_xor(float v) { return __int_as_float(__builtin_amdgcn_ds_swizzle(__float_as_int(v), (X << 10) | 0x1f)); }
__device__ __forceinline__ float wave_sum(float v) {
    v += swz_xor<1>(v); v += swz_xor<2>(v); v += swz_xor<4>(v); v += swz_xor<8>(v); v += swz_xor<16>(v);
    const auto rr = __builtin_amdgcn_permlane32_swap(__float_as_uint(v), __float_as_uint(v), false, false);
    return __uint_as_float(rr[0]) + __uint_as_float(rr[1]);
}
__device__ __forceinline__ float clamp8(float x) { return fminf(fmaxf(x, -448.0f), 448.0f); }
__device__ __forceinline__ unsigned pk_fp8x4(float a, float b, float c, float d) { int w = 0; w = __builtin_amdgcn_cvt_pk_fp8_f32(clamp8(a), clamp8(b), w, false); w = __builtin_amdgcn_cvt_pk_fp8_f32(clamp8(c), clamp8(d), w, true); return (unsigned)w; }
__device__ __forceinline__ float silu_f(float x) { return x * __builtin_amdgcn_rcpf(1.f + __expf(-x)); }

#define XB_TMO      128
#define XB_XCNT(j)  (256  + 64 * (j))
#define XB_XSUB(j)  (1280 + 64 * (j))
#define XB_XGEN(j)  (2304 + 64 * (j))
#define XB_TOP      3328
#define XB_TOPGEN   3392
#define XCD_BAR_WORDS 3456
#define XB_SPIN_CAP (1u << 18)
__device__ __forceinline__ unsigned xb_ld(unsigned* p)              { return __hip_atomic_load(p, __ATOMIC_RELAXED, __HIP_MEMORY_SCOPE_AGENT); }
__device__ __forceinline__ unsigned xb_add(unsigned* p, unsigned v) { return __hip_atomic_fetch_add(p, v, __ATOMIC_RELAXED, __HIP_MEMORY_SCOPE_AGENT); }
__device__ __forceinline__ unsigned xb_xcc_id() { return (unsigned)__builtin_amdgcn_s_getreg((3 << 11) | 20) & 0xFu; }
#define XB_SPIN(cond, bar) do { unsigned _sp = 0; while (cond) { __builtin_amdgcn_s_sleep(1); \
    if ((++_sp & 255u) == 0u) { if (xb_ld(&(bar)[XB_TMO])) break; if (_sp > XB_SPIN_CAP) { atomicAdd(&(bar)[XB_TMO], 1u); break; } } } } while (0)
struct XcdBarrier { unsigned* bar; unsigned x; volatile LAS unsigned* st; };
__device__ __forceinline__ XcdBarrier xcd_barrier_post(unsigned* bar, volatile LAS unsigned* st) {
    XcdBarrier b; b.bar = bar; b.x = xb_xcc_id(); b.st = st;
    if (threadIdx.x == 0) (void)xb_add(&bar[XB_XCNT(b.x)], 1u);
    return b;
}
__device__ __forceinline__ void xcd_barrier_complete(unsigned* bar, unsigned x, unsigned& nloc, unsigned& nx) {
    const unsigned G = gridDim.x * gridDim.y * gridDim.z;
    unsigned sum, cnt, mine, sp = 0u;
    for (;;) {
        sum = 0u; cnt = 0u; mine = 0u;
#pragma unroll
        for (unsigned j = 0; j < 16; ++j) { const unsigned c = xb_ld(&bar[XB_XCNT(j)]); sum += c; cnt += (c > 0u) ? 1u : 0u; mine = (j == x) ? c : mine; }
        if (sum == G) break;
        __builtin_amdgcn_s_sleep(1);
        if ((++sp & 255u) == 0u) { if (xb_ld(&bar[XB_TMO])) break; if (sp > XB_SPIN_CAP) { atomicAdd(&bar[XB_TMO], 1u); break; } }
    }
    nloc = mine > 0u ? mine : 1u; nx = cnt > 0u ? cnt : 1u;
}
__device__ __forceinline__ void xcd_barrier(const XcdBarrier& b) {
    asm volatile("s_waitcnt vmcnt(0)" ::: "memory");
    __syncthreads();
    if (threadIdx.x == 0) {
        unsigned* bar = b.bar;
        __builtin_amdgcn_s_waitcnt(0);
        unsigned nloc = b.st[0], nx = b.st[1];
        if (nloc == 0u) { xcd_barrier_complete(bar, b.x, nloc, nx); b.st[0] = nloc; b.st[1] = nx; }
        const unsigned old = xb_add(&bar[XB_XSUB(b.x)], 1u);
        const unsigned gen = old / nloc;
        if (old + 1u == (gen + 1u) * nloc) {
            __builtin_amdgcn_fence(__ATOMIC_RELEASE, "agent");
            asm volatile("s_waitcnt vmcnt(0)" ::: "memory");
            const unsigned og = xb_add(&bar[XB_TOP], 1u);
            const unsigned tg = og / nx;
            if (og + 1u == (tg + 1u) * nx) xb_add(&bar[XB_TOPGEN], 1u);
            else XB_SPIN(xb_ld(&bar[XB_TOPGEN]) == tg, bar);
            __builtin_amdgcn_fence(__ATOMIC_ACQUIRE, "agent");
            xb_add(&bar[XB_XGEN(b.x)], 1u);
            asm volatile("s_waitcnt vmcnt(0)" ::: "memory");
        } else {
            XB_SPIN(xb_ld(&bar[XB_XGEN(b.x)]) == gen, bar);
            __builtin_amdgcn_fence(__ATOMIC_ACQUIRE, "agent");
            asm volatile("s_waitcnt vmcnt(0)" ::: "memory");
        }
    }
    __syncthreads();
}

namespace pg8 {
constexpr int BM = 256, BK = 64, HALF = 128, HTB = HALF * BK * 2, STAGE_BYTES = 8 * HTB, NXCD = 8, WGM = 8;
__host__ __device__ __forceinline__ int lds_byte(int r, int c) { const int st = (r >> 4) * 2 + (c >> 5), rr = r & 15, cc = c & 31, ob = rr * 64 + cc * 2; return st * 1024 + (ob ^ (((ob >> 9) & 1) << 5)); }
__host__ __device__ __forceinline__ void stage_rc(int b, int& R, int& C) { const int st = b / 1024, sb = b % 1024, swz = sb ^ (((sb >> 9) & 1) << 5); R = (st >> 1) * 16 + swz / 64; C = (st & 1) * 32 + (swz % 64) / 2; }
__host__ __device__ __forceinline__ int perm32(int rho) { const int n = rho >> 4, i = rho & 15; return 8 * (i >> 2) + 4 * n + (i & 3); }

struct Unit { int pm, pn; };
struct Gemm { const void* A; int lda; const void* Bt; int ldb; int K; int sa, sb; };

struct StaticOrder {
    static constexpr bool GATHER = false;
    int nM, nN, nwg, G, c, pm0;
    __device__ void init(int nM_, int nN_, int G_, int c_, int pm0_ = 0) { nM = nM_; nN = nN_; nwg = nM * nN; G = G_; c = c_; pm0 = pm0_; }
    __device__ bool next(int i, Unit& u) const {
        const long L = (long)i * G + c; if (L >= nwg) return false;
        int wgid = (int)L; { const int q = nwg / NXCD, r = nwg % NXCD, xcd = wgid % NXCD, off = wgid / NXCD; wgid = (xcd < r ? xcd * (q + 1) : r * (q + 1) + (xcd - r) * q) + off; }
        const int nig = WGM * nN, gid = wgid / nig, fm = gid * WGM, gsz = (nM - fm) < WGM ? (nM - fm) : WGM;
        u.pm = pm0 + fm + ((wgid % nig) % gsz); u.pn = (wgid % nig) / gsz; return true;
    }
    __device__ __forceinline__ int a_row(const Unit& u, int r) const { return u.pm * BM + r; }
    __device__ __forceinline__ size_t b_base(const Unit&) const { return 0; }
    __device__ __forceinline__ const char* a_tile(const Unit& u, const char* A, size_t rowb) const { return A + (size_t)u.pm * BM * rowb; }
};
struct UpOrder {
    static constexpr bool GATHER = false;
    StaticOrder so;
    __device__ bool next(int i, Unit& u) const { return so.next(i, u); }
    __device__ __forceinline__ int a_row(const Unit& u, int r) const { return u.pm * BM + r; }
    __device__ __forceinline__ size_t b_base(const Unit&) const { return 0; }
    __device__ __forceinline__ const char* a_tile(const Unit& u, const char* A, size_t rowb) const { return A + (size_t)u.pm * BM * rowb + (u.pn >= 3 ? (size_t)(HC_CKV * 2) : (size_t)0); }
};
struct MoeGather {
    static constexpr bool GATHER = true;
    StaticOrder so; const int* rowtok; const int* pane; size_t estride;
    __device__ bool next(int i, Unit& u) const { return so.next(i, u); }
    __device__ __forceinline__ int a_row(const Unit& u, int r) const { const int t = rowtok[u.pm * BM + r]; return t < 0 ? 0 : (t >> 1); }
    __device__ __forceinline__ size_t b_base(const Unit& u) const { return (size_t)pane[u.pm] * estride; }
    __device__ __forceinline__ const char* a_tile(const Unit&, const char* A, size_t) const { return A; }
};
struct MoeDense {
    static constexpr bool GATHER = false;
    StaticOrder so; const int* pane; size_t estride; const char* A2; int split;
    __device__ bool next(int i, Unit& u) const { return so.next(i, u); }
    __device__ __forceinline__ int a_row(const Unit& u, int r) const { return u.pm * BM + r; }
    __device__ __forceinline__ size_t b_base(const Unit& u) const { return (size_t)pane[u.pm] * estride; }
    __device__ __forceinline__ const char* a_tile(const Unit& u, const char* A, size_t rowb) const { return u.pm < split ? A + (size_t)u.pm * BM * rowb : A2 + (size_t)(u.pm - split) * BM * rowb; }
};

struct EpiF16 {
    static constexpr bool PERM = true;
    f16* O; int ldc;
    __device__ __forceinline__ void operator()(const f32x4 (&acc)[2][2][4][2], const Unit& u, int wr, int wc, int fr, int fq) const {
        const int row0 = u.pm * BM + wr * 64 + fr, col0 = u.pn * BM + wc * 32 + 8 * fq;
#pragma unroll
        for (int ai = 0; ai < 2; ++ai)
#pragma unroll
            for (int m = 0; m < 4; ++m) { f16* rowp = O + (size_t)(row0 + ai * HALF + m * 16) * ldc + col0;
#pragma unroll
                for (int bj = 0; bj < 2; ++bj) { const f32x4 v0 = acc[ai][bj][m][0], v1 = acc[ai][bj][m][1];
                    u32x4 w; w.x = pk_f16(v0[0], v0[1]); w.y = pk_f16(v0[2], v0[3]); w.z = pk_f16(v1[0], v1[1]); w.w = pk_f16(v1[2], v1[3]);
                    *(u32x4*)(rowp + bj * HALF) = w; } }
    }
};
__device__ __forceinline__ void rope8(float (&v)[8], const float* cs, const float* sn, int fq, float scale) {
    const f32x4 c0 = *(const f32x4*)cs, c1 = *(const f32x4*)(cs + 4), s0 = *(const f32x4*)sn, s1 = *(const f32x4*)(sn + 4);
    const float sg = fq < 2 ? -scale : scale;
#pragma unroll
    for (int e = 0; e < 8; ++e) { const auto rr = __builtin_amdgcn_permlane32_swap(__float_as_uint(v[e]), __float_as_uint(v[e]), false, false);
        const float other = fq < 2 ? __uint_as_float(rr[1]) : __uint_as_float(rr[0]);
        const float c = e < 4 ? c0[e & 3] : c1[e & 3], sn_ = e < 4 ? s0[e & 3] : s1[e & 3];
        v[e] = v[e] * (c * scale) + other * (sn_ * sg); }
}
__device__ __forceinline__ float sum_fq(float s) { s += swz_xor<16>(s); const auto rr = __builtin_amdgcn_permlane32_swap(__float_as_uint(s), __float_as_uint(s), false, false); return __uint_as_float(rr[0]) + __uint_as_float(rr[1]); }
struct EpiWin {
    static constexpr bool PERM = true;
    f16* H; float* ssq_q; float* ssq_kv; float* kpart; const float* cosA; const float* sinA; const float* cosB; const float* sinB;
    __device__ __forceinline__ void operator()(const f32x4 (&acc)[2][2][4][2], const Unit& u, int wr, int wc, int fr, int fq) const {
        const int row0 = u.pm * BM + wr * 64 + fr;
#pragma unroll
        for (int bj = 0; bj < 2; ++bj) {
            const int cg = u.pn * 8 + bj * 4 + wc;
            if (cg >= 83) continue;
            const int col0 = cg * 32 + 8 * fq;
            float ksum[8];
#pragma unroll
            for (int e = 0; e < 8; ++e) ksum[e] = 0.f;
#pragma unroll
            for (int ai = 0; ai < 2; ++ai)
#pragma unroll
                for (int m = 0; m < 4; ++m) {
                    const int row = row0 + ai * HALF + m * 16; const int pos = row & (SEQ - 1);
                    float v[8];
#pragma unroll
                    for (int e = 0; e < 4; ++e) { v[e] = acc[ai][bj][m][0][e]; v[4 + e] = acc[ai][bj][m][1][e]; }
                    if (cg < 12) {
                        float ss = 0.f;
#pragma unroll
                        for (int e = 0; e < 8; ++e) ss += v[e] * v[e];
                        ss = sum_fq(ss);
                        if (fq == 0) { if (cg < 8) ssq_q[(size_t)row * 8 + cg] = ss; else ssq_kv[(size_t)row * 4 + (cg - 8)] = ss; }
                    } else if (cg == 12) rope8(v, cosA + pos * 16 + 8 * (fq & 1), sinA + pos * 16 + 8 * (fq & 1), fq, 1.0f);
                    else if (cg < 23) rope8(v, cosB + pos * 32 + 16 * ((cg - 13) & 1) + 8 * (fq & 1), sinB + pos * 32 + 16 * ((cg - 13) & 1) + 8 * (fq & 1), fq, 1.0f);
                    else if (cg < 33) rope8(v, cosB + pos * 32 + 16 * ((cg - 23) & 1) + 8 * (fq & 1), sinB + pos * 32 + 16 * ((cg - 23) & 1) + 8 * (fq & 1), fq, 0.125f);
                    else if (cg >= 53 && cg < 63) {
#pragma unroll
                        for (int e = 0; e < 8; ++e) v[e] *= 0.125f * LOG2E; }
                    else if (cg >= 63 && cg < 73) {
#pragma unroll
                        for (int e = 0; e < 8; ++e) ksum[e] += v[e]; }
                    u32x4 w; w.x = pk_f16(v[0], v[1]); w.y = pk_f16(v[2], v[3]); w.z = pk_f16(v[4], v[5]); w.w = pk_f16(v[6], v[7]);
                    *(u32x4*)(H + (size_t)row * HW + col0) = w;
                }
            if (cg >= 63 && cg < 73) {
#pragma unroll
                for (int e = 0; e < 8; ++e) { float x = ksum[e]; x += swz_xor<1>(x); x += swz_xor<2>(x); x += swz_xor<4>(x); x += swz_xor<8>(x); ksum[e] = x; }
                if (fr == 0) { float* kp = kpart + ((size_t)u.pm * 2 + wr) * 320 + (cg - 63) * 32 + 8 * fq;
                    *(f32x4*)kp = (f32x4){ksum[0], ksum[1], ksum[2], ksum[3]}; *(f32x4*)(kp + 4) = (f32x4){ksum[4], ksum[5], ksum[6], ksum[7]}; }
            }
        }
    }
};
struct EpiUp {
    static constexpr bool PERM = true;
    f16* Oq; f16* Okv; const float* ssq_q; const float* ssq_kv; const float* cosA; const float* sinA;
    __device__ __forceinline__ void operator()(const f32x4 (&acc)[2][2][4][2], const Unit& u, int wr, int wc, int fr, int fq) const {
        const int row0 = u.pm * BM + wr * 64 + fr; const bool isq = u.pn < 3; const int pn = isq ? u.pn : u.pn - 3;
        f16* O = isq ? Oq : Okv; const int cg_end = isq ? 18 : 24;
#pragma unroll
        for (int ai = 0; ai < 2; ++ai)
#pragma unroll
            for (int m = 0; m < 4; ++m) {
                const int row = row0 + ai * HALF + m * 16; const int pos = row & (SEQ - 1);
                float rs;
                if (isq) { const f32x4 a = *(const f32x4*)(ssq_q + (size_t)row * 8), b = *(const f32x4*)(ssq_q + (size_t)row * 8 + 4); rs = (0.10206207261596575f * LOG2E) / sqrtf(((a[0] + a[1]) + (a[2] + a[3]) + (b[0] + b[1]) + (b[2] + b[3])) * (1.f / 256.f) + RMS_EPS); }
                else { const f32x4 a = *(const f32x4*)(ssq_kv + (size_t)row * 4); rs = 1.0f / sqrtf(((a[0] + a[1]) + (a[2] + a[3])) * (1.f / 128.f) + RMS_EPS); }
#pragma unroll
                for (int bj = 0; bj < 2; ++bj) {
                    const int cg = pn * 8 + bj * 4 + wc; if (cg >= cg_end) continue;
                    float v[8];
#pragma unroll
                    for (int e = 0; e < 4; ++e) { v[e] = acc[ai][bj][m][0][e] * rs; v[4 + e] = acc[ai][bj][m][1][e] * rs; }
                    if (isq && cg >= 12) rope8(v, cosA + pos * 16 + 8 * (fq & 1), sinA + pos * 16 + 8 * (fq & 1), fq, 1.0f);
                    u32x4 w; w.x = pk_f16(v[0], v[1]); w.y = pk_f16(v[2], v[3]); w.z = pk_f16(v[4], v[5]); w.w = pk_f16(v[6], v[7]);
                    *(u32x4*)(O + (size_t)row * QW + cg * 32 + 8 * fq) = w;
                }
            }
    }
};
struct EpiResF32 {
    static constexpr bool PERM = true;
    const f16* X; f16* Y; int ldc; float alpha; float ascale;
    __device__ __forceinline__ void operator()(const f32x4 (&acc)[2][2][4][2], const Unit& u, int wr, int wc, int fr, int fq) const {
        const int row0 = u.pm * BM + wr * 64 + fr, col0 = u.pn * BM + wc * 32 + 8 * fq;
#pragma unroll
        for (int ai = 0; ai < 2; ++ai)
#pragma unroll
            for (int m = 0; m < 4; ++m) { const size_t off = (size_t)(row0 + ai * HALF + m * 16) * ldc + col0;
#pragma unroll
                for (int bj = 0; bj < 2; ++bj) { const f16x8 xv = *(const f16x8*)(X + off + bj * HALF); const f32x4 a0 = acc[ai][bj][m][0] * ascale, a1 = acc[ai][bj][m][1] * ascale;
                    u32x4 w; w.x = pk_f16(alpha * (float)xv[0] + a0[0], alpha * (float)xv[1] + a0[1]); w.y = pk_f16(alpha * (float)xv[2] + a0[2], alpha * (float)xv[3] + a0[3]);
                    w.z = pk_f16(alpha * (float)xv[4] + a1[0], alpha * (float)xv[5] + a1[1]); w.w = pk_f16(alpha * (float)xv[6] + a1[2], alpha * (float)xv[7] + a1[3]);
                    *(u32x4*)(Y + off + bj * HALF) = w; } }
    }
};
struct EpiSwiGLU {
    static constexpr bool PERM = true;
    unsigned char* O; unsigned char* O2; int split; int ldc; float ascale;
    __device__ __forceinline__ void operator()(const f32x4 (&acc)[2][2][4][2], const Unit& u, int wr, int wc, int fr, int fq) const {
        unsigned char* base = u.pm < split ? O + (size_t)u.pm * BM * ldc : O2 + (size_t)(u.pm - split) * BM * ldc;
        const int row0 = wr * 64 + fr, col0 = u.pn * HALF + wc * 32 + 8 * fq;
#pragma unroll
        for (int ai = 0; ai < 2; ++ai)
#pragma unroll
            for (int m = 0; m < 4; ++m) { unsigned char* rowp = base + (size_t)(row0 + ai * HALF + m * 16) * ldc + col0;
                float r[8];
#pragma unroll
                for (int n = 0; n < 2; ++n)
#pragma unroll
                    for (int e = 0; e < 4; ++e) r[n * 4 + e] = silu_f(acc[ai][0][m][n][e] * ascale) * (acc[ai][1][m][n][e] * (ascale * F8_HS));
                u32x2 w; w.x = pk_fp8x4(r[0], r[1], r[2], r[3]); w.y = pk_fp8x4(r[4], r[5], r[6], r[7]);
                *(u32x2*)rowp = w; }
    }
};
struct EpiScatter {
    static constexpr bool PERM = true;
    f16* C0; size_t slot_stride; const int* rowtok; const float* roww; float ascale;
    __device__ __forceinline__ void operator()(const f32x4 (&acc)[2][2][4][2], const Unit& u, int wr, int wc, int fr, int fq) const {
        const int row0 = u.pm * BM + wr * 64 + fr, col0 = u.pn * BM + wc * 32 + 8 * fq;
#pragma unroll
        for (int ai = 0; ai < 2; ++ai)
#pragma unroll
            for (int m = 0; m < 4; ++m) { const int prow = row0 + ai * HALF + m * 16; const int ts = rowtok[prow]; const float w = roww[prow] * ascale;
                if (ts >= 0) { f16* rowp = C0 + (size_t)(ts & 1) * slot_stride + (size_t)(ts >> 1) * D + col0;
#pragma unroll
                    for (int bj = 0; bj < 2; ++bj) { const f32x4 v0 = acc[ai][bj][m][0] * w, v1 = acc[ai][bj][m][1] * w;
                        u32x4 o; o.x = pk_f16(v0[0], v0[1]); o.y = pk_f16(v0[2], v0[3]); o.z = pk_f16(v1[0], v1[1]); o.w = pk_f16(v1[2], v1[3]);
                        *(u32x4*)(rowp + bj * HALF) = o; } } }
    }
};

__device__ __forceinline__ const char* sgpr_ptr(const char* p) { const unsigned long long v = (unsigned long long)p; const unsigned lo = __builtin_amdgcn_readfirstlane((unsigned)v), hi = __builtin_amdgcn_readfirstlane((unsigned)(v >> 32)); return (const char*)(((unsigned long long)hi << 32) | lo); }
template <class Sched>
__device__ __forceinline__ void a_offsets(const Sched& S, const Unit& u, int rowb, int tid, unsigned (&ao)[2][2]) {
#pragma unroll
    for (int h = 0; h < 2; ++h)
#pragma unroll
        for (int i = 0; i < 2; ++i) { int R, C; stage_rc(tid * 16 + i * 8192, R, C); ao[h][i] = (unsigned)S.a_row(u, h * HALF + R) * (unsigned)rowb + (unsigned)C * 2u; }
}

template <class Epi, class Sched, bool ALIGN_EPI, bool F8 = false>
__device__ __forceinline__ void gemm_phase(LAS unsigned char* lds, const Gemm g, const Sched& S, const Epi& E) {
    constexpr bool GATHER = Sched::GATHER; constexpr int ESZ = F8 ? 1 : 2;
    int tid_ = threadIdx.x; asm volatile("" : "+v"(tid_));
    const int tid = tid_, wid = __builtin_amdgcn_readfirstlane(tid >> 6), lane = tid & 63, wr = wid >> 2, wc = wid & 3, fr = lane & 15, fq = lane >> 4;
    const int nt = g.K * ESZ / (BK * 2); const int rowA = g.lda * ESZ, rowB = g.ldb * ESZ;
    unsigned voffB[2], voffA[2];
#pragma unroll
    for (int i = 0; i < 2; ++i) { int R, C; stage_rc(tid * 16 + i * 8192, R, C); const int Rb = Epi::PERM ? ((R & ~31) + perm32(R & 31)) : R; voffB[i] = (unsigned)(Rb * rowB + C * 2); voffA[i] = (unsigned)(R * rowA + C * 2); }
    const size_t kstep = (size_t)(BK * 2);
    const size_t hstepB = (size_t)HALF * rowB, tstepB = 2 * hstepB;
    const size_t hstepA = (size_t)HALF * rowA;
    const unsigned ldsw = (unsigned)wid * 1024u;
    const int aoff = lds_byte(wr * 64 + fr, fq * 8), boff = lds_byte(wc * 32 + fr, fq * 8);
#define PG8_SA(b, h) (((b) * 2 + (h)) * HTB)
#define PG8_SB(b, h) ((4 + (b) * 2 + (h)) * HTB)
#define PG8_STAGEB(bufoff, gbase) do { _Pragma("unroll") for (int _i = 0; _i < 2; ++_i) \
        __builtin_amdgcn_global_load_lds((const unsigned*)(sgpr_ptr((const char*)(gbase)) + voffB[_i]), (LAS unsigned*)(lds + (bufoff) + ldsw + _i * 8192), 16, 0, 0); } while (0)
#define PG8_STAGEA(bufoff, ub, kb, h) do { _Pragma("unroll") for (int _i = 0; _i < 2; ++_i) \
        __builtin_amdgcn_global_load_lds((const unsigned*)(sgpr_ptr((ub) + (kb) + (GATHER ? (size_t)0 : (size_t)(h) * hstepA)) + (GATHER ? cao[h][_i] : voffA[_i])), (LAS unsigned*)(lds + (bufoff) + ldsw + _i * 8192), 16, 0, 0); } while (0)
#define PG8_LD16(p) (*(const LAS i32x4*)(p))
#define PG8_LDA(dst, b, h) do { _Pragma("unroll") for (int m = 0; m < 4; ++m) { const LAS unsigned char* p_ = lds + PG8_SA(b, h) + aoff + m * 2048; const i32x4 lo_ = PG8_LD16(p_), hi_ = PG8_LD16(p_ + 1024); dst[m] = __builtin_shufflevector(lo_, hi_, 0, 1, 2, 3, 4, 5, 6, 7); } } while (0)
#define PG8_LDB(dst, b, h) do { _Pragma("unroll") for (int n = 0; n < 2; ++n) { const LAS unsigned char* p_ = lds + PG8_SB(b, h) + boff + n * 2048; const i32x4 lo_ = PG8_LD16(p_), hi_ = PG8_LD16(p_ + 1024); dst[n] = __builtin_shufflevector(lo_, hi_, 0, 1, 2, 3, 4, 5, 6, 7); } } while (0)
#define PG8_HALF(x, k) __builtin_bit_cast(f16x8, __builtin_shufflevector(x, x, 4 * (k), 4 * (k) + 1, 4 * (k) + 2, 4 * (k) + 3))
#define PG8_MMA(ai, bj, At, Bt) do { __builtin_amdgcn_s_setprio(1); _Pragma("unroll") for (int m = 0; m < 4; ++m) _Pragma("unroll") for (int n = 0; n < 2; ++n) { \
        if constexpr (F8) asm volatile("v_mfma_f32_16x16x128_f8f6f4 %0, %1, %2, %0" : "+v"(acc[ai][bj][m][n]) : "v"(Bt[n]), "v"(At[m])); \
        else { acc[ai][bj][m][n] = __builtin_amdgcn_mfma_f32_16x16x32_f16(PG8_HALF(Bt[n], 0), PG8_HALF(At[m], 0), acc[ai][bj][m][n], 0, 0, 0); \
               acc[ai][bj][m][n] = __builtin_amdgcn_mfma_f32_16x16x32_f16(PG8_HALF(Bt[n], 1), PG8_HALF(At[m], 1), acc[ai][bj][m][n], 0, 0, 0); } } __builtin_amdgcn_s_setprio(0); } while (0)
#define PG8_WAIT_V(n) asm volatile("s_waitcnt vmcnt(" #n ")" ::: "memory")
#define PG8_WAIT_L(n) asm volatile("s_waitcnt lgkmcnt(" #n ")" ::: "memory")
#define PG8_BAR __builtin_amdgcn_s_barrier()
#define PG8_SCHED __builtin_amdgcn_sched_barrier(0)
    Unit cur, nxt; int ui = 0;
    if (!S.next(0, cur)) return;
    unsigned cao[2][2];
    if constexpr (GATHER) a_offsets(S, cur, rowA, tid, cao);
    const char* cA = S.a_tile(cur, (const char*)g.A, (size_t)rowA);
    const char* cB = (const char*)g.Bt + S.b_base(cur) + (size_t)cur.pn * tstepB;
    PG8_STAGEB(PG8_SB(0, 0), cB); PG8_STAGEB(PG8_SB(0, 1), cB + hstepB); PG8_STAGEA(PG8_SA(0, 0), cA, 0, 0); PG8_STAGEA(PG8_SA(0, 1), cA, 0, 1);
    if (wr == 1) PG8_BAR;
    PG8_WAIT_V(2); PG8_BAR;
    PG8_STAGEB(PG8_SB(1, 0), cB + kstep); PG8_STAGEA(PG8_SA(1, 0), cA, kstep, 0); PG8_STAGEB(PG8_SB(1, 1), cB + hstepB + kstep);
    PG8_WAIT_V(6); PG8_BAR;
    f32x4 acc[2][2][4][2];
#pragma unroll
    for (int a = 0; a < 2; ++a)
#pragma unroll
        for (int b = 0; b < 2; ++b)
#pragma unroll
            for (int m = 0; m < 4; ++m)
#pragma unroll
                for (int n = 0; n < 2; ++n) acc[a][b][m][n] = (f32x4){0.f, 0.f, 0.f, 0.f};
    i32x8 At[4], B0[2], B1[2];
    for (;;) {
        const bool has_next = S.next(ui + 1, nxt);
        const char* nB = cB; const char* nA = cA;
        if (has_next) { nB = (const char*)g.Bt + S.b_base(nxt) + (size_t)nxt.pn * tstepB; nA = S.a_tile(nxt, (const char*)g.A, (size_t)rowA); }
#pragma unroll 1
        for (int t = 0; t < nt; t += 2) {
            const bool last = (t == nt - 2);
            const size_t ka1 = (size_t)(t + 1) * kstep;
            const size_t ka2 = last ? 0 : (size_t)(t + 2) * kstep, ka3 = ka2 + kstep;
            const char* a2 = last ? nA : cA;
            const char* b2 = last ? nB : cB + (size_t)(t + 2) * kstep; const char* b3 = b2 + kstep;
            PG8_LDB(B0, 0, 0); PG8_LDB(B1, 0, 1); PG8_SCHED; PG8_LDA(At, 0, 0); PG8_STAGEA(PG8_SA(1, 1), cA, ka1, 1);
            if constexpr (GATHER) { if (last && has_next) a_offsets(S, nxt, rowA, tid, cao); }
            PG8_WAIT_V(8); PG8_WAIT_L(0); PG8_BAR; PG8_MMA(0, 0, At, B0); PG8_MMA(0, 1, At, B1); PG8_BAR; PG8_SCHED;
            PG8_LDA(At, 0, 1); PG8_STAGEB(PG8_SB(0, 0), b2); PG8_STAGEB(PG8_SB(0, 1), b2 + hstepB); PG8_STAGEA(PG8_SA(0, 0), a2, ka2, 0);
            PG8_WAIT_V(8); PG8_WAIT_L(0); PG8_BAR; PG8_MMA(1, 0, At, B0); PG8_MMA(1, 1, At, B1); PG8_BAR; PG8_SCHED;
            PG8_LDB(B0, 1, 0); PG8_LDB(B1, 1, 1); PG8_SCHED; PG8_LDA(At, 1, 0); PG8_STAGEA(PG8_SA(0, 1), a2, ka2, 1);
            PG8_WAIT_V(8); PG8_WAIT_L(0); PG8_BAR; PG8_MMA(0, 0, At, B0); PG8_MMA(0, 1, At, B1); PG8_BAR; PG8_SCHED;
            PG8_LDA(At, 1, 1); PG8_STAGEB(PG8_SB(1, 0), b3); PG8_STAGEB(PG8_SB(1, 1), b3 + hstepB); PG8_STAGEA(PG8_SA(1, 0), a2, ka3, 0);
            PG8_WAIT_V(8); PG8_WAIT_L(0); PG8_BAR; PG8_MMA(1, 0, At, B0); PG8_MMA(1, 1, At, B1); PG8_BAR; PG8_SCHED;
        }
        if constexpr (ALIGN_EPI) { if (wr == 0) PG8_BAR; }
        if constexpr (F8) asm volatile("s_nop 15\n\ts_nop 15" ::: "memory");
        { int t2 = threadIdx.x; asm volatile("" : "+v"(t2)); const int l2 = t2 & 63; E(acc, cur, wr, wc, l2 & 15, l2 >> 4); }
        if (!has_next) break;
#pragma unroll
        for (int a = 0; a < 2; ++a)
#pragma unroll
            for (int b = 0; b < 2; ++b)
#pragma unroll
                for (int m = 0; m < 4; ++m)
#pragma unroll
                    for (int n = 0; n < 2; ++n) acc[a][b][m][n] = (f32x4){0.f, 0.f, 0.f, 0.f};
        cur = nxt; cB = nB; cA = nA; ++ui;
        if constexpr (ALIGN_EPI) { if (wr == 1) PG8_BAR; }
    }
    PG8_WAIT_V(0);
    if constexpr (!ALIGN_EPI) { if (wr == 0) PG8_BAR; }
    PG8_BAR;
#undef PG8_SA
#undef PG8_SB
#undef PG8_STAGEA
#undef PG8_STAGEB
#undef PG8_LDA
#undef PG8_LDB
#undef PG8_MMA
#undef PG8_HALF
#undef PG8_LD16
#undef PG8_WAIT_V
#undef PG8_WAIT_L
#undef PG8_BAR
#undef PG8_SCHED
}
}

struct Args {
    const float* x; const float* ln_emb_g; const float* ln_emb_b; const float* w_in; const float* q_norm_g; const float* kv_norm_g;
    const float* w_uq; const float* w_ukv; const float* beta_mla; const float* beta_moba; const float* w_o; const float* ln1_g; const float* ln1_b;
    const float* ffn_w_gate; const float* ffn_w_up; const float* ffn_w_down; const float* router; const float* exp_w_gate; const float* exp_w_up;
    const float* exp_w_down; const float* ln2_g; const float* ln2_b;
    float* out; unsigned char* ws; int ph_lo, ph_hi;
};
struct Frame {
    LAS unsigned char* lds; int tid, lane, wave, bid, G;
};

enum { CM_ID = 0, CM_WIN = 1, CM_UQ = 2, CM_UKV = 3, CM_GU = 4 };
__device__ __forceinline__ int colmap(int kind, int n, int aux) {
    switch (kind) {
    case CM_WIN: {
        if (n >= HC_END) return -1;
        if (n >= HC_RQ && n < HC_RV) { const int base = n < HC_RK ? HC_RQ : HC_RK, r = n - base, hh = r >> 6, p = r & 63; const int d = ((p >> 5) << 4) + (p & 15) + ((p & 16) ? 32 : 0); return base + hh * 64 + d; }
        return n; }
    case CM_UQ: {
        if (n < 384) return (n >> 6) * 96 + (n & 63);
        if (n < 576) { const int r = n - 384; return (r >> 5) * 96 + 64 + (r & 31); }
        return -1; }
    case CM_UKV: {
        if (n < 384) return (n >> 6) * 128 + (n & 63);
        { const int r = n - 384; return (r >> 6) * 128 + 64 + (r & 63); } }
    case CM_GU: {
        const int j = n >> 8, w = n & 255; return j * 128 + (w & 127) + ((w >> 7) ? aux : 0); }
    default: return n;
    }
}
__device__ __forceinline__ void transpose_item(const float* W0, const float* W1, int K, int N, f16* WT, int kind, const float* kscale, const float* kscale2, LAS float* scr, int item, int nblk, int lane, int ldt = 0) {
    if (ldt == 0) ldt = K;
    const int kb = item / nblk, nb = item % nblk, k0 = 64 * kb, n0 = 32 * nb;
    const int nn = lane & 31; int sc = colmap(kind, n0 + nn, N); const float* W = W0;
    if (kind == CM_GU && sc >= N) { sc -= N; W = W1; }
#pragma unroll 8
    for (int i = 0; i < 32; ++i) { const int kk = 2 * i + (lane >> 5); float v = 0.f; if (sc >= 0) v = W[(size_t)(k0 + kk) * N + sc]; if (kscale2) { const int k = k0 + kk; v *= k < 384 ? kscale[k] : (k >= 704 ? kscale2[k - 704] : 1.0f); } else if (kscale) v *= kscale[k0 + kk]; scr[kk * 33 + nn] = v; }
    asm volatile("s_waitcnt lgkmcnt(0)" ::: "memory");
    const int c = lane & 7;
#pragma unroll
    for (int j = 0; j < 4; ++j) { const int n = (lane >> 3) + 8 * j; const LAS float* s = scr + (8 * c) * 33 + n;
        u32x4 o; o.x = pk_f16(s[0 * 33], s[1 * 33]); o.y = pk_f16(s[2 * 33], s[3 * 33]); o.z = pk_f16(s[4 * 33], s[5 * 33]); o.w = pk_f16(s[6 * 33], s[7 * 33]);
        *(u32x4*)(WT + (size_t)(n0 + n) * ldt + k0 + 8 * c) = o; }
    asm volatile("s_waitcnt lgkmcnt(0)" ::: "memory");
}

__device__ __forceinline__ void transpose_item8(const float* W0, const float* W1, int K, int N, unsigned char* WT, int kind, LAS float* scr, int item, int nblk, int lane) {
    const int kb = item / nblk, nb = item % nblk, k0 = 64 * kb, n0 = 32 * nb;
    const int nn = lane & 31; int sc = colmap(kind, n0 + nn, N); const float* W = W0;
    if (kind == CM_GU && sc >= N) { sc -= N; W = W1; }
#pragma unroll 8
    for (int i = 0; i < 32; ++i) { const int kk = 2 * i + (lane >> 5); scr[kk * 33 + nn] = W[(size_t)(k0 + kk) * N + sc] * F8_WS; }
    asm volatile("s_waitcnt lgkmcnt(0)" ::: "memory");
    const int c = lane & 3;
#pragma unroll
    for (int j = 0; j < 2; ++j) { const int n = (lane >> 2) + 16 * j; const LAS float* sp = scr + (16 * c) * 33 + n;
        u32x4 o; o.x = pk_fp8x4(sp[0 * 33], sp[1 * 33], sp[2 * 33], sp[3 * 33]); o.y = pk_fp8x4(sp[4 * 33], sp[5 * 33], sp[6 * 33], sp[7 * 33]);
        o.z = pk_fp8x4(sp[8 * 33], sp[9 * 33], sp[10 * 33], sp[11 * 33]); o.w = pk_fp8x4(sp[12 * 33], sp[13 * 33], sp[14 * 33], sp[15 * 33]);
        *(u32x4*)(WT + (size_t)(n0 + n) * K + k0 + 16 * c) = o; }
    asm volatile("s_waitcnt lgkmcnt(0)" ::: "memory");
}

__device__ __forceinline__ void ln_stats(const f32x4 (&v)[4], float& mean, float& rstd) {
    float s = 0.f;
#pragma unroll
    for (int j = 0; j < 4; ++j) s += (v[j][0] + v[j][1]) + (v[j][2] + v[j][3]);
    mean = wave_sum(s) * (1.f / D); float s2 = 0.f;
#pragma unroll
    for (int j = 0; j < 4; ++j) { const f32x4 d = v[j] - mean; s2 += (d[0] * d[0] + d[1] * d[1]) + (d[2] * d[2] + d[3] * d[3]); }
    rstd = 1.0f / sqrtf(wave_sum(s2) * (1.f / D) + LN_EPS);
}

__device__ __forceinline__ void ln_stats16(const float (&v)[16], float& mean, float& rstd) {
    float s = 0.f;
#pragma unroll
    for (int i = 0; i < 16; ++i) s += v[i];
    mean = wave_sum(s) * (1.f / D); float s2 = 0.f;
#pragma unroll
    for (int i = 0; i < 16; ++i) { const float d = v[i] - mean; s2 += d * d; }
    rstd = 1.0f / sqrtf(wave_sum(s2) * (1.f / D) + LN_EPS);
}
__device__ __forceinline__ void ln_load_y16(const f16* yrow, int lane, float (&v)[16]) {
    const f16x8 a = *(const f16x8*)(yrow + 8 * lane), b = *(const f16x8*)(yrow + 512 + 8 * lane);
#pragma unroll
    for (int e = 0; e < 8; ++e) { v[e] = (float)a[e]; v[8 + e] = (float)b[e]; }
}
__device__ __forceinline__ void ln_affine16(float (&v)[16], float mean, float rstd, const float* g, const float* b, int lane) {
#pragma unroll
    for (int h = 0; h < 2; ++h)
#pragma unroll
        for (int q = 0; q < 2; ++q) { const f32x4 gv = *(const f32x4*)(g + 512 * h + 8 * lane + 4 * q), bv = *(const f32x4*)(b + 512 * h + 8 * lane + 4 * q);
#pragma unroll
            for (int e = 0; e < 4; ++e) v[8 * h + 4 * q + e] = (v[8 * h + 4 * q + e] - mean) * rstd * gv[e] + bv[e]; }
}
__device__ __forceinline__ void ln_store_xb16(f16* xrow, int lane, const float (&v)[16]) {
#pragma unroll
    for (int h = 0; h < 2; ++h) { u32x4 w; w.x = pk_f16(v[8 * h], v[8 * h + 1]); w.y = pk_f16(v[8 * h + 2], v[8 * h + 3]); w.z = pk_f16(v[8 * h + 4], v[8 * h + 5]); w.w = pk_f16(v[8 * h + 6], v[8 * h + 7]); *(u32x4*)(xrow + 512 * h + 8 * lane) = w; }
}

template <int DK>
__device__ __forceinline__ void stage_kv(LAS float* Ks, LAS float* Vs, const f16* kp, int kld, const f16* k2p, int k2ld, const f16* vp, int vld, size_t row0, int tid) {
    constexpr int KCH = DK / 8;
    for (int t = tid; t < 32 * KCH + 32 * 8; t += 512) {
        if (t < 32 * KCH) { const int key = t / KCH, ch = t % KCH; const f16* src = (ch < 8) ? kp + (row0 + key) * kld + ch * 8 : k2p + (row0 + key) * k2ld + (ch - 8) * 8;
            const f16x8 v = *(const f16x8*)src; LAS float* d = Ks + key * DK + ch * 8;
#pragma unroll
            for (int e = 0; e < 8; ++e) d[e] = (float)v[e]; }
        else { const int t2 = t - 32 * KCH, key = t2 >> 3, ch = t2 & 7; const f16x8 v = *(const f16x8*)(vp + (row0 + key) * vld + ch * 8); LAS float* d = Vs + key * 64 + ch * 8;
#pragma unroll
            for (int e = 0; e < 8; ++e) d[e] = (float)v[e]; }
    }
}

template <int MODE>
__device__ __forceinline__ void attn_softmax_simple(const Frame& F, const f16* qb, const f16* kvb, const f16* hb, const float* kmean, f16* ob, float* ssq_o) {
    constexpr int DK = MODE == 0 ? 96 : 64, NHD = MODE == 0 ? 6 : 5;
    LAS float* Ks = (LAS float*)F.lds; LAS float* Vs = Ks + 32 * DK; LAS float* KM = Vs + 32 * 64;
    const int tid = F.tid;
    for (int unit = F.bid; unit < BATCH * NHD * 4; unit += F.G) {
        const int qt = 3 - (unit % 4), hh = (unit / 4) % NHD, b = unit / (4 * NHD);
        const size_t brow = (size_t)b * SEQ; const int qpos = qt * 512 + tid; const size_t row = brow + qpos;
        float q[DK];
        if (MODE == 0) {
#pragma unroll
            for (int c = 0; c < 8; ++c) { const f16x8 v = *(const f16x8*)(qb + row * QW + hh * 64 + c * 8);
#pragma unroll
                for (int e = 0; e < 8; ++e) q[c * 8 + e] = (float)v[e]; }
#pragma unroll
            for (int c = 0; c < 4; ++c) { const f16x8 v = *(const f16x8*)(qb + row * QW + 384 + hh * 32 + c * 8);
#pragma unroll
                for (int e = 0; e < 8; ++e) q[64 + c * 8 + e] = (float)v[e]; }
        } else {
#pragma unroll
            for (int c = 0; c < 8; ++c) { const f16x8 v = *(const f16x8*)(hb + row * HW + HC_MQ + hh * 64 + c * 8);
#pragma unroll
                for (int e = 0; e < 8; ++e) q[c * 8 + e] = (float)v[e]; }
        }
        const int blk = qpos >> 8; unsigned sel = 0u; float slope2 = 0.f;
        if (MODE == 1) {
            __syncthreads();
            { const int n = tid >> 6, d = tid & 63; KM[n * 64 + d] = kmean[(size_t)(b * 8 + n) * 320 + hh * 64 + d]; }
            __syncthreads();
            float gt[8];
#pragma unroll
            for (int n = 0; n < 8; ++n) { float s = 0.f;
#pragma unroll
                for (int d = 0; d < 64; ++d) s += q[d] * KM[n * 64 + d];
                gt[n] = s; }
#pragma unroll
            for (int n = 0; n < 8; ++n) { int rank = 0;
#pragma unroll
                for (int m = 0; m < 8; ++m) if (m < blk && m != n) rank += (gt[m] > gt[n] || (gt[m] == gt[n] && m < n)) ? 1 : 0;
                if (n < blk && rank < 3) sel |= 1u << n; }
            slope2 = exp2f(-8.0f * (float)(hh + 1) / 5.0f) * LOG2E;
        }
        float o[64];
#pragma unroll
        for (int d = 0; d < 64; ++d) o[d] = 0.f;
        float mrun = -INFINITY, lrun = 0.f;
        const int nkeys = (qt + 1) * 512;
        for (int k0 = 0; k0 < nkeys; k0 += 32) {
            __syncthreads();
            if (MODE == 0) stage_kv<96>(Ks, Vs, kvb + hh * 64, KVW, hb + HC_KR, HW, kvb + 384 + hh * 64, KVW, brow + k0, tid);
            else stage_kv<64>(Ks, Vs, hb + HC_MK + hh * 64, HW, nullptr, 0, hb + HC_MV + hh * 64, HW, brow + k0, tid);
            __syncthreads();
            bool part;
            if (MODE == 0) part = k0 <= qpos;
            else { const int n = k0 >> 8; part = (n == blk) ? (k0 <= qpos) : (n < blk && ((sel >> n) & 1u)); }
            if (part) {
#pragma unroll 1
                for (int j = 0; j < 32; ++j) {
                    if (k0 + j > qpos) break;
                    const LAS float* Kj = Ks + j * DK; const LAS float* Vj = Vs + j * 64;
                    float a = 0.f;
#pragma unroll
                    for (int d = 0; d < DK; d += 4) { const f32x4 kv4 = *(const LAS f32x4*)(Kj + d); a += q[d] * kv4[0] + q[d + 1] * kv4[1] + q[d + 2] * kv4[2] + q[d + 3] * kv4[3]; }
                    if (MODE == 1) a -= slope2 * (float)(qpos - (k0 + j));
                    if (a > mrun) { const float alpha = exp2f(mrun - a); lrun *= alpha;
#pragma unroll
                        for (int d = 0; d < 64; ++d) o[d] *= alpha;
                        mrun = a; }
                    const float p = exp2f(a - mrun); lrun += p;
#pragma unroll
                    for (int d = 0; d < 64; d += 4) { const f32x4 v4 = *(const LAS f32x4*)(Vj + d); o[d] += p * v4[0]; o[d + 1] += p * v4[1]; o[d + 2] += p * v4[2]; o[d + 3] += p * v4[3]; }
                }
            }
        }
        const float inv = 1.0f / lrun; float ss = 0.f;
#pragma unroll
        for (int d = 0; d < 64; ++d) { o[d] *= inv; ss += o[d] * o[d]; }
        f16* op = ob + row * D + (MODE == 0 ? 0 : OC_MOBA) + hh * 64;
#pragma unroll
        for (int c = 0; c < 8; ++c) { u32x4 w; w.x = pk_f16(o[c * 8], o[c * 8 + 1]); w.y = pk_f16(o[c * 8 + 2], o[c * 8 + 3]); w.z = pk_f16(o[c * 8 + 4], o[c * 8 + 5]); w.w = pk_f16(o[c * 8 + 6], o[c * 8 + 7]); *(u32x4*)(op + c * 8) = w; }
        ssq_o[row * 16 + (MODE == 0 ? 0 : 6) + hh] = ss;
    }
}
__device__ __forceinline__ void attn_ret_simple(const Frame& F, const f16* hb, f16* ob) {
    LAS float* Ks = (LAS float*)F.lds; LAS float* Vs = Ks + 32 * 64;
    const int tid = F.tid;
    for (int unit = F.bid; unit < BATCH * 5 * 4; unit += F.G) {
        const int qt = 3 - (unit % 4), hh = (unit / 4) % 5, b = unit / 20;
        const size_t brow = (size_t)b * SEQ; const int qpos = qt * 512 + tid; const size_t row = brow + qpos;
        float q[64];
#pragma unroll
        for (int c = 0; c < 8; ++c) { const f16x8 v = *(const f16x8*)(hb + row * HW + HC_RQ + hh * 64 + c * 8);
#pragma unroll
            for (int e = 0; e < 8; ++e) q[c * 8 + e] = (float)v[e]; }
        const float lg2 = log2f(1.0f - exp2f(-5.0f - (float)hh));
        float o[64];
#pragma unroll
        for (int d = 0; d < 64; ++d) o[d] = 0.f;
        const int nkeys = (qt + 1) * 512;
        for (int k0 = 0; k0 < nkeys; k0 += 32) {
            __syncthreads();
            stage_kv<64>(Ks, Vs, hb + HC_RK + hh * 64, HW, nullptr, 0, hb + HC_RV + hh * 64, HW, brow + k0, tid);
            __syncthreads();
            if (k0 <= qpos) {
#pragma unroll 1
                for (int j = 0; j < 32; ++j) {
                    const int dl = qpos - (k0 + j); if (dl < 0) break;
                    const LAS float* Kj = Ks + j * 64; const LAS float* Vj = Vs + j * 64;
                    float a = 0.f;
#pragma unroll
                    for (int d = 0; d < 64; d += 4) { const f32x4 kv4 = *(const LAS f32x4*)(Kj + d); a += q[d] * kv4[0] + q[d + 1] * kv4[1] + q[d + 2] * kv4[2] + q[d + 3] * kv4[3]; }
                    const float p = a * exp2f(lg2 * (float)dl);
#pragma unroll
                    for (int d = 0; d < 64; d += 4) { const f32x4 v4 = *(const LAS f32x4*)(Vj + d); o[d] += p * v4[0]; o[d + 1] += p * v4[1]; o[d + 2] += p * v4[2]; o[d + 3] += p * v4[3]; }
                }
            }
        }
        float mu = 0.f;
#pragma unroll
        for (int d = 0; d < 64; ++d) mu += o[d];
        mu *= (1.f / 64.f); float var = 0.f;
#pragma unroll
        for (int d = 0; d < 64; ++d) { const float t = o[d] - mu; var += t * t; }
        const float rs = 1.0f / sqrtf(var * (1.f / 64.f) + RMS_EPS);
        f16* op = ob + row * D + OC_RET + hh * 64; const f16* gp = hb + row * HW + HC_RG + hh * 64;
#pragma unroll
        for (int c = 0; c < 8; ++c) { const f16x8 gv = *(const f16x8*)(gp + c * 8); float r[8];
#pragma unroll
            for (int e = 0; e < 8; ++e) r[e] = silu_f((float)gv[e]) * ((o[c * 8 + e] - mu) * rs);
            u32x4 w; w.x = pk_f16(r[0], r[1]); w.y = pk_f16(r[2], r[3]); w.z = pk_f16(r[4], r[5]); w.w = pk_f16(r[6], r[7]); *(u32x4*)(op + c * 8) = w; }
    }
}

namespace att {
typedef float f32x16 __attribute__((ext_vector_type(16)));
typedef short s16x4 __attribute__((ext_vector_type(4)));
constexpr int BUF_STRIDE = 20480, OFF_V = 8192, OFF_PE = 16384, OFF_OSTG = 40960, OSTG_WAVE = 32 * 272, OFF_L = OFF_OSTG + 8 * OSTG_WAVE, OFF_F = OFF_L + 1024, OFF_QW = OFF_F + 1024;
constexpr float THR = 8.0f;
__device__ __forceinline__ int crowc(int r) { return (r & 3) + 8 * (r >> 2); }
__device__ __forceinline__ float pswap_max(float v) { const auto rr = __builtin_amdgcn_permlane32_swap(__float_as_uint(v), __float_as_uint(v), false, false); return fmaxf(__uint_as_float(rr[0]), __uint_as_float(rr[1])); }
__device__ __forceinline__ float pswap_sum(float v) { const auto rr = __builtin_amdgcn_permlane32_swap(__float_as_uint(v), __float_as_uint(v), false, false); return __uint_as_float(rr[0]) + __uint_as_float(rr[1]); }
__device__ __forceinline__ float max3f(float a, float b, float c) { float r; asm("v_max3_f32 %0, %1, %2, %3" : "=v"(r) : "v"(a), "v"(b), "v"(c)); return r; }
#define ATT_WAIT_BAR() asm volatile("s_waitcnt vmcnt(0) lgkmcnt(0)\n\ts_barrier" ::: "memory")
__device__ __forceinline__ f16x8 vfrag(const LAS unsigned char* p0, const LAS unsigned char* p1) {
    const s16x4 lo = __builtin_bit_cast(s16x4, __builtin_amdgcn_ds_read_tr16_b64_v4i16((LAS s16x4*)p0));
    const s16x4 hi = __builtin_bit_cast(s16x4, __builtin_amdgcn_ds_read_tr16_b64_v4i16((LAS s16x4*)p1));
    typedef short s16x8 __attribute__((ext_vector_type(8)));
    const s16x8 v = {lo[0], lo[1], lo[2], lo[3], hi[0], hi[1], hi[2], hi[3]};
    return __builtin_bit_cast(f16x8, v);
}
template <int KIND>
__device__ __forceinline__ void attn_unit(LAS unsigned char* lds, int b, int hh, int qt, const f16* qbuf, const f16* kvbuf, const f16* hbuf, const float* kmean, f16* obuf, float* ssq_o) {
    int tid_ = threadIdx.x; asm volatile("" : "+v"(tid_));
    const int tid = tid_, lane = tid & 63, wid = __builtin_amdgcn_readfirstlane(tid >> 6), r32 = lane & 31, hi = lane >> 5;
    constexpr int NQK = KIND == 0 ? 6 : 4;
    const size_t brow = (size_t)b * SEQ;
    const int q0w = qt * 256 + wid * 32, qpos = q0w + r32;
    const f16* kbase; int kld; const f16* vbase; int vld; const f16* qrow;
    if (KIND == 0) { kbase = kvbuf + hh * 64; kld = KVW; vbase = kvbuf + 384 + hh * 64; vld = KVW; qrow = qbuf + (brow + qpos) * QW + hh * 64; }
    else if (KIND == 1) { kbase = hbuf + HC_MK + hh * 64; kld = HW; vbase = hbuf + HC_MV + hh * 64; vld = HW; qrow = hbuf + (brow + qpos) * HW + HC_MQ + hh * 64; }
    else { kbase = hbuf + HC_RK + hh * 64; kld = HW; vbase = hbuf + HC_RV + hh * 64; vld = HW; qrow = hbuf + (brow + qpos) * HW + HC_RQ + hh * 64; }
    const int dkey = 8 * wid + (lane >> 3), dcs = lane & 7;
    const char* ksrc = (const char*)(kbase + (brow + dkey) * kld + ((dcs ^ ((dkey >> 1) & 7)) << 3));
    const char* vsrc = (const char*)(vbase + (brow + dkey) * vld + (((((dcs >> 2) ^ ((dkey >> 1) & 1)) << 2) | (dcs & 3)) << 3));
    const int pkey = 16 * wid + (lane >> 2), pcs = lane & 3;
    const char* psrc = (const char*)(hbuf + (brow + pkey) * HW + HC_KR + ((pcs ^ ((pkey >> 2) & 3)) << 3));
    const size_t ktile = (size_t)64 * kld * 2, vtile = (size_t)64 * vld * 2, ptile = (size_t)64 * HW * 2;
#define ATT_GLDS(gsrc, ldsdst) do { unsigned keep_; asm volatile("s_mov_b32 %0, m0\n\ts_mov_b32 m0, %2\n\ts_nop 0\n\tglobal_load_lds_dwordx4 %1, off\n\ts_mov_b32 m0, %0" : "=&s"(keep_) : "v"(gsrc), "s"(ldsdst) : "memory"); } while (0)
    const unsigned lds0 = (unsigned)(size_t)lds + (unsigned)wid * 1024u;
#define ATT_DMA(t, buf) do { \
        ATT_GLDS(ksrc + (size_t)(t) * ktile, (unsigned)__builtin_amdgcn_readfirstlane(lds0 + (buf) * BUF_STRIDE)); \
        ATT_GLDS(vsrc + (size_t)(t) * vtile, (unsigned)__builtin_amdgcn_readfirstlane(lds0 + (buf) * BUF_STRIDE + OFF_V)); \
        if (KIND == 0) { if (wid < 4) ATT_GLDS(psrc + (size_t)(t) * ptile, (unsigned)__builtin_amdgcn_readfirstlane(lds0 + (buf) * BUF_STRIDE + OFF_PE)); } } while (0)
    const int NT = 4 * (qt + 1);
    ATT_DMA(0, 0);
    f16x8 qf[NQK];
#pragma unroll
    for (int d0 = 0; d0 < 4; ++d0) qf[d0] = *(const f16x8*)(qrow + 16 * d0 + 8 * hi);
    if (KIND == 0) { const f16* qpe = qbuf + (brow + qpos) * QW + 384 + hh * 32; qf[4] = *(const f16x8*)(qpe + 8 * hi); qf[5] = *(const f16x8*)(qpe + 16 + 8 * hi); }
#pragma unroll
    for (int d0 = 0; d0 < NQK; ++d0) asm volatile("" : "+v"(qf[d0]));
    const int ksw = (r32 >> 1) & 7, psw = (r32 >> 2) & 3;
    int koff[4];
#pragma unroll
    for (int d0 = 0; d0 < 4; ++d0) koff[d0] = r32 * 128 + (((2 * d0 + hi) ^ ksw) << 4);
    int poff[2];
#pragma unroll
    for (int d0 = 0; d0 < 2; ++d0) poff[d0] = r32 * 64 + (((2 * d0 + hi) ^ psw) << 4);
    const int vq = (lane & 15) >> 2, vp = lane & 3, vg = (lane >> 4) & 1, vsw = (vq >> 1) & 1;
    int voff[2];
#pragma unroll
    for (int d0 = 0; d0 < 2; ++d0) voff[d0] = (4 * hi + vq) * 128 + ((d0 ^ vsw) << 6) + ((2 * vg + (vp >> 1)) << 4) + 8 * (vp & 1);
    unsigned sel = 0u; float slope2 = 0.f;
    if (KIND == 1) {
        slope2 = exp2f(-8.0f * (float)(hh + 1) / 5.0f) * LOG2E;
        if (qt >= 4) {
            if (tid < 64) { const int n = tid >> 3, cs = tid & 7, c = cs ^ ((n >> 1) & 7); const float* src = kmean + (size_t)(b * 8 + n) * 640 + hh * 64 + c * 8;
                const f32x4 a0 = (*(const f32x4*)src + *(const f32x4*)(src + 320)) * (1.f / 256.f), a1 = (*(const f32x4*)(src + 4) + *(const f32x4*)(src + 324)) * (1.f / 256.f);
                u32x4 w; w.x = pk_f16(a0[0], a0[1]); w.y = pk_f16(a0[2], a0[3]); w.z = pk_f16(a1[0], a1[1]); w.w = pk_f16(a1[2], a1[3]);
                *(LAS u32x4*)(lds + BUF_STRIDE + n * 128 + cs * 16) = w; }
            asm volatile("s_waitcnt lgkmcnt(0)\n\ts_barrier" ::: "memory");
            f32x16 pg = {};
#pragma unroll
            for (int d0 = 0; d0 < 4; ++d0) { const f16x8 kf = *(const LAS f16x8*)(lds + BUF_STRIDE + koff[d0]); pg = __builtin_amdgcn_mfma_f32_32x32x16_f16(kf, qf[d0], pg, 0, 0, 0); }
            float gt[8];
#pragma unroll
            for (int r = 0; r < 4; ++r) { const auto rr = __builtin_amdgcn_permlane32_swap(__float_as_uint(pg[r]), __float_as_uint(pg[r]), false, false); gt[r] = __uint_as_float(rr[0]); gt[4 + r] = __uint_as_float(rr[1]); }
#pragma unroll
            for (int n = 0; n < 8; ++n) { int rank = 0;
#pragma unroll
                for (int m = 0; m < 8; ++m) if (m != n) rank += (m < qt && (gt[m] > gt[n] || (gt[m] == gt[n] && m < n))) ? 1 : 0;
                if (n < qt && rank < 3) sel |= 1u << n; }
        } else sel = 0xffu;
    }
    float lg2 = 0.f, e32 = 0.f; float dc[16];
    if (KIND == 2) { lg2 = log2f(1.0f - exp2f(-5.0f - (float)hh)); e32 = exp2f(-32.0f * lg2);
#pragma unroll
        for (int r = 0; r < 16; ++r) dc[r] = exp2f(-lg2 * (float)crowc(r)); }
    f32x16 o0 = {}, o1 = {};
    float mref = 0.f, lsum = 0.f; bool mset = false;
    f32x16 negm = {};
    LAS float* wsf = (LAS float*)(lds + OFF_F) + wid * 32;
    for (int t = 0; t < NT; ++t) {
        ATT_WAIT_BAR();
        if (t + 1 < NT) ATT_DMA(t + 1, (t + 1) & 1);
        const int k0 = 64 * t;
        bool active = k0 <= q0w + 31;
        if (KIND == 1) { const int n = t >> 2; if (n < qt) active = __any((sel >> n) & 1u) != 0; }
        if (!active) continue;
        const LAS unsigned char* kb = lds + (t & 1) * BUF_STRIDE;
        f32x16 p0, p1;
        if (KIND == 1) { const float cb = slope2 * (float)(k0 + 4 * hi - qpos) - mref;
#pragma unroll
            for (int r = 0; r < 16; ++r) { p0[r] = fmaf(slope2, (float)crowc(r), cb); p1[r] = fmaf(slope2, (float)(crowc(r) + 32), cb); } }
        else if (KIND == 2) { p0 = (f32x16){}; p1 = (f32x16){}; }
#pragma unroll
        for (int d0 = 0; d0 < 4; ++d0) { const f16x8 k0f = *(const LAS f16x8*)(kb + koff[d0]), k1f = *(const LAS f16x8*)(kb + koff[d0] + 4096);
            if (KIND == 0 && d0 == 0) { p0 = __builtin_amdgcn_mfma_f32_32x32x16_f16(k0f, qf[d0], negm, 0, 0, 0); p1 = __builtin_amdgcn_mfma_f32_32x32x16_f16(k1f, qf[d0], negm, 0, 0, 0); }
            else { p0 = __builtin_amdgcn_mfma_f32_32x32x16_f16(k0f, qf[d0], p0, 0, 0, 0); p1 = __builtin_amdgcn_mfma_f32_32x32x16_f16(k1f, qf[d0], p1, 0, 0, 0); } }
        if (KIND == 0) {
#pragma unroll
            for (int d0 = 0; d0 < 2; ++d0) { const f16x8 k0f = *(const LAS f16x8*)(kb + OFF_PE + poff[d0]), k1f = *(const LAS f16x8*)(kb + OFF_PE + poff[d0] + 2048);
                p0 = __builtin_amdgcn_mfma_f32_32x32x16_f16(k0f, qf[4 + d0], p0, 0, 0, 0); p1 = __builtin_amdgcn_mfma_f32_32x32x16_f16(k1f, qf[4 + d0], p1, 0, 0, 0); } }
        const bool diag = k0 + 63 > q0w;
        const int kk = qpos - k0 - 4 * hi;
        u32x4 pw[4];
        if (KIND != 2) {
            if (diag) {
#pragma unroll
                for (int r = 0; r < 16; ++r) { if (crowc(r) > kk) p0[r] = -INFINITY; if (crowc(r) + 32 > kk) p1[r] = -INFINITY; } }
            if (KIND == 1) { const int n = t >> 2; if (n < qt && !((sel >> n) & 1u)) {
#pragma unroll
                for (int r = 0; r < 16; ++r) { p0[r] = -INFINITY; p1[r] = -INFINITY; } } }
            asm volatile("s_nop 15\n\ts_nop 7" : "+v"(p0), "+v"(p1));
            float rm = max3f(p0[0], p1[0], p0[1]);
            rm = max3f(rm, p1[1], p0[2]); rm = max3f(rm, p1[2], p0[3]); rm = max3f(rm, p1[3], p0[4]); rm = max3f(rm, p1[4], p0[5]); rm = max3f(rm, p1[5], p0[6]); rm = max3f(rm, p1[6], p0[7]);
            rm = max3f(rm, p1[7], p0[8]); rm = max3f(rm, p1[8], p0[9]); rm = max3f(rm, p1[9], p0[10]); rm = max3f(rm, p1[10], p0[11]); rm = max3f(rm, p1[11], p0[12]); rm = max3f(rm, p1[12], p0[13]);
            rm = max3f(rm, p1[13], p0[14]); rm = max3f(rm, p1[14], p0[15]); rm = max3f(rm, p1[15], p1[15]);
            rm = pswap_max(rm);
            const bool need = (rm > THR) || (!mset && rm > -INFINITY);
            if (__any(need)) {
                const float delta = need ? rm : 0.f, f = mset ? __builtin_amdgcn_exp2f(-delta) : 1.0f;
                mref += delta; mset = mset || need; lsum *= f;
#pragma unroll
                for (int r = 0; r < 16; ++r) { p0[r] -= delta; p1[r] -= delta; negm[r] = -mref; }
                if (hi == 0) wsf[r32] = f;
                asm volatile("s_waitcnt lgkmcnt(0)" ::: "memory");
#pragma unroll
                for (int r = 0; r < 16; ++r) { const float fr = wsf[crowc(r) + 4 * hi]; o0[r] *= fr; o1[r] *= fr; }
            }
            float ls = 0.f;
#pragma unroll
            for (int r = 0; r < 16; ++r) { p0[r] = __builtin_amdgcn_exp2f(p0[r]); p1[r] = __builtin_amdgcn_exp2f(p1[r]); ls += p0[r] + p1[r]; }
            lsum += ls;
        } else {
            const float et = __builtin_amdgcn_exp2f(lg2 * (float)kk);
#pragma unroll
            for (int r = 0; r < 16; ++r) { const float w = et * dc[r]; p0[r] *= w; p1[r] *= w * e32; }
            if (diag) {
#pragma unroll
                for (int r = 0; r < 16; ++r) { if (crowc(r) > kk) p0[r] = 0.f; if (crowc(r) + 32 > kk) p1[r] = 0.f; } }
        }
#pragma unroll
        for (int i = 0; i < 4; ++i) { pw[0][i] = pk_f16(p0[2 * i], p0[2 * i + 1]); pw[1][i] = pk_f16(p0[8 + 2 * i], p0[8 + 2 * i + 1]); pw[2][i] = pk_f16(p1[2 * i], p1[2 * i + 1]); pw[3][i] = pk_f16(p1[8 + 2 * i], p1[8 + 2 * i + 1]); }
        const LAS unsigned char* vb = kb + OFF_V;
#pragma unroll
        for (int ks = 0; ks < 4; ++ks) {
            const f16x8 pa = __builtin_bit_cast(f16x8, pw[ks]);
            const f16x8 v0 = vfrag(vb + voff[0] + ks * 2048, vb + voff[0] + ks * 2048 + 1024);
            const f16x8 v1 = vfrag(vb + voff[1] + ks * 2048, vb + voff[1] + ks * 2048 + 1024);
            o0 = __builtin_amdgcn_mfma_f32_32x32x16_f16(pa, v0, o0, 0, 0, 0);
            o1 = __builtin_amdgcn_mfma_f32_32x32x16_f16(pa, v1, o1, 0, 0, 0);
        }
    }
    LAS float* stg = (LAS float*)(lds + OFF_OSTG + wid * OSTG_WAVE);
#pragma unroll
    for (int r = 0; r < 16; ++r) { const int row = crowc(r) + 4 * hi; stg[row * 68 + r32] = o0[r]; stg[row * 68 + 32 + r32] = o1[r]; }
    LAS float* lrow = (LAS float*)(lds + OFF_L) + wid * 32;
    if (KIND != 2) { const float lt = pswap_sum(lsum); if (hi == 0) lrow[r32] = lt; }
    asm volatile("s_waitcnt lgkmcnt(0)" ::: "memory");
    {
        const int row = lane >> 1, half = lane & 1; float v[32];
#pragma unroll
        for (int i = 0; i < 8; ++i) { const f32x4 x = *(const LAS f32x4*)(stg + row * 68 + half * 32 + i * 4); v[4 * i] = x[0]; v[4 * i + 1] = x[1]; v[4 * i + 2] = x[2]; v[4 * i + 3] = x[3]; }
        const size_t grow = brow + q0w + row;
        if (KIND != 2) {
            const float inv = 1.0f / lrow[row]; float ss = 0.f;
#pragma unroll
            for (int i = 0; i < 32; ++i) { v[i] *= inv; ss += v[i] * v[i]; }
            ss += swz_xor<1>(ss);
            if (half == 0) ssq_o[grow * 16 + (KIND == 0 ? 0 : 6) + hh] = ss;
        } else {
            float s1 = 0.f;
#pragma unroll
            for (int i = 0; i < 32; ++i) s1 += v[i];
            s1 += swz_xor<1>(s1); const float mu = s1 * (1.f / 64.f); float s2 = 0.f;
#pragma unroll
            for (int i = 0; i < 32; ++i) { v[i] -= mu; s2 += v[i] * v[i]; }
            s2 += swz_xor<1>(s2); const float rs = 1.0f / sqrtf(s2 * (1.f / 64.f) + RMS_EPS);
            const f16* gp = hbuf + grow * HW + HC_RG + hh * 64 + half * 32;
#pragma unroll
            for (int c = 0; c < 4; ++c) { const f16x8 gv = *(const f16x8*)(gp + c * 8);
#pragma unroll
                for (int e = 0; e < 8; ++e) v[c * 8 + e] = silu_f((float)gv[e]) * (v[c * 8 + e] * rs); }
        }
        f16* op = obuf + grow * D + (KIND == 0 ? 0 : (KIND == 1 ? OC_MOBA : OC_RET)) + hh * 64 + half * 32;
#pragma unroll
        for (int c = 0; c < 4; ++c) { u32x4 w; w.x = pk_f16(v[c * 8], v[c * 8 + 1]); w.y = pk_f16(v[c * 8 + 2], v[c * 8 + 3]); w.z = pk_f16(v[c * 8 + 4], v[c * 8 + 5]); w.w = pk_f16(v[c * 8 + 6], v[c * 8 + 7]); *(u32x4*)(op + c * 8) = w; }
    }
#undef ATT_DMA
#undef ATT_GLDS
}
__device__ __forceinline__ void attn_phase(LAS unsigned char* lds, unsigned* qctr, const f16* qbuf, const f16* kvbuf, const f16* hbuf, const float* kmean, f16* obuf, float* ssq_o) {
    volatile LAS int* qw = (volatile LAS int*)(lds + OFF_QW);
    for (;;) {
        asm volatile("s_waitcnt vmcnt(0) lgkmcnt(0)\n\ts_barrier" ::: "memory");
        if (threadIdx.x == 0) qw[0] = (int)__hip_atomic_fetch_add(qctr, 1u, __ATOMIC_RELAXED, __HIP_MEMORY_SCOPE_AGENT);
        asm volatile("s_waitcnt vmcnt(0) lgkmcnt(0)\n\ts_barrier" ::: "memory");
        const int idx = __builtin_amdgcn_readfirstlane(qw[0]);
        if (idx >= 2048) break;
        const int qt = 7 - (idx >> 8), j = idx & 255;
        if (j < 96) attn_unit<0>(lds, j / 6, j % 6, qt, qbuf, kvbuf, hbuf, kmean, obuf, ssq_o);
        else if (j < 176) attn_unit<1>(lds, (j - 96) / 5, (j - 96) % 5, qt, qbuf, kvbuf, hbuf, kmean, obuf, ssq_o);
        else attn_unit<2>(lds, (j - 176) / 5, (j - 176) % 5, qt, qbuf, kvbuf, hbuf, kmean, obuf, ssq_o);
    }
}
#undef ATT_WAIT_BAR
}

constexpr int NWAVES = 8;
constexpr int PH_L0 = 1, PPL0 = 9, PH_L1 = PH_L0 + PPL0, PPL1 = 10, NPHASE = PH_L1 + PPL1;
typedef const __attribute__((address_space(4))) Args* KArgs;
__device__ __forceinline__ KArgs kargs() { KArgs p = (KArgs)__builtin_amdgcn_kernarg_segment_ptr(); asm volatile("" : "+s"(p)); return p; }
__device__ __forceinline__ Frame mkframe() {
    extern __shared__ __attribute__((aligned(16))) unsigned char lds_raw[];
    Frame F; F.lds = (LAS unsigned char*)lds_raw; int t = threadIdx.x; asm volatile("" : "+v"(t)); F.tid = t; F.lane = t & 63; F.wave = __builtin_amdgcn_readfirstlane(t >> 6); F.bid = blockIdx.x; F.G = gridDim.x; return F;
}
#define WSP(T_, off) ((T_*)(ws + (off)))

__device__ __forceinline__ void ph_prologue() {
    const Frame F = mkframe(); KArgs a = kargs(); unsigned char* ws = a->ws;
    const int gw = F.bid * NWAVES + F.wave, NGW = F.G * NWAVES;
    f16* Win = WSP(f16, WS_WIN); f16* Wuq = WSP(f16, WS_WUQ); f16* Wo = WSP(f16, WS_WO); unsigned char* Wgu = WSP(unsigned char, WS_WGU); unsigned char* Wdn = WSP(unsigned char, WS_WDN);
    unsigned char* Egu = WSP(unsigned char, WS_EGU); unsigned char* Edn = WSP(unsigned char, WS_EDN); f16* xb = WSP(f16, WS_XB);
    float* cosA = WSP(float, WS_ROPE); float* sinA = cosA + SEQ * 16; float* cosB = sinA + SEQ * 16; float* sinB = cosB + SEQ * 32;
    LAS float* scr = (LAS float*)(F.lds + F.wave * 16384);
    constexpr int I_WIN = (D / 64) * (HW / 32), I_UQ = (256 / 64) * (768 / 32), I_UKV = (128 / 64) * (768 / 32), I_WO = (D / 64) * (D / 32);
    constexpr int I_GU = (D / 64) * (2 * FF / 32), I_DN = (FF / 64) * (D / 32), I_EGU = (D / 64) * (2 * FE / 32), I_EDN = (FE / 64) * (D / 32);
    constexpr int N_SMALL = 2 * (I_WIN + I_UQ + I_UKV + I_WO) + I_GU + I_DN, N_ALL = N_SMALL + NE * (I_EGU + I_EDN);
    for (int it = gw; it < N_ALL; it += NGW) {
        int r = it;
        if (r < 2 * I_WIN) { const int l = r / I_WIN; r %= I_WIN; transpose_item(a->w_in + (size_t)l * D * HC_END, nullptr, D, HC_END, Win + (size_t)l * HW * D, CM_WIN, nullptr, nullptr, scr, r, HW / 32, F.lane); continue; } r -= 2 * I_WIN;
        if (r < 2 * I_UQ) { const int l = r / I_UQ; r %= I_UQ; transpose_item(a->w_uq + (size_t)l * 256 * 576, nullptr, 256, 576, Wuq + (size_t)l * 1536 * 256, CM_UQ, a->q_norm_g + l * 256, nullptr, scr, r, 768 / 32, F.lane); continue; } r -= 2 * I_UQ;
        if (r < 2 * I_UKV) { const int l = r / I_UKV; r %= I_UKV; transpose_item(a->w_ukv + (size_t)l * 128 * 768, nullptr, 128, 768, Wuq + (size_t)l * 1536 * 256 + (size_t)768 * 256, CM_UKV, a->kv_norm_g + l * 128, nullptr, scr, r, 768 / 32, F.lane, 256); continue; } r -= 2 * I_UKV;
        if (r < 2 * I_WO) { const int l = r / I_WO; r %= I_WO; transpose_item(a->w_o + (size_t)l * D * D, nullptr, D, D, Wo + (size_t)l * D * D, CM_ID, a->beta_mla + l * 384, a->beta_moba + l * 320, scr, r, D / 32, F.lane); continue; } r -= 2 * I_WO;
        if (r < I_GU) { transpose_item8(a->ffn_w_gate, a->ffn_w_up, D, FF, Wgu, CM_GU, scr, r, 2 * FF / 32, F.lane); continue; } r -= I_GU;
        if (r < I_DN) { transpose_item8(a->ffn_w_down, nullptr, FF, D, Wdn, CM_ID, scr, r, D / 32, F.lane); continue; } r -= I_DN;
        { const int e = r / (I_EGU + I_EDN); r %= (I_EGU + I_EDN);
          if (r < I_EGU) transpose_item8(a->exp_w_gate + (size_t)e * D * FE, a->exp_w_up + (size_t)e * D * FE, D, FE, Egu + (size_t)e * 2 * FE * D, CM_GU, scr, r, 2 * FE / 32, F.lane);
          else transpose_item8(a->exp_w_down + (size_t)e * FE * D, nullptr, FE, D, Edn + (size_t)e * D * FE, CM_ID, scr, r - I_EGU, D / 32, F.lane); }
    }
    for (int i = F.bid * 512 + F.tid; i < 2 * 768 * 16; i += F.G * 512) { const int l = i / (768 * 16), r = (i / 16) % 768, c = i % 16; *(u32x4*)(Wuq + (size_t)l * 1536 * 256 + (size_t)(768 + r) * 256 + 128 + c * 8) = (u32x4){0u, 0u, 0u, 0u}; }
    for (int i = F.bid * 512 + F.tid; i < SEQ * 48; i += F.G * 512) {
        if (i < SEQ * 16) { const int pos = i >> 4, j = i & 15; const float inv = powf(10000.0f, -(float)(2 * j) / 32.0f); const float ang = (float)pos * inv; cosA[i] = cosf(ang); sinA[i] = sinf(ang); }
        else { const int k = i - SEQ * 16, pos = k >> 5, j = k & 31; const float inv = powf(10000.0f, -(float)(2 * j) / 64.0f); const float ang = (float)pos * inv; cosB[k] = cosf(ang); sinB[k] = sinf(ang); }
    }
    const float* xin = a->x; const float* gp = a->ln_emb_g; const float* bp = a->ln_emb_b;
    for (int m = gw; m < T; m += NGW) {
        const f32x4* xr = (const f32x4*)(xin + (size_t)m * D) + F.lane; f32x4 v[4];
#pragma unroll
        for (int j = 0; j < 4; ++j) v[j] = xr[64 * j];
        float mean, rstd; ln_stats(v, mean, rstd);
        u32x2* o8 = (u32x2*)(xb + (size_t)m * D) + F.lane;
#pragma unroll
        for (int j = 0; j < 4; ++j) { const f32x4 g = *((const f32x4*)gp + F.lane + 64 * j), bb = *((const f32x4*)bp + F.lane + 64 * j); const f32x4 y = (v[j] - mean) * rstd * g + bb;
            u32x2 w; w.x = pk_f16(y[0], y[1]); w.y = pk_f16(y[2], y[3]); o8[64 * j] = w; }
    }
}
__device__ __forceinline__ void ph_A(int l) {
    const Frame F = mkframe(); KArgs a = kargs(); unsigned char* ws = a->ws;
    pg8::Gemm g{WSP(f16, WS_XB), D, WSP(f16, WS_WIN) + (size_t)l * HW * D, D, D, 0, 0}; pg8::StaticOrder S; S.init(T / 256, HW / 256, F.G, F.bid);
    const float* cosA = WSP(float, WS_ROPE);
    pg8::EpiWin E{WSP(f16, WS_H), WSP(float, WS_SSQ_Q), WSP(float, WS_SSQ_KV), WSP(float, WS_KMEAN), cosA, cosA + SEQ * 16, cosA + SEQ * 32, cosA + SEQ * 64};
    pg8::gemm_phase<pg8::EpiWin, pg8::StaticOrder, true>(F.lds, g, S, E);
}
__device__ __forceinline__ void ph_B(int l) {
    const Frame F = mkframe(); KArgs a = kargs(); unsigned char* ws = a->ws;
    pg8::Gemm g{WSP(f16, WS_H), HW, WSP(f16, WS_WUQ) + (size_t)l * 1536 * 256, 256, 256, 0, 0}; pg8::UpOrder S; S.so.init(T / 256, 6, F.G, F.bid);
    const float* cosA = WSP(float, WS_ROPE);
    pg8::EpiUp E{(f16*)a->out, (f16*)((unsigned char*)a->out + 48 * MiB), WSP(float, WS_SSQ_Q), WSP(float, WS_SSQ_KV), cosA, cosA + SEQ * 16};
    pg8::gemm_phase<pg8::EpiUp, pg8::UpOrder, true>(F.lds, g, S, E);
}
constexpr int CW_ATTQ = 8192;
__device__ __forceinline__ void ph_C(int l) {
    const Frame F = mkframe(); KArgs a = kargs(); unsigned char* ws = a->ws;
    att::attn_phase(F.lds, WSP(unsigned, WS_CTL) + CW_ATTQ + 64 * l, (const f16*)a->out, (const f16*)((unsigned char*)a->out + 48 * MiB), WSP(f16, WS_H), WSP(float, WS_KMEAN), WSP(f16, WS_O), WSP(float, WS_SSQ_O));
#if defined(PROBE_ATT)
    att::attn_phase(F.lds, WSP(unsigned, WS_CTL) + CW_ATTQ + 64 * (2 + l), (const f16*)a->out, (const f16*)((unsigned char*)a->out + 48 * MiB), WSP(f16, WS_H), WSP(float, WS_KMEAN), WSP(f16, WS_O), WSP(float, WS_SSQ_O));
#endif
}
__device__ __forceinline__ void ph_C2() {
    const Frame F = mkframe(); KArgs a = kargs(); unsigned char* ws = a->ws;
    const int gw = F.bid * NWAVES + F.wave, NGW = F.G * NWAVES;
    const float* ssq_o = WSP(float, WS_SSQ_O); f16* obuf = WSP(f16, WS_O);
    for (int m = gw; m < T; m += NGW) {
        const int lane = F.lane; const float* sp = ssq_o + (size_t)m * 16;
        const f32x4 s0 = *(const f32x4*)sp, s1 = *(const f32x4*)(sp + 4), s2 = *(const f32x4*)(sp + 8);
        const float sa = 1.0f / sqrtf(((s0[0] + s0[1]) + (s0[2] + s0[3]) + (s1[0] + s1[1])) * (1.f / 384.f) + RMS_EPS);
        const float sc = 1.0f / sqrtf(((s1[2] + s1[3]) + (s2[0] + s2[1]) + s2[2]) * (1.f / 320.f) + RMS_EPS);
        f16* orow = obuf + (size_t)m * D;
        if (lane < 48) { f16x8 v = *(const f16x8*)(orow + 8 * lane);
#pragma unroll
            for (int e = 0; e < 8; ++e) v[e] = (f16)((float)v[e] * sa);
            *(f16x8*)(orow + 8 * lane) = v; }
        if (lane >= 24) { f16x8 v = *(const f16x8*)(orow + 512 + 8 * lane);
#pragma unroll
            for (int e = 0; e < 8; ++e) v[e] = (f16)((float)v[e] * sc);
            *(f16x8*)(orow + 512 + 8 * lane) = v; }
    }
}
__device__ __forceinline__ void ph_D(int l) {
    const Frame F = mkframe(); KArgs a = kargs(); unsigned char* ws = a->ws;
    pg8::Gemm g{WSP(f16, WS_O), D, WSP(f16, WS_WO) + (size_t)l * D * D, D, D, 0, 0}; pg8::StaticOrder S; S.init(T / 256, D / 256, F.G, F.bid);
    pg8::EpiResF32 E{WSP(f16, WS_XB), (f16*)a->out, D, DN_ALPHA, 1.0f};
    pg8::gemm_phase<pg8::EpiResF32, pg8::StaticOrder, true>(F.lds, g, S, E);
}
__device__ __forceinline__ void ph_D2(int l) {
    const Frame F = mkframe(); KArgs a = kargs(); unsigned char* ws = a->ws;
    const f16* ybuf = (const f16*)a->out; f16* xb = WSP(f16, WS_XB); unsigned char* xq = WSP(unsigned char, WS_XQ); int* topi = WSP(int, WS_TOPI); float* topw = WSP(float, WS_TOPW); int* cnt = WSP(int, WS_CNT);
    const float* gp = a->ln1_g + l * D; const float* bp = a->ln1_b + l * D; const float* router = a->router;
    LAS int* lcnt = (LAS int*)(F.lds);
    for (int vw = F.bid; vw < 256; vw += F.G) {
        if (l == 1) { __syncthreads(); if (F.tid < 8) lcnt[F.tid] = 0; __syncthreads(); }
        for (int rr = F.wave; rr < 128; rr += NWAVES) {
            const int m = vw * 128 + rr; const int lane = F.lane;
            float v[16]; ln_load_y16(ybuf + (size_t)m * D, lane, v);
            float mean, rstd; ln_stats16(v, mean, rstd);
            ln_affine16(v, mean, rstd, gp, bp, lane);
            ln_store_xb16(xb + (size_t)m * D, lane, v);
#pragma unroll
            for (int h = 0; h < 2; ++h) { u32x2 w; w.x = pk_fp8x4(v[8 * h] * F8_XS, v[8 * h + 1] * F8_XS, v[8 * h + 2] * F8_XS, v[8 * h + 3] * F8_XS); w.y = pk_fp8x4(v[8 * h + 4] * F8_XS, v[8 * h + 5] * F8_XS, v[8 * h + 6] * F8_XS, v[8 * h + 7] * F8_XS);
                *(u32x2*)(xq + (size_t)m * D + 512 * h + 8 * lane) = w; }
            if (l == 1) {
                float lg[8];
#pragma unroll
                for (int e = 0; e < 8; ++e) lg[e] = 0.f;
#pragma unroll
                for (int i = 0; i < 16; ++i) { const int c = 512 * (i >> 3) + 8 * lane + (i & 7); const f32x4 r0 = *(const f32x4*)(router + (size_t)c * 8), r1 = *(const f32x4*)(router + (size_t)c * 8 + 4); const float xv = v[i];
                    lg[0] += xv * r0[0]; lg[1] += xv * r0[1]; lg[2] += xv * r0[2]; lg[3] += xv * r0[3]; lg[4] += xv * r1[0]; lg[5] += xv * r1[1]; lg[6] += xv * r1[2]; lg[7] += xv * r1[3]; }
#pragma unroll
                for (int e = 0; e < 8; ++e) lg[e] = wave_sum(lg[e]);
                if (lane == 0) {
                    int i0 = 0; float v0 = lg[0];
#pragma unroll
                    for (int e = 1; e < 8; ++e) if (lg[e] > v0) { v0 = lg[e]; i0 = e; }
                    int i1 = -1; float v1 = -INFINITY;
#pragma unroll
                    for (int e = 0; e < 8; ++e) if (e != i0 && lg[e] > v1) { v1 = lg[e]; i1 = e; }
                    const float e1 = __expf(v1 - v0), w0 = 1.0f / (1.0f + e1), w1 = e1 * w0;
                    topi[(size_t)m * 2] = i0; topi[(size_t)m * 2 + 1] = i1; topw[(size_t)m * 2] = w0; topw[(size_t)m * 2 + 1] = w1;
                    __hip_atomic_fetch_add(&lcnt[i0], 1, __ATOMIC_RELAXED, __HIP_MEMORY_SCOPE_WORKGROUP); __hip_atomic_fetch_add(&lcnt[i1], 1, __ATOMIC_RELAXED, __HIP_MEMORY_SCOPE_WORKGROUP);
                }
            }
        }
        if (l == 1) { __syncthreads(); if (F.tid < 8) cnt[vw * 8 + F.tid] = lcnt[F.tid]; }
    }
}
__device__ __forceinline__ void ph_E() {
    const Frame F = mkframe(); KArgs a = kargs(); unsigned char* ws = a->ws;
    pg8::Gemm g{WSP(unsigned char, WS_XQ), D, WSP(unsigned char, WS_WGU), D, D, F8_XE, F8_WE}; pg8::StaticOrder S; S.init(T / 256, 2 * FF / 256, F.G, F.bid);
    pg8::EpiSwiGLU E{WSP(unsigned char, WS_H), WSP(unsigned char, WS_H), 1 << 30, FF, 1.0f / (F8_XS * F8_WS)};
    pg8::gemm_phase<pg8::EpiSwiGLU, pg8::StaticOrder, true, true>(F.lds, g, S, E);
}
__device__ __forceinline__ void ph_F() {
    const Frame F = mkframe(); KArgs a = kargs(); unsigned char* ws = a->ws;
    pg8::Gemm g{WSP(unsigned char, WS_H), FF, WSP(unsigned char, WS_WDN), FF, FF, F8_HE, F8_WE}; pg8::StaticOrder S; S.init(T / 256, D / 256, F.G, F.bid);
    pg8::EpiResF32 E{WSP(f16, WS_XB), (f16*)a->out, D, DN_ALPHA, 1.0f / (F8_HS * F8_WS)};
    pg8::gemm_phase<pg8::EpiResF32, pg8::StaticOrder, true, true>(F.lds, g, S, E);
}
__device__ __forceinline__ void ph_F2d() {
    const Frame F = mkframe(); KArgs a = kargs(); unsigned char* ws = a->ws;
    const int gw = F.bid * NWAVES + F.wave, NGW = F.G * NWAVES;
    const f16* ybuf = (const f16*)a->out; f16* xb = WSP(f16, WS_XB); const float* gp = a->ln2_g; const float* bp = a->ln2_b;
    for (int m = gw; m < T; m += NGW) {
        float v[16]; ln_load_y16(ybuf + (size_t)m * D, F.lane, v);
        float mean, rstd; ln_stats16(v, mean, rstd);
        ln_affine16(v, mean, rstd, gp, bp, F.lane);
        ln_store_xb16(xb + (size_t)m * D, F.lane, v);
    }
}
__device__ __forceinline__ void ph_R3() {
    const Frame F = mkframe(); KArgs a = kargs(); unsigned char* ws = a->ws;
    const int* topi = WSP(int, WS_TOPI); const float* topw = WSP(float, WS_TOPW); const int* cnt = WSP(int, WS_CNT); int* rowtok = WSP(int, WS_ROWTOK); float* roww = WSP(float, WS_ROWW); int* pane = WSP(int, WS_PANE);
    LAS int* L = (LAS int*)F.lds;
    for (int vw = F.bid; vw < 256; vw += F.G) {
        __syncthreads();
        if (F.tid < 64) L[F.tid] = 0;
        __syncthreads();
        { const int e = F.tid & 7; int tot = 0, mine = 0;
#pragma unroll
          for (int k = 0; k < 4; ++k) { const int w = (F.tid >> 3) + 64 * k; const int c = cnt[w * 8 + e]; tot += c; if (w < vw) mine += c; }
          __hip_atomic_fetch_add(&L[e], tot, __ATOMIC_RELAXED, __HIP_MEMORY_SCOPE_WORKGROUP); __hip_atomic_fetch_add(&L[16 + e], mine, __ATOMIC_RELAXED, __HIP_MEMORY_SCOPE_WORKGROUP); }
        __syncthreads();
        if (F.tid == 0) { int b = 0; for (int e = 0; e < 8; ++e) { L[8 + e] = b; b += (L[e] + 255) & ~255; } L[24] = b; }
        int myexp = -1, myrank = 0; const int tok = vw * 128 + (F.tid >> 1), slot = F.tid & 1;
        if (F.tid < 256) myexp = topi[(size_t)tok * 2 + slot];
        if (F.tid < 256) {
#pragma unroll
            for (int e = 0; e < 8; ++e) { const unsigned long long mk = __ballot(myexp == e); const int below = __builtin_popcountll(mk & ((1ull << F.lane) - 1ull));
                if (myexp == e) myrank = below; if (F.lane == 0) L[32 + F.wave * 8 + e] = __builtin_popcountll(mk); }
        }
        __syncthreads();
        if (F.tid < 256) { int p = L[8 + myexp] + L[16 + myexp] + myrank; for (int w = 0; w < F.wave; ++w) p += L[32 + w * 8 + myexp];
            rowtok[p] = tok * 2 + slot; roww[p] = topw[(size_t)tok * 2 + slot]; }
        if (vw == 0) {
            for (int e = 0; e < 8; ++e) { const int s0 = L[8 + e] + L[e], s1 = L[8 + e] + ((L[e] + 255) & ~255);
                for (int p = s0 + F.tid; p < s1; p += 512) { rowtok[p] = -1; roww[p] = 0.f; }
                for (int p = (L[8 + e] >> 8) + F.tid; p < (s1 >> 8); p += 512) pane[p] = e; }
            if (F.tid == 0) pane[MOE_MAXP] = L[24] >> 8;
        }
    }
}
__device__ __forceinline__ void ph_M1() {
    const Frame F = mkframe(); KArgs a = kargs(); unsigned char* ws = a->ws;
    const int* pane = WSP(int, WS_PANE); const int np = pane[MOE_MAXP];
    pg8::Gemm g{WSP(unsigned char, WS_XQ), D, WSP(unsigned char, WS_EGU), D, D, F8_XE, F8_WE}; pg8::MoeGather S; S.so.init(np, 2 * FE / 256, F.G, F.bid); S.rowtok = WSP(int, WS_ROWTOK); S.pane = pane; S.estride = (size_t)2 * FE * D;
    pg8::EpiSwiGLU E{(unsigned char*)a->out, WSP(unsigned char, WS_H), MOE_SPLIT, FE, 1.0f / (F8_XS * F8_WS)};
    pg8::gemm_phase<pg8::EpiSwiGLU, pg8::MoeGather, true, true>(F.lds, g, S, E);
}
__device__ __forceinline__ void ph_M2() {
    const Frame F = mkframe(); KArgs a = kargs(); unsigned char* ws = a->ws;
    const int* pane = WSP(int, WS_PANE); const int np = pane[MOE_MAXP];
    pg8::Gemm g{(const unsigned char*)a->out, FE, WSP(unsigned char, WS_EDN), FE, FE, F8_HE, F8_WE}; pg8::MoeDense S; S.so.init(np, D / 256, F.G, F.bid); S.pane = pane; S.estride = (size_t)D * FE; S.A2 = (const char*)WSP(unsigned char, WS_H); S.split = MOE_SPLIT;
    pg8::EpiScatter E{WSP(f16, WS_C), (size_t)T * D, WSP(int, WS_ROWTOK), WSP(float, WS_ROWW), 1.0f / (F8_HS * F8_WS)};
    pg8::gemm_phase<pg8::EpiScatter, pg8::MoeDense, true, true>(F.lds, g, S, E);
}
__device__ __forceinline__ void ph_F2m() {
    const Frame F = mkframe(); KArgs a = kargs(); unsigned char* ws = a->ws;
    const int gw = F.bid * NWAVES + F.wave, NGW = F.G * NWAVES;
    const f16* xb = WSP(f16, WS_XB); const f16* c0buf = WSP(f16, WS_C); const f16* c1buf = c0buf + (size_t)T * D; float* out = a->out; const float* gp = a->ln2_g + D; const float* bp = a->ln2_b + D;
    for (int m = gw; m < T; m += NGW) {
        const int lane = F.lane; f32x4 v[4];
        const f16x4* xr = (const f16x4*)(xb + (size_t)m * D) + lane; const f16x4* c0r = (const f16x4*)(c0buf + (size_t)m * D) + lane; const f16x4* c1r = (const f16x4*)(c1buf + (size_t)m * D) + lane;
#pragma unroll
        for (int j = 0; j < 4; ++j) { const f16x4 xv = xr[64 * j], p0 = c0r[64 * j], p1 = c1r[64 * j];
#pragma unroll
            for (int e = 0; e < 4; ++e) v[j][e] = DN_ALPHA * (float)xv[e] + ((float)p0[e] + (float)p1[e]); }
        float mean, rstd; ln_stats(v, mean, rstd);
        f32x4* orow = (f32x4*)(out + (size_t)m * D) + lane;
#pragma unroll
        for (int j = 0; j < 4; ++j) { const f32x4 g = *((const f32x4*)gp + lane + 64 * j), bb = *((const f32x4*)bp + lane + 64 * j); orow[64 * j] = (v[j] - mean) * rstd * g + bb; }
    }
}

#ifndef SITE_MASK
#define SITE_MASK 0xFFFFFFFFu
#endif
#define SITE(n) (((SITE_MASK) >> (n)) & 1u)
__global__ void __launch_bounds__(NWAVES * 64, 2) mega_fwd(Args args_unused) {
    extern __shared__ __attribute__((aligned(16))) unsigned char lds_raw[];
    volatile LAS unsigned* MISC = (volatile LAS unsigned*)((LAS unsigned char*)lds_raw + MISC_OFF);
    if (threadIdx.x < 64) MISC[threadIdx.x] = 0u;
    __syncthreads();
#if MK_ONE_LAUNCH
    (void)xcd_barrier_post((unsigned*)(kargs()->ws + WS_CTL) + CW_BAR, MISC + 8);
#define GRID_BAR() do { XcdBarrier bar_; bar_.bar = (unsigned*)(kargs()->ws + WS_CTL) + CW_BAR; bar_.x = xb_xcc_id(); bar_.st = (volatile LAS unsigned*)((LAS unsigned char*)lds_raw + MISC_OFF) + 8; xcd_barrier(bar_); } while (0)
#else
#define GRID_BAR() do {} while (0)
#endif
    const int lo = kargs()->ph_lo, hi = kargs()->ph_hi;
#define IN(k) (lo <= (k) && (k) < hi)
#define SEAM(k) do { if (IN(k) && IN((k) + 1)) GRID_BAR(); } while (0)
    if (SITE(0) && IN(0)) ph_prologue();
#if defined(PROBE_PRO)
    if (SITE(0) && IN(0)) { __syncthreads(); ph_prologue(); }
#endif
    SEAM(0);
#pragma unroll
    for (int l = 0; l < 2; ++l) {
        const int pb = l == 0 ? PH_L0 : PH_L1;
        if (SITE(1) && IN(pb + 0)) ph_A(l);
        SEAM(pb + 0);
        if (SITE(3) && IN(pb + 1)) ph_B(l);
        SEAM(pb + 1);
        if (SITE(5) && IN(pb + 2)) ph_C(l);
        SEAM(pb + 2);
        if (SITE(6) && IN(pb + 3)) ph_C2();
        SEAM(pb + 3);
        if (SITE(7) && IN(pb + 4)) ph_D(l);
        SEAM(pb + 4);
        if (SITE(8) && IN(pb + 5)) ph_D2(l);
        SEAM(pb + 5);
        if (l == 0) {
            if (SITE(9) && IN(pb + 6)) ph_E();
            SEAM(pb + 6);
            if (SITE(10) && IN(pb + 7)) ph_F();
            SEAM(pb + 7);
            if (SITE(11) && IN(pb + 8)) ph_F2d();
            SEAM(pb + 8);
        } else {
            if (SITE(12) && IN(pb + 6)) ph_R3();
            SEAM(pb + 6);
            if (SITE(13) && IN(pb + 7)) ph_M1();
            SEAM(pb + 7);
            if (SITE(14) && IN(pb + 8)) ph_M2();
            SEAM(pb + 8);
            if (SITE(15) && IN(pb + 9)) ph_F2m();
        }
    }
#undef IN
#undef SEAM
}

extern "C" void kernel_launch(void* const* d_in, const int* in_sizes, int n_in, void* d_out, int out_size, void* d_ws, size_t ws_size, hipStream_t stream) {
    static int grid = 0;
    if (grid == 0) {
        if (n_in != 22 || in_sizes[0] != T * D || out_size != T * D || ws_size < WS_END) { fprintf(stderr, "kernel_launch: unexpected shapes / workspace (n_in %d, ws %zu)\n", n_in, ws_size); grid = -1; return; }
        int dev = 0, cus = 0;
        if (hipGetDevice(&dev) != hipSuccess || hipDeviceGetAttribute(&cus, hipDeviceAttributeMultiprocessorCount, dev) != hipSuccess) { grid = -1; return; }
        if (hipFuncSetAttribute((const void*)mega_fwd, hipFuncAttributeMaxDynamicSharedMemorySize, LDS_BYTES) != hipSuccess) { fprintf(stderr, "kernel_launch: hipFuncSetAttribute failed\n"); grid = -1; return; }
        int per_cu = 0;
        if (hipOccupancyMaxActiveBlocksPerMultiprocessor(&per_cu, (const void*)mega_fwd, NWAVES * 64, LDS_BYTES) != hipSuccess || per_cu < 1) { fprintf(stderr, "kernel_launch: occupancy query says %d\n", per_cu); }
        (void)hipGetLastError();
        grid = cus > 256 ? 256 : cus;
    }
    if (grid < 0) return;
    (void)hipMemsetAsync((char*)d_ws + WS_CTL, 0, CTL_ZERO_BYTES, stream);
    Args a{};
    a.x = (const float*)d_in[0]; a.ln_emb_g = (const float*)d_in[1]; a.ln_emb_b = (const float*)d_in[2]; a.w_in = (const float*)d_in[3]; a.q_norm_g = (const float*)d_in[4]; a.kv_norm_g = (const float*)d_in[5];
    a.w_uq = (const float*)d_in[6]; a.w_ukv = (const float*)d_in[7]; a.beta_mla = (const float*)d_in[8]; a.beta_moba = (const float*)d_in[9]; a.w_o = (const float*)d_in[10]; a.ln1_g = (const float*)d_in[11]; a.ln1_b = (const float*)d_in[12];
    a.ffn_w_gate = (const float*)d_in[13]; a.ffn_w_up = (const float*)d_in[14]; a.ffn_w_down = (const float*)d_in[15]; a.router = (const float*)d_in[16]; a.exp_w_gate = (const float*)d_in[17]; a.exp_w_up = (const float*)d_in[18];
    a.exp_w_down = (const float*)d_in[19]; a.ln2_g = (const float*)d_in[20]; a.ln2_b = (const float*)d_in[21];
    a.out = (float*)d_out; a.ws = (unsigned char*)d_ws;
#if MK_ONE_LAUNCH
    a.ph_lo = 0; a.ph_hi = NPHASE;
    hipLaunchKernelGGL(mega_fwd, dim3(grid), dim3(NWAVES * 64), LDS_BYTES, stream, a);
#else
    for (int p = 0; p < NPHASE; ++p) { a.ph_lo = p; a.ph_hi = p + 1; hipLaunchKernelGGL(mega_fwd, dim3(grid), dim3(NWAVES * 64), LDS_BYTES, stream, a); }
#endif
}
```

```cpp
#include <hip/hip_runtime.h>
#include <cstdio>
#include <cstdint>
#include <cmath>

#ifndef MK_ONE_LAUNCH
#define MK_ONE_LAUNCH 1
#endif

#define LAS __attribute__((address_space(3)))
#define GAS __attribute__((address_space(1)))
typedef _Float16 f16;
typedef _Float16 f16x2 __attribute__((ext_vector_type(2)));
typedef _Float16 f16x4 __attribute__((ext_vector_type(4)));
typedef _Float16 f16x8 __attribute__((ext_vector_type(8)));
typedef float f32x2 __attribute__((ext_vector_type(2)));
typedef float f32x4 __attribute__((ext_vector_type(4)));
typedef unsigned u32x2 __attribute__((ext_vector_type(2)));
typedef unsigned u32x4 __attribute__((ext_vector_type(4)));
typedef GAS unsigned gu32;
typedef int i32x4 __attribute__((ext_vector_type(4)));
typedef int i32x8 __attribute__((ext_vector_type(8)));

constexpr int BATCH = 16, SEQ = 2048, T = BATCH * SEQ, D = 1024;
constexpr int HW = 2816;
constexpr int HC_CQ = 0, HC_CKV = 256, HC_KR = 384, HC_RQ = 416, HC_RK = 736, HC_RV = 1056, HC_RG = 1376, HC_MQ = 1696, HC_MK = 2016, HC_MV = 2336, HC_END = 2656;
constexpr int QW = 768, KVW = 768;
constexpr int OC_RET = 384, OC_MOBA = 704;
constexpr int FF = 2816, FE = 3584, NE = 8;
constexpr float LN_EPS = 1e-5f, RMS_EPS = 1e-6f;
constexpr float DN_ALPHA = 1.41421356237f;
constexpr float LOG2E = 1.4426950408889634f;
constexpr float F8_XS = 8.0f, F8_HS = 16.0f, F8_WS = 256.0f; constexpr int F8_XE = 127 - 3, F8_HE = 127 - 4, F8_WE = 127 - 8;
constexpr int MOE_MAXP = 264;

constexpr size_t MiB = 1u << 20;
constexpr size_t WS_CTL = 0, CTL_ZERO_BYTES = 256 * 1024;
constexpr size_t WS_ROPE = 256 * 1024;
constexpr size_t WS_SSQ_Q = 1 * MiB;
constexpr size_t WS_SSQ_O = 2 * MiB;
constexpr size_t WS_KMEAN = 4 * MiB;
constexpr size_t WS_SSQ_KV = 18 * MiB + 512 * 1024;
constexpr size_t WS_TOPI = WS_KMEAN + 512 * 1024;
constexpr size_t WS_TOPW = WS_TOPI + (size_t)T * 8;
constexpr size_t WS_CNT = WS_TOPW + (size_t)T * 8;
constexpr size_t WS_ROWTOK = WS_CNT + 8192;
constexpr size_t WS_ROWW = WS_ROWTOK + (size_t)MOE_MAXP * 256 * 4;
constexpr size_t WS_PANE = WS_ROWW + (size_t)MOE_MAXP * 256 * 4;
constexpr size_t WS_WIN = 6 * MiB;
constexpr size_t WS_WUQ = 17 * MiB;
constexpr size_t WS_WO = 19 * MiB;
constexpr size_t WS_WGU = 23 * MiB;
constexpr size_t WS_WDN = 29 * MiB;
constexpr size_t WS_EGU = 32 * MiB;
constexpr size_t WS_EDN = 88 * MiB;
constexpr size_t WS_XB = 116 * MiB;
constexpr size_t WS_XQ = 180 * MiB;
constexpr size_t WS_H = 212 * MiB;
constexpr size_t WS_O = 388 * MiB;
constexpr size_t WS_C = 324 * MiB;
constexpr size_t WS_END = 452 * MiB;
constexpr int MOE_SPLIT = 146;
static_assert((size_t)MOE_SPLIT * 256 * FE <= 128 * MiB && WS_H + (size_t)(MOE_MAXP - MOE_SPLIT) * 256 * FE <= WS_C && WS_C + (size_t)2 * T * D * 2 <= WS_END, "MoE buffers");

constexpr int CW_TMO = 0, CW_BAR = 1024;

constexpr int RING_BYTES = 131072;
constexpr int MISC_OFF = RING_BYTES;
constexpr int LDS_BYTES = 147456;

__device__ __forceinline__ unsigned pk_f16(float lo, float hi) { f16x2 v = {(f16)lo, (f16)hi}; return __builtin_bit_cast(unsigned, v); }
template <int X> __device__ __forceinline__ float swz_xor(float v) { return __int_as_float(__builtin_amdgcn_ds_swizzle(__float_as_int(v), (X << 10) | 0x1f)); }
__device__ __forceinline__ float wave_sum(float v) {
    v += swz_xor<1>(v); v += swz_xor<2>(v); v += swz_xor<4>(v); v += swz_xor<8>(v); v += swz_xor<16>(v);
    const auto rr = __builtin_amdgcn_permlane32_swap(__float_as_uint(v), __float_as_uint(v), false, false);
    return __uint_as_float(rr[0]) + __uint_as_float(rr[1]);
}
__device__ __forceinline__ float clamp8(float x) { return fminf(fmaxf(x, -448.0f), 448.0f); }
__device__ __forceinline__ unsigned pk_fp8x4(float a, float b, float c, float d) { int w = 0; w = __builtin_amdgcn_cvt_pk_fp8_f32(clamp8(a), clamp8(b), w, false); w = __builtin_amdgcn_cvt_pk_fp8_f32(clamp8(c), clamp8(d), w, true); return (unsigned)w; }
__device__ __forceinline__ float silu_f(float x) { return x * __builtin_amdgcn_rcpf(1.f + __expf(-x)); }

#define XB_TMO      128
#define XB_XCNT(j)  (256  + 64 * (j))
#define XB_XSUB(j)  (1280 + 64 * (j))
#define XB_XGEN(j)  (2304 + 64 * (j))
#define XB_TOP      3328
#define XB_TOPGEN   3392
#define XCD_BAR_WORDS 3456
#define XB_SPIN_CAP (1u << 18)
__device__ __forceinline__ unsigned xb_ld(unsigned* p)              { return __hip_atomic_load(p, __ATOMIC_RELAXED, __HIP_MEMORY_SCOPE_AGENT); }
__device__ __forceinline__ unsigned xb_add(unsigned* p, unsigned v) { return __hip_atomic_fetch_add(p, v, __ATOMIC_RELAXED, __HIP_MEMORY_SCOPE_AGENT); }
__device__ __forceinline__ unsigned xb_xcc_id() { return (unsigned)__builtin_amdgcn_s_getreg((3 << 11) | 20) & 0xFu; }
#define XB_SPIN(cond, bar) do { unsigned _sp = 0; while (cond) { __builtin_amdgcn_s_sleep(1); \
    if ((++_sp & 255u) == 0u) { if (xb_ld(&(bar)[XB_TMO])) break; if (_sp > XB_SPIN_CAP) { atomicAdd(&(bar)[XB_TMO], 1u); break; } } } } while (0)
struct XcdBarrier { unsigned* bar; unsigned x; volatile LAS unsigned* st; };
__device__ __forceinline__ XcdBarrier xcd_barrier_post(unsigned* bar, volatile LAS unsigned* st) {
    XcdBarrier b; b.bar = bar; b.x = xb_xcc_id(); b.st = st;
    if (threadIdx.x == 0) (void)xb_add(&bar[XB_XCNT(b.x)], 1u);
    return b;
}
__device__ __forceinline__ void xcd_barrier_complete(unsigned* bar, unsigned x, unsigned& nloc, unsigned& nx) {
    const unsigned G = gridDim.x * gridDim.y * gridDim.z;
    unsigned sum, cnt, mine, sp = 0u;
    for (;;) {
        sum = 0u; cnt = 0u; mine = 0u;
#pragma unroll
        for (unsigned j = 0; j < 16; ++j) { const unsigned c = xb_ld(&bar[XB_XCNT(j)]); sum += c; cnt += (c > 0u) ? 1u : 0u; mine = (j == x) ? c : mine; }
        if (sum == G) break;
        __builtin_amdgcn_s_sleep(1);
        if ((++sp & 255u) == 0u) { if (xb_ld(&bar[XB_TMO])) break; if (sp > XB_SPIN_CAP) { atomicAdd(&bar[XB_TMO], 1u); break; } }
    }
    nloc = mine > 0u ? mine : 1u; nx = cnt > 0u ? cnt : 1u;
}
__device__ __forceinline__ void xcd_barrier(const XcdBarrier& b) {
    asm volatile("s_waitcnt vmcnt(0)" ::: "memory");
    __syncthreads();
    if (threadIdx.x == 0) {
        unsigned* bar = b.bar;
        __builtin_amdgcn_s_waitcnt(0);
        unsigned nloc = b.st[0], nx = b.st[1];
        if (nloc == 0u) { xcd_barrier_complete(bar, b.x, nloc, nx); b.st[0] = nloc; b.st[1] = nx; }
        const unsigned old = xb_add(&bar[XB_XSUB(b.x)], 1u);
        const unsigned gen = old / nloc;
        if (old + 1u == (gen + 1u) * nloc) {
            __builtin_amdgcn_fence(__ATOMIC_RELEASE, "agent");
            asm volatile("s_waitcnt vmcnt(0)" ::: "memory");
            const unsigned og = xb_add(&bar[XB_TOP], 1u);
            const unsigned tg = og / nx;
            if (og + 1u == (tg + 1u) * nx) xb_add(&bar[XB_TOPGEN], 1u);
            else XB_SPIN(xb_ld(&bar[XB_TOPGEN]) == tg, bar);
            __builtin_amdgcn_fence(__ATOMIC_ACQUIRE, "agent");
            xb_add(&bar[XB_XGEN(b.x)], 1u);
            asm volatile("s_waitcnt vmcnt(0)" ::: "memory");
        } else {
            XB_SPIN(xb_ld(&bar[XB_XGEN(b.x)]) == gen, bar);
            __builtin_amdgcn_fence(__ATOMIC_ACQUIRE, "agent");
            asm volatile("s_waitcnt vmcnt(0)" ::: "memory");
        }
    }
    __syncthreads();
}

namespace pg8 {
constexpr int BM = 256, BK = 64, HALF = 128, HTB = HALF * BK * 2, STAGE_BYTES = 8 * HTB, NXCD = 8, WGM = 8;
__host__ __device__ __forceinline__ int lds_byte(int r, int c) { const int st = (r >> 4) * 2 + (c >> 5), rr = r & 15, cc = c & 31, ob = rr * 64 + cc * 2; return st * 1024 + (ob ^ (((ob >> 9) & 1) << 5)); }
__host__ __device__ __forceinline__ void stage_rc(int b, int& R, int& C) { const int st = b / 1024, sb = b % 1024, swz = sb ^ (((sb >> 9) & 1) << 5); R = (st >> 1) * 16 + swz / 64; C = (st & 1) * 32 + (swz % 64) / 2; }
__host__ __device__ __forceinline__ int perm32(int rho) { const int n = rho >> 4, i = rho & 15; return 8 * (i >> 2) + 4 * n + (i & 3); }

struct Unit { int pm, pn; };
struct Gemm { const void* A; int lda; const void* Bt; int ldb; int K; int sa, sb; };

struct StaticOrder {
    static constexpr bool GATHER = false;
    int nM, nN, nwg, G, c, pm0;
    __device__ void init(int nM_, int nN_, int G_, int c_, int pm0_ = 0) { nM = nM_; nN = nN_; nwg = nM * nN; G = G_; c = c_; pm0 = pm0_; }
    __device__ bool next(int i, Unit& u) const {
        const long L = (long)i * G + c; if (L >= nwg) return false;
        int wgid = (int)L; { const int q = nwg / NXCD, r = nwg % NXCD, xcd = wgid % NXCD, off = wgid / NXCD; wgid = (xcd < r ? xcd * (q + 1) : r * (q + 1) + (xcd - r) * q) + off; }
        const int nig = WGM * nN, gid = wgid / nig, fm = gid * WGM, gsz = (nM - fm) < WGM ? (nM - fm) : WGM;
        u.pm = pm0 + fm + ((wgid % nig) % gsz); u.pn = (wgid % nig) / gsz; return true;
    }
    __device__ __forceinline__ int a_row(const Unit& u, int r) const { return u.pm * BM + r; }
    __device__ __forceinline__ size_t b_base(const Unit&) const { return 0; }
    __device__ __forceinline__ const char* a_tile(const Unit& u, const char* A, size_t rowb) const { return A + (size_t)u.pm * BM * rowb; }
};
struct UpOrder {
    static constexpr bool GATHER = false;
    StaticOrder so;
    __device__ bool next(int i, Unit& u) const { return so.next(i, u); }
    __device__ __forceinline__ int a_row(const Unit& u, int r) const { return u.pm * BM + r; }
    __device__ __forceinline__ size_t b_base(const Unit&) const { return 0; }
    __device__ __forceinline__ const char* a_tile(const Unit& u, const char* A, size_t rowb) const { return A + (size_t)u.pm * BM * rowb + (u.pn >= 3 ? (size_t)(HC_CKV * 2) : (size_t)0); }
};
struct MoeGather {
    static constexpr bool GATHER = true;
    StaticOrder so; const int* rowtok; const int* pane; size_t estride;
    __device__ bool next(int i, Unit& u) const { return so.next(i, u); }
    __device__ __forceinline__ int a_row(const Unit& u, int r) const { const int t = rowtok[u.pm * BM + r]; return t < 0 ? 0 : (t >> 1); }
    __device__ __forceinline__ size_t b_base(const Unit& u) const { return (size_t)pane[u.pm] * estride; }
    __device__ __forceinline__ const char* a_tile(const Unit&, const char* A, size_t) const { return A; }
};
struct MoeDense {
    static constexpr bool GATHER = false;
    StaticOrder so; const int* pane; size_t estride; const char* A2; int split;
    __device__ bool next(int i, Unit& u) const { return so.next(i, u); }
    __device__ __forceinline__ int a_row(const Unit& u, int r) const { return u.pm * BM + r; }
    __device__ __forceinline__ size_t b_base(const Unit& u) const { return (size_t)pane[u.pm] * estride; }
    __device__ __forceinline__ const char* a_tile(const Unit& u, const char* A, size_t rowb) const { return u.pm < split ? A + (size_t)u.pm * BM * rowb : A2 + (size_t)(u.pm - split) * BM * rowb; }
};

struct EpiF16 {
    static constexpr bool PERM = true;
    f16* O; int ldc;
    __device__ __forceinline__ void operator()(const f32x4 (&acc)[2][2][4][2], const Unit& u, int wr, int wc, int fr, int fq) const {
        const int row0 = u.pm * BM + wr * 64 + fr, col0 = u.pn * BM + wc * 32 + 8 * fq;
#pragma unroll
        for (int ai = 0; ai < 2; ++ai)
#pragma unroll
            for (int m = 0; m < 4; ++m) { f16* rowp = O + (size_t)(row0 + ai * HALF + m * 16) * ldc + col0;
#pragma unroll
                for (int bj = 0; bj < 2; ++bj) { const f32x4 v0 = acc[ai][bj][m][0], v1 = acc[ai][bj][m][1];
                    u32x4 w; w.x = pk_f16(v0[0], v0[1]); w.y = pk_f16(v0[2], v0[3]); w.z = pk_f16(v1[0], v1[1]); w.w = pk_f16(v1[2], v1[3]);
                    *(u32x4*)(rowp + bj * HALF) = w; } }
    }
};
__device__ __forceinline__ void rope8(float (&v)[8], const float* cs, const float* sn, int fq, float scale) {
    const f32x4 c0 = *(const f32x4*)cs, c1 = *(const f32x4*)(cs + 4), s0 = *(const f32x4*)sn, s1 = *(const f32x4*)(sn + 4);
    const float sg = fq < 2 ? -scale : scale;
#pragma unroll
    for (int e = 0; e < 8; ++e) { const auto rr = __builtin_amdgcn_permlane32_swap(__float_as_uint(v[e]), __float_as_uint(v[e]), false, false);
        const float other = fq < 2 ? __uint_as_float(rr[1]) : __uint_as_float(rr[0]);
        const float c = e < 4 ? c0[e & 3] : c1[e & 3], sn_ = e < 4 ? s0[e & 3] : s1[e & 3];
        v[e] = v[e] * (c * scale) + other * (sn_ * sg); }
}
__device__ __forceinline__ float sum_fq(float s) { s += swz_xor<16>(s); const auto rr = __builtin_amdgcn_permlane32_swap(__float_as_uint(s), __float_as_uint(s), false, false); return __uint_as_float(rr[0]) + __uint_as_float(rr[1]); }
struct EpiWin {
    static constexpr bool PERM = true;
    f16* H; float* ssq_q; float* ssq_kv; float* kpart; const float* cosA; const float* sinA; const float* cosB; const float* sinB;
    __device__ __forceinline__ void operator()(const f32x4 (&acc)[2][2][4][2], const Unit& u, int wr, int wc, int fr, int fq) const {
        const int row0 = u.pm * BM + wr * 64 + fr;
#pragma unroll
        for (int bj = 0; bj < 2; ++bj) {
            const int cg = u.pn * 8 + bj * 4 + wc;
            if (cg >= 83) continue;
            const int col0 = cg * 32 + 8 * fq;
            float ksum[8];
#pragma unroll
            for (int e = 0; e < 8; ++e) ksum[e] = 0.f;
#pragma unroll
            for (int ai = 0; ai < 2; ++ai)
#pragma unroll
                for (int m = 0; m < 4; ++m) {
                    const int row = row0 + ai * HALF + m * 16; const int pos = row & (SEQ - 1);
                    float v[8];
#pragma unroll
                    for (int e = 0; e < 4; ++e) { v[e] = acc[ai][bj][m][0][e]; v[4 + e] = acc[ai][bj][m][1][e]; }
                    if (cg < 12) {
                        float ss = 0.f;
#pragma unroll
                        for (int e = 0; e < 8; ++e) ss += v[e] * v[e];
                        ss = sum_fq(ss);
                        if (fq == 0) { if (cg < 8) ssq_q[(size_t)row * 8 + cg] = ss; else ssq_kv[(size_t)row * 4 + (cg - 8)] = ss; }
                    } else if (cg == 12) rope8(v, cosA + pos * 16 + 8 * (fq & 1), sinA + pos * 16 + 8 * (fq & 1), fq, 1.0f);
                    else if (cg < 23) rope8(v, cosB + pos * 32 + 16 * ((cg - 13) & 1) + 8 * (fq & 1), sinB + pos * 32 + 16 * ((cg - 13) & 1) + 8 * (fq & 1), fq, 1.0f);
                    else if (cg < 33) rope8(v, cosB + pos * 32 + 16 * ((cg - 23) & 1) + 8 * (fq & 1), sinB + pos * 32 + 16 * ((cg - 23) & 1) + 8 * (fq & 1), fq, 0.125f);
                    else if (cg >= 53 && cg < 63) {
#pragma unroll
                        for (int e = 0; e < 8; ++e) v[e] *= 0.125f * LOG2E; }
                    else if (cg >= 63 && cg < 73) {
#pragma unroll
                        for (int e = 0; e < 8; ++e) ksum[e] += v[e]; }
                    u32x4 w; w.x = pk_f16(v[0], v[1]); w.y = pk_f16(v[2], v[3]); w.z = pk_f16(v[4], v[5]); w.w = pk_f16(v[6], v[7]);
                    *(u32x4*)(H + (size_t)row * HW + col0) = w;
                }
            if (cg >= 63 && cg < 73) {
#pragma unroll
                for (int e = 0; e < 8; ++e) { float x = ksum[e]; x += swz_xor<1>(x); x += swz_xor<2>(x); x += swz_xor<4>(x); x += swz_xor<8>(x); ksum[e] = x; }
                if (fr == 0) { float* kp = kpart + ((size_t)u.pm * 2 + wr) * 320 + (cg - 63) * 32 + 8 * fq;
                    *(f32x4*)kp = (f32x4){ksum[0], ksum[1], ksum[2], ksum[3]}; *(f32x4*)(kp + 4) = (f32x4){ksum[4], ksum[5], ksum[6], ksum[7]}; }
            }
        }
    }
};
struct EpiUp {
    static constexpr bool PERM = true;
    f16* Oq; f16* Okv; const float* ssq_q; const float* ssq_kv; const float* cosA; const float* sinA;
    __device__ __forceinline__ void operator()(const f32x4 (&acc)[2][2][4][2], const Unit& u, int wr, int wc, int fr, int fq) const {
        const int row0 = u.pm * BM + wr * 64 + fr; const bool isq = u.pn < 3; const int pn = isq ? u.pn : u.pn - 3;
        f16* O = isq ? Oq : Okv; const int cg_end = isq ? 18 : 24;
#pragma unroll
        for (int ai = 0; ai < 2; ++ai)
#pragma unroll
            for (int m = 0; m < 4; ++m) {
                const int row = row0 + ai * HALF + m * 16; const int pos = row & (SEQ - 1);
                float rs;
                if (isq) { const f32x4 a = *(const f32x4*)(ssq_q + (size_t)row * 8), b = *(const f32x4*)(ssq_q + (size_t)row * 8 + 4); rs = (0.10206207261596575f * LOG2E) / sqrtf(((a[0] + a[1]) + (a[2] + a[3]) + (b[0] + b[1]) + (b[2] + b[3])) * (1.f / 256.f) + RMS_EPS); }
                else { const f32x4 a = *(const f32x4*)(ssq_kv + (size_t)row * 4); rs = 1.0f / sqrtf(((a[0] + a[1]) + (a[2] + a[3])) * (1.f / 128.f) + RMS_EPS); }
#pragma unroll
                for (int bj = 0; bj < 2; ++bj) {
                    const int cg = pn * 8 + bj * 4 + wc; if (cg >= cg_end) continue;
                    float v[8];
#pragma unroll
                    for (int e = 0; e < 4; ++e) { v[e] = acc[ai][bj][m][0][e] * rs; v[4 + e] = acc[ai][bj][m][1][e] * rs; }
                    if (isq && cg >= 12) rope8(v, cosA + pos * 16 + 8 * (fq & 1), sinA + pos * 16 + 8 * (fq & 1), fq, 1.0f);
                    u32x4 w; w.x = pk_f16(v[0], v[1]); w.y = pk_f16(v[2], v[3]); w.z = pk_f16(v[4], v[5]); w.w = pk_f16(v[6], v[7]);
                    *(u32x4*)(O + (size_t)row * QW + cg * 32 + 8 * fq) = w;
                }
            }
    }
};
struct EpiResF32 {
    static constexpr bool PERM = true;
    const f16* X; f16* Y; int ldc; float alpha; float ascale;
    __device__ __forceinline__ void operator()(const f32x4 (&acc)[2][2][4][2], const Unit& u, int wr, int wc, int fr, int fq) const {
        const int row0 = u.pm * BM + wr * 64 + fr, col0 = u.pn * BM + wc * 32 + 8 * fq;
#pragma unroll
        for (int ai = 0; ai < 2; ++ai)
#pragma unroll
            for (int m = 0; m < 4; ++m) { const size_t off = (size_t)(row0 + ai * HALF + m * 16) * ldc + col0;
#pragma unroll
                for (int bj = 0; bj < 2; ++bj) { const f16x8 xv = *(const f16x8*)(X + off + bj * HALF); const f32x4 a0 = acc[ai][bj][m][0] * ascale, a1 = acc[ai][bj][m][1] * ascale;
                    u32x4 w; w.x = pk_f16(alpha * (float)xv[0] + a0[0], alpha * (float)xv[1] + a0[1]); w.y = pk_f16(alpha * (float)xv[2] + a0[2], alpha * (float)xv[3] + a0[3]);
                    w.z = pk_f16(alpha * (float)xv[4] + a1[0], alpha * (float)xv[5] + a1[1]); w.w = pk_f16(alpha * (float)xv[6] + a1[2], alpha * (float)xv[7] + a1[3]);
                    *(u32x4*)(Y + off + bj * HALF) = w; } }
    }
};
struct EpiSwiGLU {
    static constexpr bool PERM = true;
    unsigned char* O; unsigned char* O2; int split; int ldc; float ascale;
    __device__ __forceinline__ void operator()(const f32x4 (&acc)[2][2][4][2], const Unit& u, int wr, int wc, int fr, int fq) const {
        unsigned char* base = u.pm < split ? O + (size_t)u.pm * BM * ldc : O2 + (size_t)(u.pm - split) * BM * ldc;
        const int row0 = wr * 64 + fr, col0 = u.pn * HALF + wc * 32 + 8 * fq;
#pragma unroll
        for (int ai = 0; ai < 2; ++ai)
#pragma unroll
            for (int m = 0; m < 4; ++m) { unsigned char* rowp = base + (size_t)(row0 + ai * HALF + m * 16) * ldc + col0;
                float r[8];
#pragma unroll
                for (int n = 0; n < 2; ++n)
#pragma unroll
                    for (int e = 0; e < 4; ++e) r[n * 4 + e] = silu_f(acc[ai][0][m][n][e] * ascale) * (acc[ai][1][m][n][e] * (ascale * F8_HS));
                u32x2 w; w.x = pk_fp8x4(r[0], r[1], r[2], r[3]); w.y = pk_fp8x4(r[4], r[5], r[6], r[7]);
                *(u32x2*)rowp = w; }
    }
};
struct EpiScatter {
    static constexpr bool PERM = true;
    f16* C0; size_t slot_stride; const int* rowtok; const float* roww; float ascale;
    __device__ __forceinline__ void operator()(const f32x4 (&acc)[2][2][4][2], const Unit& u, int wr, int wc, int fr, int fq) const {
        const int row0 = u.pm * BM + wr * 64 + fr, col0 = u.pn * BM + wc * 32 + 8 * fq;
#pragma unroll
        for (int ai = 0; ai < 2; ++ai)
#pragma unroll
            for (int m = 0; m < 4; ++m) { const int prow = row0 + ai * HALF + m * 16; const int ts = rowtok[prow]; const float w = roww[prow] * ascale;
                if (ts >= 0) { f16* rowp = C0 + (size_t)(ts & 1) * slot_stride + (size_t)(ts >> 1) * D + col0;
#pragma unroll
                    for (int bj = 0; bj < 2; ++bj) { const f32x4 v0 = acc[ai][bj][m][0] * w, v1 = acc[ai][bj][m][1] * w;
                        u32x4 o; o.x = pk_f16(v0[0], v0[1]); o.y = pk_f16(v0[2], v0[3]); o.z = pk_f16(v1[0], v1[1]); o.w = pk_f16(v1[2], v1[3]);
                        *(u32x4*)(rowp + bj * HALF) = o; } } }
    }
};

__device__ __forceinline__ const char* sgpr_ptr(const char* p) { const unsigned long long v = (unsigned long long)p; const unsigned lo = __builtin_amdgcn_readfirstlane((unsigned)v), hi = __builtin_amdgcn_readfirstlane((unsigned)(v >> 32)); return (const char*)(((unsigned long long)hi << 32) | lo); }
template <class Sched>
__device__ __forceinline__ void a_offsets(const Sched& S, const Unit& u, int rowb, int tid, unsigned (&ao)[2][2]) {
#pragma unroll
    for (int h = 0; h < 2; ++h)
#pragma unroll
        for (int i = 0; i < 2; ++i) { int R, C; stage_rc(tid * 16 + i * 8192, R, C); ao[h][i] = (unsigned)S.a_row(u, h * HALF + R) * (unsigned)rowb + (unsigned)C * 2u; }
}

template <class Epi, class Sched, bool ALIGN_EPI, bool F8 = false>
__device__ __forceinline__ void gemm_phase(LAS unsigned char* lds, const Gemm g, const Sched& S, const Epi& E) {
    constexpr bool GATHER = Sched::GATHER; constexpr int ESZ = F8 ? 1 : 2;
    int tid_ = threadIdx.x; asm volatile("" : "+v"(tid_));
    const int tid = tid_, wid = __builtin_amdgcn_readfirstlane(tid >> 6), lane = tid & 63, wr = wid >> 2, wc = wid & 3, fr = lane & 15, fq = lane >> 4;
    const int nt = g.K * ESZ / (BK * 2); const int rowA = g.lda * ESZ, rowB = g.ldb * ESZ;
    unsigned voffB[2], voffA[2];
#pragma unroll
    for (int i = 0; i < 2; ++i) { int R, C; stage_rc(tid * 16 + i * 8192, R, C); const int Rb = Epi::PERM ? ((R & ~31) + perm32(R & 31)) : R; voffB[i] = (unsigned)(Rb * rowB + C * 2); voffA[i] = (unsigned)(R * rowA + C * 2); }
    const size_t kstep = (size_t)(BK * 2);
    const size_t hstepB = (size_t)HALF * rowB, tstepB = 2 * hstepB;
    const size_t hstepA = (size_t)HALF * rowA;
    const unsigned ldsw = (unsigned)wid * 1024u;
    const int aoff = lds_byte(wr * 64 + fr, fq * 8), boff = lds_byte(wc * 32 + fr, fq * 8);
#define PG8_SA(b, h) (((b) * 2 + (h)) * HTB)
#define PG8_SB(b, h) ((4 + (b) * 2 + (h)) * HTB)
#define PG8_STAGEB(bufoff, gbase) do { _Pragma("unroll") for (int _i = 0; _i < 2; ++_i) \
        __builtin_amdgcn_global_load_lds((const unsigned*)(sgpr_ptr((const char*)(gbase)) + voffB[_i]), (LAS unsigned*)(lds + (bufoff) + ldsw + _i * 8192), 16, 0, 0); } while (0)
#define PG8_STAGEA(bufoff, ub, kb, h) do { _Pragma("unroll") for (int _i = 0; _i < 2; ++_i) \
        __builtin_amdgcn_global_load_lds((const unsigned*)(sgpr_ptr((ub) + (kb) + (GATHER ? (size_t)0 : (size_t)(h) * hstepA)) + (GATHER ? cao[h][_i] : voffA[_i])), (LAS unsigned*)(lds + (bufoff) + ldsw + _i * 8192), 16, 0, 0); } while (0)
#define PG8_LD16(p) (*(const LAS i32x4*)(p))
#define PG8_LDA(dst, b, h) do { _Pragma("unroll") for (int m = 0; m < 4; ++m) { const LAS unsigned char* p_ = lds + PG8_SA(b, h) + aoff + m * 2048; const i32x4 lo_ = PG8_LD16(p_), hi_ = PG8_LD16(p_ + 1024); dst[m] = __builtin_shufflevector(lo_, hi_, 0, 1, 2, 3, 4, 5, 6, 7); } } while (0)
#define PG8_LDB(dst, b, h) do { _Pragma("unroll") for (int n = 0; n < 2; ++n) { const LAS unsigned char* p_ = lds + PG8_SB(b, h) + boff + n * 2048; const i32x4 lo_ = PG8_LD16(p_), hi_ = PG8_LD16(p_ + 1024); dst[n] = __builtin_shufflevector(lo_, hi_, 0, 1, 2, 3, 4, 5, 6, 7); } } while (0)
#define PG8_HALF(x, k) __builtin_bit_cast(f16x8, __builtin_shufflevector(x, x, 4 * (k), 4 * (k) + 1, 4 * (k) + 2, 4 * (k) + 3))
#define PG8_MMA(ai, bj, At, Bt) do { __builtin_amdgcn_s_setprio(1); _Pragma("unroll") for (int m = 0; m < 4; ++m) _Pragma("unroll") for (int n = 0; n < 2; ++n) { \
        if constexpr (F8) asm volatile("v_mfma_f32_16x16x128_f8f6f4 %0, %1, %2, %0" : "+v"(acc[ai][bj][m][n]) : "v"(Bt[n]), "v"(At[m])); \
        else { acc[ai][bj][m][n] = __builtin_amdgcn_mfma_f32_16x16x32_f16(PG8_HALF(Bt[n], 0), PG8_HALF(At[m], 0), acc[ai][bj][m][n], 0, 0, 0); \
               acc[ai][bj][m][n] = __builtin_amdgcn_mfma_f32_16x16x32_f16(PG8_HALF(Bt[n], 1), PG8_HALF(At[m], 1), acc[ai][bj][m][n], 0, 0, 0); } } __builtin_amdgcn_s_setprio(0); } while (0)
#define PG8_WAIT_V(n) asm volatile("s_waitcnt vmcnt(" #n ")" ::: "memory")
#define PG8_WAIT_L(n) asm volatile("s_waitcnt lgkmcnt(" #n ")" ::: "memory")
#define PG8_BAR __builtin_amdgcn_s_barrier()
#define PG8_SCHED __builtin_amdgcn_sched_barrier(0)
    Unit cur, nxt; int ui = 0;
    if (!S.next(0, cur)) return;
    unsigned cao[2][2];
    if constexpr (GATHER) a_offsets(S, cur, rowA, tid, cao);
    const char* cA = S.a_tile(cur, (const char*)g.A, (size_t)rowA);
    const char* cB = (const char*)g.Bt + S.b_base(cur) + (size_t)cur.pn * tstepB;
    PG8_STAGEB(PG8_SB(0, 0), cB); PG8_STAGEB(PG8_SB(0, 1), cB + hstepB); PG8_STAGEA(PG8_SA(0, 0), cA, 0, 0); PG8_STAGEA(PG8_SA(0, 1), cA, 0, 1);
    if (wr == 1) PG8_BAR;
    PG8_WAIT_V(2); PG8_BAR;
    PG8_STAGEB(PG8_SB(1, 0), cB + kstep); PG8_STAGEA(PG8_SA(1, 0), cA, kstep, 0); PG8_STAGEB(PG8_SB(1, 1), cB + hstepB + kstep);
    PG8_WAIT_V(6); PG8_BAR;
    f32x4 acc[2][2][4][2];
#pragma unroll
    for (int a = 0; a < 2; ++a)
#pragma unroll
        for (int b = 0; b < 2; ++b)
#pragma unroll
            for (int m = 0; m < 4; ++m)
#pragma unroll
                for (int n = 0; n < 2; ++n) acc[a][b][m][n] = (f32x4){0.f, 0.f, 0.f, 0.f};
    i32x8 At[4], B0[2], B1[2];
    for (;;) {
        const bool has_next = S.next(ui + 1, nxt);
        const char* nB = cB; const char* nA = cA;
        if (has_next) { nB = (const char*)g.Bt + S.b_base(nxt) + (size_t)nxt.pn * tstepB; nA = S.a_tile(nxt, (const char*)g.A, (size_t)rowA); }
#pragma unroll 1
        for (int t = 0; t < nt; t += 2) {
            const bool last = (t == nt - 2);
            const size_t ka1 = (size_t)(t + 1) * kstep;
            const size_t ka2 = last ? 0 : (size_t)(t + 2) * kstep, ka3 = ka2 + kstep;
            const char* a2 = last ? nA : cA;
            const char* b2 = last ? nB : cB + (size_t)(t + 2) * kstep; const char* b3 = b2 + kstep;
            PG8_LDB(B0, 0, 0); PG8_LDB(B1, 0, 1); PG8_SCHED; PG8_LDA(At, 0, 0); PG8_STAGEA(PG8_SA(1, 1), cA, ka1, 1);
            if constexpr (GATHER) { if (last && has_next) a_offsets(S, nxt, rowA, tid, cao); }
            PG8_WAIT_V(8); PG8_WAIT_L(0); PG8_BAR; PG8_MMA(0, 0, At, B0); PG8_MMA(0, 1, At, B1); PG8_BAR; PG8_SCHED;
            PG8_LDA(At, 0, 1); PG8_STAGEB(PG8_SB(0, 0), b2); PG8_STAGEB(PG8_SB(0, 1), b2 + hstepB); PG8_STAGEA(PG8_SA(0, 0), a2, ka2, 0);
            PG8_WAIT_V(8); PG8_WAIT_L(0); PG8_BAR; PG8_MMA(1, 0, At, B0); PG8_MMA(1, 1, At, B1); PG8_BAR; PG8_SCHED;
            PG8_LDB(B0, 1, 0); PG8_LDB(B1, 1, 1); PG8_SCHED; PG8_LDA(At, 1, 0); PG8_STAGEA(PG8_SA(0, 1), a2, ka2, 1);
            PG8_WAIT_V(8); PG8_WAIT_L(0); PG8_BAR; PG8_MMA(0, 0, At, B0); PG8_MMA(0, 1, At, B1); PG8_BAR; PG8_SCHED;
            PG8_LDA(At, 1, 1); PG8_STAGEB(PG8_SB(1, 0), b3); PG8_STAGEB(PG8_SB(1, 1), b3 + hstepB); PG8_STAGEA(PG8_SA(1, 0), a2, ka3, 0);
            PG8_WAIT_V(8); PG8_WAIT_L(0); PG8_BAR; PG8_MMA(1, 0, At, B0); PG8_MMA(1, 1, At, B1); PG8_BAR; PG8_SCHED;
        }
        if constexpr (ALIGN_EPI) { if (wr == 0) PG8_BAR; }
        if constexpr (F8) asm volatile("s_nop 15\n\ts_nop 15" ::: "memory");
        { int t2 = threadIdx.x; asm volatile("" : "+v"(t2)); const int l2 = t2 & 63; E(acc, cur, wr, wc, l2 & 15, l2 >> 4); }
        if (!has_next) break;
#pragma unroll
        for (int a = 0; a < 2; ++a)
#pragma unroll
            for (int b = 0; b < 2; ++b)
#pragma unroll
                for (int m = 0; m < 4; ++m)
#pragma unroll
                    for (int n = 0; n < 2; ++n) acc[a][b][m][n] = (f32x4){0.f, 0.f, 0.f, 0.f};
        cur = nxt; cB = nB; cA = nA; ++ui;
        if constexpr (ALIGN_EPI) { if (wr == 1) PG8_BAR; }
    }
    PG8_WAIT_V(0);
    if constexpr (!ALIGN_EPI) { if (wr == 0) PG8_BAR; }
    PG8_BAR;
#undef PG8_SA
#undef PG8_SB
#undef PG8_STAGEA
#undef PG8_STAGEB
#undef PG8_LDA
#undef PG8_LDB
#undef PG8_MMA
#undef PG8_HALF
#undef PG8_LD16
#undef PG8_WAIT_V
#undef PG8_WAIT_L
#undef PG8_BAR
#undef PG8_SCHED
}
}

struct Args {
    const float* x; const float* ln_emb_g; const float* ln_emb_b; const float* w_in; const float* q_norm_g; const float* kv_norm_g;
    const float* w_uq; const float* w_ukv; const float* beta_mla; const float* beta_moba; const float* w_o; const float* ln1_g; const float* ln1_b;
    const float* ffn_w_gate; const float* ffn_w_up; const float* ffn_w_down; const float* router; const float* exp_w_gate; const float* exp_w_up;
    const float* exp_w_down; const float* ln2_g; const float* ln2_b;
    float* out; unsigned char* ws; int ph_lo, ph_hi;
};
struct Frame {
    LAS unsigned char* lds; int tid, lane, wave, bid, G;
};

enum { CM_ID = 0, CM_WIN = 1, CM_UQ = 2, CM_UKV = 3, CM_GU = 4 };
__device__ __forceinline__ int colmap(int kind, int n, int aux) {
    switch (kind) {
    case CM_WIN: {
        if (n >= HC_END) return -1;
        if (n >= HC_RQ && n < HC_RV) { const int base = n < HC_RK ? HC_RQ : HC_RK, r = n - base, hh = r >> 6, p = r & 63; const int d = ((p >> 5) << 4) + (p & 15) + ((p & 16) ? 32 : 0); return base + hh * 64 + d; }
        return n; }
    case CM_UQ: {
        if (n < 384) return (n >> 6) * 96 + (n & 63);
        if (n < 576) { const int r = n - 384; return (r >> 5) * 96 + 64 + (r & 31); }
        return -1; }
    case CM_UKV: {
        if (n < 384) return (n >> 6) * 128 + (n & 63);
        { const int r = n - 384; return (r >> 6) * 128 + 64 + (r & 63); } }
    case CM_GU: {
        const int j = n >> 8, w = n & 255; return j * 128 + (w & 127) + ((w >> 7) ? aux : 0); }
    default: return n;
    }
}
__device__ __forceinline__ void transpose_item(const float* W0, const float* W1, int K, int N, f16* WT, int kind, const float* kscale, const float* kscale2, LAS float* scr, int item, int nblk, int lane, int ldt = 0) {
    if (ldt == 0) ldt = K;
    const int kb = item / nblk, nb = item % nblk, k0 = 64 * kb, n0 = 32 * nb;
    const int nn = lane & 31; int sc = colmap(kind, n0 + nn, N); const float* W = W0;
    if (kind == CM_GU && sc >= N) { sc -= N; W = W1; }
#pragma unroll 8
    for (int i = 0; i < 32; ++i) { const int kk = 2 * i + (lane >> 5); float v = 0.f; if (sc >= 0) v = W[(size_t)(k0 + kk) * N + sc]; if (kscale2) { const int k = k0 + kk; v *= k < 384 ? kscale[k] : (k >= 704 ? kscale2[k - 704] : 1.0f); } else if (kscale) v *= kscale[k0 + kk]; scr[kk * 33 + nn] = v; }
    asm volatile("s_waitcnt lgkmcnt(0)" ::: "memory");
    const int c = lane & 7;
#pragma unroll
    for (int j = 0; j < 4; ++j) { const int n = (lane >> 3) + 8 * j; const LAS float* s = scr + (8 * c) * 33 + n;
        u32x4 o; o.x = pk_f16(s[0 * 33], s[1 * 33]); o.y = pk_f16(s[2 * 33], s[3 * 33]); o.z = pk_f16(s[4 * 33], s[5 * 33]); o.w = pk_f16(s[6 * 33], s[7 * 33]);
        *(u32x4*)(WT + (size_t)(n0 + n) * ldt + k0 + 8 * c) = o; }
    asm volatile("s_waitcnt lgkmcnt(0)" ::: "memory");
}

__device__ __forceinline__ void transpose_item8(const float* W0, const float* W1, int K, int N, unsigned char* WT, int kind, LAS float* scr, int item, int nblk, int lane) {
    const int kb = item / nblk, nb = item % nblk, k0 = 64 * kb, n0 = 32 * nb;
    const int nn = lane & 31; int sc = colmap(kind, n0 + nn, N); const float* W = W0;
    if (kind == CM_GU && sc >= N) { sc -= N; W = W1; }
#pragma unroll 8
    for (int i = 0; i < 32; ++i) { const int kk = 2 * i + (lane >> 5); scr[kk * 33 + nn] = W[(size_t)(k0 + kk) * N + sc] * F8_WS; }
    asm volatile("s_waitcnt lgkmcnt(0)" ::: "memory");
    const int c = lane & 3;
#pragma unroll
    for (int j = 0; j < 2; ++j) { const int n = (lane >> 2) + 16 * j; const LAS float* sp = scr + (16 * c) * 33 + n;
        u32x4 o; o.x = pk_fp8x4(sp[0 * 33], sp[1 * 33], sp[2 * 33], sp[3 * 33]); o.y = pk_fp8x4(sp[4 * 33], sp[5 * 33], sp[6 * 33], sp[7 * 33]);
        o.z = pk_fp8x4(sp[8 * 33], sp[9 * 33], sp[10 * 33], sp[11 * 33]); o.w = pk_fp8x4(sp[12 * 33], sp[13 * 33], sp[14 * 33], sp[15 * 33]);
        *(u32x4*)(WT + (size_t)(n0 + n) * K + k0 + 16 * c) = o; }
    asm volatile("s_waitcnt lgkmcnt(0)" ::: "memory");
}

__device__ __forceinline__ void ln_stats(const f32x4 (&v)[4], float& mean, float& rstd) {
    float s = 0.f;
#pragma unroll
    for (int j = 0; j < 4; ++j) s += (v[j][0] + v[j][1]) + (v[j][2] + v[j][3]);
    mean = wave_sum(s) * (1.f / D); float s2 = 0.f;
#pragma unroll
    for (int j = 0; j < 4; ++j) { const f32x4 d = v[j] - mean; s2 += (d[0] * d[0] + d[1] * d[1]) + (d[2] * d[2] + d[3] * d[3]); }
    rstd = 1.0f / sqrtf(wave_sum(s2) * (1.f / D) + LN_EPS);
}

__device__ __forceinline__ void ln_stats16(const float (&v)[16], float& mean, float& rstd) {
    float s = 0.f;
#pragma unroll
    for (int i = 0; i < 16; ++i) s += v[i];
    mean = wave_sum(s) * (1.f / D); float s2 = 0.f;
#pragma unroll
    for (int i = 0; i < 16; ++i) { const float d = v[i] - mean; s2 += d * d; }
    rstd = 1.0f / sqrtf(wave_sum(s2) * (1.f / D) + LN_EPS);
}
__device__ __forceinline__ void ln_load_y16(const f16* yrow, int lane, float (&v)[16]) {
    const f16x8 a = *(const f16x8*)(yrow + 8 * lane), b = *(const f16x8*)(yrow + 512 + 8 * lane);
#pragma unroll
    for (int e = 0; e < 8; ++e) { v[e] = (float)a[e]; v[8 + e] = (float)b[e]; }
}
__device__ __forceinline__ void ln_affine16(float (&v)[16], float mean, float rstd, const float* g, const float* b, int lane) {
#pragma unroll
    for (int h = 0; h < 2; ++h)
#pragma unroll
        for (int q = 0; q < 2; ++q) { const f32x4 gv = *(const f32x4*)(g + 512 * h + 8 * lane + 4 * q), bv = *(const f32x4*)(b + 512 * h + 8 * lane + 4 * q);
#pragma unroll
            for (int e = 0; e < 4; ++e) v[8 * h + 4 * q + e] = (v[8 * h + 4 * q + e] - mean) * rstd * gv[e] + bv[e]; }
}
__device__ __forceinline__ void ln_store_xb16(f16* xrow, int lane, const float (&v)[16]) {
#pragma unroll
    for (int h = 0; h < 2; ++h) { u32x4 w; w.x = pk_f16(v[8 * h], v[8 * h + 1]); w.y = pk_f16(v[8 * h + 2], v[8 * h + 3]); w.z = pk_f16(v[8 * h + 4], v[8 * h + 5]); w.w = pk_f16(v[8 * h + 6], v[8 * h + 7]); *(u32x4*)(xrow + 512 * h + 8 * lane) = w; }
}

template <int DK>
__device__ __forceinline__ void stage_kv(LAS float* Ks, LAS float* Vs, const f16* kp, int kld, const f16* k2p, int k2ld, const f16* vp, int vld, size_t row0, int tid) {
    constexpr int KCH = DK / 8;
    for (int t = tid; t < 32 * KCH + 32 * 8; t += 512) {
        if (t < 32 * KCH) { const int key = t / KCH, ch = t % KCH; const f16* src = (ch < 8) ? kp + (row0 + key) * kld + ch * 8 : k2p + (row0 + key) * k2ld + (ch - 8) * 8;
            const f16x8 v = *(const f16x8*)src; LAS float* d = Ks + key * DK + ch * 8;
#pragma unroll
            for (int e = 0; e < 8; ++e) d[e] = (float)v[e]; }
        else { const int t2 = t - 32 * KCH, key = t2 >> 3, ch = t2 & 7; const f16x8 v = *(const f16x8*)(vp + (row0 + key) * vld + ch * 8); LAS float* d = Vs + key * 64 + ch * 8;
#pragma unroll
            for (int e = 0; e < 8; ++e) d[e] = (float)v[e]; }
    }
}

template <int MODE>
__device__ __forceinline__ void attn_softmax_simple(const Frame& F, const f16* qb, const f16* kvb, const f16* hb, const float* kmean, f16* ob, float* ssq_o) {
    constexpr int DK = MODE == 0 ? 96 : 64, NHD = MODE == 0 ? 6 : 5;
    LAS float* Ks = (LAS float*)F.lds; LAS float* Vs = Ks + 32 * DK; LAS float* KM = Vs + 32 * 64;
    const int tid = F.tid;
    for (int unit = F.bid; unit < BATCH * NHD * 4; unit += F.G) {
        const int qt = 3 - (unit % 4), hh = (unit / 4) % NHD, b = unit / (4 * NHD);
        const size_t brow = (size_t)b * SEQ; const int qpos = qt * 512 + tid; const size_t row = brow + qpos;
        float q[DK];
        if (MODE == 0) {
#pragma unroll
            for (int c = 0; c < 8; ++c) { const f16x8 v = *(const f16x8*)(qb + row * QW + hh * 64 + c * 8);
#pragma unroll
                for (int e = 0; e < 8; ++e) q[c * 8 + e] = (float)v[e]; }
#pragma unroll
            for (int c = 0; c < 4; ++c) { const f16x8 v = *(const f16x8*)(qb + row * QW + 384 + hh * 32 + c * 8);
#pragma unroll
                for (int e = 0; e < 8; ++e) q[64 + c * 8 + e] = (float)v[e]; }
        } else {
#pragma unroll
            for (int c = 0; c < 8; ++c) { const f16x8 v = *(const f16x8*)(hb + row * HW + HC_MQ + hh * 64 + c * 8);
#pragma unroll
                for (int e = 0; e < 8; ++e) q[c * 8 + e] = (float)v[e]; }
        }
        const int blk = qpos >> 8; unsigned sel = 0u; float slope2 = 0.f;
        if (MODE == 1) {
            __syncthreads();
            { const int n = tid >> 6, d = tid & 63; KM[n * 64 + d] = kmean[(size_t)(b * 8 + n) * 320 + hh * 64 + d]; }
            __syncthreads();
            float gt[8];
#pragma unroll
            for (int n = 0; n < 8; ++n) { float s = 0.f;
#pragma unroll
                for (int d = 0; d < 64; ++d) s += q[d] * KM[n * 64 + d];
                gt[n] = s; }
#pragma unroll
            for (int n = 0; n < 8; ++n) { int rank = 0;
#pragma unroll
                for (int m = 0; m < 8; ++m) if (m < blk && m != n) rank += (gt[m] > gt[n] || (gt[m] == gt[n] && m < n)) ? 1 : 0;
                if (n < blk && rank < 3) sel |= 1u << n; }
            slope2 = exp2f(-8.0f * (float)(hh + 1) / 5.0f) * LOG2E;
        }
        float o[64];
#pragma unroll
        for (int d = 0; d < 64; ++d) o[d] = 0.f;
        float mrun = -INFINITY, lrun = 0.f;
        const int nkeys = (qt + 1) * 512;
        for (int k0 = 0; k0 < nkeys; k0 += 32) {
            __syncthreads();
            if (MODE == 0) stage_kv<96>(Ks, Vs, kvb + hh * 64, KVW, hb + HC_KR, HW, kvb + 384 + hh * 64, KVW, brow + k0, tid);
            else stage_kv<64>(Ks, Vs, hb + HC_MK + hh * 64, HW, nullptr, 0, hb + HC_MV + hh * 64, HW, brow + k0, tid);
            __syncthreads();
            bool part;
            if (MODE == 0) part = k0 <= qpos;
            else { const int n = k0 >> 8; part = (n == blk) ? (k0 <= qpos) : (n < blk && ((sel >> n) & 1u)); }
            if (part) {
#pragma unroll 1
                for (int j = 0; j < 32; ++j) {
                    if (k0 + j > qpos) break;
                    const LAS float* Kj = Ks + j * DK; const LAS float* Vj = Vs + j * 64;
                    float a = 0.f;
#pragma unroll
                    for (int d = 0; d < DK; d += 4) { const f32x4 kv4 = *(const LAS f32x4*)(Kj + d); a += q[d] * kv4[0] + q[d + 1] * kv4[1] + q[d + 2] * kv4[2] + q[d + 3] * kv4[3]; }
                    if (MODE == 1) a -= slope2 * (float)(qpos - (k0 + j));
                    if (a > mrun) { const float alpha = exp2f(mrun - a); lrun *= alpha;
#pragma unroll
                        for (int d = 0; d < 64; ++d) o[d] *= alpha;
                        mrun = a; }
                    const float p = exp2f(a - mrun); lrun += p;
#pragma unroll
                    for (int d = 0; d < 64; d += 4) { const f32x4 v4 = *(const LAS f32x4*)(Vj + d); o[d] += p * v4[0]; o[d + 1] += p * v4[1]; o[d + 2] += p * v4[2]; o[d + 3] += p * v4[3]; }
                }
            }
        }
        const float inv = 1.0f / lrun; float ss = 0.f;
#pragma unroll
        for (int d = 0; d < 64; ++d) { o[d] *= inv; ss += o[d] * o[d]; }
        f16* op = ob + row * D + (MODE == 0 ? 0 : OC_MOBA) + hh * 64;
#pragma unroll
        for (int c = 0; c < 8; ++c) { u32x4 w; w.x = pk_f16(o[c * 8], o[c * 8 + 1]); w.y = pk_f16(o[c * 8 + 2], o[c * 8 + 3]); w.z = pk_f16(o[c * 8 + 4], o[c * 8 + 5]); w.w = pk_f16(o[c * 8 + 6], o[c * 8 + 7]); *(u32x4*)(op + c * 8) = w; }
        ssq_o[row * 16 + (MODE == 0 ? 0 : 6) + hh] = ss;
    }
}
__device__ __forceinline__ void attn_ret_simple(const Frame& F, const f16* hb, f16* ob) {
    LAS float* Ks = (LAS float*)F.lds; LAS float* Vs = Ks + 32 * 64;
    const int tid = F.tid;
    for (int unit = F.bid; unit < BATCH * 5 * 4; unit += F.G) {
        const int qt = 3 - (unit % 4), hh = (unit / 4) % 5, b = unit / 20;
        const size_t brow = (size_t)b * SEQ; const int qpos = qt * 512 + tid; const size_t row = brow + qpos;
        float q[64];
#pragma unroll
        for (int c = 0; c < 8; ++c) { const f16x8 v = *(const f16x8*)(hb + row * HW + HC_RQ + hh * 64 + c * 8);
#pragma unroll
            for (int e = 0; e < 8; ++e) q[c * 8 + e] = (float)v[e]; }
        const float lg2 = log2f(1.0f - exp2f(-5.0f - (float)hh));
        float o[64];
#pragma unroll
        for (int d = 0; d < 64; ++d) o[d] = 0.f;
        const int nkeys = (qt + 1) * 512;
        for (int k0 = 0; k0 < nkeys; k0 += 32) {
            __syncthreads();
            stage_kv<64>(Ks, Vs, hb + HC_RK + hh * 64, HW, nullptr, 0, hb + HC_RV + hh * 64, HW, brow + k0, tid);
            __syncthreads();
            if (k0 <= qpos) {
#pragma unroll 1
                for (int j = 0; j < 32; ++j) {
                    const int dl = qpos - (k0 + j); if (dl < 0) break;
                    const LAS float* Kj = Ks + j * 64; const LAS float* Vj = Vs + j * 64;
                    float a = 0.f;
#pragma unroll
                    for (int d = 0; d < 64; d += 4) { const f32x4 kv4 = *(const LAS f32x4*)(Kj + d); a += q[d] * kv4[0] + q[d + 1] * kv4[1] + q[d + 2] * kv4[2] + q[d + 3] * kv4[3]; }
                    const float p = a * exp2f(lg2 * (float)dl);
#pragma unroll
                    for (int d = 0; d < 64; d += 4) { const f32x4 v4 = *(const LAS f32x4*)(Vj + d); o[d] += p * v4[0]; o[d + 1] += p * v4[1]; o[d + 2] += p * v4[2]; o[d + 3] += p * v4[3]; }
                }
            }
        }
        float mu = 0.f;
#pragma unroll
        for (int d = 0; d < 64; ++d) mu += o[d];
        mu *= (1.f / 64.f); float var = 0.f;
#pragma unroll
        for (int d = 0; d < 64; ++d) { const float t = o[d] - mu; var += t * t; }
        const float rs = 1.0f / sqrtf(var * (1.f / 64.f) + RMS_EPS);
        f16* op = ob + row * D + OC_RET + hh * 64; const f16* gp = hb + row * HW + HC_RG + hh * 64;
#pragma unroll
        for (int c = 0; c < 8; ++c) { const f16x8 gv = *(const f16x8*)(gp + c * 8); float r[8];
#pragma unroll
            for (int e = 0; e < 8; ++e) r[e] = silu_f((float)gv[e]) * ((o[c * 8 + e] - mu) * rs);
            u32x4 w; w.x = pk_f16(r[0], r[1]); w.y = pk_f16(r[2], r[3]); w.z = pk_f16(r[4], r[5]); w.w = pk_f16(r[6], r[7]); *(u32x4*)(op + c * 8) = w; }
    }
}

namespace att {
typedef float f32x16 __attribute__((ext_vector_type(16)));
typedef short s16x4 __attribute__((ext_vector_type(4)));
constexpr int BUF_STRIDE = 40960, OFF_V = 16384, OFF_PE = 32768, OFF_OSTG = 0, OSTG_WAVE = 32 * 272, OFF_L = MISC_OFF + 256, OFF_F = OFF_L + 1024, OFF_QW = OFF_F + 1024;
static_assert(2 * BUF_STRIDE <= RING_BYTES && 8 * OSTG_WAVE <= RING_BYTES && OFF_QW + 16 <= LDS_BYTES, "attention LDS map");
constexpr float THR = 8.0f;
__device__ __forceinline__ int crowc(int r) { return (r & 3) + 8 * (r >> 2); }
__device__ __forceinline__ float pswap_max(float v) { const auto rr = __builtin_amdgcn_permlane32_swap(__float_as_uint(v), __float_as_uint(v), false, false); return fmaxf(__uint_as_float(rr[0]), __uint_as_float(rr[1])); }
__device__ __forceinline__ float pswap_sum(float v) { const auto rr = __builtin_amdgcn_permlane32_swap(__float_as_uint(v), __float_as_uint(v), false, false); return __uint_as_float(rr[0]) + __uint_as_float(rr[1]); }
__device__ __forceinline__ float max3f(float a, float b, float c) { float r; asm("v_max3_f32 %0, %1, %2, %3" : "=v"(r) : "v"(a), "v"(b), "v"(c)); return r; }
#define ATT_WAIT_BAR() asm volatile("s_waitcnt vmcnt(0) lgkmcnt(0)\n\ts_barrier" ::: "memory")
__device__ __forceinline__ f16x8 vfrag(const LAS unsigned char* p0, const LAS unsigned char* p1) {
    const s16x4 lo = __builtin_bit_cast(s16x4, __builtin_amdgcn_ds_read_tr16_b64_v4i16((LAS s16x4*)p0));
    const s16x4 hi = __builtin_bit_cast(s16x4, __builtin_amdgcn_ds_read_tr16_b64_v4i16((LAS s16x4*)p1));
    typedef short s16x8 __attribute__((ext_vector_type(8)));
    const s16x8 v = {lo[0], lo[1], lo[2], lo[3], hi[0], hi[1], hi[2], hi[3]};
    return __builtin_bit_cast(f16x8, v);
}
template <int KIND>
__device__ __forceinline__ void attn_unit(LAS unsigned char* lds, int b, int hh, int qt, const f16* qbuf, const f16* kvbuf, const f16* hbuf, const float* kmean, f16* obuf, float* ssq_o) {
    int tid_ = threadIdx.x; asm volatile("" : "+v"(tid_));
    const int tid = tid_, lane = tid & 63, wid = __builtin_amdgcn_readfirstlane(tid >> 6), r32 = lane & 31, hi = lane >> 5;
    constexpr int NQK = KIND == 0 ? 6 : 4;
    const size_t brow = (size_t)b * SEQ;
    const int q0w = qt * 256 + wid * 32, qpos = q0w + r32;
    const f16* kbase; int kld; const f16* vbase; int vld; const f16* qrow;
    if (KIND == 0) { kbase = kvbuf + hh * 64; kld = KVW; vbase = kvbuf + 384 + hh * 64; vld = KVW; qrow = qbuf + (brow + qpos) * QW + hh * 64; }
    else if (KIND == 1) { kbase = hbuf + HC_MK + hh * 64; kld = HW; vbase = hbuf + HC_MV + hh * 64; vld = HW; qrow = hbuf + (brow + qpos) * HW + HC_MQ + hh * 64; }
    else { kbase = hbuf + HC_RK + hh * 64; kld = HW; vbase = hbuf + HC_RV + hh * 64; vld = HW; qrow = hbuf + (brow + qpos) * HW + HC_RQ + hh * 64; }
    const int dkey = 8 * wid + (lane >> 3), dcs = lane & 7;
    const char* ksrc = (const char*)(kbase + (brow + dkey) * kld + ((dcs ^ ((dkey >> 1) & 7)) << 3));
    const char* vsrc = (const char*)(vbase + (brow + dkey) * vld + (((((dcs >> 2) ^ ((dkey >> 1) & 1)) << 2) | (dcs & 3)) << 3));
    const int pkey = 16 * wid + (lane >> 2), pcs = lane & 3;
    const char* psrc = (const char*)(hbuf + (brow + pkey) * HW + HC_KR + ((pcs ^ ((pkey >> 2) & 3)) << 3));
    const size_t ktile = (size_t)64 * kld * 2, vtile = (size_t)64 * vld * 2, ptile = (size_t)64 * HW * 2;
#define ATT_GLDS(gsrc, ldsdst) do { unsigned keep_; asm volatile("s_mov_b32 %0, m0\n\ts_mov_b32 m0, %2\n\ts_nop 0\n\tglobal_load_lds_dwordx4 %1, off\n\ts_mov_b32 m0, %0" : "=&s"(keep_) : "v"(gsrc), "s"(ldsdst) : "memory"); } while (0)
    const unsigned lds0 = (unsigned)(size_t)lds + (unsigned)wid * 1024u;
#define ATT_DMA(st, buf) do { _Pragma("unroll") for (int j_ = 0; j_ < 2; ++j_) { \
        ATT_GLDS(ksrc + (size_t)(2 * (st) + j_) * ktile, (unsigned)__builtin_amdgcn_readfirstlane(lds0 + (buf) * BUF_STRIDE + j_ * 8192)); \
        ATT_GLDS(vsrc + (size_t)(2 * (st) + j_) * vtile, (unsigned)__builtin_amdgcn_readfirstlane(lds0 + (buf) * BUF_STRIDE + OFF_V + j_ * 8192)); \
        if (KIND == 0) { if (wid < 4) ATT_GLDS(psrc + (size_t)(2 * (st) + j_) * ptile, (unsigned)__builtin_amdgcn_readfirstlane(lds0 + (buf) * BUF_STRIDE + OFF_PE + j_ * 4096)); } } } while (0)
    const int NS = 2 * (qt + 1);
    ATT_DMA(0, 0);
    f16x8 qf[NQK];
#pragma unroll
    for (int d0 = 0; d0 < 4; ++d0) qf[d0] = *(const f16x8*)(qrow + 16 * d0 + 8 * hi);
    if (KIND == 0) { const f16* qpe = qbuf + (brow + qpos) * QW + 384 + hh * 32; qf[4] = *(const f16x8*)(qpe + 8 * hi); qf[5] = *(const f16x8*)(qpe + 16 + 8 * hi); }
#pragma unroll
    for (int d0 = 0; d0 < NQK; ++d0) asm volatile("" : "+v"(qf[d0]));
    const int ksw = (r32 >> 1) & 7, psw = (r32 >> 2) & 3;
    int koff[4];
#pragma unroll
    for (int d0 = 0; d0 < 4; ++d0) koff[d0] = r32 * 128 + (((2 * d0 + hi) ^ ksw) << 4);
    int poff[2];
#pragma unroll
    for (int d0 = 0; d0 < 2; ++d0) poff[d0] = r32 * 64 + (((2 * d0 + hi) ^ psw) << 4);
    const int vq = (lane & 15) >> 2, vp = lane & 3, vg = (lane >> 4) & 1, vsw = (vq >> 1) & 1;
    int voff[2];
#pragma unroll
    for (int d0 = 0; d0 < 2; ++d0) voff[d0] = (4 * hi + vq) * 128 + ((d0 ^ vsw) << 6) + ((2 * vg + (vp >> 1)) << 4) + 8 * (vp & 1);
    unsigned sel = 0u; float slope2 = 0.f;
    if (KIND == 1) {
        slope2 = exp2f(-8.0f * (float)(hh + 1) / 5.0f) * LOG2E;
        if (qt >= 4) {
            if (tid < 64) { const int n = tid >> 3, cs = tid & 7, c = cs ^ ((n >> 1) & 7); const float* src = kmean + (size_t)(b * 8 + n) * 640 + hh * 64 + c * 8;
                const f32x4 a0 = (*(const f32x4*)src + *(const f32x4*)(src + 320)) * (1.f / 256.f), a1 = (*(const f32x4*)(src + 4) + *(const f32x4*)(src + 324)) * (1.f / 256.f);
                u32x4 w; w.x = pk_f16(a0[0], a0[1]); w.y = pk_f16(a0[2], a0[3]); w.z = pk_f16(a1[0], a1[1]); w.w = pk_f16(a1[2], a1[3]);
                *(LAS u32x4*)(lds + BUF_STRIDE + n * 128 + cs * 16) = w; }
            asm volatile("s_waitcnt lgkmcnt(0)\n\ts_barrier" ::: "memory");
            f32x16 pg = {};
#pragma unroll
            for (int d0 = 0; d0 < 4; ++d0) { const f16x8 kf = *(const LAS f16x8*)(lds + BUF_STRIDE + koff[d0]); pg = __builtin_amdgcn_mfma_f32_32x32x16_f16(kf, qf[d0], pg, 0, 0, 0); }
            float gt[8];
#pragma unroll
            for (int r = 0; r < 4; ++r) { const auto rr = __builtin_amdgcn_permlane32_swap(__float_as_uint(pg[r]), __float_as_uint(pg[r]), false, false); gt[r] = __uint_as_float(rr[0]); gt[4 + r] = __uint_as_float(rr[1]); }
#pragma unroll
            for (int n = 0; n < 8; ++n) { int rank = 0;
#pragma unroll
                for (int m = 0; m < 8; ++m) if (m != n) rank += (m < qt && (gt[m] > gt[n] || (gt[m] == gt[n] && m < n))) ? 1 : 0;
                if (n < qt && rank < 3) sel |= 1u << n; }
        } else sel = 0xffu;
    }
    float lg2 = 0.f, e32 = 0.f; float dc[16];
    if (KIND == 2) { lg2 = log2f(1.0f - exp2f(-5.0f - (float)hh)); e32 = exp2f(-32.0f * lg2);
#pragma unroll
        for (int r = 0; r < 16; ++r) dc[r] = exp2f(-lg2 * (float)crowc(r)); }
    f32x16 o0 = {}, o1 = {};
    float mref = 0.f, lsum = 0.f; bool mset = false;
    f32x16 negm = {};
    LAS float* wsf = (LAS float*)(lds + OFF_F) + wid * 32;
    for (int st = 0; st < NS; ++st) {
        ATT_WAIT_BAR();
        if (st + 1 < NS) ATT_DMA(st + 1, (st + 1) & 1);
        const int k0 = 128 * st;
        bool active = k0 <= q0w + 31;
        if (KIND == 1) { const int n = st >> 1; if (n < qt) active = __any((sel >> n) & 1u) != 0; }
        if (!active) continue;
        const bool act1 = (KIND == 1 && (st >> 1) < qt) ? true : (k0 + 64 <= q0w + 31);
        const LAS unsigned char* kb = lds + (st & 1) * BUF_STRIDE;
        f32x16 p[4];
#pragma unroll
        for (int j = 0; j < 2; ++j) {
            if (j == 1 && !act1) break;
            if (KIND == 1) { const float cb = slope2 * (float)(k0 + 64 * j + 4 * hi - qpos) - mref;
#pragma unroll
                for (int r = 0; r < 16; ++r) { p[2 * j][r] = fmaf(slope2, (float)crowc(r), cb); p[2 * j + 1][r] = fmaf(slope2, (float)(crowc(r) + 32), cb); } }
            else if (KIND == 2) { p[2 * j] = (f32x16){}; p[2 * j + 1] = (f32x16){}; }
#pragma unroll
            for (int d0 = 0; d0 < 4; ++d0) { const f16x8 k0f = *(const LAS f16x8*)(kb + j * 8192 + koff[d0]), k1f = *(const LAS f16x8*)(kb + j * 8192 + koff[d0] + 4096);
                if (KIND == 0 && d0 == 0) { p[2 * j] = __builtin_amdgcn_mfma_f32_32x32x16_f16(k0f, qf[d0], negm, 0, 0, 0); p[2 * j + 1] = __builtin_amdgcn_mfma_f32_32x32x16_f16(k1f, qf[d0], negm, 0, 0, 0); }
                else { p[2 * j] = __builtin_amdgcn_mfma_f32_32x32x16_f16(k0f, qf[d0], p[2 * j], 0, 0, 0); p[2 * j + 1] = __builtin_amdgcn_mfma_f32_32x32x16_f16(k1f, qf[d0], p[2 * j + 1], 0, 0, 0); } }
            if (KIND == 0) {
#pragma unroll
                for (int d0 = 0; d0 < 2; ++d0) { const f16x8 k0f = *(const LAS f16x8*)(kb + OFF_PE + j * 4096 + poff[d0]), k1f = *(const LAS f16x8*)(kb + OFF_PE + j * 4096 + poff[d0] + 2048);
                    p[2 * j] = __builtin_amdgcn_mfma_f32_32x32x16_f16(k0f, qf[4 + d0], p[2 * j], 0, 0, 0); p[2 * j + 1] = __builtin_amdgcn_mfma_f32_32x32x16_f16(k1f, qf[4 + d0], p[2 * j + 1], 0, 0, 0); } }
        }
        if (!act1) { p[2] = (f32x16){}; p[3] = (f32x16){};
#pragma unroll
            for (int r = 0; r < 16; ++r) { p[2][r] = KIND == 2 ? 0.f : -INFINITY; p[3][r] = KIND == 2 ? 0.f : -INFINITY; } }
        u32x4 pw[8];
        if (KIND != 2) {
#pragma unroll
            for (int j = 0; j < 2; ++j) { const bool diag = k0 + 64 * j + 63 > q0w; const int kk = qpos - k0 - 64 * j - 4 * hi;
                if (diag && (j == 0 || act1)) {
#pragma unroll
                    for (int r = 0; r < 16; ++r) { if (crowc(r) > kk) p[2 * j][r] = -INFINITY; if (crowc(r) + 32 > kk) p[2 * j + 1][r] = -INFINITY; } } }
            if (KIND == 1) { const int n = st >> 1; if (n < qt && !((sel >> n) & 1u)) {
#pragma unroll
                for (int r = 0; r < 16; ++r) { p[0][r] = -INFINITY; p[1][r] = -INFINITY; p[2][r] = -INFINITY; p[3][r] = -INFINITY; } } }
            asm volatile("s_nop 15\n\ts_nop 7" : "+v"(p[0]), "+v"(p[1]), "+v"(p[2]), "+v"(p[3]));
            float rm = max3f(p[0][0], p[1][0], p[2][0]), rm2 = max3f(p[3][0], p[0][1], p[1][1]);
#pragma unroll
            for (int r = 1; r < 16; ++r) { rm = max3f(rm, p[0][r], p[1][r]); rm2 = max3f(rm2, p[2][r], p[3][r]); }
            rm = max3f(rm, rm2, p[2][1]); rm = max3f(rm, p[3][1], p[2][0]);
            rm = pswap_max(rm);
            const bool need = (rm > THR) || (!mset && rm > -INFINITY);
            if (__any(need)) {
                const float delta = need ? rm : 0.f, f = mset ? __builtin_amdgcn_exp2f(-delta) : 1.0f;
                mref += delta; mset = mset || need; lsum *= f;
#pragma unroll
                for (int r = 0; r < 16; ++r) { p[0][r] -= delta; p[1][r] -= delta; p[2][r] -= delta; p[3][r] -= delta; negm[r] = -mref; }
                if (hi == 0) wsf[r32] = f;
                asm volatile("s_waitcnt lgkmcnt(0)" ::: "memory");
#pragma unroll
                for (int r = 0; r < 16; ++r) { const float fr = wsf[crowc(r) + 4 * hi]; o0[r] *= fr; o1[r] *= fr; }
            }
            float ls = 0.f, ls2 = 0.f;
#pragma unroll
            for (int r = 0; r < 16; ++r) { p[0][r] = __builtin_amdgcn_exp2f(p[0][r]); p[1][r] = __builtin_amdgcn_exp2f(p[1][r]); p[2][r] = __builtin_amdgcn_exp2f(p[2][r]); p[3][r] = __builtin_amdgcn_exp2f(p[3][r]);
                ls += p[0][r] + p[1][r]; ls2 += p[2][r] + p[3][r]; }
            lsum += ls + ls2;
        } else {
#pragma unroll
            for (int j = 0; j < 2; ++j) { if (j == 1 && !act1) break;
                const bool diag = k0 + 64 * j + 63 > q0w; const int kk = qpos - k0 - 64 * j - 4 * hi;
                const float et = __builtin_amdgcn_exp2f(lg2 * (float)kk);
#pragma unroll
                for (int r = 0; r < 16; ++r) { const float w = et * dc[r]; p[2 * j][r] *= w; p[2 * j + 1][r] *= w * e32; }
                if (diag) {
#pragma unroll
                    for (int r = 0; r < 16; ++r) { if (crowc(r) > kk) p[2 * j][r] = 0.f; if (crowc(r) + 32 > kk) p[2 * j + 1][r] = 0.f; } } }
        }
#pragma unroll
        for (int q4 = 0; q4 < 4; ++q4)
#pragma unroll
            for (int i = 0; i < 4; ++i) { pw[2 * q4][i] = pk_f16(p[q4][2 * i], p[q4][2 * i + 1]); pw[2 * q4 + 1][i] = pk_f16(p[q4][8 + 2 * i], p[q4][8 + 2 * i + 1]); }
        const LAS unsigned char* vb = kb + OFF_V;
#pragma unroll
        for (int ks = 0; ks < 8; ++ks) {
            if (ks == 4 && !act1) break;
            const f16x8 pa = __builtin_bit_cast(f16x8, pw[ks]);
            const f16x8 v0 = vfrag(vb + voff[0] + ks * 2048, vb + voff[0] + ks * 2048 + 1024);
            const f16x8 v1 = vfrag(vb + voff[1] + ks * 2048, vb + voff[1] + ks * 2048 + 1024);
            o0 = __builtin_amdgcn_mfma_f32_32x32x16_f16(pa, v0, o0, 0, 0, 0);
            o1 = __builtin_amdgcn_mfma_f32_32x32x16_f16(pa, v1, o1, 0, 0, 0);
        }
    }
    ATT_WAIT_BAR();
    LAS float* stg = (LAS float*)(lds + OFF_OSTG + wid * OSTG_WAVE);
#pragma unroll
    for (int r = 0; r < 16; ++r) { const int row = crowc(r) + 4 * hi; stg[row * 68 + r32] = o0[r]; stg[row * 68 + 32 + r32] = o1[r]; }
    LAS float* lrow = (LAS float*)(lds + OFF_L) + wid * 32;
    if (KIND != 2) { const float lt = pswap_sum(lsum); if (hi == 0) lrow[r32] = lt; }
    asm volatile("s_waitcnt lgkmcnt(0)" ::: "memory");
    {
        const int row = lane >> 1, half = lane & 1; float v[32];
#pragma unroll
        for (int i = 0; i < 8; ++i) { const f32x4 x = *(const LAS f32x4*)(stg + row * 68 + half * 32 + i * 4); v[4 * i] = x[0]; v[4 * i + 1] = x[1]; v[4 * i + 2] = x[2]; v[4 * i + 3] = x[3]; }
        const size_t grow = brow + q0w + row;
        if (KIND != 2) {
            const float inv = 1.0f / lrow[row]; float ss = 0.f;
#pragma unroll
            for (int i = 0; i < 32; ++i) { v[i] *= inv; ss += v[i] * v[i]; }
            ss += swz_xor<1>(ss);
            if (half == 0) ssq_o[grow * 16 + (KIND == 0 ? 0 : 6) + hh] = ss;
        } else {
            float s1 = 0.f;
#pragma unroll
            for (int i = 0; i < 32; ++i) s1 += v[i];
            s1 += swz_xor<1>(s1); const float mu = s1 * (1.f / 64.f); float s2 = 0.f;
#pragma unroll
            for (int i = 0; i < 32; ++i) { v[i] -= mu; s2 += v[i] * v[i]; }
            s2 += swz_xor<1>(s2); const float rs = 1.0f / sqrtf(s2 * (1.f / 64.f) + RMS_EPS);
            const f16* gp = hbuf + grow * HW + HC_RG + hh * 64 + half * 32;
#pragma unroll
            for (int c = 0; c < 4; ++c) { const f16x8 gv = *(const f16x8*)(gp + c * 8);
#pragma unroll
                for (int e = 0; e < 8; ++e) v[c * 8 + e] = silu_f((float)gv[e]) * (v[c * 8 + e] * rs); }
        }
        f16* op = obuf + grow * D + (KIND == 0 ? 0 : (KIND == 1 ? OC_MOBA : OC_RET)) + hh * 64 + half * 32;
#pragma unroll
        for (int c = 0; c < 4; ++c) { u32x4 w; w.x = pk_f16(v[c * 8], v[c * 8 + 1]); w.y = pk_f16(v[c * 8 + 2], v[c * 8 + 3]); w.z = pk_f16(v[c * 8 + 4], v[c * 8 + 5]); w.w = pk_f16(v[c * 8 + 6], v[c * 8 + 7]); *(u32x4*)(op + c * 8) = w; }
    }
#undef ATT_DMA
#undef ATT_GLDS
}
__device__ __forceinline__ void attn_phase(LAS unsigned char* lds, unsigned* qctr, const f16* qbuf, const f16* kvbuf, const f16* hbuf, const float* kmean, f16* obuf, float* ssq_o) {
    volatile LAS int* qw = (volatile LAS int*)(lds + OFF_QW);
    for (;;) {
        asm volatile("s_waitcnt vmcnt(0) lgkmcnt(0)\n\ts_barrier" ::: "memory");
        if (threadIdx.x == 0) qw[0] = (int)__hip_atomic_fetch_add(qctr, 1u, __ATOMIC_RELAXED, __HIP_MEMORY_SCOPE_AGENT);
        asm volatile("s_waitcnt vmcnt(0) lgkmcnt(0)\n\ts_barrier" ::: "memory");
        const int idx = __builtin_amdgcn_readfirstlane(qw[0]);
        if (idx >= 2048) break;
        const int qt = 7 - (idx >> 8), j = idx & 255;
        if (j < 96) attn_unit<0>(lds, j / 6, j % 6, qt, qbuf, kvbuf, hbuf, kmean, obuf, ssq_o);
        else if (j < 176) attn_unit<1>(lds, (j - 96) / 5, (j - 96) % 5, qt, qbuf, kvbuf, hbuf, kmean, obuf, ssq_o);
        else attn_unit<2>(lds, (j - 176) / 5, (j - 176) % 5, qt, qbuf, kvbuf, hbuf, kmean, obuf, ssq_o);
    }
}
#undef ATT_WAIT_BAR
}

constexpr int NWAVES = 8;
constexpr int PH_L0 = 1, PPL0 = 9, PH_L1 = PH_L0 + PPL0, PPL1 = 10, NPHASE = PH_L1 + PPL1;
typedef const __attribute__((address_space(4))) Args* KArgs;
__device__ __forceinline__ KArgs kargs() { KArgs p = (KArgs)__builtin_amdgcn_kernarg_segment_ptr(); asm volatile("" : "+s"(p)); return p; }
__device__ __forceinline__ Frame mkframe() {
    extern __shared__ __attribute__((aligned(16))) unsigned char lds_raw[];
    Frame F; F.lds = (LAS unsigned char*)lds_raw; int t = threadIdx.x; asm volatile("" : "+v"(t)); F.tid = t; F.lane = t & 63; F.wave = __builtin_amdgcn_readfirstlane(t >> 6); F.bid = blockIdx.x; F.G = gridDim.x; return F;
}
#define WSP(T_, off) ((T_*)(ws + (off)))

__device__ __forceinline__ void ph_prologue() {
    const Frame F = mkframe(); KArgs a = kargs(); unsigned char* ws = a->ws;
    const int gw = F.bid * NWAVES + F.wave, NGW = F.G * NWAVES;
    f16* Win = WSP(f16, WS_WIN); f16* Wuq = WSP(f16, WS_WUQ); f16* Wo = WSP(f16, WS_WO); unsigned char* Wgu = WSP(unsigned char, WS_WGU); unsigned char* Wdn = WSP(unsigned char, WS_WDN);
    unsigned char* Egu = WSP(unsigned char, WS_EGU); unsigned char* Edn = WSP(unsigned char, WS_EDN); f16* xb = WSP(f16, WS_XB);
    float* cosA = WSP(float, WS_ROPE); float* sinA = cosA + SEQ * 16; float* cosB = sinA + SEQ * 16; float* sinB = cosB + SEQ * 32;
    LAS float* scr = (LAS float*)(F.lds + F.wave * 16384);
    constexpr int I_WIN = (D / 64) * (HW / 32), I_UQ = (256 / 64) * (768 / 32), I_UKV = (128 / 64) * (768 / 32), I_WO = (D / 64) * (D / 32);
    constexpr int I_GU = (D / 64) * (2 * FF / 32), I_DN = (FF / 64) * (D / 32), I_EGU = (D / 64) * (2 * FE / 32), I_EDN = (FE / 64) * (D / 32);
    constexpr int N_SMALL = 2 * (I_WIN + I_UQ + I_UKV + I_WO) + I_GU + I_DN, N_ALL = N_SMALL + NE * (I_EGU + I_EDN);
    for (int it = gw; it < N_ALL; it += NGW) {
        int r = it;
        if (r < 2 * I_WIN) { const int l = r / I_WIN; r %= I_WIN; transpose_item(a->w_in + (size_t)l * D * HC_END, nullptr, D, HC_END, Win + (size_t)l * HW * D, CM_WIN, nullptr, nullptr, scr, r, HW / 32, F.lane); continue; } r -= 2 * I_WIN;
        if (r < 2 * I_UQ) { const int l = r / I_UQ; r %= I_UQ; transpose_item(a->w_uq + (size_t)l * 256 * 576, nullptr, 256, 576, Wuq + (size_t)l * 1536 * 256, CM_UQ, a->q_norm_g + l * 256, nullptr, scr, r, 768 / 32, F.lane); continue; } r -= 2 * I_UQ;
        if (r < 2 * I_UKV) { const int l = r / I_UKV; r %= I_UKV; transpose_item(a->w_ukv + (size_t)l * 128 * 768, nullptr, 128, 768, Wuq + (size_t)l * 1536 * 256 + (size_t)768 * 256, CM_UKV, a->kv_norm_g + l * 128, nullptr, scr, r, 768 / 32, F.lane, 256); continue; } r -= 2 * I_UKV;
        if (r < 2 * I_WO) { const int l = r / I_WO; r %= I_WO; transpose_item(a->w_o + (size_t)l * D * D, nullptr, D, D, Wo + (size_t)l * D * D, CM_ID, a->beta_mla + l * 384, a->beta_moba + l * 320, scr, r, D / 32, F.lane); continue; } r -= 2 * I_WO;
        if (r < I_GU) { transpose_item8(a->ffn_w_gate, a->ffn_w_up, D, FF, Wgu, CM_GU, scr, r, 2 * FF / 32, F.lane); continue; } r -= I_GU;
        if (r < I_DN) { transpose_item8(a->ffn_w_down, nullptr, FF, D, Wdn, CM_ID, scr, r, D / 32, F.lane); continue; } r -= I_DN;
        { const int e = r / (I_EGU + I_EDN); r %= (I_EGU + I_EDN);
          if (r < I_EGU) transpose_item8(a->exp_w_gate + (size_t)e * D * FE, a->exp_w_up + (size_t)e * D * FE, D, FE, Egu + (size_t)e * 2 * FE * D, CM_GU, scr, r, 2 * FE / 32, F.lane);
          else transpose_item8(a->exp_w_down + (size_t)e * FE * D, nullptr, FE, D, Edn + (size_t)e * D * FE, CM_ID, scr, r - I_EGU, D / 32, F.lane); }
    }
    for (int i = F.bid * 512 + F.tid; i < 2 * 768 * 16; i += F.G * 512) { const int l = i / (768 * 16), r = (i / 16) % 768, c = i % 16; *(u32x4*)(Wuq + (size_t)l * 1536 * 256 + (size_t)(768 + r) * 256 + 128 + c * 8) = (u32x4){0u, 0u, 0u, 0u}; }
    for (int i = F.bid * 512 + F.tid; i < SEQ * 48; i += F.G * 512) {
        if (i < SEQ * 16) { const int pos = i >> 4, j = i & 15; const float inv = powf(10000.0f, -(float)(2 * j) / 32.0f); const float ang = (float)pos * inv; cosA[i] = cosf(ang); sinA[i] = sinf(ang); }
        else { const int k = i - SEQ * 16, pos = k >> 5, j = k & 31; const float inv = powf(10000.0f, -(float)(2 * j) / 64.0f); const float ang = (float)pos * inv; cosB[k] = cosf(ang); sinB[k] = sinf(ang); }
    }
    const float* xin = a->x; const float* gp = a->ln_emb_g; const float* bp = a->ln_emb_b;
    for (int m = gw; m < T; m += NGW) {
        const f32x4* xr = (const f32x4*)(xin + (size_t)m * D) + F.lane; f32x4 v[4];
#pragma unroll
        for (int j = 0; j < 4; ++j) v[j] = xr[64 * j];
        float mean, rstd; ln_stats(v, mean, rstd);
        u32x2* o8 = (u32x2*)(xb + (size_t)m * D) + F.lane;
#pragma unroll
        for (int j = 0; j < 4; ++j) { const f32x4 g = *((const f32x4*)gp + F.lane + 64 * j), bb = *((const f32x4*)bp + F.lane + 64 * j); const f32x4 y = (v[j] - mean) * rstd * g + bb;
            u32x2 w; w.x = pk_f16(y[0], y[1]); w.y = pk_f16(y[2], y[3]); o8[64 * j] = w; }
    }
}
__device__ __forceinline__ void ph_A(int l) {
    const Frame F = mkframe(); KArgs a = kargs(); unsigned char* ws = a->ws;
    pg8::Gemm g{WSP(f16, WS_XB), D, WSP(f16, WS_WIN) + (size_t)l * HW * D, D, D, 0, 0}; pg8::StaticOrder S; S.init(T / 256, HW / 256, F.G, F.bid);
    const float* cosA = WSP(float, WS_ROPE);
    pg8::EpiWin E{WSP(f16, WS_H), WSP(float, WS_SSQ_Q), WSP(float, WS_SSQ_KV), WSP(float, WS_KMEAN), cosA, cosA + SEQ * 16, cosA + SEQ * 32, cosA + SEQ * 64};
    pg8::gemm_phase<pg8::EpiWin, pg8::StaticOrder, true>(F.lds, g, S, E);
}
__device__ __forceinline__ void ph_B(int l) {
    const Frame F = mkframe(); KArgs a = kargs(); unsigned char* ws = a->ws;
    pg8::Gemm g{WSP(f16, WS_H), HW, WSP(f16, WS_WUQ) + (size_t)l * 1536 * 256, 256, 256, 0, 0}; pg8::UpOrder S; S.so.init(T / 256, 6, F.G, F.bid);
    const float* cosA = WSP(float, WS_ROPE);
    pg8::EpiUp E{(f16*)a->out, (f16*)((unsigned char*)a->out + 48 * MiB), WSP(float, WS_SSQ_Q), WSP(float, WS_SSQ_KV), cosA, cosA + SEQ * 16};
    pg8::gemm_phase<pg8::EpiUp, pg8::UpOrder, true>(F.lds, g, S, E);
}
constexpr int CW_ATTQ = 8192;
__device__ __forceinline__ void ph_C(int l) {
    const Frame F = mkframe(); KArgs a = kargs(); unsigned char* ws = a->ws;
    att::attn_phase(F.lds, WSP(unsigned, WS_CTL) + CW_ATTQ + 64 * l, (const f16*)a->out, (const f16*)((unsigned char*)a->out + 48 * MiB), WSP(f16, WS_H), WSP(float, WS_KMEAN), WSP(f16, WS_O), WSP(float, WS_SSQ_O));
#if defined(PROBE_ATT)
    att::attn_phase(F.lds, WSP(unsigned, WS_CTL) + CW_ATTQ + 64 * (2 + l), (const f16*)a->out, (const f16*)((unsigned char*)a->out + 48 * MiB), WSP(f16, WS_H), WSP(float, WS_KMEAN), WSP(f16, WS_O), WSP(float, WS_SSQ_O));
#endif
}
__device__ __forceinline__ void ph_C2() {
    const Frame F = mkframe(); KArgs a = kargs(); unsigned char* ws = a->ws;
    const int gw = F.bid * NWAVES + F.wave, NGW = F.G * NWAVES;
    const float* ssq_o = WSP(float, WS_SSQ_O); f16* obuf = WSP(f16, WS_O);
    for (int m = gw; m < T; m += NGW) {
        const int lane = F.lane; const float* sp = ssq_o + (size_t)m * 16;
        const f32x4 s0 = *(const f32x4*)sp, s1 = *(const f32x4*)(sp + 4), s2 = *(const f32x4*)(sp + 8);
        const float sa = 1.0f / sqrtf(((s0[0] + s0[1]) + (s0[2] + s0[3]) + (s1[0] + s1[1])) * (1.f / 384.f) + RMS_EPS);
        const float sc = 1.0f / sqrtf(((s1[2] + s1[3]) + (s2[0] + s2[1]) + s2[2]) * (1.f / 320.f) + RMS_EPS);
        f16* orow = obuf + (size_t)m * D;
        if (lane < 48) { f16x8 v = *(const f16x8*)(orow + 8 * lane);
#pragma unroll
            for (int e = 0; e < 8; ++e) v[e] = (f16)((float)v[e] * sa);
            *(f16x8*)(orow + 8 * lane) = v; }
        if (lane >= 24) { f16x8 v = *(const f16x8*)(orow + 512 + 8 * lane);
#pragma unroll
            for (int e = 0; e < 8; ++e) v[e] = (f16)((float)v[e] * sc);
            *(f16x8*)(orow + 512 + 8 * lane) = v; }
    }
}
__device__ __forceinline__ void ph_D(int l) {
    const Frame F = mkframe(); KArgs a = kargs(); unsigned char* ws = a->ws;
    pg8::Gemm g{WSP(f16, WS_O), D, WSP(f16, WS_WO) + (size_t)l * D * D, D, D, 0, 0}; pg8::StaticOrder S; S.init(T / 256, D / 256, F.G, F.bid);
    pg8::EpiResF32 E{WSP(f16, WS_XB), (f16*)a->out, D, DN_ALPHA, 1.0f};
    pg8::gemm_phase<pg8::EpiResF32, pg8::StaticOrder, true>(F.lds, g, S, E);
}
__device__ __forceinline__ void ph_D2(int l) {
    const Frame F = mkframe(); KArgs a = kargs(); unsigned char* ws = a->ws;
    const f16* ybuf = (const f16*)a->out; f16* xb = WSP(f16, WS_XB); unsigned char* xq = WSP(unsigned char, WS_XQ); int* topi = WSP(int, WS_TOPI); float* topw = WSP(float, WS_TOPW); int* cnt = WSP(int, WS_CNT);
    const float* gp = a->ln1_g + l * D; const float* bp = a->ln1_b + l * D; const float* router = a->router;
    LAS int* lcnt = (LAS int*)(F.lds);
    for (int vw = F.bid; vw < 256; vw += F.G) {
        if (l == 1) { __syncthreads(); if (F.tid < 8) lcnt[F.tid] = 0; __syncthreads(); }
        for (int rr = F.wave; rr < 128; rr += NWAVES) {
            const int m = vw * 128 + rr; const int lane = F.lane;
            float v[16]; ln_load_y16(ybuf + (size_t)m * D, lane, v);
            float mean, rstd; ln_stats16(v, mean, rstd);
            ln_affine16(v, mean, rstd, gp, bp, lane);
            ln_store_xb16(xb + (size_t)m * D, lane, v);
#pragma unroll
            for (int h = 0; h < 2; ++h) { u32x2 w; w.x = pk_fp8x4(v[8 * h] * F8_XS, v[8 * h + 1] * F8_XS, v[8 * h + 2] * F8_XS, v[8 * h + 3] * F8_XS); w.y = pk_fp8x4(v[8 * h + 4] * F8_XS, v[8 * h + 5] * F8_XS, v[8 * h + 6] * F8_XS, v[8 * h + 7] * F8_XS);
                *(u32x2*)(xq + (size_t)m * D + 512 * h + 8 * lane) = w; }
            if (l == 1) {
                float lg[8];
#pragma unroll
                for (int e = 0; e < 8; ++e) lg[e] = 0.f;
#pragma unroll
                for (int i = 0; i < 16; ++i) { const int c = 512 * (i >> 3) + 8 * lane + (i & 7); const f32x4 r0 = *(const f32x4*)(router + (size_t)c * 8), r1 = *(const f32x4*)(router + (size_t)c * 8 + 4); const float xv = v[i];
                    lg[0] += xv * r0[0]; lg[1] += xv * r0[1]; lg[2] += xv * r0[2]; lg[3] += xv * r0[3]; lg[4] += xv * r1[0]; lg[5] += xv * r1[1]; lg[6] += xv * r1[2]; lg[7] += xv * r1[3]; }
#pragma unroll
                for (int e = 0; e < 8; ++e) lg[e] = wave_sum(lg[e]);
                if (lane == 0) {
                    int i0 = 0; float v0 = lg[0];
#pragma unroll
                    for (int e = 1; e < 8; ++e) if (lg[e] > v0) { v0 = lg[e]; i0 = e; }
                    int i1 = -1; float v1 = -INFINITY;
#pragma unroll
                    for (int e = 0; e < 8; ++e) if (e != i0 && lg[e] > v1) { v1 = lg[e]; i1 = e; }
                    const float e1 = __expf(v1 - v0), w0 = 1.0f / (1.0f + e1), w1 = e1 * w0;
                    topi[(size_t)m * 2] = i0; topi[(size_t)m * 2 + 1] = i1; topw[(size_t)m * 2] = w0; topw[(size_t)m * 2 + 1] = w1;
                    __hip_atomic_fetch_add(&lcnt[i0], 1, __ATOMIC_RELAXED, __HIP_MEMORY_SCOPE_WORKGROUP); __hip_atomic_fetch_add(&lcnt[i1], 1, __ATOMIC_RELAXED, __HIP_MEMORY_SCOPE_WORKGROUP);
                }
            }
        }
        if (l == 1) { __syncthreads(); if (F.tid < 8) cnt[vw * 8 + F.tid] = lcnt[F.tid]; }
    }
}
__device__ __forceinline__ void ph_E() {
    const Frame F = mkframe(); KArgs a = kargs(); unsigned char* ws = a->ws;
    pg8::Gemm g{WSP(unsigned char, WS_XQ), D, WSP(unsigned char, WS_WGU), D, D, F8_XE, F8_WE}; pg8::StaticOrder S; S.init(T / 256, 2 * FF / 256, F.G, F.bid);
    pg8::EpiSwiGLU E{WSP(unsigned char, WS_H), WSP(unsigned char, WS_H), 1 << 30, FF, 1.0f / (F8_XS * F8_WS)};
    pg8::gemm_phase<pg8::EpiSwiGLU, pg8::StaticOrder, true, true>(F.lds, g, S, E);
}
__device__ __forceinline__ void ph_F() {
    const Frame F = mkframe(); KArgs a = kargs(); unsigned char* ws = a->ws;
    pg8::Gemm g{WSP(unsigned char, WS_H), FF, WSP(unsigned char, WS_WDN), FF, FF, F8_HE, F8_WE}; pg8::StaticOrder S; S.init(T / 256, D / 256, F.G, F.bid);
    pg8::EpiResF32 E{WSP(f16, WS_XB), (f16*)a->out, D, DN_ALPHA, 1.0f / (F8_HS * F8_WS)};
    pg8::gemm_phase<pg8::EpiResF32, pg8::StaticOrder, true, true>(F.lds, g, S, E);
}
__device__ __forceinline__ void ph_F2d() {
    const Frame F = mkframe(); KArgs a = kargs(); unsigned char* ws = a->ws;
    const int gw = F.bid * NWAVES + F.wave, NGW = F.G * NWAVES;
    const f16* ybuf = (const f16*)a->out; f16* xb = WSP(f16, WS_XB); const float* gp = a->ln2_g; const float* bp = a->ln2_b;
    for (int m = gw; m < T; m += NGW) {
        float v[16]; ln_load_y16(ybuf + (size_t)m * D, F.lane, v);
        float mean, rstd; ln_stats16(v, mean, rstd);
        ln_affine16(v, mean, rstd, gp, bp, F.lane);
        ln_store_xb16(xb + (size_t)m * D, F.lane, v);
    }
}
__device__ __forceinline__ void ph_R3() {
    const Frame F = mkframe(); KArgs a = kargs(); unsigned char* ws = a->ws;
    const int* topi = WSP(int, WS_TOPI); const float* topw = WSP(float, WS_TOPW); const int* cnt = WSP(int, WS_CNT); int* rowtok = WSP(int, WS_ROWTOK); float* roww = WSP(float, WS_ROWW); int* pane = WSP(int, WS_PANE);
    LAS int* L = (LAS int*)F.lds;
    for (int vw = F.bid; vw < 256; vw += F.G) {
        __syncthreads();
        if (F.tid < 64) L[F.tid] = 0;
        __syncthreads();
        { const int e = F.tid & 7; int tot = 0, mine = 0;
#pragma unroll
          for (int k = 0; k < 4; ++k) { const int w = (F.tid >> 3) + 64 * k; const int c = cnt[w * 8 + e]; tot += c; if (w < vw) mine += c; }
          __hip_atomic_fetch_add(&L[e], tot, __ATOMIC_RELAXED, __HIP_MEMORY_SCOPE_WORKGROUP); __hip_atomic_fetch_add(&L[16 + e], mine, __ATOMIC_RELAXED, __HIP_MEMORY_SCOPE_WORKGROUP); }
        __syncthreads();
        if (F.tid == 0) { int b = 0; for (int e = 0; e < 8; ++e) { L[8 + e] = b; b += (L[e] + 255) & ~255; } L[24] = b; }
        int myexp = -1, myrank = 0; const int tok = vw * 128 + (F.tid >> 1), slot = F.tid & 1;
        if (F.tid < 256) myexp = topi[(size_t)tok * 2 + slot];
        if (F.tid < 256) {
#pragma unroll
            for (int e = 0; e < 8; ++e) { const unsigned long long mk = __ballot(myexp == e); const int below = __builtin_popcountll(mk & ((1ull << F.lane) - 1ull));
                if (myexp == e) myrank = below; if (F.lane == 0) L[32 + F.wave * 8 + e] = __builtin_popcountll(mk); }
        }
        __syncthreads();
        if (F.tid < 256) { int p = L[8 + myexp] + L[16 + myexp] + myrank; for (int w = 0; w < F.wave; ++w) p += L[32 + w * 8 + myexp];
            rowtok[p] = tok * 2 + slot; roww[p] = topw[(size_t)tok * 2 + slot]; }
        if (vw == 0) {
            for (int e = 0; e < 8; ++e) { const int s0 = L[8 + e] + L[e], s1 = L[8 + e] + ((L[e] + 255) & ~255);
                for (int p = s0 + F.tid; p < s1; p += 512) { rowtok[p] = -1; roww[p] = 0.f; }
                for (int p = (L[8 + e] >> 8) + F.tid; p < (s1 >> 8); p += 512) pane[p] = e; }
            if (F.tid == 0) pane[MOE_MAXP] = L[24] >> 8;
        }
    }
}
__device__ __forceinline__ void ph_M1() {
    const Frame F = mkframe(); KArgs a = kargs(); unsigned char* ws = a->ws;
    const int* pane = WSP(int, WS_PANE); const int np = pane[MOE_MAXP];
    pg8::Gemm g{WSP(unsigned char, WS_XQ), D, WSP(unsigned char, WS_EGU), D, D, F8_XE, F8_WE}; pg8::MoeGather S; S.so.init(np, 2 * FE / 256, F.G, F.bid); S.rowtok = WSP(int, WS_ROWTOK); S.pane = pane; S.estride = (size_t)2 * FE * D;
    pg8::EpiSwiGLU E{(unsigned char*)a->out, WSP(unsigned char, WS_H), MOE_SPLIT, FE, 1.0f / (F8_XS * F8_WS)};
    pg8::gemm_phase<pg8::EpiSwiGLU, pg8::MoeGather, true, true>(F.lds, g, S, E);
}
__device__ __forceinline__ void ph_M2() {
    const Frame F = mkframe(); KArgs a = kargs(); unsigned char* ws = a->ws;
    const int* pane = WSP(int, WS_PANE); const int np = pane[MOE_MAXP];
    pg8::Gemm g{(const unsigned char*)a->out, FE, WSP(unsigned char, WS_EDN), FE, FE, F8_HE, F8_WE}; pg8::MoeDense S; S.so.init(np, D / 256, F.G, F.bid); S.pane = pane; S.estride = (size_t)D * FE; S.A2 = (const char*)WSP(unsigned char, WS_H); S.split = MOE_SPLIT;
    pg8::EpiScatter E{WSP(f16, WS_C), (size_t)T * D, WSP(int, WS_ROWTOK), WSP(float, WS_ROWW), 1.0f / (F8_HS * F8_WS)};
    pg8::gemm_phase<pg8::EpiScatter, pg8::MoeDense, true, true>(F.lds, g, S, E);
}
__device__ __forceinline__ void ph_F2m() {
    const Frame F = mkframe(); KArgs a = kargs(); unsigned char* ws = a->ws;
    const int gw = F.bid * NWAVES + F.wave, NGW = F.G * NWAVES;
    const f16* xb = WSP(f16, WS_XB); const f16* c0buf = WSP(f16, WS_C); const f16* c1buf = c0buf + (size_t)T * D; float* out = a->out; const float* gp = a->ln2_g + D; const float* bp = a->ln2_b + D;
    for (int m = gw; m < T; m += NGW) {
        const int lane = F.lane; f32x4 v[4];
        const f16x4* xr = (const f16x4*)(xb + (size_t)m * D) + lane; const f16x4* c0r = (const f16x4*)(c0buf + (size_t)m * D) + lane; const f16x4* c1r = (const f16x4*)(c1buf + (size_t)m * D) + lane;
#pragma unroll
        for (int j = 0; j < 4; ++j) { const f16x4 xv = xr[64 * j], p0 = c0r[64 * j], p1 = c1r[64 * j];
#pragma unroll
            for (int e = 0; e < 4; ++e) v[j][e] = DN_ALPHA * (float)xv[e] + ((float)p0[e] + (float)p1[e]); }
        float mean, rstd; ln_stats(v, mean, rstd);
        f32x4* orow = (f32x4*)(out + (size_t)m * D) + lane;
#pragma unroll
        for (int j = 0; j < 4; ++j) { const f32x4 g = *((const f32x4*)gp + lane + 64 * j), bb = *((const f32x4*)bp + lane + 64 * j); orow[64 * j] = (v[j] - mean) * rstd * g + bb; }
    }
}

#ifndef SITE_MASK
#define SITE_MASK 0xFFFFFFFFu
#endif
#define SITE(n) (((SITE_MASK) >> (n)) & 1u)
__global__ void __launch_bounds__(NWAVES * 64, 2) mega_fwd(Args args_unused) {
    extern __shared__ __attribute__((aligned(16))) unsigned char lds_raw[];
    volatile LAS unsigned* MISC = (volatile LAS unsigned*)((LAS unsigned char*)lds_raw + MISC_OFF);
    if (threadIdx.x < 64) MISC[threadIdx.x] = 0u;
    __syncthreads();
#if MK_ONE_LAUNCH
    (void)xcd_barrier_post((unsigned*)(kargs()->ws + WS_CTL) + CW_BAR, MISC + 8);
#define GRID_BAR() do { XcdBarrier bar_; bar_.bar = (unsigned*)(kargs()->ws + WS_CTL) + CW_BAR; bar_.x = xb_xcc_id(); bar_.st = (volatile LAS unsigned*)((LAS unsigned char*)lds_raw + MISC_OFF) + 8; xcd_barrier(bar_); } while (0)
#else
#define GRID_BAR() do {} while (0)
#endif
    const int lo = kargs()->ph_lo, hi = kargs()->ph_hi;
#define IN(k) (lo <= (k) && (k) < hi)
#define SEAM(k) do { if (IN(k) && IN((k) + 1)) GRID_BAR(); } while (0)
    if (SITE(0) && IN(0)) ph_prologue();
#if defined(PROBE_PRO)
    if (SITE(0) && IN(0)) { __syncthreads(); ph_prologue(); }
#endif
    SEAM(0);
#pragma unroll
    for (int l = 0; l < 2; ++l) {
        const int pb = l == 0 ? PH_L0 : PH_L1;
        if (SITE(1) && IN(pb + 0)) ph_A(l);
        SEAM(pb + 0);
        if (SITE(3) && IN(pb + 1)) ph_B(l);
        SEAM(pb + 1);
        if (SITE(5) && IN(pb + 2)) ph_C(l);
        SEAM(pb + 2);
        if (SITE(6) && IN(pb + 3)) ph_C2();
        SEAM(pb + 3);
        if (SITE(7) && IN(pb + 4)) ph_D(l);
        SEAM(pb + 4);
        if (SITE(8) && IN(pb + 5)) ph_D2(l);
        SEAM(pb + 5);
        if (l == 0) {
            if (SITE(9) && IN(pb + 6)) ph_E();
            SEAM(pb + 6);
            if (SITE(10) && IN(pb + 7)) ph_F();
            SEAM(pb + 7);
            if (SITE(11) && IN(pb + 8)) ph_F2d();
            SEAM(pb + 8);
        } else {
            if (SITE(12) && IN(pb + 6)) ph_R3();
            SEAM(pb + 6);
            if (SITE(13) && IN(pb + 7)) ph_M1();
            SEAM(pb + 7);
            if (SITE(14) && IN(pb + 8)) ph_M2();
            SEAM(pb + 8);
            if (SITE(15) && IN(pb + 9)) ph_F2m();
        }
    }
#undef IN
#undef SEAM
}

extern "C" void kernel_launch(void* const* d_in, const int* in_sizes, int n_in, void* d_out, int out_size, void* d_ws, size_t ws_size, hipStream_t stream) {
    static int grid = 0;
    if (grid == 0) {
        if (n_in != 22 || in_sizes[0] != T * D || out_size != T * D || ws_size < WS_END) { fprintf(stderr, "kernel_launch: unexpected shapes / workspace (n_in %d, ws %zu)\n", n_in, ws_size); grid = -1; return; }
        int dev = 0, cus = 0;
        if (hipGetDevice(&dev) != hipSuccess || hipDeviceGetAttribute(&cus, hipDeviceAttributeMultiprocessorCount, dev) != hipSuccess) { grid = -1; return; }
        if (hipFuncSetAttribute((const void*)mega_fwd, hipFuncAttributeMaxDynamicSharedMemorySize, LDS_BYTES) != hipSuccess) { fprintf(stderr, "kernel_launch: hipFuncSetAttribute failed\n"); grid = -1; return; }
        int per_cu = 0;
        if (hipOccupancyMaxActiveBlocksPerMultiprocessor(&per_cu, (const void*)mega_fwd, NWAVES * 64, LDS_BYTES) != hipSuccess || per_cu < 1) { fprintf(stderr, "kernel_launch: occupancy query says %d\n", per_cu); }
        (void)hipGetLastError();
        grid = cus > 256 ? 256 : cus;
    }
    if (grid < 0) return;
    (void)hipMemsetAsync((char*)d_ws + WS_CTL, 0, CTL_ZERO_BYTES, stream);
    Args a{};
    a.x = (const float*)d_in[0]; a.ln_emb_g = (const float*)d_in[1]; a.ln_emb_b = (const float*)d_in[2]; a.w_in = (const float*)d_in[3]; a.q_norm_g = (const float*)d_in[4]; a.kv_norm_g = (const float*)d_in[5];
    a.w_uq = (const float*)d_in[6]; a.w_ukv = (const float*)d_in[7]; a.beta_mla = (const float*)d_in[8]; a.beta_moba = (const float*)d_in[9]; a.w_o = (const float*)d_in[10]; a.ln1_g = (const float*)d_in[11]; a.ln1_b = (const float*)d_in[12];
    a.ffn_w_gate = (const float*)d_in[13]; a.ffn_w_up = (const float*)d_in[14]; a.ffn_w_down = (const float*)d_in[15]; a.router = (const float*)d_in[16]; a.exp_w_gate = (const float*)d_in[17]; a.exp_w_up = (const float*)d_in[18];
    a.exp_w_down = (const float*)d_in[19]; a.ln2_g = (const float*)d_in[20]; a.ln2_b = (const float*)d_in[21];
    a.out = (float*)d_out; a.ws = (unsigned char*)d_ws;
#if MK_ONE_LAUNCH
    a.ph_lo = 0; a.ph_hi = NPHASE;
    hipLaunchKernelGGL(mega_fwd, dim3(grid), dim3(NWAVES * 64), LDS_BYTES, stream, a);
#else
    for (int p = 0; p < NPHASE; ++p) { a.ph_lo = p; a.ph_hi = p + 1; hipLaunchKernelGGL(mega_fwd, dim3(grid), dim3(NWAVES * 64), LDS_BYTES, stream, a); }
#endif
}
```

```cpp
#include <hip/hip_runtime.h>
#include <cstdio>
#include <cstdint>
#include <cmath>

#ifndef MK_ONE_LAUNCH
#define MK_ONE_LAUNCH 1
#endif

#define LAS __attribute__((address_space(3)))
#define GAS __attribute__((address_space(1)))
typedef _Float16 f16;
typedef _Float16 f16x2 __attribute__((ext_vector_type(2)));
typedef _Float16 f16x4 __attribute__((ext_vector_type(4)));
typedef _Float16 f16x8 __attribute__((ext_vector_type(8)));
typedef float f32x2 __attribute__((ext_vector_type(2)));
typedef float f32x4 __attribute__((ext_vector_type(4)));
typedef unsigned u32x2 __attribute__((ext_vector_type(2)));
typedef unsigned u32x4 __attribute__((ext_vector_type(4)));
typedef GAS unsigned gu32;
typedef int i32x4 __attribute__((ext_vector_type(4)));
typedef int i32x8 __attribute__((ext_vector_type(8)));

constexpr int BATCH = 16, SEQ = 2048, T = BATCH * SEQ, D = 1024;
constexpr int HW = 2816;
constexpr int HC_CQ = 0, HC_CKV = 256, HC_KR = 384, HC_RQ = 416, HC_RK = 736, HC_RV = 1056, HC_RG = 1376, HC_MQ = 1696, HC_MK = 2016, HC_MV = 2336, HC_END = 2656;
constexpr int QW = 768, KVW = 768;
constexpr int OW = 1152, OC_MOBA = 384, OC_RET = 768;
constexpr int FF = 2816, FE = 3584, NE = 8;
constexpr float LN_EPS = 1e-5f, RMS_EPS = 1e-6f;
constexpr float DN_ALPHA = 1.41421356237f;
constexpr float LOG2E = 1.4426950408889634f;
constexpr float F8_XS = 8.0f, F8_HS = 16.0f, F8_WS = 256.0f; constexpr int F8_XE = 127 - 3, F8_HE = 127 - 4, F8_WE = 127 - 8;
constexpr int MOE_MAXP = 264;

constexpr size_t MiB = 1u << 20;
constexpr size_t WS_CTL = 0, CTL_ZERO_BYTES = 256 * 1024;
constexpr size_t WS_ROPE = 256 * 1024;
constexpr size_t WS_SSQ_Q = 1 * MiB;
constexpr size_t WS_SSQ_O = 2 * MiB;
constexpr size_t WS_KMEAN = 4 * MiB;
constexpr size_t WS_SSQ_KV = 18 * MiB + 512 * 1024;
constexpr size_t WS_TOPI = WS_KMEAN + 512 * 1024;
constexpr size_t WS_TOPW = WS_TOPI + (size_t)T * 8;
constexpr size_t WS_CNT = WS_TOPW + (size_t)T * 8;
constexpr size_t WS_ROWTOK = WS_CNT + 8192;
constexpr size_t WS_ROWW = WS_ROWTOK + (size_t)MOE_MAXP * 256 * 4;
constexpr size_t WS_PANE = WS_ROWW + (size_t)MOE_MAXP * 256 * 4;
constexpr size_t WS_WIN = 6 * MiB;
constexpr size_t WS_WUQ = 17 * MiB;
constexpr size_t WS_WO = 462 * MiB;
constexpr size_t WS_WGU = 23 * MiB;
constexpr size_t WS_WDN = 29 * MiB;
constexpr size_t WS_EGU = 32 * MiB;
constexpr size_t WS_EDN = 88 * MiB;
constexpr size_t WS_XB = 116 * MiB;
constexpr size_t WS_XQ = 180 * MiB;
constexpr size_t WS_H = 212 * MiB;
constexpr size_t WS_O = 388 * MiB;
constexpr size_t WS_C = 324 * MiB;
constexpr size_t WS_END = 460 * MiB;
constexpr int MOE_SPLIT = 146;
static_assert((size_t)MOE_SPLIT * 256 * FE <= 128 * MiB && WS_H + (size_t)(MOE_MAXP - MOE_SPLIT) * 256 * FE <= WS_C && WS_C + (size_t)2 * T * D * 2 <= WS_END && WS_O + (size_t)T * OW * 2 <= WS_END, "MoE buffers");

constexpr int CW_TMO = 0, CW_BAR = 1024;

constexpr int RING_BYTES = 131072;
constexpr int MISC_OFF = RING_BYTES;
constexpr int LDS_BYTES = 147456;

__device__ __forceinline__ unsigned pk_f16(float lo, float hi) { f16x2 v = {(f16)lo, (f16)hi}; return __builtin_bit_cast(unsigned, v); }
template <int X> __device__ __forceinline__ float swz_xor(float v) { return __int_as_float(__builtin_amdgcn_ds_swizzle(__float_as_int(v), (X << 10) | 0x1f)); }
__device__ __forceinline__ float wave_sum(float v) {
    v += swz_xor<1>(v); v += swz_xor<2>(v); v += swz_xor<4>(v); v += swz_xor<8>(v); v += swz_xor<16>(v);
    const auto rr = __builtin_amdgcn_permlane32_swap(__float_as_uint(v), __float_as_uint(v), false, false);
    return __uint_as_float(rr[0]) + __uint_as_float(rr[1]);
}
__device__ __forceinline__ float clamp8(float x) { return fminf(fmaxf(x, -448.0f), 448.0f); }
__device__ __forceinline__ unsigned pk_fp8x4(float a, float b, float c, float d) { int w = 0; w = __builtin_amdgcn_cvt_pk_fp8_f32(clamp8(a), clamp8(b), w, false); w = __builtin_amdgcn_cvt_pk_fp8_f32(clamp8(c), clamp8(d), w, true); return (unsigned)w; }
__device__ __forceinline__ float silu_f(float x) { return x * __builtin_amdgcn_rcpf(1.f + __expf(-x)); }

#define XB_TMO      128
#define XB_XCNT(j)  (256  + 64 * (j))
#define XB_XSUB(j)  (1280 + 64 * (j))
#define XB_XGEN(j)  (2304 + 64 * (j))
#define XB_TOP      3328
#define XB_TOPGEN   3392
#define XCD_BAR_WORDS 3456
#define XB_SPIN_CAP (1u << 18)
__device__ __forceinline__ unsigned xb_ld(unsigned* p)              { return __hip_atomic_load(p, __ATOMIC_RELAXED, __HIP_MEMORY_SCOPE_AGENT); }
__device__ __forceinline__ unsigned xb_add(unsigned* p, unsigned v) { return __hip_atomic_fetch_add(p, v, __ATOMIC_RELAXED, __HIP_MEMORY_SCOPE_AGENT); }
__device__ __forceinline__ unsigned xb_xcc_id() { return (unsigned)__builtin_amdgcn_s_getreg((3 << 11) | 20) & 0xFu; }
#define XB_SPIN(cond, bar) do { unsigned _sp = 0; while (cond) { __builtin_amdgcn_s_sleep(1); \
    if ((++_sp & 255u) == 0u) { if (xb_ld(&(bar)[XB_TMO])) break; if (_sp > XB_SPIN_CAP) { atomicAdd(&(bar)[XB_TMO], 1u); break; } } } } while (0)
struct XcdBarrier { unsigned* bar; unsigned x; volatile LAS unsigned* st; };
__device__ __forceinline__ XcdBarrier xcd_barrier_post(unsigned* bar, volatile LAS unsigned* st) {
    XcdBarrier b; b.bar = bar; b.x = xb_xcc_id(); b.st = st;
    if (threadIdx.x == 0) (void)xb_add(&bar[XB_XCNT(b.x)], 1u);
    return b;
}
__device__ __forceinline__ void xcd_barrier_complete(unsigned* bar, unsigned x, unsigned& nloc, unsigned& nx) {
    const unsigned G = gridDim.x * gridDim.y * gridDim.z;
    unsigned sum, cnt, mine, sp = 0u;
    for (;;) {
        sum = 0u; cnt = 0u; mine = 0u;
#pragma unroll
        for (unsigned j = 0; j < 16; ++j) { const unsigned c = xb_ld(&bar[XB_XCNT(j)]); sum += c; cnt += (c > 0u) ? 1u : 0u; mine = (j == x) ? c : mine; }
        if (sum == G) break;
        __builtin_amdgcn_s_sleep(1);
        if ((++sp & 255u) == 0u) { if (xb_ld(&bar[XB_TMO])) break; if (sp > XB_SPIN_CAP) { atomicAdd(&bar[XB_TMO], 1u); break; } }
    }
    nloc = mine > 0u ? mine : 1u; nx = cnt > 0u ? cnt : 1u;
}
__device__ __forceinline__ void xcd_barrier(const XcdBarrier& b) {
    asm volatile("s_waitcnt vmcnt(0)" ::: "memory");
    __syncthreads();
    if (threadIdx.x == 0) {
        unsigned* bar = b.bar;
        __builtin_amdgcn_s_waitcnt(0);
        unsigned nloc = b.st[0], nx = b.st[1];
        if (nloc == 0u) { xcd_barrier_complete(bar, b.x, nloc, nx); b.st[0] = nloc; b.st[1] = nx; }
        const unsigned old = xb_add(&bar[XB_XSUB(b.x)], 1u);
        const unsigned gen = old / nloc;
        if (old + 1u == (gen + 1u) * nloc) {
            __builtin_amdgcn_fence(__ATOMIC_RELEASE, "agent");
            asm volatile("s_waitcnt vmcnt(0)" ::: "memory");
            const unsigned og = xb_add(&bar[XB_TOP], 1u);
            const unsigned tg = og / nx;
            if (og + 1u == (tg + 1u) * nx) xb_add(&bar[XB_TOPGEN], 1u);
            else XB_SPIN(xb_ld(&bar[XB_TOPGEN]) == tg, bar);
            __builtin_amdgcn_fence(__ATOMIC_ACQUIRE, "agent");
            xb_add(&bar[XB_XGEN(b.x)], 1u);
            asm volatile("s_waitcnt vmcnt(0)" ::: "memory");
        } else {
            XB_SPIN(xb_ld(&bar[XB_XGEN(b.x)]) == gen, bar);
            __builtin_amdgcn_fence(__ATOMIC_ACQUIRE, "agent");
            asm volatile("s_waitcnt vmcnt(0)" ::: "memory");
        }
    }
    __syncthreads();
}

namespace pg8 {
constexpr int BM = 256, BK = 64, HALF = 128, HTB = HALF * BK * 2, STAGE_BYTES = 8 * HTB, NXCD = 8, WGM = 8;
__host__ __device__ __forceinline__ int lds_byte(int r, int c) { const int st = (r >> 4) * 2 + (c >> 5), rr = r & 15, cc = c & 31, ob = rr * 64 + cc * 2; return st * 1024 + (ob ^ (((ob >> 9) & 1) << 5)); }
__host__ __device__ __forceinline__ void stage_rc(int b, int& R, int& C) { const int st = b / 1024, sb = b % 1024, swz = sb ^ (((sb >> 9) & 1) << 5); R = (st >> 1) * 16 + swz / 64; C = (st & 1) * 32 + (swz % 64) / 2; }
__host__ __device__ __forceinline__ int perm32(int rho) { const int n = rho >> 4, i = rho & 15; return 8 * (i >> 2) + 4 * n + (i & 3); }

struct Unit { int pm, pn; };
struct Gemm { const void* A; int lda; const void* Bt; int ldb; int K; int sa, sb; };

struct StaticOrder {
    static constexpr bool GATHER = false;
    int nM, nN, nwg, G, c, pm0;
    __device__ void init(int nM_, int nN_, int G_, int c_, int pm0_ = 0) { nM = nM_; nN = nN_; nwg = nM * nN; G = G_; c = c_; pm0 = pm0_; }
    __device__ bool next(int i, Unit& u) const {
        const long L = (long)i * G + c; if (L >= nwg) return false;
        int wgid = (int)L; { const int q = nwg / NXCD, r = nwg % NXCD, xcd = wgid % NXCD, off = wgid / NXCD; wgid = (xcd < r ? xcd * (q + 1) : r * (q + 1) + (xcd - r) * q) + off; }
        const int nig = WGM * nN, gid = wgid / nig, fm = gid * WGM, gsz = (nM - fm) < WGM ? (nM - fm) : WGM;
        u.pm = pm0 + fm + ((wgid % nig) % gsz); u.pn = (wgid % nig) / gsz; return true;
    }
    __device__ __forceinline__ int a_row(const Unit& u, int r) const { return u.pm * BM + r; }
    __device__ __forceinline__ size_t b_base(const Unit&) const { return 0; }
    __device__ __forceinline__ const char* a_tile(const Unit& u, const char* A, size_t rowb) const { return A + (size_t)u.pm * BM * rowb; }
};
struct UpOrder {
    static constexpr bool GATHER = false;
    StaticOrder so;
    __device__ bool next(int i, Unit& u) const { return so.next(i, u); }
    __device__ __forceinline__ int a_row(const Unit& u, int r) const { return u.pm * BM + r; }
    __device__ __forceinline__ size_t b_base(const Unit&) const { return 0; }
    __device__ __forceinline__ const char* a_tile(const Unit& u, const char* A, size_t rowb) const { return A + (size_t)u.pm * BM * rowb + (u.pn >= 3 ? (size_t)(HC_CKV * 2) : (size_t)0); }
};
struct MoeGather {
    static constexpr bool GATHER = true;
    StaticOrder so; const int* rowtok; const int* pane; size_t estride;
    __device__ bool next(int i, Unit& u) const { return so.next(i, u); }
    __device__ __forceinline__ int a_row(const Unit& u, int r) const { const int t = rowtok[u.pm * BM + r]; return t < 0 ? 0 : (t >> 1); }
    __device__ __forceinline__ size_t b_base(const Unit& u) const { return (size_t)pane[u.pm] * estride; }
    __device__ __forceinline__ const char* a_tile(const Unit&, const char* A, size_t) const { return A; }
};
struct MoeDense {
    static constexpr bool GATHER = false;
    StaticOrder so; const int* pane; size_t estride; const char* A2; int split;
    __device__ bool next(int i, Unit& u) const { return so.next(i, u); }
    __device__ __forceinline__ int a_row(const Unit& u, int r) const { return u.pm * BM + r; }
    __device__ __forceinline__ size_t b_base(const Unit& u) const { return (size_t)pane[u.pm] * estride; }
    __device__ __forceinline__ const char* a_tile(const Unit& u, const char* A, size_t rowb) const { return u.pm < split ? A + (size_t)u.pm * BM * rowb : A2 + (size_t)(u.pm - split) * BM * rowb; }
};

struct EpiF16 {
    static constexpr bool PERM = true; static constexpr bool KSCALE = false;
    f16* O; int ldc;
    __device__ __forceinline__ void operator()(const f32x4 (&acc)[2][2][4][2], const Unit& u, int wr, int wc, int fr, int fq) const {
        const int row0 = u.pm * BM + wr * 64 + fr, col0 = u.pn * BM + wc * 32 + 8 * fq;
#pragma unroll
        for (int ai = 0; ai < 2; ++ai)
#pragma unroll
            for (int m = 0; m < 4; ++m) { f16* rowp = O + (size_t)(row0 + ai * HALF + m * 16) * ldc + col0;
#pragma unroll
                for (int bj = 0; bj < 2; ++bj) { const f32x4 v0 = acc[ai][bj][m][0], v1 = acc[ai][bj][m][1];
                    u32x4 w; w.x = pk_f16(v0[0], v0[1]); w.y = pk_f16(v0[2], v0[3]); w.z = pk_f16(v1[0], v1[1]); w.w = pk_f16(v1[2], v1[3]);
                    *(u32x4*)(rowp + bj * HALF) = w; } }
    }
};
__device__ __forceinline__ void rope8(float (&v)[8], const float* cs, const float* sn, int fq, float scale) {
    const f32x4 c0 = *(const f32x4*)cs, c1 = *(const f32x4*)(cs + 4), s0 = *(const f32x4*)sn, s1 = *(const f32x4*)(sn + 4);
    const float sg = fq < 2 ? -scale : scale;
#pragma unroll
    for (int e = 0; e < 8; ++e) { const auto rr = __builtin_amdgcn_permlane32_swap(__float_as_uint(v[e]), __float_as_uint(v[e]), false, false);
        const float other = fq < 2 ? __uint_as_float(rr[1]) : __uint_as_float(rr[0]);
        const float c = e < 4 ? c0[e & 3] : c1[e & 3], sn_ = e < 4 ? s0[e & 3] : s1[e & 3];
        v[e] = v[e] * (c * scale) + other * (sn_ * sg); }
}
__device__ __forceinline__ float sum_fq(float s) { s += swz_xor<16>(s); const auto rr = __builtin_amdgcn_permlane32_swap(__float_as_uint(s), __float_as_uint(s), false, false); return __uint_as_float(rr[0]) + __uint_as_float(rr[1]); }
struct EpiWin {
    static constexpr bool PERM = true; static constexpr bool KSCALE = false;
    f16* H; float* ssq_q; float* ssq_kv; float* kpart; const float* cosA; const float* sinA; const float* cosB; const float* sinB;
    __device__ __forceinline__ void operator()(const f32x4 (&acc)[2][2][4][2], const Unit& u, int wr, int wc, int fr, int fq) const {
        const int row0 = u.pm * BM + wr * 64 + fr;
#pragma unroll
        for (int bj = 0; bj < 2; ++bj) {
            const int cg = u.pn * 8 + bj * 4 + wc;
            if (cg >= 83) continue;
            const int col0 = cg * 32 + 8 * fq;
            float ksum[8];
#pragma unroll
            for (int e = 0; e < 8; ++e) ksum[e] = 0.f;
#pragma unroll
            for (int ai = 0; ai < 2; ++ai)
#pragma unroll
                for (int m = 0; m < 4; ++m) {
                    const int row = row0 + ai * HALF + m * 16; const int pos = row & (SEQ - 1);
                    float v[8];
#pragma unroll
                    for (int e = 0; e < 4; ++e) { v[e] = acc[ai][bj][m][0][e]; v[4 + e] = acc[ai][bj][m][1][e]; }
                    if (cg < 12) {
                        float ss = 0.f;
#pragma unroll
                        for (int e = 0; e < 8; ++e) ss += v[e] * v[e];
                        ss = sum_fq(ss);
                        if (fq == 0) { if (cg < 8) ssq_q[(size_t)row * 8 + cg] = ss; else ssq_kv[(size_t)row * 4 + (cg - 8)] = ss; }
                    } else if (cg == 12) rope8(v, cosA + pos * 16 + 8 * (fq & 1), sinA + pos * 16 + 8 * (fq & 1), fq, 1.0f);
                    else if (cg < 23) rope8(v, cosB + pos * 32 + 16 * ((cg - 13) & 1) + 8 * (fq & 1), sinB + pos * 32 + 16 * ((cg - 13) & 1) + 8 * (fq & 1), fq, 1.0f);
                    else if (cg < 33) rope8(v, cosB + pos * 32 + 16 * ((cg - 23) & 1) + 8 * (fq & 1), sinB + pos * 32 + 16 * ((cg - 23) & 1) + 8 * (fq & 1), fq, 0.125f);
                    else if (cg >= 53 && cg < 63) {
#pragma unroll
                        for (int e = 0; e < 8; ++e) v[e] *= 0.125f * LOG2E; }
                    else if (cg >= 63 && cg < 73) {
#pragma unroll
                        for (int e = 0; e < 8; ++e) ksum[e] += v[e]; }
                    u32x4 w; w.x = pk_f16(v[0], v[1]); w.y = pk_f16(v[2], v[3]); w.z = pk_f16(v[4], v[5]); w.w = pk_f16(v[6], v[7]);
                    *(u32x4*)(H + (size_t)row * HW + col0) = w;
                }
            if (cg >= 63 && cg < 73) {
#pragma unroll
                for (int e = 0; e < 8; ++e) { float x = ksum[e]; x += swz_xor<1>(x); x += swz_xor<2>(x); x += swz_xor<4>(x); x += swz_xor<8>(x); ksum[e] = x; }
                if (fr == 0) { float* kp = kpart + ((size_t)u.pm * 2 + wr) * 320 + (cg - 63) * 32 + 8 * fq;
                    *(f32x4*)kp = (f32x4){ksum[0], ksum[1], ksum[2], ksum[3]}; *(f32x4*)(kp + 4) = (f32x4){ksum[4], ksum[5], ksum[6], ksum[7]}; }
            }
        }
    }
};
struct EpiUp {
    static constexpr bool PERM = true; static constexpr bool KSCALE = false;
    f16* Oq; f16* Okv; const float* ssq_q; const float* ssq_kv; const float* cosA; const float* sinA;
    __device__ __forceinline__ void operator()(const f32x4 (&acc)[2][2][4][2], const Unit& u, int wr, int wc, int fr, int fq) const {
        const int row0 = u.pm * BM + wr * 64 + fr; const bool isq = u.pn < 3; const int pn = isq ? u.pn : u.pn - 3;
        f16* O = isq ? Oq : Okv; const int cg_end = isq ? 18 : 24;
#pragma unroll
        for (int ai = 0; ai < 2; ++ai)
#pragma unroll
            for (int m = 0; m < 4; ++m) {
                const int row = row0 + ai * HALF + m * 16; const int pos = row & (SEQ - 1);
                float rs;
                if (isq) { const f32x4 a = *(const f32x4*)(ssq_q + (size_t)row * 8), b = *(const f32x4*)(ssq_q + (size_t)row * 8 + 4); rs = (0.10206207261596575f * LOG2E) / sqrtf(((a[0] + a[1]) + (a[2] + a[3]) + (b[0] + b[1]) + (b[2] + b[3])) * (1.f / 256.f) + RMS_EPS); }
                else { const f32x4 a = *(const f32x4*)(ssq_kv + (size_t)row * 4); rs = 1.0f / sqrtf(((a[0] + a[1]) + (a[2] + a[3])) * (1.f / 128.f) + RMS_EPS); }
#pragma unroll
                for (int bj = 0; bj < 2; ++bj) {
                    const int cg = pn * 8 + bj * 4 + wc; if (cg >= cg_end) continue;
                    float v[8];
#pragma unroll
                    for (int e = 0; e < 4; ++e) { v[e] = acc[ai][bj][m][0][e] * rs; v[4 + e] = acc[ai][bj][m][1][e] * rs; }
                    if (isq && cg >= 12) rope8(v, cosA + pos * 16 + 8 * (fq & 1), sinA + pos * 16 + 8 * (fq & 1), fq, 1.0f);
                    u32x4 w; w.x = pk_f16(v[0], v[1]); w.y = pk_f16(v[2], v[3]); w.z = pk_f16(v[4], v[5]); w.w = pk_f16(v[6], v[7]);
                    *(u32x4*)(O + (size_t)row * QW + cg * 32 + 8 * fq) = w;
                }
            }
    }
};
struct EpiResF32 {
    static constexpr bool PERM = true; static constexpr bool KSCALE = false;
    const f16* X; f16* Y; int ldc; float alpha; float ascale;
    __device__ __forceinline__ void operator()(const f32x4 (&acc)[2][2][4][2], const Unit& u, int wr, int wc, int fr, int fq) const {
        const int row0 = u.pm * BM + wr * 64 + fr, col0 = u.pn * BM + wc * 32 + 8 * fq;
#pragma unroll
        for (int ai = 0; ai < 2; ++ai)
#pragma unroll
            for (int m = 0; m < 4; ++m) { const size_t off = (size_t)(row0 + ai * HALF + m * 16) * ldc + col0;
#pragma unroll
                for (int bj = 0; bj < 2; ++bj) { const f16x8 xv = *(const f16x8*)(X + off + bj * HALF); const f32x4 a0 = acc[ai][bj][m][0] * ascale, a1 = acc[ai][bj][m][1] * ascale;
                    u32x4 w; w.x = pk_f16(alpha * (float)xv[0] + a0[0], alpha * (float)xv[1] + a0[1]); w.y = pk_f16(alpha * (float)xv[2] + a0[2], alpha * (float)xv[3] + a0[3]);
                    w.z = pk_f16(alpha * (float)xv[4] + a1[0], alpha * (float)xv[5] + a1[1]); w.w = pk_f16(alpha * (float)xv[6] + a1[2], alpha * (float)xv[7] + a1[3]);
                    *(u32x4*)(Y + off + bj * HALF) = w; } }
    }
};
struct EpiResMix : EpiResF32 {
    static constexpr bool KSCALE = true;
    const float* ssq_o;
    __device__ __forceinline__ void load_scales(const Unit& u, int wr, int fr, float (&s1)[2][4], float (&s2)[2][4]) const {
#pragma unroll
        for (int ai = 0; ai < 2; ++ai)
#pragma unroll
            for (int m = 0; m < 4; ++m) { const float* sp = ssq_o + (size_t)(u.pm * BM + ai * HALF + wr * 64 + m * 16 + fr) * 16;
                const f32x4 a = *(const f32x4*)sp, b = *(const f32x4*)(sp + 4), c = *(const f32x4*)(sp + 8);
                const float sa = 1.0f / sqrtf(((a[0] + a[1]) + (a[2] + a[3]) + (b[0] + b[1])) * (1.f / 384.f) + RMS_EPS);
                const float sc = 1.0f / sqrtf(((b[2] + b[3]) + (c[0] + c[1]) + c[2]) * (1.f / 320.f) + RMS_EPS);
                s1[ai][m] = sa / sc; s2[ai][m] = sc; }
    }
};
struct EpiSwiGLU {
    static constexpr bool PERM = true; static constexpr bool KSCALE = false;
    unsigned char* O; unsigned char* O2; int split; int ldc; float ascale;
    __device__ __forceinline__ void operator()(const f32x4 (&acc)[2][2][4][2], const Unit& u, int wr, int wc, int fr, int fq) const {
        unsigned char* base = u.pm < split ? O + (size_t)u.pm * BM * ldc : O2 + (size_t)(u.pm - split) * BM * ldc;
        const int row0 = wr * 64 + fr, col0 = u.pn * HALF + wc * 32 + 8 * fq;
#pragma unroll
        for (int ai = 0; ai < 2; ++ai)
#pragma unroll
            for (int m = 0; m < 4; ++m) { unsigned char* rowp = base + (size_t)(row0 + ai * HALF + m * 16) * ldc + col0;
                float r[8];
#pragma unroll
                for (int n = 0; n < 2; ++n)
#pragma unroll
                    for (int e = 0; e < 4; ++e) r[n * 4 + e] = silu_f(acc[ai][0][m][n][e] * ascale) * (acc[ai][1][m][n][e] * (ascale * F8_HS));
                u32x2 w; w.x = pk_fp8x4(r[0], r[1], r[2], r[3]); w.y = pk_fp8x4(r[4], r[5], r[6], r[7]);
                *(u32x2*)rowp = w; }
    }
};
struct EpiScatter {
    static constexpr bool PERM = true; static constexpr bool KSCALE = false;
    f16* C0; size_t slot_stride; const int* rowtok; const float* roww; float ascale;
    __device__ __forceinline__ void operator()(const f32x4 (&acc)[2][2][4][2], const Unit& u, int wr, int wc, int fr, int fq) const {
        const int row0 = u.pm * BM + wr * 64 + fr, col0 = u.pn * BM + wc * 32 + 8 * fq;
#pragma unroll
        for (int ai = 0; ai < 2; ++ai)
#pragma unroll
            for (int m = 0; m < 4; ++m) { const int prow = row0 + ai * HALF + m * 16; const int ts = rowtok[prow]; const float w = roww[prow] * ascale;
                if (ts >= 0) { f16* rowp = C0 + (size_t)(ts & 1) * slot_stride + (size_t)(ts >> 1) * D + col0;
#pragma unroll
                    for (int bj = 0; bj < 2; ++bj) { const f32x4 v0 = acc[ai][bj][m][0] * w, v1 = acc[ai][bj][m][1] * w;
                        u32x4 o; o.x = pk_f16(v0[0], v0[1]); o.y = pk_f16(v0[2], v0[3]); o.z = pk_f16(v1[0], v1[1]); o.w = pk_f16(v1[2], v1[3]);
                        *(u32x4*)(rowp + bj * HALF) = o; } } }
    }
};

__device__ __forceinline__ const char* sgpr_ptr(const char* p) { const unsigned long long v = (unsigned long long)p; const unsigned lo = __builtin_amdgcn_readfirstlane((unsigned)v), hi = __builtin_amdgcn_readfirstlane((unsigned)(v >> 32)); return (const char*)(((unsigned long long)hi << 32) | lo); }
template <class Sched>
__device__ __forceinline__ void a_offsets(const Sched& S, const Unit& u, int rowb, int tid, unsigned (&ao)[2][2]) {
#pragma unroll
    for (int h = 0; h < 2; ++h)
#pragma unroll
        for (int i = 0; i < 2; ++i) { int R, C; stage_rc(tid * 16 + i * 8192, R, C); ao[h][i] = (unsigned)S.a_row(u, h * HALF + R) * (unsigned)rowb + (unsigned)C * 2u; }
}

template <class Epi, class Sched, bool ALIGN_EPI, bool F8 = false>
__device__ __forceinline__ void gemm_phase(LAS unsigned char* lds, const Gemm g, const Sched& S, const Epi& E) {
    constexpr bool GATHER = Sched::GATHER; constexpr int ESZ = F8 ? 1 : 2;
    int tid_ = threadIdx.x; asm volatile("" : "+v"(tid_));
    const int tid = tid_, wid = __builtin_amdgcn_readfirstlane(tid >> 6), lane = tid & 63, wr = wid >> 2, wc = wid & 3, fr = lane & 15, fq = lane >> 4;
    const int nt = g.K * ESZ / (BK * 2); const int rowA = g.lda * ESZ, rowB = g.ldb * ESZ;
    unsigned voffB[2], voffA[2];
#pragma unroll
    for (int i = 0; i < 2; ++i) { int R, C; stage_rc(tid * 16 + i * 8192, R, C); const int Rb = Epi::PERM ? ((R & ~31) + perm32(R & 31)) : R; voffB[i] = (unsigned)(Rb * rowB + C * 2); voffA[i] = (unsigned)(R * rowA + C * 2); }
    const size_t kstep = (size_t)(BK * 2);
    const size_t hstepB = (size_t)HALF * rowB, tstepB = 2 * hstepB;
    const size_t hstepA = (size_t)HALF * rowA;
    const unsigned ldsw = (unsigned)wid * 1024u;
    const int aoff = lds_byte(wr * 64 + fr, fq * 8), boff = lds_byte(wc * 32 + fr, fq * 8);
#define PG8_SA(b, h) (((b) * 2 + (h)) * HTB)
#define PG8_SB(b, h) ((4 + (b) * 2 + (h)) * HTB)
#define PG8_STAGEB(bufoff, gbase) do { _Pragma("unroll") for (int _i = 0; _i < 2; ++_i) \
        __builtin_amdgcn_global_load_lds((const unsigned*)(sgpr_ptr((const char*)(gbase)) + voffB[_i]), (LAS unsigned*)(lds + (bufoff) + ldsw + _i * 8192), 16, 0, 0); } while (0)
#define PG8_STAGEA(bufoff, ub, kb, h) do { _Pragma("unroll") for (int _i = 0; _i < 2; ++_i) \
        __builtin_amdgcn_global_load_lds((const unsigned*)(sgpr_ptr((ub) + (kb) + (GATHER ? (size_t)0 : (size_t)(h) * hstepA)) + (GATHER ? cao[h][_i] : voffA[_i])), (LAS unsigned*)(lds + (bufoff) + ldsw + _i * 8192), 16, 0, 0); } while (0)
#define PG8_LD16(p) (*(const LAS i32x4*)(p))
#define PG8_LDA(dst, b, h) do { _Pragma("unroll") for (int m = 0; m < 4; ++m) { const LAS unsigned char* p_ = lds + PG8_SA(b, h) + aoff + m * 2048; const i32x4 lo_ = PG8_LD16(p_), hi_ = PG8_LD16(p_ + 1024); dst[m] = __builtin_shufflevector(lo_, hi_, 0, 1, 2, 3, 4, 5, 6, 7); } } while (0)
#define PG8_LDB(dst, b, h) do { _Pragma("unroll") for (int n = 0; n < 2; ++n) { const LAS unsigned char* p_ = lds + PG8_SB(b, h) + boff + n * 2048; const i32x4 lo_ = PG8_LD16(p_), hi_ = PG8_LD16(p_ + 1024); dst[n] = __builtin_shufflevector(lo_, hi_, 0, 1, 2, 3, 4, 5, 6, 7); } } while (0)
#define PG8_HALF(x, k) __builtin_bit_cast(f16x8, __builtin_shufflevector(x, x, 4 * (k), 4 * (k) + 1, 4 * (k) + 2, 4 * (k) + 3))
#define PG8_MMA(ai, bj, At, Bt) do { __builtin_amdgcn_s_setprio(1); _Pragma("unroll") for (int m = 0; m < 4; ++m) _Pragma("unroll") for (int n = 0; n < 2; ++n) { \
        if constexpr (F8) asm volatile("v_mfma_f32_16x16x128_f8f6f4 %0, %1, %2, %0" : "+v"(acc[ai][bj][m][n]) : "v"(Bt[n]), "v"(At[m])); \
        else { acc[ai][bj][m][n] = __builtin_amdgcn_mfma_f32_16x16x32_f16(PG8_HALF(Bt[n], 0), PG8_HALF(At[m], 0), acc[ai][bj][m][n], 0, 0, 0); \
               acc[ai][bj][m][n] = __builtin_amdgcn_mfma_f32_16x16x32_f16(PG8_HALF(Bt[n], 1), PG8_HALF(At[m], 1), acc[ai][bj][m][n], 0, 0, 0); } } __builtin_amdgcn_s_setprio(0); } while (0)
#define PG8_WAIT_V(n) asm volatile("s_waitcnt vmcnt(" #n ")" ::: "memory")
#define PG8_WAIT_L(n) asm volatile("s_waitcnt lgkmcnt(" #n ")" ::: "memory")
#define PG8_BAR __builtin_amdgcn_s_barrier()
#define PG8_SCHED __builtin_amdgcn_sched_barrier(0)
    Unit cur, nxt; int ui = 0;
    if (!S.next(0, cur)) return;
    unsigned cao[2][2];
    if constexpr (GATHER) a_offsets(S, cur, rowA, tid, cao);
    const char* cA = S.a_tile(cur, (const char*)g.A, (size_t)rowA);
    const char* cB = (const char*)g.Bt + S.b_base(cur) + (size_t)cur.pn * tstepB;
    PG8_STAGEB(PG8_SB(0, 0), cB); PG8_STAGEB(PG8_SB(0, 1), cB + hstepB); PG8_STAGEA(PG8_SA(0, 0), cA, 0, 0); PG8_STAGEA(PG8_SA(0, 1), cA, 0, 1);
    if (wr == 1) PG8_BAR;
    PG8_WAIT_V(2); PG8_BAR;
    PG8_STAGEB(PG8_SB(1, 0), cB + kstep); PG8_STAGEA(PG8_SA(1, 0), cA, kstep, 0); PG8_STAGEB(PG8_SB(1, 1), cB + hstepB + kstep);
    PG8_WAIT_V(6); PG8_BAR;
    f32x4 acc[2][2][4][2];
#pragma unroll
    for (int a = 0; a < 2; ++a)
#pragma unroll
        for (int b = 0; b < 2; ++b)
#pragma unroll
            for (int m = 0; m < 4; ++m)
#pragma unroll
                for (int n = 0; n < 2; ++n) acc[a][b][m][n] = (f32x4){0.f, 0.f, 0.f, 0.f};
    i32x8 At[4], B0[2], B1[2];
    for (;;) {
        const bool has_next = S.next(ui + 1, nxt);
        float ks1[2][4], ks2[2][4];
        if constexpr (Epi::KSCALE) E.load_scales(cur, wr, fr, ks1, ks2);
        const char* nB = cB; const char* nA = cA;
        if (has_next) { nB = (const char*)g.Bt + S.b_base(nxt) + (size_t)nxt.pn * tstepB; nA = S.a_tile(nxt, (const char*)g.A, (size_t)rowA); }
#pragma unroll 1
        for (int t = 0; t < nt; t += 2) {
            const bool last = (t == nt - 2);
            if constexpr (Epi::KSCALE) { if (t == 6 || t == 12) {
#pragma unroll
                for (int a = 0; a < 2; ++a)
#pragma unroll
                    for (int m = 0; m < 4; ++m) { const float f = t == 6 ? ks1[a][m] : ks2[a][m];
#pragma unroll
                        for (int b = 0; b < 2; ++b)
#pragma unroll
                            for (int n = 0; n < 2; ++n) acc[a][b][m][n] *= f; } } }
            const size_t ka1 = (size_t)(t + 1) * kstep;
            const size_t ka2 = last ? 0 : (size_t)(t + 2) * kstep, ka3 = ka2 + kstep;
            const char* a2 = last ? nA : cA;
            const char* b2 = last ? nB : cB + (size_t)(t + 2) * kstep; const char* b3 = b2 + kstep;
            PG8_LDB(B0, 0, 0); PG8_LDB(B1, 0, 1); PG8_SCHED; PG8_LDA(At, 0, 0); PG8_STAGEA(PG8_SA(1, 1), cA, ka1, 1);
            if constexpr (GATHER) { if (last && has_next) a_offsets(S, nxt, rowA, tid, cao); }
            PG8_WAIT_V(8); PG8_WAIT_L(0); PG8_BAR; PG8_MMA(0, 0, At, B0); PG8_MMA(0, 1, At, B1); PG8_BAR; PG8_SCHED;
            PG8_LDA(At, 0, 1); PG8_STAGEB(PG8_SB(0, 0), b2); PG8_STAGEB(PG8_SB(0, 1), b2 + hstepB); PG8_STAGEA(PG8_SA(0, 0), a2, ka2, 0);
            PG8_WAIT_V(8); PG8_WAIT_L(0); PG8_BAR; PG8_MMA(1, 0, At, B0); PG8_MMA(1, 1, At, B1); PG8_BAR; PG8_SCHED;
            PG8_LDB(B0, 1, 0); PG8_LDB(B1, 1, 1); PG8_SCHED; PG8_LDA(At, 1, 0); PG8_STAGEA(PG8_SA(0, 1), a2, ka2, 1);
            PG8_WAIT_V(8); PG8_WAIT_L(0); PG8_BAR; PG8_MMA(0, 0, At, B0); PG8_MMA(0, 1, At, B1); PG8_BAR; PG8_SCHED;
            PG8_LDA(At, 1, 1); PG8_STAGEB(PG8_SB(1, 0), b3); PG8_STAGEB(PG8_SB(1, 1), b3 + hstepB); PG8_STAGEA(PG8_SA(1, 0), a2, ka3, 0);
            PG8_WAIT_V(8); PG8_WAIT_L(0); PG8_BAR; PG8_MMA(1, 0, At, B0); PG8_MMA(1, 1, At, B1); PG8_BAR; PG8_SCHED;
        }
        if constexpr (ALIGN_EPI) { if (wr == 0) PG8_BAR; }
        if constexpr (F8) asm volatile("s_nop 15\n\ts_nop 15" ::: "memory");
        { int t2 = threadIdx.x; asm volatile("" : "+v"(t2)); const int l2 = t2 & 63; E(acc, cur, wr, wc, l2 & 15, l2 >> 4); }
        if (!has_next) break;
#pragma unroll
        for (int a = 0; a < 2; ++a)
#pragma unroll
            for (int b = 0; b < 2; ++b)
#pragma unroll
                for (int m = 0; m < 4; ++m)
#pragma unroll
                    for (int n = 0; n < 2; ++n) acc[a][b][m][n] = (f32x4){0.f, 0.f, 0.f, 0.f};
        cur = nxt; cB = nB; cA = nA; ++ui;
        if constexpr (ALIGN_EPI) { if (wr == 1) PG8_BAR; }
    }
    PG8_WAIT_V(0);
    if constexpr (!ALIGN_EPI) { if (wr == 0) PG8_BAR; }
    PG8_BAR;
#undef PG8_SA
#undef PG8_SB
#undef PG8_STAGEA
#undef PG8_STAGEB
#undef PG8_LDA
#undef PG8_LDB
#undef PG8_MMA
#undef PG8_HALF
#undef PG8_LD16
#undef PG8_WAIT_V
#undef PG8_WAIT_L
#undef PG8_BAR
#undef PG8_SCHED
}
}

struct Args {
    const float* x; const float* ln_emb_g; const float* ln_emb_b; const float* w_in; const float* q_norm_g; const float* kv_norm_g;
    const float* w_uq; const float* w_ukv; const float* beta_mla; const float* beta_moba; const float* w_o; const float* ln1_g; const float* ln1_b;
    const float* ffn_w_gate; const float* ffn_w_up; const float* ffn_w_down; const float* router; const float* exp_w_gate; const float* exp_w_up;
    const float* exp_w_down; const float* ln2_g; const float* ln2_b;
    float* out; unsigned char* ws; int ph_lo, ph_hi;
};
struct Frame {
    LAS unsigned char* lds; int tid, lane, wave, bid, G;
};

enum { CM_ID = 0, CM_WIN = 1, CM_UQ = 2, CM_UKV = 3, CM_GU = 4, CM_WO = 5 };
__device__ __forceinline__ int colmap(int kind, int n, int aux) {
    switch (kind) {
    case CM_WIN: {
        if (n >= HC_END) return -1;
        if (n >= HC_RQ && n < HC_RV) { const int base = n < HC_RK ? HC_RQ : HC_RK, r = n - base, hh = r >> 6, p = r & 63; const int d = ((p >> 5) << 4) + (p & 15) + ((p & 16) ? 32 : 0); return base + hh * 64 + d; }
        return n; }
    case CM_UQ: {
        if (n < 384) return (n >> 6) * 96 + (n & 63);
        if (n < 576) { const int r = n - 384; return (r >> 5) * 96 + 64 + (r & 31); }
        return -1; }
    case CM_UKV: {
        if (n < 384) return (n >> 6) * 128 + (n & 63);
        { const int r = n - 384; return (r >> 6) * 128 + 64 + (r & 63); } }
    case CM_GU: {
        const int j = n >> 8, w = n & 255; return j * 128 + (w & 127) + ((w >> 7) ? aux : 0); }
    default: return n;
    }
}
__device__ __forceinline__ void transpose_item(const float* W0, const float* W1, int K, int N, f16* WT, int kind, const float* kscale, const float* kscale2, LAS float* scr, int item, int nblk, int lane, int ldt = 0) {
    if (ldt == 0) ldt = K;
    const int kb = item / nblk, nb = item % nblk, n0 = 32 * nb; const int kd0 = 64 * kb;
    int k0 = kd0;
    const int nn = lane & 31; int sc = colmap(kind == CM_WO ? CM_ID : kind, n0 + nn, N); const float* W = W0;
    if (kind == CM_GU && sc >= N) { sc -= N; W = W1; }
    if (kind == CM_WO) { if (kb < 6) k0 = 64 * kb; else if (kb < 11) k0 = 704 + 64 * (kb - 6); else if (kb == 11 || kb == 17) { k0 = 0; sc = -1; } else k0 = 384 + 64 * (kb - 12); }
#pragma unroll 8
    for (int i = 0; i < 32; ++i) { const int kk = 2 * i + (lane >> 5); float v = 0.f; if (sc >= 0) v = W[(size_t)(k0 + kk) * N + sc]; if (kscale2) { const int k = k0 + kk; v *= k < 384 ? kscale[k] : (k >= 704 ? kscale2[k - 704] : 1.0f); } else if (kscale) v *= kscale[k0 + kk]; scr[kk * 33 + nn] = v; }
    asm volatile("s_waitcnt lgkmcnt(0)" ::: "memory");
    const int c = lane & 7;
#pragma unroll
    for (int j = 0; j < 4; ++j) { const int n = (lane >> 3) + 8 * j; const LAS float* s = scr + (8 * c) * 33 + n;
        u32x4 o; o.x = pk_f16(s[0 * 33], s[1 * 33]); o.y = pk_f16(s[2 * 33], s[3 * 33]); o.z = pk_f16(s[4 * 33], s[5 * 33]); o.w = pk_f16(s[6 * 33], s[7 * 33]);
        *(u32x4*)(WT + (size_t)(n0 + n) * ldt + kd0 + 8 * c) = o; }
    asm volatile("s_waitcnt lgkmcnt(0)" ::: "memory");
}

__device__ __forceinline__ void transpose_item8(const float* W0, const float* W1, int K, int N, unsigned char* WT, int kind, LAS float* scr, int item, int nblk, int lane) {
    const int kb = item / nblk, nb = item % nblk, k0 = 64 * kb, n0 = 32 * nb;
    const int nn = lane & 31; int sc = colmap(kind, n0 + nn, N); const float* W = W0;
    if (kind == CM_GU && sc >= N) { sc -= N; W = W1; }
#pragma unroll 8
    for (int i = 0; i < 32; ++i) { const int kk = 2 * i + (lane >> 5); scr[kk * 33 + nn] = W[(size_t)(k0 + kk) * N + sc] * F8_WS; }
    asm volatile("s_waitcnt lgkmcnt(0)" ::: "memory");
    const int c = lane & 3;
#pragma unroll
    for (int j = 0; j < 2; ++j) { const int n = (lane >> 2) + 16 * j; const LAS float* sp = scr + (16 * c) * 33 + n;
        u32x4 o; o.x = pk_fp8x4(sp[0 * 33], sp[1 * 33], sp[2 * 33], sp[3 * 33]); o.y = pk_fp8x4(sp[4 * 33], sp[5 * 33], sp[6 * 33], sp[7 * 33]);
        o.z = pk_fp8x4(sp[8 * 33], sp[9 * 33], sp[10 * 33], sp[11 * 33]); o.w = pk_fp8x4(sp[12 * 33], sp[13 * 33], sp[14 * 33], sp[15 * 33]);
        *(u32x4*)(WT + (size_t)(n0 + n) * K + k0 + 16 * c) = o; }
    asm volatile("s_waitcnt lgkmcnt(0)" ::: "memory");
}

__device__ __forceinline__ void ln_stats(const f32x4 (&v)[4], float& mean, float& rstd) {
    float s = 0.f;
#pragma unroll
    for (int j = 0; j < 4; ++j) s += (v[j][0] + v[j][1]) + (v[j][2] + v[j][3]);
    mean = wave_sum(s) * (1.f / D); float s2 = 0.f;
#pragma unroll
    for (int j = 0; j < 4; ++j) { const f32x4 d = v[j] - mean; s2 += (d[0] * d[0] + d[1] * d[1]) + (d[2] * d[2] + d[3] * d[3]); }
    rstd = 1.0f / sqrtf(wave_sum(s2) * (1.f / D) + LN_EPS);
}

__device__ __forceinline__ void ln_stats16(const float (&v)[16], float& mean, float& rstd) {
    float s = 0.f;
#pragma unroll
    for (int i = 0; i < 16; ++i) s += v[i];
    mean = wave_sum(s) * (1.f / D); float s2 = 0.f;
#pragma unroll
    for (int i = 0; i < 16; ++i) { const float d = v[i] - mean; s2 += d * d; }
    rstd = 1.0f / sqrtf(wave_sum(s2) * (1.f / D) + LN_EPS);
}
__device__ __forceinline__ void ln_load_y16(const f16* yrow, int lane, float (&v)[16]) {
    const f16x8 a = *(const f16x8*)(yrow + 8 * lane), b = *(const f16x8*)(yrow + 512 + 8 * lane);
#pragma unroll
    for (int e = 0; e < 8; ++e) { v[e] = (float)a[e]; v[8 + e] = (float)b[e]; }
}
__device__ __forceinline__ void ln_affine16(float (&v)[16], float mean, float rstd, const float* g, const float* b, int lane) {
#pragma unroll
    for (int h = 0; h < 2; ++h)
#pragma unroll
        for (int q = 0; q < 2; ++q) { const f32x4 gv = *(const f32x4*)(g + 512 * h + 8 * lane + 4 * q), bv = *(const f32x4*)(b + 512 * h + 8 * lane + 4 * q);
#pragma unroll
            for (int e = 0; e < 4; ++e) v[8 * h + 4 * q + e] = (v[8 * h + 4 * q + e] - mean) * rstd * gv[e] + bv[e]; }
}
__device__ __forceinline__ void ln_store_xb16(f16* xrow, int lane, const float (&v)[16]) {
#pragma unroll
    for (int h = 0; h < 2; ++h) { u32x4 w; w.x = pk_f16(v[8 * h], v[8 * h + 1]); w.y = pk_f16(v[8 * h + 2], v[8 * h + 3]); w.z = pk_f16(v[8 * h + 4], v[8 * h + 5]); w.w = pk_f16(v[8 * h + 6], v[8 * h + 7]); *(u32x4*)(xrow + 512 * h + 8 * lane) = w; }
}

template <int DK>
__device__ __forceinline__ void stage_kv(LAS float* Ks, LAS float* Vs, const f16* kp, int kld, const f16* k2p, int k2ld, const f16* vp, int vld, size_t row0, int tid) {
    constexpr int KCH = DK / 8;
    for (int t = tid; t < 32 * KCH + 32 * 8; t += 512) {
        if (t < 32 * KCH) { const int key = t / KCH, ch = t % KCH; const f16* src = (ch < 8) ? kp + (row0 + key) * kld + ch * 8 : k2p + (row0 + key) * k2ld + (ch - 8) * 8;
            const f16x8 v = *(const f16x8*)src; LAS float* d = Ks + key * DK + ch * 8;
#pragma unroll
            for (int e = 0; e < 8; ++e) d[e] = (float)v[e]; }
        else { const int t2 = t - 32 * KCH, key = t2 >> 3, ch = t2 & 7; const f16x8 v = *(const f16x8*)(vp + (row0 + key) * vld + ch * 8); LAS float* d = Vs + key * 64 + ch * 8;
#pragma unroll
            for (int e = 0; e < 8; ++e) d[e] = (float)v[e]; }
    }
}

template <int MODE>
__device__ __forceinline__ void attn_softmax_simple(const Frame& F, const f16* qb, const f16* kvb, const f16* hb, const float* kmean, f16* ob, float* ssq_o) {
    constexpr int DK = MODE == 0 ? 96 : 64, NHD = MODE == 0 ? 6 : 5;
    LAS float* Ks = (LAS float*)F.lds; LAS float* Vs = Ks + 32 * DK; LAS float* KM = Vs + 32 * 64;
    const int tid = F.tid;
    for (int unit = F.bid; unit < BATCH * NHD * 4; unit += F.G) {
        const int qt = 3 - (unit % 4), hh = (unit / 4) % NHD, b = unit / (4 * NHD);
        const size_t brow = (size_t)b * SEQ; const int qpos = qt * 512 + tid; const size_t row = brow + qpos;
        float q[DK];
        if (MODE == 0) {
#pragma unroll
            for (int c = 0; c < 8; ++c) { const f16x8 v = *(const f16x8*)(qb + row * QW + hh * 64 + c * 8);
#pragma unroll
                for (int e = 0; e < 8; ++e) q[c * 8 + e] = (float)v[e]; }
#pragma unroll
            for (int c = 0; c < 4; ++c) { const f16x8 v = *(const f16x8*)(qb + row * QW + 384 + hh * 32 + c * 8);
#pragma unroll
                for (int e = 0; e < 8; ++e) q[64 + c * 8 + e] = (float)v[e]; }
        } else {
#pragma unroll
            for (int c = 0; c < 8; ++c) { const f16x8 v = *(const f16x8*)(hb + row * HW + HC_MQ + hh * 64 + c * 8);
#pragma unroll
                for (int e = 0; e < 8; ++e) q[c * 8 + e] = (float)v[e]; }
        }
        const int blk = qpos >> 8; unsigned sel = 0u; float slope2 = 0.f;
        if (MODE == 1) {
            __syncthreads();
            { const int n = tid >> 6, d = tid & 63; KM[n * 64 + d] = kmean[(size_t)(b * 8 + n) * 320 + hh * 64 + d]; }
            __syncthreads();
            float gt[8];
#pragma unroll
            for (int n = 0; n < 8; ++n) { float s = 0.f;
#pragma unroll
                for (int d = 0; d < 64; ++d) s += q[d] * KM[n * 64 + d];
                gt[n] = s; }
#pragma unroll
            for (int n = 0; n < 8; ++n) { int rank = 0;
#pragma unroll
                for (int m = 0; m < 8; ++m) if (m < blk && m != n) rank += (gt[m] > gt[n] || (gt[m] == gt[n] && m < n)) ? 1 : 0;
                if (n < blk && rank < 3) sel |= 1u << n; }
            slope2 = exp2f(-8.0f * (float)(hh + 1) / 5.0f) * LOG2E;
        }
        float o[64];
#pragma unroll
        for (int d = 0; d < 64; ++d) o[d] = 0.f;
        float mrun = -INFINITY, lrun = 0.f;
        const int nkeys = (qt + 1) * 512;
        for (int k0 = 0; k0 < nkeys; k0 += 32) {
            __syncthreads();
            if (MODE == 0) stage_kv<96>(Ks, Vs, kvb + hh * 64, KVW, hb + HC_KR, HW, kvb + 384 + hh * 64, KVW, brow + k0, tid);
            else stage_kv<64>(Ks, Vs, hb + HC_MK + hh * 64, HW, nullptr, 0, hb + HC_MV + hh * 64, HW, brow + k0, tid);
            __syncthreads();
            bool part;
            if (MODE == 0) part = k0 <= qpos;
            else { const int n = k0 >> 8; part = (n == blk) ? (k0 <= qpos) : (n < blk && ((sel >> n) & 1u)); }
            if (part) {
#pragma unroll 1
                for (int j = 0; j < 32; ++j) {
                    if (k0 + j > qpos) break;
                    const LAS float* Kj = Ks + j * DK; const LAS float* Vj = Vs + j * 64;
                    float a = 0.f;
#pragma unroll
                    for (int d = 0; d < DK; d += 4) { const f32x4 kv4 = *(const LAS f32x4*)(Kj + d); a += q[d] * kv4[0] + q[d + 1] * kv4[1] + q[d + 2] * kv4[2] + q[d + 3] * kv4[3]; }
                    if (MODE == 1) a -= slope2 * (float)(qpos - (k0 + j));
                    if (a > mrun) { const float alpha = exp2f(mrun - a); lrun *= alpha;
#pragma unroll
                        for (int d = 0; d < 64; ++d) o[d] *= alpha;
                        mrun = a; }
                    const float p = exp2f(a - mrun); lrun += p;
#pragma unroll
                    for (int d = 0; d < 64; d += 4) { const f32x4 v4 = *(const LAS f32x4*)(Vj + d); o[d] += p * v4[0]; o[d + 1] += p * v4[1]; o[d + 2] += p * v4[2]; o[d + 3] += p * v4[3]; }
                }
            }
        }
        const float inv = 1.0f / lrun; float ss = 0.f;
#pragma unroll
        for (int d = 0; d < 64; ++d) { o[d] *= inv; ss += o[d] * o[d]; }
        f16* op = ob + row * D + (MODE == 0 ? 0 : OC_MOBA) + hh * 64;
#pragma unroll
        for (int c = 0; c < 8; ++c) { u32x4 w; w.x = pk_f16(o[c * 8], o[c * 8 + 1]); w.y = pk_f16(o[c * 8 + 2], o[c * 8 + 3]); w.z = pk_f16(o[c * 8 + 4], o[c * 8 + 5]); w.w = pk_f16(o[c * 8 + 6], o[c * 8 + 7]); *(u32x4*)(op + c * 8) = w; }
        ssq_o[row * 16 + (MODE == 0 ? 0 : 6) + hh] = ss;
    }
}
__device__ __forceinline__ void attn_ret_simple(const Frame& F, const f16* hb, f16* ob) {
    LAS float* Ks = (LAS float*)F.lds; LAS float* Vs = Ks + 32 * 64;
    const int tid = F.tid;
    for (int unit = F.bid; unit < BATCH * 5 * 4; unit += F.G) {
        const int qt = 3 - (unit % 4), hh = (unit / 4) % 5, b = unit / 20;
        const size_t brow = (size_t)b * SEQ; const int qpos = qt * 512 + tid; const size_t row = brow + qpos;
        float q[64];
#pragma unroll
        for (int c = 0; c < 8; ++c) { const f16x8 v = *(const f16x8*)(hb + row * HW + HC_RQ + hh * 64 + c * 8);
#pragma unroll
            for (int e = 0; e < 8; ++e) q[c * 8 + e] = (float)v[e]; }
        const float lg2 = log2f(1.0f - exp2f(-5.0f - (float)hh));
        float o[64];
#pragma unroll
        for (int d = 0; d < 64; ++d) o[d] = 0.f;
        const int nkeys = (qt + 1) * 512;
        for (int k0 = 0; k0 < nkeys; k0 += 32) {
            __syncthreads();
            stage_kv<64>(Ks, Vs, hb + HC_RK + hh * 64, HW, nullptr, 0, hb + HC_RV + hh * 64, HW, brow + k0, tid);
            __syncthreads();
            if (k0 <= qpos) {
#pragma unroll 1
                for (int j = 0; j < 32; ++j) {
                    const int dl = qpos - (k0 + j); if (dl < 0) break;
                    const LAS float* Kj = Ks + j * 64; const LAS float* Vj = Vs + j * 64;
                    float a = 0.f;
#pragma unroll
                    for (int d = 0; d < 64; d += 4) { const f32x4 kv4 = *(const LAS f32x4*)(Kj + d); a += q[d] * kv4[0] + q[d + 1] * kv4[1] + q[d + 2] * kv4[2] + q[d + 3] * kv4[3]; }
                    const float p = a * exp2f(lg2 * (float)dl);
#pragma unroll
                    for (int d = 0; d < 64; d += 4) { const f32x4 v4 = *(const LAS f32x4*)(Vj + d); o[d] += p * v4[0]; o[d + 1] += p * v4[1]; o[d + 2] += p * v4[2]; o[d + 3] += p * v4[3]; }
                }
            }
        }
        float mu = 0.f;
#pragma unroll
        for (int d = 0; d < 64; ++d) mu += o[d];
        mu *= (1.f / 64.f); float var = 0.f;
#pragma unroll
        for (int d = 0; d < 64; ++d) { const float t = o[d] - mu; var += t * t; }
        const float rs = 1.0f / sqrtf(var * (1.f / 64.f) + RMS_EPS);
        f16* op = ob + row * D + OC_RET + hh * 64; const f16* gp = hb + row * HW + HC_RG + hh * 64;
#pragma unroll
        for (int c = 0; c < 8; ++c) { const f16x8 gv = *(const f16x8*)(gp + c * 8); float r[8];
#pragma unroll
            for (int e = 0; e < 8; ++e) r[e] = silu_f((float)gv[e]) * ((o[c * 8 + e] - mu) * rs);
            u32x4 w; w.x = pk_f16(r[0], r[1]); w.y = pk_f16(r[2], r[3]); w.z = pk_f16(r[4], r[5]); w.w = pk_f16(r[6], r[7]); *(u32x4*)(op + c * 8) = w; }
    }
}

namespace att {
typedef float f32x16 __attribute__((ext_vector_type(16)));
typedef short s16x4 __attribute__((ext_vector_type(4)));
constexpr int BUF_STRIDE = 40960, OFF_V = 16384, OFF_PE = 32768, OFF_OSTG = 0, OSTG_WAVE = 32 * 272, OFF_L = MISC_OFF + 256, OFF_F = OFF_L + 1024, OFF_QW = OFF_F + 1024;
static_assert(2 * BUF_STRIDE <= RING_BYTES && 8 * OSTG_WAVE <= RING_BYTES && OFF_QW + 16 <= LDS_BYTES, "attention LDS map");
constexpr float THR = 8.0f;
__device__ __forceinline__ int crowc(int r) { return (r & 3) + 8 * (r >> 2); }
__device__ __forceinline__ float pswap_max(float v) { const auto rr = __builtin_amdgcn_permlane32_swap(__float_as_uint(v), __float_as_uint(v), false, false); return fmaxf(__uint_as_float(rr[0]), __uint_as_float(rr[1])); }
__device__ __forceinline__ float pswap_sum(float v) { const auto rr = __builtin_amdgcn_permlane32_swap(__float_as_uint(v), __float_as_uint(v), false, false); return __uint_as_float(rr[0]) + __uint_as_float(rr[1]); }
__device__ __forceinline__ float max3f(float a, float b, float c) { float r; asm("v_max3_f32 %0, %1, %2, %3" : "=v"(r) : "v"(a), "v"(b), "v"(c)); return r; }
#define ATT_WAIT_BAR() asm volatile("s_waitcnt vmcnt(0) lgkmcnt(0)\n\ts_barrier" ::: "memory")
__device__ __forceinline__ f16x8 vfrag(const LAS unsigned char* p0, const LAS unsigned char* p1) {
    const s16x4 lo = __builtin_bit_cast(s16x4, __builtin_amdgcn_ds_read_tr16_b64_v4i16((LAS s16x4*)p0));
    const s16x4 hi = __builtin_bit_cast(s16x4, __builtin_amdgcn_ds_read_tr16_b64_v4i16((LAS s16x4*)p1));
    typedef short s16x8 __attribute__((ext_vector_type(8)));
    const s16x8 v = {lo[0], lo[1], lo[2], lo[3], hi[0], hi[1], hi[2], hi[3]};
    return __builtin_bit_cast(f16x8, v);
}
template <int KIND>
__device__ __forceinline__ void attn_unit(LAS unsigned char* lds, int b, int hh, int qt, const f16* qbuf, const f16* kvbuf, const f16* hbuf, const float* kmean, f16* obuf, float* ssq_o) {
    int tid_ = threadIdx.x; asm volatile("" : "+v"(tid_));
    const int tid = tid_, lane = tid & 63, wid = __builtin_amdgcn_readfirstlane(tid >> 6), r32 = lane & 31, hi = lane >> 5;
    constexpr int NQK = KIND == 0 ? 6 : 4;
    const size_t brow = (size_t)b * SEQ;
    const int q0w = qt * 256 + wid * 32, qpos = q0w + r32;
    const f16* kbase; int kld; const f16* vbase; int vld; const f16* qrow;
    if (KIND == 0) { kbase = kvbuf + hh * 64; kld = KVW; vbase = kvbuf + 384 + hh * 64; vld = KVW; qrow = qbuf + (brow + qpos) * QW + hh * 64; }
    else if (KIND == 1) { kbase = hbuf + HC_MK + hh * 64; kld = HW; vbase = hbuf + HC_MV + hh * 64; vld = HW; qrow = hbuf + (brow + qpos) * HW + HC_MQ + hh * 64; }
    else { kbase = hbuf + HC_RK + hh * 64; kld = HW; vbase = hbuf + HC_RV + hh * 64; vld = HW; qrow = hbuf + (brow + qpos) * HW + HC_RQ + hh * 64; }
    const int dkey = 8 * wid + (lane >> 3), dcs = lane & 7;
    const char* ksrc = (const char*)(kbase + (brow + dkey) * kld + ((dcs ^ ((dkey >> 1) & 7)) << 3));
    const char* vsrc = (const char*)(vbase + (brow + dkey) * vld + (((((dcs >> 2) ^ ((dkey >> 1) & 1)) << 2) | (dcs & 3)) << 3));
    const int pkey = 16 * wid + (lane >> 2), pcs = lane & 3;
    const char* psrc = (const char*)(hbuf + (brow + pkey) * HW + HC_KR + ((pcs ^ ((pkey >> 2) & 3)) << 3));
    const size_t ktile = (size_t)64 * kld * 2, vtile = (size_t)64 * vld * 2, ptile = (size_t)64 * HW * 2;
#define ATT_GLDS(gsrc, ldsdst) do { unsigned keep_; asm volatile("s_mov_b32 %0, m0\n\ts_mov_b32 m0, %2\n\ts_nop 0\n\tglobal_load_lds_dwordx4 %1, off\n\ts_mov_b32 m0, %0" : "=&s"(keep_) : "v"(gsrc), "s"(ldsdst) : "memory"); } while (0)
    const unsigned lds0 = (unsigned)(size_t)lds + (unsigned)wid * 1024u;
#define ATT_DMA(st, buf) do { _Pragma("unroll") for (int j_ = 0; j_ < 2; ++j_) { \
        ATT_GLDS(ksrc + (size_t)(2 * (st) + j_) * ktile, (unsigned)__builtin_amdgcn_readfirstlane(lds0 + (buf) * BUF_STRIDE + j_ * 8192)); \
        ATT_GLDS(vsrc + (size_t)(2 * (st) + j_) * vtile, (unsigned)__builtin_amdgcn_readfirstlane(lds0 + (buf) * BUF_STRIDE + OFF_V + j_ * 8192)); \
        if (KIND == 0) { if (wid < 4) ATT_GLDS(psrc + (size_t)(2 * (st) + j_) * ptile, (unsigned)__builtin_amdgcn_readfirstlane(lds0 + (buf) * BUF_STRIDE + OFF_PE + j_ * 4096)); } } } while (0)
    const int NS = 2 * (qt + 1);
    ATT_DMA(0, 0);
    f16x8 qf[NQK];
#pragma unroll
    for (int d0 = 0; d0 < 4; ++d0) qf[d0] = *(const f16x8*)(qrow + 16 * d0 + 8 * hi);
    if (KIND == 0) { const f16* qpe = qbuf + (brow + qpos) * QW + 384 + hh * 32; qf[4] = *(const f16x8*)(qpe + 8 * hi); qf[5] = *(const f16x8*)(qpe + 16 + 8 * hi); }
#pragma unroll
    for (int d0 = 0; d0 < NQK; ++d0) asm volatile("" : "+v"(qf[d0]));
    const int ksw = (r32 >> 1) & 7, psw = (r32 >> 2) & 3;
    int koff[4];
#pragma unroll
    for (int d0 = 0; d0 < 4; ++d0) koff[d0] = r32 * 128 + (((2 * d0 + hi) ^ ksw) << 4);
    int poff[2];
#pragma unroll
    for (int d0 = 0; d0 < 2; ++d0) poff[d0] = r32 * 64 + (((2 * d0 + hi) ^ psw) << 4);
    const int vq = (lane & 15) >> 2, vp = lane & 3, vg = (lane >> 4) & 1, vsw = (vq >> 1) & 1;
    int voff[2];
#pragma unroll
    for (int d0 = 0; d0 < 2; ++d0) voff[d0] = (4 * hi + vq) * 128 + ((d0 ^ vsw) << 6) + ((2 * vg + (vp >> 1)) << 4) + 8 * (vp & 1);
    unsigned sel = 0u; float slope2 = 0.f;
    if (KIND == 1) {
        slope2 = exp2f(-8.0f * (float)(hh + 1) / 5.0f) * LOG2E;
        if (qt >= 4) {
            if (tid < 64) { const int n = tid >> 3, cs = tid & 7, c = cs ^ ((n >> 1) & 7); const float* src = kmean + (size_t)(b * 8 + n) * 640 + hh * 64 + c * 8;
                const f32x4 a0 = (*(const f32x4*)src + *(const f32x4*)(src + 320)) * (1.f / 256.f), a1 = (*(const f32x4*)(src + 4) + *(const f32x4*)(src + 324)) * (1.f / 256.f);
                u32x4 w; w.x = pk_f16(a0[0], a0[1]); w.y = pk_f16(a0[2], a0[3]); w.z = pk_f16(a1[0], a1[1]); w.w = pk_f16(a1[2], a1[3]);
                *(LAS u32x4*)(lds + BUF_STRIDE + n * 128 + cs * 16) = w; }
            asm volatile("s_waitcnt lgkmcnt(0)\n\ts_barrier" ::: "memory");
            f32x16 pg = {};
#pragma unroll
            for (int d0 = 0; d0 < 4; ++d0) { const f16x8 kf = *(const LAS f16x8*)(lds + BUF_STRIDE + koff[d0]); pg = __builtin_amdgcn_mfma_f32_32x32x16_f16(kf, qf[d0], pg, 0, 0, 0); }
            float gt[8];
#pragma unroll
            for (int r = 0; r < 4; ++r) { const auto rr = __builtin_amdgcn_permlane32_swap(__float_as_uint(pg[r]), __float_as_uint(pg[r]), false, false); gt[r] = __uint_as_float(rr[0]); gt[4 + r] = __uint_as_float(rr[1]); }
#pragma unroll
            for (int n = 0; n < 8; ++n) { int rank = 0;
#pragma unroll
                for (int m = 0; m < 8; ++m) if (m != n) rank += (m < qt && (gt[m] > gt[n] || (gt[m] == gt[n] && m < n))) ? 1 : 0;
                if (n < qt && rank < 3) sel |= 1u << n; }
        } else sel = 0xffu;
    }
    float lg2 = 0.f, e32 = 0.f; float dc[16];
    if (KIND == 2) { lg2 = log2f(1.0f - exp2f(-5.0f - (float)hh)); e32 = exp2f(-32.0f * lg2);
#pragma unroll
        for (int r = 0; r < 16; ++r) dc[r] = exp2f(-lg2 * (float)crowc(r)); }
    f32x16 o0 = {}, o1 = {};
    float mref = 0.f, lsum = 0.f; bool mset = false;
    f32x16 negm = {};
    LAS float* wsf = (LAS float*)(lds + OFF_F) + wid * 32;
    for (int st = 0; st < NS; ++st) {
        ATT_WAIT_BAR();
        if (st + 1 < NS) ATT_DMA(st + 1, (st + 1) & 1);
        const int k0 = 128 * st;
        bool active = k0 <= q0w + 31;
        if (KIND == 1) { const int n = st >> 1; if (n < qt) active = __any((sel >> n) & 1u) != 0; }
        if (!active) continue;
        const bool act1 = (KIND == 1 && (st >> 1) < qt) ? true : (k0 + 64 <= q0w + 31);
        const LAS unsigned char* kb = lds + (st & 1) * BUF_STRIDE;
        f32x16 p[4];
#pragma unroll
        for (int j = 0; j < 2; ++j) {
            if (j == 1 && !act1) break;
            if (KIND == 1) { const float cb = slope2 * (float)(k0 + 64 * j + 4 * hi - qpos) - mref;
#pragma unroll
                for (int r = 0; r < 16; ++r) { p[2 * j][r] = fmaf(slope2, (float)crowc(r), cb); p[2 * j + 1][r] = fmaf(slope2, (float)(crowc(r) + 32), cb); } }
            else if (KIND == 2) { p[2 * j] = (f32x16){}; p[2 * j + 1] = (f32x16){}; }
#pragma unroll
            for (int d0 = 0; d0 < 4; ++d0) { const f16x8 k0f = *(const LAS f16x8*)(kb + j * 8192 + koff[d0]), k1f = *(const LAS f16x8*)(kb + j * 8192 + koff[d0] + 4096);
                if (KIND == 0 && d0 == 0) { p[2 * j] = __builtin_amdgcn_mfma_f32_32x32x16_f16(k0f, qf[d0], negm, 0, 0, 0); p[2 * j + 1] = __builtin_amdgcn_mfma_f32_32x32x16_f16(k1f, qf[d0], negm, 0, 0, 0); }
                else { p[2 * j] = __builtin_amdgcn_mfma_f32_32x32x16_f16(k0f, qf[d0], p[2 * j], 0, 0, 0); p[2 * j + 1] = __builtin_amdgcn_mfma_f32_32x32x16_f16(k1f, qf[d0], p[2 * j + 1], 0, 0, 0); } }
            if (KIND == 0) {
#pragma unroll
                for (int d0 = 0; d0 < 2; ++d0) { const f16x8 k0f = *(const LAS f16x8*)(kb + OFF_PE + j * 4096 + poff[d0]), k1f = *(const LAS f16x8*)(kb + OFF_PE + j * 4096 + poff[d0] + 2048);
                    p[2 * j] = __builtin_amdgcn_mfma_f32_32x32x16_f16(k0f, qf[4 + d0], p[2 * j], 0, 0, 0); p[2 * j + 1] = __builtin_amdgcn_mfma_f32_32x32x16_f16(k1f, qf[4 + d0], p[2 * j + 1], 0, 0, 0); } }
        }
        if (!act1) { p[2] = (f32x16){}; p[3] = (f32x16){};
#pragma unroll
            for (int r = 0; r < 16; ++r) { p[2][r] = KIND == 2 ? 0.f : -INFINITY; p[3][r] = KIND == 2 ? 0.f : -INFINITY; } }
        u32x4 pw[8];
        if (KIND != 2) {
#pragma unroll
            for (int j = 0; j < 2; ++j) { const bool diag = k0 + 64 * j + 63 > q0w; const int kk = qpos - k0 - 64 * j - 4 * hi;
                if (diag && (j == 0 || act1)) {
#pragma unroll
                    for (int r = 0; r < 16; ++r) { if (crowc(r) > kk) p[2 * j][r] = -INFINITY; if (crowc(r) + 32 > kk) p[2 * j + 1][r] = -INFINITY; } } }
            if (KIND == 1) { const int n = st >> 1; if (n < qt && !((sel >> n) & 1u)) {
#pragma unroll
                for (int r = 0; r < 16; ++r) { p[0][r] = -INFINITY; p[1][r] = -INFINITY; p[2][r] = -INFINITY; p[3][r] = -INFINITY; } } }
            asm volatile("s_nop 15\n\ts_nop 7" : "+v"(p[0]), "+v"(p[1]), "+v"(p[2]), "+v"(p[3]));
            float rm = max3f(p[0][0], p[1][0], p[2][0]), rm2 = max3f(p[3][0], p[0][1], p[1][1]);
#pragma unroll
            for (int r = 1; r < 16; ++r) { rm = max3f(rm, p[0][r], p[1][r]); rm2 = max3f(rm2, p[2][r], p[3][r]); }
            rm = max3f(rm, rm2, p[2][1]); rm = max3f(rm, p[3][1], p[2][0]);
            rm = pswap_max(rm);
            const bool need = (rm > THR) || (!mset && rm > -INFINITY);
            if (__any(need)) {
                const float delta = need ? rm : 0.f, f = mset ? __builtin_amdgcn_exp2f(-delta) : 1.0f;
                mref += delta; mset = mset || need; lsum *= f;
#pragma unroll
                for (int r = 0; r < 16; ++r) { p[0][r] -= delta; p[1][r] -= delta; p[2][r] -= delta; p[3][r] -= delta; negm[r] = -mref; }
                if (hi == 0) wsf[r32] = f;
                asm volatile("s_waitcnt lgkmcnt(0)" ::: "memory");
#pragma unroll
                for (int r = 0; r < 16; ++r) { const float fr = wsf[crowc(r) + 4 * hi]; o0[r] *= fr; o1[r] *= fr; }
            }
            float ls = 0.f, ls2 = 0.f;
#pragma unroll
            for (int r = 0; r < 16; ++r) { p[0][r] = __builtin_amdgcn_exp2f(p[0][r]); p[1][r] = __builtin_amdgcn_exp2f(p[1][r]); p[2][r] = __builtin_amdgcn_exp2f(p[2][r]); p[3][r] = __builtin_amdgcn_exp2f(p[3][r]);
                ls += p[0][r] + p[1][r]; ls2 += p[2][r] + p[3][r]; }
            lsum += ls + ls2;
        } else {
#pragma unroll
            for (int j = 0; j < 2; ++j) { if (j == 1 && !act1) break;
                const bool diag = k0 + 64 * j + 63 > q0w; const int kk = qpos - k0 - 64 * j - 4 * hi;
                const float et = __builtin_amdgcn_exp2f(lg2 * (float)kk);
#pragma unroll
                for (int r = 0; r < 16; ++r) { const float w = et * dc[r]; p[2 * j][r] *= w; p[2 * j + 1][r] *= w * e32; }
                if (diag) {
#pragma unroll
                    for (int r = 0; r < 16; ++r) { if (crowc(r) > kk) p[2 * j][r] = 0.f; if (crowc(r) + 32 > kk) p[2 * j + 1][r] = 0.f; } } }
        }
#pragma unroll
        for (int q4 = 0; q4 < 4; ++q4)
#pragma unroll
            for (int i = 0; i < 4; ++i) { pw[2 * q4][i] = pk_f16(p[q4][2 * i], p[q4][2 * i + 1]); pw[2 * q4 + 1][i] = pk_f16(p[q4][8 + 2 * i], p[q4][8 + 2 * i + 1]); }
        const LAS unsigned char* vb = kb + OFF_V;
#pragma unroll
        for (int ks = 0; ks < 8; ++ks) {
            if (ks == 4 && !act1) break;
            const f16x8 pa = __builtin_bit_cast(f16x8, pw[ks]);
            const f16x8 v0 = vfrag(vb + voff[0] + ks * 2048, vb + voff[0] + ks * 2048 + 1024);
            const f16x8 v1 = vfrag(vb + voff[1] + ks * 2048, vb + voff[1] + ks * 2048 + 1024);
            o0 = __builtin_amdgcn_mfma_f32_32x32x16_f16(pa, v0, o0, 0, 0, 0);
            o1 = __builtin_amdgcn_mfma_f32_32x32x16_f16(pa, v1, o1, 0, 0, 0);
        }
    }
    ATT_WAIT_BAR();
    LAS float* stg = (LAS float*)(lds + OFF_OSTG + wid * OSTG_WAVE);
#pragma unroll
    for (int r = 0; r < 16; ++r) { const int row = crowc(r) + 4 * hi; stg[row * 68 + r32] = o0[r]; stg[row * 68 + 32 + r32] = o1[r]; }
    LAS float* lrow = (LAS float*)(lds + OFF_L) + wid * 32;
    if (KIND != 2) { const float lt = pswap_sum(lsum); if (hi == 0) lrow[r32] = lt; }
    asm volatile("s_waitcnt lgkmcnt(0)" ::: "memory");
    {
        const int row = lane >> 1, half = lane & 1; float v[32];
#pragma unroll
        for (int i = 0; i < 8; ++i) { const f32x4 x = *(const LAS f32x4*)(stg + row * 68 + half * 32 + i * 4); v[4 * i] = x[0]; v[4 * i + 1] = x[1]; v[4 * i + 2] = x[2]; v[4 * i + 3] = x[3]; }
        const size_t grow = brow + q0w + row;
        if (KIND != 2) {
            const float inv = 1.0f / lrow[row]; float ss = 0.f;
#pragma unroll
            for (int i = 0; i < 32; ++i) { v[i] *= inv; ss += v[i] * v[i]; }
            ss += swz_xor<1>(ss);
            if (half == 0) ssq_o[grow * 16 + (KIND == 0 ? 0 : 6) + hh] = ss;
        } else {
            float s1 = 0.f;
#pragma unroll
            for (int i = 0; i < 32; ++i) s1 += v[i];
            s1 += swz_xor<1>(s1); const float mu = s1 * (1.f / 64.f); float s2 = 0.f;
#pragma unroll
            for (int i = 0; i < 32; ++i) { v[i] -= mu; s2 += v[i] * v[i]; }
            s2 += swz_xor<1>(s2); const float rs = 1.0f / sqrtf(s2 * (1.f / 64.f) + RMS_EPS);
            const f16* gp = hbuf + grow * HW + HC_RG + hh * 64 + half * 32;
#pragma unroll
            for (int c = 0; c < 4; ++c) { const f16x8 gv = *(const f16x8*)(gp + c * 8);
#pragma unroll
                for (int e = 0; e < 8; ++e) v[c * 8 + e] = silu_f((float)gv[e]) * (v[c * 8 + e] * rs); }
        }
        f16* op = obuf + grow * OW + (KIND == 0 ? 0 : (KIND == 1 ? OC_MOBA : OC_RET)) + hh * 64 + half * 32;
        if (KIND != 0 && hh == 4) {
#pragma unroll
            for (int c = 0; c < 4; ++c) *(u32x4*)(op + 64 + c * 8) = (u32x4){0u, 0u, 0u, 0u}; }
#pragma unroll
        for (int c = 0; c < 4; ++c) { u32x4 w; w.x = pk_f16(v[c * 8], v[c * 8 + 1]); w.y = pk_f16(v[c * 8 + 2], v[c * 8 + 3]); w.z = pk_f16(v[c * 8 + 4], v[c * 8 + 5]); w.w = pk_f16(v[c * 8 + 6], v[c * 8 + 7]); *(u32x4*)(op + c * 8) = w; }
    }
#undef ATT_DMA
#undef ATT_GLDS
}
__device__ __forceinline__ void attn_phase(LAS unsigned char* lds, unsigned* qctr, const f16* qbuf, const f16* kvbuf, const f16* hbuf, const float* kmean, f16* obuf, float* ssq_o) {
    volatile LAS int* qw = (volatile LAS int*)(lds + OFF_QW);
    for (;;) {
        asm volatile("s_waitcnt vmcnt(0) lgkmcnt(0)\n\ts_barrier" ::: "memory");
        if (threadIdx.x == 0) qw[0] = (int)__hip_atomic_fetch_add(qctr, 1u, __ATOMIC_RELAXED, __HIP_MEMORY_SCOPE_AGENT);
        asm volatile("s_waitcnt vmcnt(0) lgkmcnt(0)\n\ts_barrier" ::: "memory");
        const int idx = __builtin_amdgcn_readfirstlane(qw[0]);
        if (idx >= 2048) break;
        const int qt = 7 - (idx >> 8), j = idx & 255;
        if (j < 96) attn_unit<0>(lds, j / 6, j % 6, qt, qbuf, kvbuf, hbuf, kmean, obuf, ssq_o);
        else if (j < 176) attn_unit<1>(lds, (j - 96) / 5, (j - 96) % 5, qt, qbuf, kvbuf, hbuf, kmean, obuf, ssq_o);
        else attn_unit<2>(lds, (j - 176) / 5, (j - 176) % 5, qt, qbuf, kvbuf, hbuf, kmean, obuf, ssq_o);
    }
}
#undef ATT_WAIT_BAR
}

constexpr int NWAVES = 8;
constexpr int PH_L0 = 1, PPL0 = 8, PH_L1 = PH_L0 + PPL0, PPL1 = 9, NPHASE = PH_L1 + PPL1;
typedef const __attribute__((address_space(4))) Args* KArgs;
__device__ __forceinline__ KArgs kargs() { KArgs p = (KArgs)__builtin_amdgcn_kernarg_segment_ptr(); asm volatile("" : "+s"(p)); return p; }
__device__ __forceinline__ Frame mkframe() {
    extern __shared__ __attribute__((aligned(16))) unsigned char lds_raw[];
    Frame F; F.lds = (LAS unsigned char*)lds_raw; int t = threadIdx.x; asm volatile("" : "+v"(t)); F.tid = t; F.lane = t & 63; F.wave = __builtin_amdgcn_readfirstlane(t >> 6); F.bid = blockIdx.x; F.G = gridDim.x; return F;
}
#define WSP(T_, off) ((T_*)(ws + (off)))

__device__ __forceinline__ void ph_prologue() {
    const Frame F = mkframe(); KArgs a = kargs(); unsigned char* ws = a->ws;
    const int gw = F.bid * NWAVES + F.wave, NGW = F.G * NWAVES;
    f16* Win = WSP(f16, WS_WIN); f16* Wuq = WSP(f16, WS_WUQ); f16* Wo = WSP(f16, WS_WO); unsigned char* Wgu = WSP(unsigned char, WS_WGU); unsigned char* Wdn = WSP(unsigned char, WS_WDN);
    unsigned char* Egu = WSP(unsigned char, WS_EGU); unsigned char* Edn = WSP(unsigned char, WS_EDN); f16* xb = WSP(f16, WS_XB);
    float* cosA = WSP(float, WS_ROPE); float* sinA = cosA + SEQ * 16; float* cosB = sinA + SEQ * 16; float* sinB = cosB + SEQ * 32;
    LAS float* scr = (LAS float*)(F.lds + F.wave * 16384);
    constexpr int I_WIN = (D / 64) * (HW / 32), I_UQ = (256 / 64) * (768 / 32), I_UKV = (128 / 64) * (768 / 32), I_WO = (OW / 64) * (D / 32);
    constexpr int I_GU = (D / 64) * (2 * FF / 32), I_DN = (FF / 64) * (D / 32), I_EGU = (D / 64) * (2 * FE / 32), I_EDN = (FE / 64) * (D / 32);
    constexpr int N_SMALL = 2 * (I_WIN + I_UQ + I_UKV + I_WO) + I_GU + I_DN, N_ALL = N_SMALL + NE * (I_EGU + I_EDN);
    for (int it = gw; it < N_ALL; it += NGW) {
        int r = it;
        if (r < 2 * I_WIN) { const int l = r / I_WIN; r %= I_WIN; transpose_item(a->w_in + (size_t)l * D * HC_END, nullptr, D, HC_END, Win + (size_t)l * HW * D, CM_WIN, nullptr, nullptr, scr, r, HW / 32, F.lane); continue; } r -= 2 * I_WIN;
        if (r < 2 * I_UQ) { const int l = r / I_UQ; r %= I_UQ; transpose_item(a->w_uq + (size_t)l * 256 * 576, nullptr, 256, 576, Wuq + (size_t)l * 1536 * 256, CM_UQ, a->q_norm_g + l * 256, nullptr, scr, r, 768 / 32, F.lane); continue; } r -= 2 * I_UQ;
        if (r < 2 * I_UKV) { const int l = r / I_UKV; r %= I_UKV; transpose_item(a->w_ukv + (size_t)l * 128 * 768, nullptr, 128, 768, Wuq + (size_t)l * 1536 * 256 + (size_t)768 * 256, CM_UKV, a->kv_norm_g + l * 128, nullptr, scr, r, 768 / 32, F.lane, 256); continue; } r -= 2 * I_UKV;
        if (r < 2 * I_WO) { const int l = r / I_WO; r %= I_WO; transpose_item(a->w_o + (size_t)l * D * D, nullptr, D, D, Wo + (size_t)l * D * OW, CM_WO, a->beta_mla + l * 384, a->beta_moba + l * 320, scr, r, D / 32, F.lane, OW); continue; } r -= 2 * I_WO;
        if (r < I_GU) { transpose_item8(a->ffn_w_gate, a->ffn_w_up, D, FF, Wgu, CM_GU, scr, r, 2 * FF / 32, F.lane); continue; } r -= I_GU;
        if (r < I_DN) { transpose_item8(a->ffn_w_down, nullptr, FF, D, Wdn, CM_ID, scr, r, D / 32, F.lane); continue; } r -= I_DN;
        { const int e = r / (I_EGU + I_EDN); r %= (I_EGU + I_EDN);
          if (r < I_EGU) transpose_item8(a->exp_w_gate + (size_t)e * D * FE, a->exp_w_up + (size_t)e * D * FE, D, FE, Egu + (size_t)e * 2 * FE * D, CM_GU, scr, r, 2 * FE / 32, F.lane);
          else transpose_item8(a->exp_w_down + (size_t)e * FE * D, nullptr, FE, D, Edn + (size_t)e * D * FE, CM_ID, scr, r - I_EGU, D / 32, F.lane); }
    }
    for (int i = F.bid * 512 + F.tid; i < 2 * 768 * 16; i += F.G * 512) { const int l = i / (768 * 16), r = (i / 16) % 768, c = i % 16; *(u32x4*)(Wuq + (size_t)l * 1536 * 256 + (size_t)(768 + r) * 256 + 128 + c * 8) = (u32x4){0u, 0u, 0u, 0u}; }
    for (int i = F.bid * 512 + F.tid; i < SEQ * 48; i += F.G * 512) {
        if (i < SEQ * 16) { const int pos = i >> 4, j = i & 15; const float inv = powf(10000.0f, -(float)(2 * j) / 32.0f); const float ang = (float)pos * inv; cosA[i] = cosf(ang); sinA[i] = sinf(ang); }
        else { const int k = i - SEQ * 16, pos = k >> 5, j = k & 31; const float inv = powf(10000.0f, -(float)(2 * j) / 64.0f); const float ang = (float)pos * inv; cosB[k] = cosf(ang); sinB[k] = sinf(ang); }
    }
    const float* xin = a->x; const float* gp = a->ln_emb_g; const float* bp = a->ln_emb_b;
    for (int m = gw; m < T; m += NGW) {
        const f32x4* xr = (const f32x4*)(xin + (size_t)m * D) + F.lane; f32x4 v[4];
#pragma unroll
        for (int j = 0; j < 4; ++j) v[j] = xr[64 * j];
        float mean, rstd; ln_stats(v, mean, rstd);
        u32x2* o8 = (u32x2*)(xb + (size_t)m * D) + F.lane;
#pragma unroll
        for (int j = 0; j < 4; ++j) { const f32x4 g = *((const f32x4*)gp + F.lane + 64 * j), bb = *((const f32x4*)bp + F.lane + 64 * j); const f32x4 y = (v[j] - mean) * rstd * g + bb;
            u32x2 w; w.x = pk_f16(y[0], y[1]); w.y = pk_f16(y[2], y[3]); o8[64 * j] = w; }
    }
}
__device__ __forceinline__ void ph_A(int l) {
    const Frame F = mkframe(); KArgs a = kargs(); unsigned char* ws = a->ws;
    pg8::Gemm g{WSP(f16, WS_XB), D, WSP(f16, WS_WIN) + (size_t)l * HW * D, D, D, 0, 0}; pg8::StaticOrder S; S.init(T / 256, HW / 256, F.G, F.bid);
    const float* cosA = WSP(float, WS_ROPE);
    pg8::EpiWin E{WSP(f16, WS_H), WSP(float, WS_SSQ_Q), WSP(float, WS_SSQ_KV), WSP(float, WS_KMEAN), cosA, cosA + SEQ * 16, cosA + SEQ * 32, cosA + SEQ * 64};
    pg8::gemm_phase<pg8::EpiWin, pg8::StaticOrder, true>(F.lds, g, S, E);
}
__device__ __forceinline__ void ph_B(int l) {
    const Frame F = mkframe(); KArgs a = kargs(); unsigned char* ws = a->ws;
    pg8::Gemm g{WSP(f16, WS_H), HW, WSP(f16, WS_WUQ) + (size_t)l * 1536 * 256, 256, 256, 0, 0}; pg8::UpOrder S; S.so.init(T / 256, 6, F.G, F.bid);
    const float* cosA = WSP(float, WS_ROPE);
    pg8::EpiUp E{(f16*)a->out, (f16*)((unsigned char*)a->out + 48 * MiB), WSP(float, WS_SSQ_Q), WSP(float, WS_SSQ_KV), cosA, cosA + SEQ * 16};
    pg8::gemm_phase<pg8::EpiUp, pg8::UpOrder, true>(F.lds, g, S, E);
}
constexpr int CW_ATTQ = 8192;
__device__ __forceinline__ void ph_C(int l) {
    const Frame F = mkframe(); KArgs a = kargs(); unsigned char* ws = a->ws;
    att::attn_phase(F.lds, WSP(unsigned, WS_CTL) + CW_ATTQ + 64 * l, (const f16*)a->out, (const f16*)((unsigned char*)a->out + 48 * MiB), WSP(f16, WS_H), WSP(float, WS_KMEAN), WSP(f16, WS_O), WSP(float, WS_SSQ_O));
#if defined(PROBE_ATT)
    att::attn_phase(F.lds, WSP(unsigned, WS_CTL) + CW_ATTQ + 64 * (2 + l), (const f16*)a->out, (const f16*)((unsigned char*)a->out + 48 * MiB), WSP(f16, WS_H), WSP(float, WS_KMEAN), WSP(f16, WS_O), WSP(float, WS_SSQ_O));
#endif
}
__device__ __forceinline__ void ph_C2() {
    const Frame F = mkframe(); KArgs a = kargs(); unsigned char* ws = a->ws;
    const int gw = F.bid * NWAVES + F.wave, NGW = F.G * NWAVES;
    const float* ssq_o = WSP(float, WS_SSQ_O); f16* obuf = WSP(f16, WS_O);
    for (int m = gw; m < T; m += NGW) {
        const int lane = F.lane; const float* sp = ssq_o + (size_t)m * 16;
        const f32x4 s0 = *(const f32x4*)sp, s1 = *(const f32x4*)(sp + 4), s2 = *(const f32x4*)(sp + 8);
        const float sa = 1.0f / sqrtf(((s0[0] + s0[1]) + (s0[2] + s0[3]) + (s1[0] + s1[1])) * (1.f / 384.f) + RMS_EPS);
        const float sc = 1.0f / sqrtf(((s1[2] + s1[3]) + (s2[0] + s2[1]) + s2[2]) * (1.f / 320.f) + RMS_EPS);
        f16* orow = obuf + (size_t)m * D;
        if (lane < 48) { f16x8 v = *(const f16x8*)(orow + 8 * lane);
#pragma unroll
            for (int e = 0; e < 8; ++e) v[e] = (f16)((float)v[e] * sa);
            *(f16x8*)(orow + 8 * lane) = v; }
        if (lane >= 24) { f16x8 v = *(const f16x8*)(orow + 512 + 8 * lane);
#pragma unroll
            for (int e = 0; e < 8; ++e) v[e] = (f16)((float)v[e] * sc);
            *(f16x8*)(orow + 512 + 8 * lane) = v; }
    }
}
__device__ __forceinline__ void ph_D(int l) {
    const Frame F = mkframe(); KArgs a = kargs(); unsigned char* ws = a->ws;
    pg8::Gemm g{WSP(f16, WS_O), OW, WSP(f16, WS_WO) + (size_t)l * D * OW, OW, OW, 0, 0}; pg8::StaticOrder S; S.init(T / 256, D / 256, F.G, F.bid);
    pg8::EpiResMix E; E.X = WSP(f16, WS_XB); E.Y = (f16*)a->out; E.ldc = D; E.alpha = DN_ALPHA; E.ascale = 1.0f; E.ssq_o = WSP(float, WS_SSQ_O);
    pg8::gemm_phase<pg8::EpiResMix, pg8::StaticOrder, true>(F.lds, g, S, E);
}
__device__ __forceinline__ void ph_D2(int l) {
    const Frame F = mkframe(); KArgs a = kargs(); unsigned char* ws = a->ws;
    const f16* ybuf = (const f16*)a->out; f16* xb = WSP(f16, WS_XB); unsigned char* xq = WSP(unsigned char, WS_XQ); int* topi = WSP(int, WS_TOPI); float* topw = WSP(float, WS_TOPW); int* cnt = WSP(int, WS_CNT);
    const float* gp = a->ln1_g + l * D; const float* bp = a->ln1_b + l * D; const float* router = a->router;
    LAS int* lcnt = (LAS int*)(F.lds);
    for (int vw = F.bid; vw < 256; vw += F.G) {
        if (l == 1) { __syncthreads(); if (F.tid < 8) lcnt[F.tid] = 0; __syncthreads(); }
        for (int rr = F.wave; rr < 128; rr += NWAVES) {
            const int m = vw * 128 + rr; const int lane = F.lane;
            float v[16]; ln_load_y16(ybuf + (size_t)m * D, lane, v);
            float mean, rstd; ln_stats16(v, mean, rstd);
            ln_affine16(v, mean, rstd, gp, bp, lane);
            ln_store_xb16(xb + (size_t)m * D, lane, v);
#pragma unroll
            for (int h = 0; h < 2; ++h) { u32x2 w; w.x = pk_fp8x4(v[8 * h] * F8_XS, v[8 * h + 1] * F8_XS, v[8 * h + 2] * F8_XS, v[8 * h + 3] * F8_XS); w.y = pk_fp8x4(v[8 * h + 4] * F8_XS, v[8 * h + 5] * F8_XS, v[8 * h + 6] * F8_XS, v[8 * h + 7] * F8_XS);
                *(u32x2*)(xq + (size_t)m * D + 512 * h + 8 * lane) = w; }
            if (l == 1) {
                float lg[8];
#pragma unroll
                for (int e = 0; e < 8; ++e) lg[e] = 0.f;
#pragma unroll
                for (int i = 0; i < 16; ++i) { const int c = 512 * (i >> 3) + 8 * lane + (i & 7); const f32x4 r0 = *(const f32x4*)(router + (size_t)c * 8), r1 = *(const f32x4*)(router + (size_t)c * 8 + 4); const float xv = v[i];
                    lg[0] += xv * r0[0]; lg[1] += xv * r0[1]; lg[2] += xv * r0[2]; lg[3] += xv * r0[3]; lg[4] += xv * r1[0]; lg[5] += xv * r1[1]; lg[6] += xv * r1[2]; lg[7] += xv * r1[3]; }
#pragma unroll
                for (int e = 0; e < 8; ++e) lg[e] = wave_sum(lg[e]);
                if (lane == 0) {
                    int i0 = 0; float v0 = lg[0];
#pragma unroll
                    for (int e = 1; e < 8; ++e) if (lg[e] > v0) { v0 = lg[e]; i0 = e; }
                    int i1 = -1; float v1 = -INFINITY;
#pragma unroll
                    for (int e = 0; e < 8; ++e) if (e != i0 && lg[e] > v1) { v1 = lg[e]; i1 = e; }
                    const float e1 = __expf(v1 - v0), w0 = 1.0f / (1.0f + e1), w1 = e1 * w0;
                    topi[(size_t)m * 2] = i0; topi[(size_t)m * 2 + 1] = i1; topw[(size_t)m * 2] = w0; topw[(size_t)m * 2 + 1] = w1;
                    __hip_atomic_fetch_add(&lcnt[i0], 1, __ATOMIC_RELAXED, __HIP_MEMORY_SCOPE_WORKGROUP); __hip_atomic_fetch_add(&lcnt[i1], 1, __ATOMIC_RELAXED, __HIP_MEMORY_SCOPE_WORKGROUP);
                }
            }
        }
        if (l == 1) { __syncthreads(); if (F.tid < 8) cnt[vw * 8 + F.tid] = lcnt[F.tid]; }
    }
}
__device__ __forceinline__ void ph_E() {
    const Frame F = mkframe(); KArgs a = kargs(); unsigned char* ws = a->ws;
    pg8::Gemm g{WSP(unsigned char, WS_XQ), D, WSP(unsigned char, WS_WGU), D, D, F8_XE, F8_WE}; pg8::StaticOrder S; S.init(T / 256, 2 * FF / 256, F.G, F.bid);
    pg8::EpiSwiGLU E{WSP(unsigned char, WS_H), WSP(unsigned char, WS_H), 1 << 30, FF, 1.0f / (F8_XS * F8_WS)};
    pg8::gemm_phase<pg8::EpiSwiGLU, pg8::StaticOrder, true, true>(F.lds, g, S, E);
}
__device__ __forceinline__ void ph_F() {
    const Frame F = mkframe(); KArgs a = kargs(); unsigned char* ws = a->ws;
    pg8::Gemm g{WSP(unsigned char, WS_H), FF, WSP(unsigned char, WS_WDN), FF, FF, F8_HE, F8_WE}; pg8::StaticOrder S; S.init(T / 256, D / 256, F.G, F.bid);
    pg8::EpiResF32 E{WSP(f16, WS_XB), (f16*)a->out, D, DN_ALPHA, 1.0f / (F8_HS * F8_WS)};
    pg8::gemm_phase<pg8::EpiResF32, pg8::StaticOrder, true, true>(F.lds, g, S, E);
}
__device__ __forceinline__ void ph_F2d() {
    const Frame F = mkframe(); KArgs a = kargs(); unsigned char* ws = a->ws;
    const int gw = F.bid * NWAVES + F.wave, NGW = F.G * NWAVES;
    const f16* ybuf = (const f16*)a->out; f16* xb = WSP(f16, WS_XB); const float* gp = a->ln2_g; const float* bp = a->ln2_b;
    for (int m = gw; m < T; m += NGW) {
        float v[16]; ln_load_y16(ybuf + (size_t)m * D, F.lane, v);
        float mean, rstd; ln_stats16(v, mean, rstd);
        ln_affine16(v, mean, rstd, gp, bp, F.lane);
        ln_store_xb16(xb + (size_t)m * D, F.lane, v);
    }
}
__device__ __forceinline__ void ph_R3() {
    const Frame F = mkframe(); KArgs a = kargs(); unsigned char* ws = a->ws;
    const int* topi = WSP(int, WS_TOPI); const float* topw = WSP(float, WS_TOPW); const int* cnt = WSP(int, WS_CNT); int* rowtok = WSP(int, WS_ROWTOK); float* roww = WSP(float, WS_ROWW); int* pane = WSP(int, WS_PANE);
    LAS int* L = (LAS int*)F.lds;
    for (int vw = F.bid; vw < 256; vw += F.G) {
        __syncthreads();
        if (F.tid < 64) L[F.tid] = 0;
        __syncthreads();
        { const int e = F.tid & 7; int tot = 0, mine = 0;
#pragma unroll
          for (int k = 0; k < 4; ++k) { const int w = (F.tid >> 3) + 64 * k; const int c = cnt[w * 8 + e]; tot += c; if (w < vw) mine += c; }
          __hip_atomic_fetch_add(&L[e], tot, __ATOMIC_RELAXED, __HIP_MEMORY_SCOPE_WORKGROUP); __hip_atomic_fetch_add(&L[16 + e], mine, __ATOMIC_RELAXED, __HIP_MEMORY_SCOPE_WORKGROUP); }
        __syncthreads();
        if (F.tid == 0) { int b = 0; for (int e = 0; e < 8; ++e) { L[8 + e] = b; b += (L[e] + 255) & ~255; } L[24] = b; }
        int myexp = -1, myrank = 0; const int tok = vw * 128 + (F.tid >> 1), slot = F.tid & 1;
        if (F.tid < 256) myexp = topi[(size_t)tok * 2 + slot];
        if (F.tid < 256) {
#pragma unroll
            for (int e = 0; e < 8; ++e) { const unsigned long long mk = __ballot(myexp == e); const int below = __builtin_popcountll(mk & ((1ull << F.lane) - 1ull));
                if (myexp == e) myrank = below; if (F.lane == 0) L[32 + F.wave * 8 + e] = __builtin_popcountll(mk); }
        }
        __syncthreads();
        if (F.tid < 256) { int p = L[8 + myexp] + L[16 + myexp] + myrank; for (int w = 0; w < F.wave; ++w) p += L[32 + w * 8 + myexp];
            rowtok[p] = tok * 2 + slot; roww[p] = topw[(size_t)tok * 2 + slot]; }
        if (vw == 0) {
            for (int e = 0; e < 8; ++e) { const int s0 = L[8 + e] + L[e], s1 = L[8 + e] + ((L[e] + 255) & ~255);
                for (int p = s0 + F.tid; p < s1; p += 512) { rowtok[p] = -1; roww[p] = 0.f; }
                for (int p = (L[8 + e] >> 8) + F.tid; p < (s1 >> 8); p += 512) pane[p] = e; }
            if (F.tid == 0) pane[MOE_MAXP] = L[24] >> 8;
        }
    }
}
__device__ __forceinline__ void ph_M1() {
    const Frame F = mkframe(); KArgs a = kargs(); unsigned char* ws = a->ws;
    const int* pane = WSP(int, WS_PANE); const int np = pane[MOE_MAXP];
    pg8::Gemm g{WSP(unsigned char, WS_XQ), D, WSP(unsigned char, WS_EGU), D, D, F8_XE, F8_WE}; pg8::MoeGather S; S.so.init(np, 2 * FE / 256, F.G, F.bid); S.rowtok = WSP(int, WS_ROWTOK); S.pane = pane; S.estride = (size_t)2 * FE * D;
    pg8::EpiSwiGLU E{(unsigned char*)a->out, WSP(unsigned char, WS_H), MOE_SPLIT, FE, 1.0f / (F8_XS * F8_WS)};
    pg8::gemm_phase<pg8::EpiSwiGLU, pg8::MoeGather, true, true>(F.lds, g, S, E);
}
__device__ __forceinline__ void ph_M2() {
    const Frame F = mkframe(); KArgs a = kargs(); unsigned char* ws = a->ws;
    const int* pane = WSP(int, WS_PANE); const int np = pane[MOE_MAXP];
    pg8::Gemm g{(const unsigned char*)a->out, FE, WSP(unsigned char, WS_EDN), FE, FE, F8_HE, F8_WE}; pg8::MoeDense S; S.so.init(np, D / 256, F.G, F.bid); S.pane = pane; S.estride = (size_t)D * FE; S.A2 = (const char*)WSP(unsigned char, WS_H); S.split = MOE_SPLIT;
    pg8::EpiScatter E{WSP(f16, WS_C), (size_t)T * D, WSP(int, WS_ROWTOK), WSP(float, WS_ROWW), 1.0f / (F8_HS * F8_WS)};
    pg8::gemm_phase<pg8::EpiScatter, pg8::MoeDense, true, true>(F.lds, g, S, E);
}
__device__ __forceinline__ void ph_F2m() {
    const Frame F = mkframe(); KArgs a = kargs(); unsigned char* ws = a->ws;
    const int gw = F.bid * NWAVES + F.wave, NGW = F.G * NWAVES;
    const f16* xb = WSP(f16, WS_XB); const f16* c0buf = WSP(f16, WS_C); const f16* c1buf = c0buf + (size_t)T * D; float* out = a->out; const float* gp = a->ln2_g + D; const float* bp = a->ln2_b + D;
    for (int m = gw; m < T; m += NGW) {
        const int lane = F.lane; f32x4 v[4];
        const f16x4* xr = (const f16x4*)(xb + (size_t)m * D) + lane; const f16x4* c0r = (const f16x4*)(c0buf + (size_t)m * D) + lane; const f16x4* c1r = (const f16x4*)(c1buf + (size_t)m * D) + lane;
#pragma unroll
        for (int j = 0; j < 4; ++j) { const f16x4 xv = xr[64 * j], p0 = c0r[64 * j], p1 = c1r[64 * j];
#pragma unroll
            for (int e = 0; e < 4; ++e) v[j][e] = DN_ALPHA * (float)xv[e] + ((float)p0[e] + (float)p1[e]); }
        float mean, rstd; ln_stats(v, mean, rstd);
        f32x4* orow = (f32x4*)(out + (size_t)m * D) + lane;
#pragma unroll
        for (int j = 0; j < 4; ++j) { const f32x4 g = *((const f32x4*)gp + lane + 64 * j), bb = *((const f32x4*)bp + lane + 64 * j); orow[64 * j] = (v[j] - mean) * rstd * g + bb; }
    }
}

#ifndef SITE_MASK
#define SITE_MASK 0xFFFFFFFFu
#endif
#define SITE(n) (((SITE_MASK) >> (n)) & 1u)
__global__ void __launch_bounds__(NWAVES * 64, 2) mega_fwd(Args args_unused) {
    extern __shared__ __attribute__((aligned(16))) unsigned char lds_raw[];
    volatile LAS unsigned* MISC = (volatile LAS unsigned*)((LAS unsigned char*)lds_raw + MISC_OFF);
    if (threadIdx.x < 64) MISC[threadIdx.x] = 0u;
    __syncthreads();
#if MK_ONE_LAUNCH
    (void)xcd_barrier_post((unsigned*)(kargs()->ws + WS_CTL) + CW_BAR, MISC + 8);
#define GRID_BAR() do { XcdBarrier bar_; bar_.bar = (unsigned*)(kargs()->ws + WS_CTL) + CW_BAR; bar_.x = xb_xcc_id(); bar_.st = (volatile LAS unsigned*)((LAS unsigned char*)lds_raw + MISC_OFF) + 8; xcd_barrier(bar_); } while (0)
#else
#define GRID_BAR() do {} while (0)
#endif
    const int lo = kargs()->ph_lo, hi = kargs()->ph_hi;
#define IN(k) (lo <= (k) && (k) < hi)
#define SEAM(k) do { if (IN(k) && IN((k) + 1)) GRID_BAR(); } while (0)
    if (SITE(0) && IN(0)) ph_prologue();
#if defined(PROBE_PRO)
    if (SITE(0) && IN(0)) { __syncthreads(); ph_prologue(); }
#endif
    SEAM(0);
#pragma unroll
    for (int l = 0; l < 2; ++l) {
        const int pb = l == 0 ? PH_L0 : PH_L1;
        if (SITE(1) && IN(pb + 0)) ph_A(l);
        SEAM(pb + 0);
        if (SITE(3) && IN(pb + 1)) ph_B(l);
        SEAM(pb + 1);
        if (SITE(5) && IN(pb + 2)) ph_C(l);
        SEAM(pb + 2);
        if (SITE(7) && IN(pb + 3)) ph_D(l);
        SEAM(pb + 3);
        if (SITE(8) && IN(pb + 4)) ph_D2(l);
        SEAM(pb + 4);
        if (l == 0) {
            if (SITE(9) && IN(pb + 5)) ph_E();
            SEAM(pb + 5);
            if (SITE(10) && IN(pb + 6)) ph_F();
            SEAM(pb + 6);
            if (SITE(11) && IN(pb + 7)) ph_F2d();
            SEAM(pb + 7);
        } else {
            if (SITE(12) && IN(pb + 5)) ph_R3();
            SEAM(pb + 5);
            if (SITE(13) && IN(pb + 6)) ph_M1();
            SEAM(pb + 6);
            if (SITE(14) && IN(pb + 7)) ph_M2();
            SEAM(pb + 7);
            if (SITE(15) && IN(pb + 8)) ph_F2m();
        }
    }
#undef IN
#undef SEAM
}

extern "C" void kernel_launch(void* const* d_in, const int* in_sizes, int n_in, void* d_out, int out_size, void* d_ws, size_t ws_size, hipStream_t stream) {
    static int grid = 0;
    if (grid == 0) {
        if (n_in != 22 || in_sizes[0] != T * D || out_size != T * D || ws_size < (size_t)468 * MiB) { fprintf(stderr, "kernel_launch: unexpected shapes / workspace (n_in %d, ws %zu)\n", n_in, ws_size); grid = -1; return; }
        int dev = 0, cus = 0;
        if (hipGetDevice(&dev) != hipSuccess || hipDeviceGetAttribute(&cus, hipDeviceAttributeMultiprocessorCount, dev) != hipSuccess) { grid = -1; return; }
        if (hipFuncSetAttribute((const void*)mega_fwd, hipFuncAttributeMaxDynamicSharedMemorySize, LDS_BYTES) != hipSuccess) { fprintf(stderr, "kernel_launch: hipFuncSetAttribute failed\n"); grid = -1; return; }
        int per_cu = 0;
        if (hipOccupancyMaxActiveBlocksPerMultiprocessor(&per_cu, (const void*)mega_fwd, NWAVES * 64, LDS_BYTES) != hipSuccess || per_cu < 1) { fprintf(stderr, "kernel_launch: occupancy query says %d\n", per_cu); }
        (void)hipGetLastError();
        grid = cus > 256 ? 256 : cus;
    }
    if (grid < 0) return;
    (void)hipMemsetAsync((char*)d_ws + WS_CTL, 0, CTL_ZERO_BYTES, stream);
    Args a{};
    a.x = (const float*)d_in[0]; a.ln_emb_g = (const float*)d_in[1]; a.ln_emb_b = (const float*)d_in[2]; a.w_in = (const float*)d_in[3]; a.q_norm_g = (const float*)d_in[4]; a.kv_norm_g = (const float*)d_in[5];
    a.w_uq = (const float*)d_in[6]; a.w_ukv = (const float*)d_in[7]; a.beta_mla = (const float*)d_in[8]; a.beta_moba = (const float*)d_in[9]; a.w_o = (const float*)d_in[10]; a.ln1_g = (const float*)d_in[11]; a.ln1_b = (const float*)d_in[12];
    a.ffn_w_gate = (const float*)d_in[13]; a.ffn_w_up = (const float*)d_in[14]; a.ffn_w_down = (const float*)d_in[15]; a.router = (const float*)d_in[16]; a.exp_w_gate = (const float*)d_in[17]; a.exp_w_up = (const float*)d_in[18];
    a.exp_w_down = (const float*)d_in[19]; a.ln2_g = (const float*)d_in[20]; a.ln2_b = (const float*)d_in[21];
    a.out = (float*)d_out; a.ws = (unsigned char*)d_ws;
#if MK_ONE_LAUNCH
    a.ph_lo = 0; a.ph_hi = NPHASE;
    hipLaunchKernelGGL(mega_fwd, dim3(grid), dim3(NWAVES * 64), LDS_BYTES, stream, a);
#else
    for (int p = 0; p < NPHASE; ++p) { a.ph_lo = p; a.ph_hi = p + 1; hipLaunchKernelGGL(mega_fwd, dim3(grid), dim3(NWAVES * 64), LDS_BYTES, stream, a); }
#endif
}
```
